# Optimizing an MI355X kernel written in HIP

```python
import math
import jax, jax.numpy as jnp
from jax import lax
import numpy as np

D_MODEL = 1024
BATCH = 4
SEQ = 8192
DEPTH = 1

PLE_DIM = 256
EPS = 1e-6

LRU_WIDTH = 1024
LRU_BLOCKS = 8
LRU_BLOCK = LRU_WIDTH // LRU_BLOCKS
LRU_CONV = 4
LRU_C = 8.0

N_HEADS = 8
HEAD_DIM = 128
N_KV_HEADS = 2
GROUP = N_HEADS // N_KV_HEADS
ATTN_WIDTH = N_HEADS * HEAD_DIM
KV_WIDTH = N_KV_HEADS * HEAD_DIM
IDX_HEADS = 8
IDX_DIM = 64
TOPK_MAX = 256
Q_BLOCK = 128

N_BUCKETS = 32
MAX_DISTANCE = 128

D_FF = 3072
FFN_CONV = 3

IN_SPLITS = (LRU_WIDTH, LRU_WIDTH, ATTN_WIDTH, KV_WIDTH, KV_WIDTH,
             IDX_HEADS * IDX_DIM, IDX_DIM, IDX_HEADS, D_MODEL, D_MODEL)
IN_WIDTH = sum(IN_SPLITS)

kernel_name = 'hybrid_rglru_dsa_convglu_block'


def _rmsnorm(x, g):
    x32 = x.astype(jnp.float32)
    y = x32 * lax.rsqrt(jnp.mean(x32 * x32, axis=-1, keepdims=True) + EPS)
    return (y * g.astype(jnp.float32)).astype(x.dtype)


def _split_cols(h):
    parts = []
    start = 0
    for n in IN_SPLITS:
        parts.append(h[..., start:start + n])
        start += n
    return parts


def _causal_dwconv(x, w, b):
    width = w.shape[0]
    s = x.shape[1]
    xp = jnp.pad(x, ((0, 0), (width - 1, 0), (0, 0)))
    y = b
    for j in range(width):
        y = y + xp[:, j:j + s] * w[j]
    return y


def _rg_lru(x, wa, ba, wx, bx, lam):
    b, s, _ = x.shape
    xb = x.reshape(b, s, LRU_BLOCKS, LRU_BLOCK)
    r = jax.nn.sigmoid(jnp.einsum('bsnc,ncd->bsnd', xb, wa).reshape(b, s, LRU_WIDTH) + ba)
    i = jax.nn.sigmoid(jnp.einsum('bsnc,ncd->bsnd', xb, wx).reshape(b, s, LRU_WIDTH) + bx)
    log_a = -LRU_C * r.astype(jnp.float32) * jax.nn.softplus(-lam.astype(jnp.float32))
    a = jnp.exp(log_a)
    mult = jnp.sqrt(-jnp.expm1(2.0 * log_a))
    u = mult * (i * x).astype(jnp.float32)

    def combine(left, right):
        a1, b1 = left
        a2, b2 = right
        return a1 * a2, a2 * b1 + b2

    _, h = lax.associative_scan(combine, (a, u), axis=1)
    return h.astype(x.dtype)


def _t5_bucket(dist):
    max_exact = N_BUCKETS // 2
    d_f = jnp.maximum(dist, 1).astype(jnp.float32)
    large = max_exact + (jnp.log(d_f / max_exact) / math.log(MAX_DISTANCE / max_exact)
                         * (N_BUCKETS - max_exact)).astype(jnp.int32)
    large = jnp.minimum(large, N_BUCKETS - 1)
    return jnp.where(dist < max_exact, dist, large)


def _dsa_attention(q, k, v, qi, ki, wi, rel_bias):
    b, s = q.shape[0], q.shape[1]
    n_blk = s // Q_BLOCK
    top_k = min(TOPK_MAX, s // 4)
    key_pos = jnp.arange(s, dtype=jnp.int32)
    q_pos = key_pos.reshape(n_blk, Q_BLOCK)
    ki32 = ki.astype(jnp.float32)

    def blockify(a):
        return jnp.moveaxis(a.reshape((b, n_blk, Q_BLOCK) + a.shape[2:]), 1, 0)

    def one_block(args):
        qb, qib, wib, tpos = args
        dots = jnp.einsum('bthd,bsd->bths', qib.astype(jnp.float32), ki32) * (IDX_DIM ** -0.5)
        score = jnp.einsum('bth,bths->bts', wib.astype(jnp.float32), jax.nn.relu(dots))
        causal = key_pos[None, :] <= tpos[:, None]
        score = jnp.where(causal[None], score, -jnp.inf)
        _, sel = lax.top_k(score, top_k)
        k_sel = jax.vmap(lambda kb, ib: kb[ib])(k, sel)
        v_sel = jax.vmap(lambda vb, ib: vb[ib])(v, sel)
        qg = qb.reshape(b, Q_BLOCK, N_KV_HEADS, GROUP, HEAD_DIM)
        logits = jnp.einsum('btngd,btknd->btngk', qg, k_sel).astype(jnp.float32) * (HEAD_DIM ** -0.5)
        dist = tpos[None, :, None] - sel
        bias = rel_bias[_t5_bucket(jnp.maximum(dist, 0))]
        bias = bias.reshape(b, Q_BLOCK, top_k, N_KV_HEADS, GROUP).transpose(0, 1, 3, 4, 2)
        logits = logits + bias.astype(jnp.float32)
        logits = jnp.where((dist >= 0)[:, :, None, None, :], logits, -jnp.inf)
        probs = jax.nn.softmax(logits, axis=-1).astype(v.dtype)
        o = jnp.einsum('btngk,btknd->btngd', probs, v_sel)
        return o.reshape(b, Q_BLOCK, N_HEADS, HEAD_DIM)

    out = lax.map(one_block, (blockify(q), blockify(qi), blockify(wi), q_pos))
    return jnp.moveaxis(out, 0, 1).reshape(b, s, ATTN_WIDTH)


def setup_inputs(seed: int = 0) -> dict:
    key = jax.random.key(seed)
    ks = jax.random.split(key, 32)
    f32 = jnp.float32

    def nrm(k, shape, fan_in):
        return jax.random.normal(k, shape, f32) * (fan_in ** -0.5)

    def gain(k, shape):
        return 1.0 + 0.05 * jax.random.normal(k, shape, f32)

    def small(k, shape):
        return 0.01 * jax.random.normal(k, shape, f32)

    u = jax.random.uniform(ks[10], (DEPTH, LRU_WIDTH), f32, 0.9, 0.999)
    sa = u ** (1.0 / LRU_C)
    lru_lambda = jnp.log(sa) - jnp.log1p(-sa)

    return {
        'x': jax.random.normal(ks[0], (BATCH, SEQ, D_MODEL), f32),
        'p': jax.random.normal(ks[1], (DEPTH, BATCH, SEQ, PLE_DIM), f32),
        'mix_norm': gain(ks[2], (DEPTH, D_MODEL)),
        'w_in': nrm(ks[3], (DEPTH, D_MODEL, IN_WIDTH), D_MODEL),
        'lru_conv_w': nrm(ks[4], (DEPTH, LRU_CONV, LRU_WIDTH), LRU_CONV),
        'lru_conv_b': small(ks[5], (DEPTH, LRU_WIDTH)),
        'lru_wa': nrm(ks[6], (DEPTH, LRU_BLOCKS, LRU_BLOCK, LRU_BLOCK), LRU_BLOCK),
        'lru_ba': small(ks[7], (DEPTH, LRU_WIDTH)),
        'lru_wx': nrm(ks[8], (DEPTH, LRU_BLOCKS, LRU_BLOCK, LRU_BLOCK), LRU_BLOCK),
        'lru_bx': small(ks[9], (DEPTH, LRU_WIDTH)),
        'lru_lambda': lru_lambda,
        'q_norm': gain(ks[11], (DEPTH, HEAD_DIM)),
        'k_norm': gain(ks[12], (DEPTH, HEAD_DIM)),
        'rel_bias': 0.5 * jax.random.normal(ks[13], (N_BUCKETS, N_HEADS), f32),
        'w_lru_br': nrm(ks[14], (DEPTH, LRU_WIDTH, D_MODEL), LRU_WIDTH),
        'w_attn_br': nrm(ks[15], (DEPTH, ATTN_WIDTH, D_MODEL), ATTN_WIDTH),
        'w_out': nrm(ks[16], (DEPTH, D_MODEL, D_MODEL), D_MODEL),
        'ffn_norm': gain(ks[17], (DEPTH, D_MODEL)),
        'w_up': nrm(ks[18], (DEPTH, D_MODEL, 2 * D_FF), D_MODEL),
        'ffn_conv_w': nrm(ks[19], (DEPTH, FFN_CONV, D_FF), FFN_CONV),
        'ffn_conv_b': small(ks[20], (DEPTH, D_FF)),
        'w_down': nrm(ks[21], (DEPTH, D_FF, D_MODEL), D_FF),
        'ple_norm': gain(ks[22], (DEPTH, D_MODEL)),
        'w_ple_gate': nrm(ks[23], (DEPTH, D_MODEL, D_MODEL), D_MODEL),
        'w_ple_proj': nrm(ks[24], (DEPTH, PLE_DIM, D_MODEL), PLE_DIM),
    }


def reference(x, p, mix_norm, w_in, lru_conv_w, lru_conv_b, lru_wa, lru_ba, lru_wx, lru_bx,
              lru_lambda, q_norm, k_norm, rel_bias, w_lru_br, w_attn_br, w_out, ffn_norm,
              w_up, ffn_conv_w, ffn_conv_b, w_down, ple_norm, w_ple_gate, w_ple_proj):
    b, s, _ = x.shape
    for l in range(DEPTH):
        xn = _rmsnorm(x, mix_norm[l])
        h = xn @ w_in[l]
        lru_x, lru_gate, q, k, v, qi, ki, wi, gate_a, gate_b = _split_cols(h)

        ua = _causal_dwconv(lru_x, lru_conv_w[l], lru_conv_b[l])
        ya = _rg_lru(ua, lru_wa[l], lru_ba[l], lru_wx[l], lru_bx[l], lru_lambda[l])
        ya = (ya * jax.nn.gelu(lru_gate)) @ w_lru_br[l]

        qh = _rmsnorm(q.reshape(b, s, N_HEADS, HEAD_DIM), q_norm[l])
        kh = _rmsnorm(k.reshape(b, s, N_KV_HEADS, HEAD_DIM), k_norm[l])
        vh = v.reshape(b, s, N_KV_HEADS, HEAD_DIM)
        qih = qi.reshape(b, s, IDX_HEADS, IDX_DIM)
        wih = wi * (IDX_HEADS ** -0.5)
        yb = _dsa_attention(qh, kh, vh, qih, ki, wih, rel_bias) @ w_attn_br[l]

        merged = jax.nn.sigmoid(gate_a) * ya + jax.nn.sigmoid(gate_b) * yb
        x = x + merged @ w_out[l]

        xn = _rmsnorm(x, ffn_norm[l])
        up = xn @ w_up[l]
        g_ffn = _causal_dwconv(up[..., :D_FF], ffn_conv_w[l], ffn_conv_b[l])
        x = x + (jax.nn.gelu(g_ffn) * up[..., D_FF:]) @ w_down[l]

        g_ple = jax.nn.sigmoid(_rmsnorm(x, ple_norm[l]) @ w_ple_gate[l])
        x = x + g_ple * (p[l] @ w_ple_proj[l])
    return x
```

```cpp
#include <hip/hip_runtime.h>
#include <cstdio>
#include <cstdint>

#define GAS __attribute__((address_space(1)))
#define LAS __attribute__((address_space(3)))
typedef _Float16 h16;
typedef _Float16 h8 __attribute__((ext_vector_type(8)));
typedef _Float16 h4 __attribute__((ext_vector_type(4)));
typedef _Float16 h2 __attribute__((ext_vector_type(2)));
typedef __fp16 fh4 __attribute__((__vector_size__(4 * sizeof(__fp16))));
typedef float f32x4 __attribute__((ext_vector_type(4)));
typedef float f32x2 __attribute__((ext_vector_type(2)));
typedef unsigned u32x4 __attribute__((ext_vector_type(4)));
typedef unsigned u32x2 __attribute__((ext_vector_type(2)));
typedef unsigned long long u64;

__device__ __forceinline__ unsigned pkh(float a, float b) { h2 r; r.x = (h16)a; r.y = (h16)b; return __builtin_bit_cast(unsigned, r); }
__device__ __forceinline__ float sigmoid_f(float x) { return __builtin_amdgcn_rcpf(1.0f + __builtin_amdgcn_exp2f(-1.4426950408889634f * x)); }
__device__ __forceinline__ float gelu_tanh(float x) { const float u = 1.5957691216057308f * (x + 0.044715f * x * x * x); return x * sigmoid_f(u); }
#define LDS_WAIT() asm volatile("s_waitcnt lgkmcnt(0)" ::: "memory")
#define VM_WAIT() asm volatile("s_waitcnt vmcnt(0)" ::: "memory")

namespace pg8 {
constexpr int BM = 256, BK = 64, HALF = 128, HTB = HALF * BK * 2, STAGE_BYTES = 8 * HTB, NXCD = 8, WGM = 8;
__host__ __device__ __forceinline__ int lds_byte(int r, int c) { const int st = (r >> 4) * 2 + (c >> 5), rr = r & 15, cc = c & 31, ob = rr * 64 + cc * 2; return st * 1024 + (ob ^ (((ob >> 9) & 1) << 5)); }
__host__ __device__ __forceinline__ void stage_rc(int b, int& R, int& C) { const int st = b / 1024, sb = b % 1024, swz = sb ^ (((sb >> 9) & 1) << 5); R = (st >> 1) * 16 + swz / 64; C = (st & 1) * 32 + (swz % 64) / 2; }
__host__ __device__ __forceinline__ int perm32(int rho) { const int n = rho >> 4, i = rho & 15; return 8 * (i >> 2) + 4 * n + (i & 3); }

struct Unit { int pm, pn; };
struct Gemm { const h16* A; const h16* Bt; int M, N, K; };

struct StaticOrder {
    int nM, nN, nwg, G, c;
    __host__ __device__ void init(int M, int N, int G_, int c_) { nM = M / BM; nN = N / BM; nwg = nM * nN; G = G_; c = c_; }
    __host__ __device__ bool next(int i, Unit& u) const {
        const long L = (long)i * G + c; if (L >= nwg) return false;
        int wgid = (int)L; { const int q = nwg / NXCD, r = nwg % NXCD, xcd = wgid % NXCD, off = wgid / NXCD; wgid = (xcd < r ? xcd * (q + 1) : r * (q + 1) + (xcd - r) * q) + off; }
        const int nig = WGM * nN, gid = wgid / nig, fm = gid * WGM, gsz = (nM - fm) < WGM ? (nM - fm) : WGM;
        u.pm = fm + ((wgid % nig) % gsz); u.pn = (wgid % nig) / gsz; return true;
    }
};

template <class Epi, bool ALIGN_EPI = true, bool SP2 = true>
__device__ __forceinline__ void gemm_phase(LAS unsigned char* lds, const Gemm g, const StaticOrder& S, const Epi& E) {
    const int tid = threadIdx.x, wid = __builtin_amdgcn_readfirstlane(tid >> 6), lane = tid & 63, wr = wid >> 2, wc = wid & 3, fr = lane & 15, fq = lane >> 4;
    const int K = g.K, nt = K / BK;
    unsigned voffA[2], voffB[2];
#pragma unroll
    for (int i = 0; i < 2; ++i) { int R, C; stage_rc(tid * 16 + i * 8192, R, C); const int Rb = Epi::PERM ? ((R & ~31) + perm32(R & 31)) : R;
        voffA[i] = (unsigned)(R * K + C) * 2u; voffB[i] = (unsigned)(Rb * K + C) * 2u; }
    const size_t kstep = (size_t)(BK * 2);
    const size_t hstep = (size_t)HALF * K * 2;
    const size_t tstep = 2 * hstep;
    const unsigned ldsw = (unsigned)wid * 1024u;
    const int aoff = lds_byte(wr * 64 + fr, fq * 8), boff = lds_byte(wc * 32 + fr, fq * 8);
#define PG8_SA(b, h) (((b) * 2 + (h)) * HTB)
#define PG8_SB(b, h) ((4 + (b) * 2 + (h)) * HTB)
#define PG8_STAGE(bufoff, gbase, voff) do { _Pragma("unroll") for (int _i = 0; _i < 2; ++_i) \
        __builtin_amdgcn_global_load_lds((const unsigned*)((const char*)(gbase) + (voff)[_i]), (LAS unsigned*)(lds + (bufoff) + ldsw + _i * 8192), 16, 0, 0); } while (0)
#define PG8_LDA(dst, b, h) do { _Pragma("unroll") for (int m = 0; m < 4; ++m) _Pragma("unroll") for (int k = 0; k < 2; ++k) dst[m][k] = *(const LAS h8*)(lds + PG8_SA(b, h) + aoff + m * 2048 + k * 1024); } while (0)
#define PG8_LDB(dst, b, h) do { _Pragma("unroll") for (int n = 0; n < 2; ++n) _Pragma("unroll") for (int k = 0; k < 2; ++k) dst[n][k] = *(const LAS h8*)(lds + PG8_SB(b, h) + boff + n * 2048 + k * 1024); } while (0)
#define PG8_MMA(ai, bj, At, Bt) do { __builtin_amdgcn_s_setprio(1); _Pragma("unroll") for (int m = 0; m < 4; ++m) _Pragma("unroll") for (int n = 0; n < 2; ++n) _Pragma("unroll") for (int k = 0; k < 2; ++k) \
        acc[ai][bj][m][n] = __builtin_amdgcn_mfma_f32_16x16x32_f16(Bt[n][k], At[m][k], acc[ai][bj][m][n], 0, 0, 0); __builtin_amdgcn_s_setprio(0); } while (0)
#define PG8_WAIT_V(n) asm volatile("s_waitcnt vmcnt(" #n ")" ::: "memory")
#define PG8_WAIT_L(n) asm volatile("s_waitcnt lgkmcnt(" #n ")" ::: "memory")
#define PG8_BAR __builtin_amdgcn_s_barrier()
#define PG8_SCHED __builtin_amdgcn_sched_barrier(0)
    Unit cur, nxt; int ui = 0;
    if (!S.next(0, cur)) return;
    f32x4 acc[2][2][4][2];
#pragma unroll
    for (int a = 0; a < 2; ++a)
#pragma unroll
        for (int b = 0; b < 2; ++b)
#pragma unroll
            for (int m = 0; m < 4; ++m)
#pragma unroll
                for (int n = 0; n < 2; ++n) acc[a][b][m][n] = (f32x4){0.f, 0.f, 0.f, 0.f};
    h8 At[4][2], B0[2][2], B1[2][2];
    const char* cA = (const char*)g.A + (size_t)cur.pm * tstep; const char* cB = (const char*)g.Bt + (size_t)cur.pn * tstep;
    if constexpr (SP2) {
        PG8_STAGE(PG8_SB(0, 0), cB, voffB); PG8_STAGE(PG8_SB(0, 1), cB + hstep, voffB); PG8_STAGE(PG8_SA(0, 0), cA, voffA); PG8_STAGE(PG8_SA(0, 1), cA + hstep, voffA);
        if (wr == 1) PG8_BAR;
        PG8_WAIT_V(2); PG8_BAR;
        PG8_STAGE(PG8_SB(1, 0), cB + kstep, voffB); PG8_STAGE(PG8_SA(1, 0), cA + kstep, voffA); PG8_STAGE(PG8_SB(1, 1), cB + hstep + kstep, voffB);
        PG8_WAIT_V(6); PG8_BAR;
    } else {
        PG8_STAGE(PG8_SB(0, 0), cB, voffB); PG8_STAGE(PG8_SA(0, 0), cA, voffA); PG8_STAGE(PG8_SB(0, 1), cB + hstep, voffB); PG8_STAGE(PG8_SA(0, 1), cA + hstep, voffA);
        if (wr == 1) PG8_BAR;
        PG8_WAIT_V(4); PG8_BAR;
        PG8_STAGE(PG8_SB(1, 0), cB + kstep, voffB); PG8_STAGE(PG8_SA(1, 0), cA + kstep, voffA); PG8_STAGE(PG8_SB(1, 1), cB + hstep + kstep, voffB);
        PG8_WAIT_V(6); PG8_BAR;
    }
    for (;;) {
        const bool has_next = S.next(ui + 1, nxt);
        const char* nA = has_next ? (const char*)g.A + (size_t)nxt.pm * tstep : cA; const char* nB = has_next ? (const char*)g.Bt + (size_t)nxt.pn * tstep : cB;
        for (int t = 0; t < nt; t += 2) {
            const bool last = (t == nt - 2);
            const char* a1 = cA + (size_t)(t + 1) * kstep;
            const char* a2 = last ? nA : cA + (size_t)(t + 2) * kstep; const char* b2 = last ? nB : cB + (size_t)(t + 2) * kstep;
            const char* a3 = a2 + kstep; const char* b3 = b2 + kstep;
            if constexpr (SP2) {
            PG8_LDB(B0, 0, 0); PG8_LDB(B1, 0, 1); PG8_SCHED; PG8_LDA(At, 0, 0); PG8_STAGE(PG8_SA(1, 1), a1 + hstep, voffA);
            PG8_WAIT_V(8); PG8_WAIT_L(0); PG8_BAR; PG8_MMA(0, 0, At, B0); PG8_MMA(0, 1, At, B1); PG8_BAR; PG8_SCHED;
            PG8_LDA(At, 0, 1); PG8_STAGE(PG8_SB(0, 0), b2, voffB); PG8_STAGE(PG8_SB(0, 1), b2 + hstep, voffB); PG8_STAGE(PG8_SA(0, 0), a2, voffA);
            PG8_WAIT_V(8); PG8_WAIT_L(0); PG8_BAR; PG8_MMA(1, 0, At, B0); PG8_MMA(1, 1, At, B1); PG8_BAR; PG8_SCHED;
            PG8_LDB(B0, 1, 0); PG8_LDB(B1, 1, 1); PG8_SCHED; PG8_LDA(At, 1, 0); PG8_STAGE(PG8_SA(0, 1), a2 + hstep, voffA);
            PG8_WAIT_V(8); PG8_WAIT_L(0); PG8_BAR; PG8_MMA(0, 0, At, B0); PG8_MMA(0, 1, At, B1); PG8_BAR; PG8_SCHED;
            PG8_LDA(At, 1, 1); PG8_STAGE(PG8_SB(1, 0), b3, voffB); PG8_STAGE(PG8_SB(1, 1), b3 + hstep, voffB); PG8_STAGE(PG8_SA(1, 0), a3, voffA);
            PG8_WAIT_V(8); PG8_WAIT_L(0); PG8_BAR; PG8_MMA(1, 0, At, B0); PG8_MMA(1, 1, At, B1); PG8_BAR; PG8_SCHED;
            } else {
            PG8_LDB(B0, 0, 0); PG8_SCHED; PG8_LDA(At, 0, 0); PG8_STAGE(PG8_SA(1, 1), a1 + hstep, voffA);
            PG8_WAIT_L(8); PG8_BAR; PG8_WAIT_L(0); PG8_MMA(0, 0, At, B0); PG8_BAR; PG8_SCHED;
            PG8_LDB(B1, 0, 1); PG8_STAGE(PG8_SB(0, 0), b2, voffB);
            PG8_BAR; PG8_WAIT_L(0); PG8_MMA(0, 1, At, B1); PG8_BAR;
            PG8_LDA(At, 0, 1); PG8_STAGE(PG8_SA(0, 0), a2, voffA);
            PG8_BAR; PG8_WAIT_L(0); PG8_MMA(1, 0, At, B0); PG8_BAR; PG8_SCHED;
            PG8_STAGE(PG8_SB(0, 1), b2 + hstep, voffB);
            PG8_WAIT_V(6); PG8_BAR; PG8_MMA(1, 1, At, B1); PG8_BAR;
            PG8_LDB(B0, 1, 0); PG8_SCHED; PG8_LDA(At, 1, 0); PG8_STAGE(PG8_SA(0, 1), a2 + hstep, voffA);
            PG8_WAIT_L(8); PG8_BAR; PG8_WAIT_L(0); PG8_MMA(0, 0, At, B0); PG8_BAR; PG8_SCHED;
            PG8_LDB(B1, 1, 1); PG8_STAGE(PG8_SB(1, 0), b3, voffB);
            PG8_BAR; PG8_WAIT_L(0); PG8_MMA(0, 1, At, B1); PG8_BAR;
            PG8_LDA(At, 1, 1); PG8_STAGE(PG8_SA(1, 0), a3, voffA);
            PG8_BAR; PG8_WAIT_L(0); PG8_MMA(1, 0, At, B0); PG8_BAR; PG8_SCHED;
            PG8_STAGE(PG8_SB(1, 1), b3 + hstep, voffB);
            PG8_WAIT_V(6); PG8_BAR; PG8_MMA(1, 1, At, B1); PG8_BAR;
            }
        }
        if constexpr (ALIGN_EPI) { if (wr == 0) PG8_BAR; }
        E(acc, cur, wr, wc, fr, fq);
        if (!has_next) break;
#pragma unroll
        for (int a = 0; a < 2; ++a)
#pragma unroll
            for (int b = 0; b < 2; ++b)
#pragma unroll
                for (int m = 0; m < 4; ++m)
#pragma unroll
                    for (int n = 0; n < 2; ++n) acc[a][b][m][n] = (f32x4){0.f, 0.f, 0.f, 0.f};
        cur = nxt; cA = nA; cB = nB; ++ui;
        if constexpr (ALIGN_EPI) { if (wr == 1) PG8_BAR; }
    }
    PG8_WAIT_V(0);
    if constexpr (!ALIGN_EPI) { if (wr == 0) PG8_BAR; }
    PG8_BAR;
#undef PG8_SA
#undef PG8_SB
#undef PG8_STAGE
#undef PG8_LDA
#undef PG8_LDB
#undef PG8_MMA
#undef PG8_WAIT_V
#undef PG8_WAIT_L
#undef PG8_BAR
#undef PG8_SCHED
}
}

constexpr int NB = 4, SEQ = 8192, MTOK = NB * SEQ, DM = 1024, DFF = 3072, PLE = 256;
constexpr int NIN = 6216, NIN_PAD = 6400;
constexpr float EPS = 1e-6f;
constexpr int NWAVES = 8, NTHR = 512;

typedef const f32x4 (&AccRef)[2][2][4][2];

template <int ACT> __device__ __forceinline__ float act_f(float v) {
    if (ACT == 1) return gelu_tanh(v);
    if (ACT == 2) return sigmoid_f(v);
    if (ACT == 3) return v * 0.125f;
    return v;
}
template <int ACT> __device__ __forceinline__ void store_tile_h(AccRef acc, h16* base, int ldc, int row0, int col0) {
    const unsigned bo0 = ((unsigned)row0 * (unsigned)ldc + (unsigned)col0) * 2u;
#pragma unroll
    for (int ai = 0; ai < 2; ++ai)
#pragma unroll
        for (int m = 0; m < 4; ++m) { const unsigned bo = bo0 + (unsigned)((ai * 128 + m * 16) * ldc * 2);
#pragma unroll
            for (int bj = 0; bj < 2; ++bj) { const f32x4 v0 = acc[ai][bj][m][0], v1 = acc[ai][bj][m][1];
                u32x4 w; w.x = pkh(act_f<ACT>(v0[0]), act_f<ACT>(v0[1])); w.y = pkh(act_f<ACT>(v0[2]), act_f<ACT>(v0[3]));
                w.z = pkh(act_f<ACT>(v1[0]), act_f<ACT>(v1[1])); w.w = pkh(act_f<ACT>(v1[2]), act_f<ACT>(v1[3]));
                *(u32x4*)((char*)base + bo + bj * 256) = w; }
            if (ACT == 1 || ACT == 2) __builtin_amdgcn_sched_barrier(0); }
}

struct EpiIn {
    static constexpr bool PERM = true;
    h16 *LX, *GG, *Q, *K, *V, *QI, *KI, *SGA, *SGB; float* WI;
    __device__ __forceinline__ void operator()(AccRef acc, const pg8::Unit& u, int wr, int wc, int fr, int fq) const {
        const int pn = u.pn, row0 = u.pm * 256 + wr * 64 + fr, cw = wc * 32 + 8 * fq;
        if (pn < 4 || (pn >= 8 && pn < 14)) {
            h16* base = pn < 4 ? LX : (pn < 12 ? Q : (pn == 12 ? K : V)); const int ldc = pn < 12 ? DM : 256; const int ct = pn < 4 ? pn * 256 : (pn < 12 ? (pn - 8) * 256 : 0);
            if (pn < 12) store_tile_h<0>(acc, base, DM, row0, ct + cw); else store_tile_h<0>(acc, base, 256, row0, cw);
            (void)ldc;
        }
        else if (pn < 8) store_tile_h<1>(acc, GG, DM, row0, (pn - 4) * 256 + cw);
        else if (pn < 16) store_tile_h<3>(acc, QI, 512, row0, (pn - 14) * 256 + cw);
        else if (pn == 16) {
            if (wc < 2) {
#pragma unroll
                for (int ai = 0; ai < 2; ++ai)
#pragma unroll
                    for (int m = 0; m < 4; ++m) { const f32x4 v0 = acc[ai][0][m][0], v1 = acc[ai][0][m][1];
                        u32x4 w; w.x = pkh(v0[0], v0[1]); w.y = pkh(v0[2], v0[3]); w.z = pkh(v1[0], v1[1]); w.w = pkh(v1[2], v1[3]);
                        *(u32x4*)(KI + (size_t)(row0 + ai * 128 + m * 16) * 64 + cw) = w; }
            } else if (wc == 2 && fq == 0) {
#pragma unroll
                for (int ai = 0; ai < 2; ++ai)
#pragma unroll
                    for (int m = 0; m < 4; ++m) { float* p = WI + (size_t)(row0 + ai * 128 + m * 16) * 8;
                        *(f32x4*)p = acc[ai][0][m][0] * 0.35355339059327373f; *(f32x4*)(p + 4) = acc[ai][0][m][1] * 0.35355339059327373f; }
            }
        }
        else { h16* base = pn < 21 ? SGA : SGB; const int ct = pn < 21 ? (pn - 17) * 256 : (pn - 21) * 256; store_tile_h<2>(acc, base, DM, row0, ct + cw); }
    }
};

template <int SECOND> struct EpiMerge {
    static constexpr bool PERM = true;
    const h16* SG; h16* T1; h16* OUT;
    __device__ __forceinline__ void operator()(AccRef acc, const pg8::Unit& u, int wr, int wc, int fr, int fq) const {
        const int row0 = u.pm * 256 + wr * 64 + fr, col0 = u.pn * 256 + wc * 32 + 8 * fq;
#pragma unroll
        for (int ai = 0; ai < 2; ++ai)
#pragma unroll
            for (int m = 0; m < 4; ++m) { const size_t off = (size_t)(row0 + ai * 128 + m * 16) * DM + col0;
#pragma unroll
                for (int bj = 0; bj < 2; ++bj) { const f32x4 v0 = acc[ai][bj][m][0], v1 = acc[ai][bj][m][1];
                    const h8 sg = *(const h8*)(SG + off + bj * 128);
                    float r[8];
#pragma unroll
                    for (int j = 0; j < 4; ++j) { r[j] = (float)sg[j] * v0[j]; r[4 + j] = (float)sg[4 + j] * v1[j]; }
                    if (SECOND) { const h8 t1 = *(const h8*)(T1 + off + bj * 128);
#pragma unroll
                        for (int j = 0; j < 8; ++j) r[j] += (float)t1[j]; }
                    u32x4 w; w.x = pkh(r[0], r[1]); w.y = pkh(r[2], r[3]); w.z = pkh(r[4], r[5]); w.w = pkh(r[6], r[7]);
                    *(u32x4*)((SECOND ? OUT : T1) + off + bj * 128) = w; }
                asm volatile("" ::: "memory"); }
    }
};

template <bool BASE_F32> struct EpiResid {
    static constexpr bool PERM = true;
    const float* BF; const h16* BH; h16* XOUT; float* SSQ;
    __device__ __forceinline__ void operator()(AccRef acc, const pg8::Unit& u, int wr, int wc, int fr, int fq) const {
        const int row0 = u.pm * 256 + wr * 64 + fr, col0 = u.pn * 256 + wc * 32 + 8 * fq;
#pragma unroll
        for (int ai = 0; ai < 2; ++ai)
#pragma unroll
            for (int m = 0; m < 4; ++m) { const int row = row0 + ai * 128 + m * 16; const size_t off = (size_t)row * DM + col0; float ss = 0.f;
#pragma unroll
                for (int bj = 0; bj < 2; ++bj) { const f32x4 v0 = acc[ai][bj][m][0], v1 = acc[ai][bj][m][1];
                    float r[8];
                    if (BASE_F32) { const f32x4 b0 = *(const f32x4*)(BF + off + bj * 128), b1 = *(const f32x4*)(BF + off + bj * 128 + 4);
#pragma unroll
                        for (int j = 0; j < 4; ++j) { r[j] = b0[j] + v0[j]; r[4 + j] = b1[j] + v1[j]; } }
                    else { const h8 b = *(const h8*)(BH + off + bj * 128);
#pragma unroll
                        for (int j = 0; j < 4; ++j) { r[j] = (float)b[j] + v0[j]; r[4 + j] = (float)b[4 + j] + v1[j]; } }
#pragma unroll
                    for (int j = 0; j < 8; ++j) ss += r[j] * r[j];
                    u32x4 w; w.x = pkh(r[0], r[1]); w.y = pkh(r[2], r[3]); w.z = pkh(r[4], r[5]); w.w = pkh(r[6], r[7]);
                    *(u32x4*)(XOUT + off + bj * 128) = w; }
                ss += __shfl_xor(ss, 16); ss += __shfl_xor(ss, 32);
                if (fq == 0) unsafeAtomicAdd(SSQ + row, ss);
                asm volatile("" ::: "memory"); }
    }
};

struct EpiUp {
    static constexpr bool PERM = true;
    const float* SSQ; h16* UPG; h16* UPV;
    __device__ __forceinline__ void operator()(AccRef acc, const pg8::Unit& u, int wr, int wc, int fr, int fq) const {
        const int row0 = u.pm * 256 + wr * 64 + fr, col0 = u.pn * 128 + wc * 32 + 8 * fq;
#pragma unroll
        for (int ai = 0; ai < 2; ++ai)
#pragma unroll
            for (int m = 0; m < 4; ++m) { const int row = row0 + ai * 128 + m * 16; const size_t off = (size_t)row * DFF + col0;
                const float r = __builtin_amdgcn_rsqf(SSQ[row] * (1.0f / DM) + EPS);
#pragma unroll
                for (int bj = 0; bj < 2; ++bj) { const f32x4 v0 = acc[ai][bj][m][0] * r, v1 = acc[ai][bj][m][1] * r;
                    u32x4 w; w.x = pkh(v0[0], v0[1]); w.y = pkh(v0[2], v0[3]); w.z = pkh(v1[0], v1[1]); w.w = pkh(v1[2], v1[3]);
                    *(u32x4*)((bj ? UPV : UPG) + off) = w; } }
    }
};

struct EpiF32 {
    static constexpr bool PERM = false;
    float* C;
    __device__ __forceinline__ void operator()(AccRef acc, const pg8::Unit& u, int wr, int wc, int fr, int fq) const {
        const int row0 = u.pm * 256 + wr * 64 + fr, col0 = u.pn * 256 + wc * 32 + 4 * fq;
#pragma unroll
        for (int ai = 0; ai < 2; ++ai)
#pragma unroll
            for (int m = 0; m < 4; ++m) { float* rowp = C + (size_t)(row0 + ai * 128 + m * 16) * DM + col0;
#pragma unroll
                for (int bj = 0; bj < 2; ++bj)
#pragma unroll
                    for (int n = 0; n < 2; ++n) *(f32x4*)(rowp + bj * 128 + n * 16) = acc[ai][bj][m][n]; }
    }
};
struct EpiPle {
    static constexpr bool PERM = false;
    const float* SSQ; const h16* X2; float* C;
    __device__ __forceinline__ void operator()(AccRef acc, const pg8::Unit& u, int wr, int wc, int fr, int fq) const {
        const int row0 = u.pm * 256 + wr * 64 + fr, col0 = u.pn * 256 + wc * 32 + 4 * fq;
        const unsigned e0 = (unsigned)row0 * DM + (unsigned)col0;
#pragma unroll
        for (int ai = 0; ai < 2; ++ai)
#pragma unroll
            for (int m = 0; m < 4; ++m) { const int row = row0 + ai * 128 + m * 16; const unsigned eo = e0 + (unsigned)((ai * 128 + m * 16) * DM);
                const float r = __builtin_amdgcn_rsqf(SSQ[row] * (1.0f / DM) + EPS);
#pragma unroll
                for (int bj = 0; bj < 2; ++bj)
#pragma unroll
                    for (int n = 0; n < 2; ++n) { const unsigned o2 = eo + bj * 128 + n * 16;
                        const f32x4 t = *(const f32x4*)((const char*)C + (size_t)o2 * 4u); const h4 xb = *(const h4*)((const char*)X2 + (size_t)o2 * 2u); const f32x4 a = acc[ai][bj][m][n];
                        f32x4 o;
#pragma unroll
                        for (int j = 0; j < 4; ++j) o[j] = (float)xb[j] + sigmoid_f(a[j] * r) * t[j];
                        *(f32x4*)((char*)C + (size_t)o2 * 4u) = o; }
                asm volatile("" ::: "memory"); __builtin_amdgcn_sched_barrier(0); }
    }
};

#define XB_TMO      128
#define XB_XCNT(j)  (256  + 64 * (j))
#define XB_XSUB(j)  (1280 + 64 * (j))
#define XB_XGEN(j)  (2304 + 64 * (j))
#define XB_TOP      3328
#define XB_TOPGEN   3392
#define XCD_BAR_WORDS 3456
#define XB_SPIN_CAP (1u << 20)

__device__ __forceinline__ unsigned xb_ld(unsigned* p)              { return __hip_atomic_load(p, __ATOMIC_RELAXED, __HIP_MEMORY_SCOPE_AGENT); }
__device__ __forceinline__ unsigned xb_add(unsigned* p, unsigned v) { return __hip_atomic_fetch_add(p, v, __ATOMIC_RELAXED, __HIP_MEMORY_SCOPE_AGENT); }
__device__ __forceinline__ unsigned xb_xcc_id() { return (unsigned)__builtin_amdgcn_s_getreg((3 << 11) | 20) & 0xFu; }
#define XB_SPIN(cond, bar) do { unsigned _sp = 0; while (cond) { __builtin_amdgcn_s_sleep(1); \
    if ((++_sp & 255u) == 0u) { if (xb_ld(&(bar)[XB_TMO])) break; if (_sp > XB_SPIN_CAP) { atomicAdd(&(bar)[XB_TMO], 1u); break; } } } } while (0)

struct XcdBarrier { unsigned* bar; unsigned x; volatile LAS unsigned* st; };

__device__ __forceinline__ XcdBarrier xcd_barrier_post(unsigned* bar, volatile LAS unsigned* st) {
    XcdBarrier b; b.bar = bar; b.x = xb_xcc_id(); b.st = st;
    if (threadIdx.x == 0) (void)xb_add(&bar[XB_XCNT(b.x)], 1u);
    return b;
}
__device__ __forceinline__ void xcd_barrier_complete(unsigned* bar, unsigned x, unsigned& nloc, unsigned& nx) {
    const unsigned G = gridDim.x * gridDim.y * gridDim.z;
    unsigned sum, cnt, mine, sp = 0u;
    for (;;) {
        sum = 0u; cnt = 0u; mine = 0u;
#pragma unroll
        for (unsigned j = 0; j < 16; ++j) { const unsigned c = xb_ld(&bar[XB_XCNT(j)]); sum += c; cnt += (c > 0u) ? 1u : 0u; mine = (j == x) ? c : mine; }
        if (sum == G) break;
        __builtin_amdgcn_s_sleep(1);
        if ((++sp & 255u) == 0u) { if (xb_ld(&bar[XB_TMO])) break; if (sp > XB_SPIN_CAP) { atomicAdd(&bar[XB_TMO], 1u); break; } }
    }
    nloc = mine > 0u ? mine : 1u; nx = cnt > 0u ? cnt : 1u;
}
__device__ __forceinline__ void xcd_barrier(const XcdBarrier& b) {
    asm volatile("s_waitcnt vmcnt(0)" ::: "memory");
    __syncthreads();
    if (threadIdx.x == 0) {
        unsigned* bar = b.bar;
        __builtin_amdgcn_s_waitcnt(0);
        unsigned nloc = b.st[0], nx = b.st[1];
        if (nloc == 0u) { xcd_barrier_complete(bar, b.x, nloc, nx); b.st[0] = nloc; b.st[1] = nx; }
        const unsigned old = xb_add(&bar[XB_XSUB(b.x)], 1u);
        const unsigned gen = old / nloc;
        if (old + 1u == (gen + 1u) * nloc) {
            __builtin_amdgcn_fence(__ATOMIC_RELEASE, "agent");
            asm volatile("s_waitcnt vmcnt(0)" ::: "memory");
            const unsigned og = xb_add(&bar[XB_TOP], 1u);
            const unsigned tg = og / nx;
            if (og + 1u == (tg + 1u) * nx) xb_add(&bar[XB_TOPGEN], 1u);
            else XB_SPIN(xb_ld(&bar[XB_TOPGEN]) == tg, bar);
            __builtin_amdgcn_fence(__ATOMIC_ACQUIRE, "agent");
            xb_add(&bar[XB_XGEN(b.x)], 1u);
            asm volatile("s_waitcnt vmcnt(0)" ::: "memory");
        } else {
            XB_SPIN(xb_ld(&bar[XB_XGEN(b.x)]) == gen, bar);
            __builtin_amdgcn_fence(__ATOMIC_ACQUIRE, "agent");
            asm volatile("s_waitcnt vmcnt(0)" ::: "memory");
        }
    }
    __syncthreads();
}

constexpr size_t MiB = 1u << 20;
constexpr size_t WS_CTL = 0, CTL_ZERO_BYTES = 1 * MiB;
constexpr size_t WS_SA = 1 * MiB, WS_SH = 2 * MiB;
constexpr size_t WS_WI = 3 * MiB;
constexpr size_t WS_KI = 4 * MiB;
constexpr size_t WS_W = 8 * MiB;
constexpr size_t W_IN = WS_W, W_LRU = W_IN + (size_t)NIN_PAD * DM * 2, W_ATT = W_LRU + 2 * MiB, W_OUT = W_ATT + 2 * MiB, W_PG = W_OUT + 2 * MiB,
                 W_UP = W_PG + 2 * MiB, W_DOWN = W_UP + 12 * MiB, W_PP = W_DOWN + 6 * MiB, W_GATE = W_PP + MiB / 2, W_END = W_GATE + MiB / 2;
static_assert(W_END <= 48 * MiB, "weights region");
constexpr size_t WS_A0 = 48 * MiB;
constexpr size_t WS_IDX = 48 * MiB, WS_NV = 64 * MiB;
constexpr size_t WS_T1 = 48 * MiB;
constexpr size_t WS_X1H = 48 * MiB;
constexpr size_t WS_PH = 112 * MiB;
constexpr size_t WS_LX = 128 * MiB;
constexpr size_t WS_GG = 192 * MiB;
constexpr size_t WS_Q = 256 * MiB;
constexpr size_t WS_K = 320 * MiB, WS_V = 336 * MiB;
constexpr size_t WS_QI = 352 * MiB;
constexpr size_t WS_SGA = 384 * MiB, WS_SGB = 448 * MiB;
constexpr size_t WS_UPG = 128 * MiB, WS_UPV = 320 * MiB;
constexpr size_t WS_X2H = 128 * MiB;
constexpr size_t WS_END = 512 * MiB;
constexpr int CW_BAR = 1024;
constexpr int CW_Q2 = 8192, CW_Q3 = 8192 + 64;
constexpr size_t CTL_SSQ1 = 256 * 1024, CTL_SSQ2 = 512 * 1024;
static_assert((CW_BAR + XCD_BAR_WORDS) * 4 <= 32768 && CTL_SSQ2 + MTOK * 4 <= CTL_ZERO_BYTES, "ctl map");

constexpr int LDS_BYTES = 159744;
constexpr int MISC_OFF = LDS_BYTES - 256;

struct Params {
    const float* in[25]; float* out; unsigned char* ws; int ph_lo, ph_hi, k_ple, pad;
};

__device__ __forceinline__ float wave_sum(float v) {
#pragma unroll
    for (int o = 1; o < 64; o <<= 1) v += __shfl_xor(v, o);
    return v;
}
template <int MAP> __device__ __forceinline__ int rowmap(int n) {
    if (MAP == 1) return n < 4168 ? n : n + 184;
    if (MAP == 2) return n < DFF ? ((n >> 7) * 256 + (n & 127)) : (((n - DFF) >> 7) * 256 + 128 + ((n - DFF) & 127));
    return n;
}
template <int MAP> __device__ __forceinline__ void p0_transpose_item(const float* W, int K, int N, h16* WT, const float* gain, LAS float* scr, int item, int lane) {
    const int nblk = (N + 31) / 32, kb = item / nblk, nb = item % nblk, k0 = 64 * kb, n0 = 32 * nb;
    const int nn = n0 + (lane & 31);
#pragma unroll 8
    for (int i = 0; i < 32; ++i) { const int kk = 2 * i + (lane >> 5); float v = 0.f; if (nn < N) v = W[(size_t)(k0 + kk) * N + nn]; if (gain) v *= gain[k0 + kk]; scr[kk * 33 + (lane & 31)] = v; }
    LDS_WAIT(); asm volatile("" ::: "memory");
    const int c = lane & 7;
#pragma unroll
    for (int j = 0; j < 4; ++j) { const int n = (lane >> 3) + 8 * j; const LAS float* s = scr + (8 * c) * 33 + n;
        u32x4 o; o.x = pkh(s[0 * 33], s[1 * 33]); o.y = pkh(s[2 * 33], s[3 * 33]); o.z = pkh(s[4 * 33], s[5 * 33]); o.w = pkh(s[6 * 33], s[7 * 33]);
        if (n0 + n < N) *(u32x4*)(WT + (size_t)rowmap<MAP>(n0 + n) * K + k0 + 8 * c) = o; }
    LDS_WAIT(); asm volatile("" ::: "memory");
}

struct Ctx {
    unsigned char* ws; float* out;
    const float *conv_w, *conv_b, *ba, *bx, *lam, *qn, *kn, *relb, *fcw, *fcb;
};
__device__ __forceinline__ unsigned ordered_u32(float v) { const unsigned u = __builtin_bit_cast(unsigned, v); return u ^ ((unsigned)((int)u >> 31) | 0x80000000u); }

constexpr int UA_STR = 272;
constexpr int LRU_UA = 0, LRU_HL = 128 * UA_STR, LRU_PP = 2 * 128 * UA_STR;
__device__ __forceinline__ void lru1_unit(const Ctx& C, LAS unsigned char* lds, int unit) {
    const int tid = threadIdx.x, lane = tid & 63, wv = tid >> 6;
    const int b = unit >> 9, j = (unit >> 3) & 63, n = unit & 7;
    const h16* LX = (const h16*)(C.ws + WS_LX);
    const size_t mrow0 = (size_t)b * SEQ + (size_t)j * 128;
    {
        const int cg = tid & 15, rg = tid >> 4, ch0 = n * 128 + cg * 8, tl = rg * 4, tseq = j * 128 + tl;
        h8 xr[7];
#pragma unroll
        for (int i = 0; i < 7; ++i) { const int tt = tseq - 3 + i; if (tt >= 0) xr[i] = *(const h8*)(LX + ((size_t)b * SEQ + tt) * DM + ch0); else { for (int e = 0; e < 8; ++e) xr[i][e] = (h16)0.f; } }
        float cb[8]; { const f32x4 t0 = *(const f32x4*)(C.conv_b + ch0), t1 = *(const f32x4*)(C.conv_b + ch0 + 4); for (int e = 0; e < 4; ++e) { cb[e] = t0[e]; cb[4 + e] = t1[e]; } }
        float y[4][8];
#pragma unroll
        for (int r = 0; r < 4; ++r)
#pragma unroll
            for (int e = 0; e < 8; ++e) y[r][e] = cb[e];
#pragma unroll
        for (int jj = 0; jj < 4; ++jj) { const f32x4 w0 = *(const f32x4*)(C.conv_w + jj * DM + ch0), w1 = *(const f32x4*)(C.conv_w + jj * DM + ch0 + 4);
#pragma unroll
            for (int r = 0; r < 4; ++r)
#pragma unroll
                for (int e = 0; e < 4; ++e) { y[r][e] += w0[e] * (float)xr[r + jj][e]; y[r][4 + e] += w1[e] * (float)xr[r + jj][4 + e]; } }
#pragma unroll
        for (int r = 0; r < 4; ++r) { u32x4 w; w.x = pkh(y[r][0], y[r][1]); w.y = pkh(y[r][2], y[r][3]); w.z = pkh(y[r][4], y[r][5]); w.w = pkh(y[r][6], y[r][7]);
            *(LAS u32x4*)(lds + LRU_UA + (tl + r) * UA_STR + cg * 16) = w; }
    }
    __syncthreads();
    {
        const int q = lane & 15, c = lane >> 4, oc = wv * 16 + q, ch = n * 128 + oc;
        const h16* WG = (const h16*)(C.ws + W_GATE) + (size_t)n * 256 * 128;
        h8 Ba[4], Bx[4];
#pragma unroll
        for (int ks = 0; ks < 4; ++ks) { Ba[ks] = *(const h8*)(WG + (size_t)oc * 128 + 32 * ks + 8 * c); Bx[ks] = *(const h8*)(WG + (size_t)(128 + oc) * 128 + 32 * ks + 8 * c); }
        const float bav = C.ba[ch], bxv = C.bx[ch], m8sp = -8.0f * log1pf(expf(-C.lam[ch]));
        float cH = 0.f, cP = 1.f;
        for (int tt = 0; tt < 8; ++tt) {
            f32x4 aa = {0.f, 0.f, 0.f, 0.f}, ax = {0.f, 0.f, 0.f, 0.f};
#pragma unroll
            for (int ks = 0; ks < 4; ++ks) { const h8 A = *(const LAS h8*)(lds + LRU_UA + (16 * tt + q) * UA_STR + (32 * ks + 8 * c) * 2);
                aa = __builtin_amdgcn_mfma_f32_16x16x32_f16(A, Ba[ks], aa, 0, 0, 0); ax = __builtin_amdgcn_mfma_f32_16x16x32_f16(A, Bx[ks], ax, 0, 0, 0); }
            float hl[4], pl[4]; float h = 0.f, p = 1.f;
#pragma unroll
            for (int i = 0; i < 4; ++i) { const int t = 16 * tt + 4 * c + i;
                const float uav = (float)*(const LAS h16*)(lds + LRU_UA + t * UA_STR + oc * 2);
                const float ra = sigmoid_f(aa[i] + bav), ix = sigmoid_f(ax[i] + bxv);
                const float la = m8sp * ra, a = __builtin_amdgcn_exp2f(la * 1.4426950408889634f);
                const float mult = __builtin_sqrtf(fmaxf(1.0f - a * a, 0.f));
                const float u = mult * ix * uav;
                h = a * h + u; p *= a; hl[i] = h; pl[i] = p; }
            float Ak[4], Hk[4];
#pragma unroll
            for (int k = 0; k < 4; ++k) { Ak[k] = __shfl(p, q + 16 * k); Hk[k] = __shfl(h, q + 16 * k); }
            float PA = 1.f, PH = 0.f;
#pragma unroll
            for (int k = 0; k < 3; ++k) if (k < c) { PH = PH * Ak[k] + Hk[k]; PA *= Ak[k]; }
            const float hin = cH * PA + PH, pin = cP * PA;
#pragma unroll
            for (int i = 0; i < 4; ++i) { const int t = 16 * tt + 4 * c + i;
                *(LAS h16*)(lds + LRU_HL + t * UA_STR + oc * 2) = (h16)(hl[i] + pl[i] * hin);
                *(LAS h16*)(lds + LRU_PP + t * UA_STR + oc * 2) = (h16)(pin * pl[i]); }
            const float AT = Ak[0] * Ak[1] * Ak[2] * Ak[3], HT = ((Hk[0] * Ak[1] + Hk[1]) * Ak[2] + Hk[2]) * Ak[3] + Hk[3];
            cH = cH * AT + HT; cP = cP * AT;
        }
        if (c == 0) { const size_t so = ((size_t)b * 64 + j) * DM + ch; ((float*)(C.ws + WS_SA))[so] = cP; ((float*)(C.ws + WS_SH))[so] = cH; }
    }
    __syncthreads();
    {
        const int cg = tid & 15, rg = tid >> 4; h16* HLOC = (h16*)C.out; h16* PPRD = (h16*)C.out + (size_t)MTOK * DM;
#pragma unroll
        for (int r = 0; r < 4; ++r) { const int t = rg * 4 + r; const size_t go = (mrow0 + t) * DM + n * 128 + cg * 8;
            *(u32x4*)(HLOC + go) = *(const LAS u32x4*)(lds + LRU_HL + t * UA_STR + cg * 16);
            *(u32x4*)(PPRD + go) = *(const LAS u32x4*)(lds + LRU_PP + t * UA_STR + cg * 16); }
    }
}

__device__ __forceinline__ void lru2_unit(const Ctx& C, LAS unsigned char* lds, int unit) {
    const int tid = threadIdx.x;
    const int b = unit >> 9, j = (unit >> 3) & 63, n = unit & 7;
    LAS float* carry = (LAS float*)lds;
    if (tid < 128) { const int ch = n * 128 + tid; const float* SA = (const float*)(C.ws + WS_SA) + (size_t)b * 64 * DM + ch; const float* SH = (const float*)(C.ws + WS_SH) + (size_t)b * 64 * DM + ch;
        float cr = 0.f; for (int jj = 0; jj < j; ++jj) cr = SA[(size_t)jj * DM] * cr + SH[(size_t)jj * DM];
        carry[tid] = cr; }
    __syncthreads();
    const int cg = tid & 15, rg = tid >> 4; const h16* HLOC = (const h16*)C.out; const h16* PPRD = (const h16*)C.out + (size_t)MTOK * DM;
    const h16* GG = (const h16*)(C.ws + WS_GG); h16* YA = (h16*)(C.ws + WS_LX);
    float cr[8];
#pragma unroll
    for (int e = 0; e < 8; ++e) cr[e] = carry[cg * 8 + e];
#pragma unroll
    for (int r = 0; r < 4; ++r) { const size_t go = ((size_t)b * SEQ + j * 128 + rg * 4 + r) * DM + n * 128 + cg * 8;
        const h8 hl = *(const h8*)(HLOC + go), pp = *(const h8*)(PPRD + go), gg = *(const h8*)(GG + go);
        float y[8];
#pragma unroll
        for (int e = 0; e < 8; ++e) y[e] = ((float)hl[e] + (float)pp[e] * cr[e]) * (float)gg[e];
        u32x4 w; w.x = pkh(y[0], y[1]); w.y = pkh(y[2], y[3]); w.z = pkh(y[4], y[5]); w.w = pkh(y[6], y[7]);
        *(u32x4*)(YA + go) = w; }
}

__device__ __forceinline__ void knorm_unit(const Ctx& C, int unit) {
    const int tid = threadIdx.x, lane = tid & 63, wv = tid >> 6;
    h16* K = (h16*)(C.ws + WS_K);
    const int col = lane * 4, d0 = col & 127;
    const f32x4 g = *(const f32x4*)(C.kn + d0);
    for (int r = 0; r < 16; ++r) { const size_t row = (size_t)unit * 128 + wv * 16 + r;
        const h4 v = *(const h4*)(K + row * 256 + col);
        float ss = 0.f, f[4];
#pragma unroll
        for (int e = 0; e < 4; ++e) { f[e] = (float)v[e]; ss += f[e] * f[e]; }
#pragma unroll
        for (int o = 1; o < 32; o <<= 1) ss += __shfl_xor(ss, o);
        const float rs = __builtin_amdgcn_rsqf(ss * (1.0f / 128.0f) + EPS);
        u32x2 w; w.x = pkh(f[0] * rs * g[0], f[1] * rs * g[1]); w.y = pkh(f[2] * rs * g[2], f[3] * rs * g[3]);
        *(u32x2*)(K + row * 256 + col) = w; }
}

constexpr int IX_STR = 260;
constexpr int IX_SLAB = 16 * IX_STR * 4;
constexpr int IX_CAP = 768;
constexpr int IX_CAND = 2 * IX_SLAB;
constexpr int IX_HIST = IX_CAND + 16 * IX_CAP * 8;
constexpr int IX_OUT = IX_HIST + 8 * 1024;
constexpr int IX_END = IX_OUT + 8 * 512;
static_assert(IX_END <= MISC_OFF, "indexer LDS");
constexpr int IX_NE = IX_CAP / 64;

__device__ __forceinline__ void radix_pass(LAS unsigned* hist, const u64 (&e)[IX_NE], int cnt, int lane, u64 prefix, int p, int r, int& bin, int& above, int& inbin) {
    *(LAS u32x4*)(hist + lane * 4) = (u32x4){0u, 0u, 0u, 0u};
    LDS_WAIT();
#pragma unroll
    for (int k = 0; k < IX_NE; ++k) { const int idx = k * 64 + lane; if (idx < cnt && (e[k] >> (8 * p + 8)) == prefix) __hip_atomic_fetch_add(hist + ((unsigned)(e[k] >> (8 * p)) & 255u), 1u, __ATOMIC_RELAXED, __HIP_MEMORY_SCOPE_WORKGROUP); }
    LDS_WAIT();
    const u32x4 hv = *(const LAS u32x4*)(hist + lane * 4);
    const int s = (int)(hv.x + hv.y + hv.z + hv.w);
    int S = s;
#pragma unroll
    for (int d = 1; d < 64; d <<= 1) { const int t = __shfl_down(S, d); if (lane + d < 64) S += t; }
    const int Sx = S - s;
    int mybin = 0, myabove = 0, myin = 0; bool found = false;
    { int cum = Sx; const unsigned hh[4] = {hv.x, hv.y, hv.z, hv.w};
#pragma unroll
      for (int k = 3; k >= 0; --k) { if (!found && cum < r && r <= cum + (int)hh[k]) { found = true; mybin = lane * 4 + k; myabove = cum; myin = (int)hh[k]; } cum += (int)hh[k]; } }
    const u64 m = __ballot(found);
    const int src = m ? (int)__builtin_ctzll(m) : 0;
    bin = __builtin_amdgcn_readlane(mybin, src); above = __builtin_amdgcn_readlane(myabove, src); inbin = __builtin_amdgcn_readlane(myin, src);
}

__device__ __forceinline__ void ix_load_entries(const LAS u64* cand, int cnt, int lane, u64 (&e)[IX_NE]) {
#pragma unroll
    for (int k = 0; k < IX_NE; ++k) { const int idx = k * 64 + lane; e[k] = idx < cnt ? cand[idx] : 0ull; }
}
__device__ __forceinline__ void ix_compact(LAS u64* cand, LAS unsigned* hist, int lane, int& cnt, unsigned& T) {
    u64 e[IX_NE]; ix_load_entries(cand, cnt, lane, e);
    u64 prefix = 0ull; int r = 256, p = 5;
    for (;; --p) { int bn, ab, ib; radix_pass(hist, e, cnt, lane, prefix, p, r, bn, ab, ib);
        prefix = (prefix << 8) | (u64)bn; r -= ab;
        const int kept = 256 - r + ib;
        if (p == 0 || (p <= 4 && kept <= 512)) break; }
    const int sh = 8 * p;
    int base = 0;
#pragma unroll
    for (int k = 0; k < IX_NE; ++k) { const int idx = k * 64 + lane; const bool keep = idx < cnt && (e[k] >> sh) >= prefix;
        const u64 m = __ballot(keep); const int pos = base + (int)__builtin_amdgcn_mbcnt_hi((unsigned)(m >> 32), __builtin_amdgcn_mbcnt_lo((unsigned)m, 0u));
        if (keep) cand[pos] = e[k]; base += (int)__builtin_popcountll(m); }
    LDS_WAIT();
    cnt = base; T = p >= 2 ? (unsigned)(prefix << (8 * (p - 2))) : (unsigned)(prefix >> (8 * (2 - p))) + 1u;
}
__device__ __forceinline__ void ix_final(LAS u64* cand, LAS unsigned* hist, LAS unsigned short* outl, int lane, int cnt, unsigned short* idx_row, int* nv_ptr) {
    u64 e[IX_NE]; ix_load_entries(cand, cnt, lane, e);
    u64 thr = 0ull; int sh = 0;
    if (cnt > 256) { u64 prefix = 0ull; int r = 256;
        for (int p = 5; p >= 0; --p) { int bn, ab, ib; radix_pass(hist, e, cnt, lane, prefix, p, r, bn, ab, ib);
            prefix = (prefix << 8) | (u64)bn; r -= ab; thr = prefix; sh = 8 * p;
            if (ib == r) break; } }
    int base = 0;
#pragma unroll
    for (int k = 0; k < IX_NE; ++k) { const int idx = k * 64 + lane; const bool sel = idx < cnt && (e[k] >> sh) >= thr;
        const u64 m = __ballot(sel); const int pos = base + (int)__builtin_amdgcn_mbcnt_hi((unsigned)(m >> 32), __builtin_amdgcn_mbcnt_lo((unsigned)m, 0u));
        if (sel && pos < 256) outl[pos] = (unsigned short)(0xFFFFu - (unsigned)(e[k] & 0xFFFFull)); base += (int)__builtin_popcountll(m); }
    LDS_WAIT();
    const int nsel = base < 256 ? base : 256;
    *(u32x2*)(idx_row + lane * 4) = *(const LAS u32x2*)(outl + lane * 4);
    if (lane == 0) *nv_ptr = nsel;
}

__device__ __forceinline__ void ix_filter(const LAS float* row, LAS u64* cand, int lane, int kbase, int& cnt, unsigned T) {
    const f32x4 v = *(const LAS f32x4*)(row + lane * 4);
#pragma unroll
    for (int i = 0; i < 4; ++i) { const unsigned o = ordered_u32(v[i]); const bool pass = o >= T;
        const u64 m = __ballot(pass);
        if (m) { const int pos = cnt + (int)__builtin_amdgcn_mbcnt_hi((unsigned)(m >> 32), __builtin_amdgcn_mbcnt_lo((unsigned)m, 0u));
            if (pass && pos < IX_CAP) cand[pos] = ((u64)o << 16) | (u64)(0xFFFFu - (unsigned)(kbase + lane * 4 + i));
            cnt += (int)__builtin_popcountll(m); } }
}

__device__ __forceinline__ void indexer_unit(const Ctx& C, LAS unsigned char* lds, int unit) {
    const int tid = threadIdx.x, lane = tid & 63, wv = __builtin_amdgcn_readfirstlane(tid >> 6);
    const int b = unit & 3, qt = 511 - (unit >> 2), t0 = qt * 16;
    const int q = lane & 15, c = lane >> 4;
    const size_t m0 = (size_t)b * SEQ + t0;
    const h16* QI = (const h16*)(C.ws + WS_QI); const h16* KI = (const h16*)(C.ws + WS_KI) + (size_t)b * SEQ * 64; const float* WI = (const float*)(C.ws + WS_WI);
    h8 qf[8][2];
#pragma unroll
    for (int h = 0; h < 8; ++h)
#pragma unroll
        for (int ks = 0; ks < 2; ++ks) qf[h][ks] = *(const h8*)(QI + (m0 + q) * 512 + h * 64 + 32 * ks + 8 * c);
    float wvv[8]; { const f32x4 w0 = *(const f32x4*)(WI + (m0 + q) * 8), w1 = *(const f32x4*)(WI + (m0 + q) * 8 + 4); for (int e = 0; e < 4; ++e) { wvv[e] = w0[e]; wvv[4 + e] = w1[e]; } }
    const int nkeys = t0 + 16, nslab = (nkeys + 255) >> 8;
    LAS u64* candA = (LAS u64*)(lds + IX_CAND) + (size_t)(2 * wv) * IX_CAP; LAS u64* candB = candA + IX_CAP;
    LAS unsigned* hist = (LAS unsigned*)(lds + IX_HIST) + wv * 256;
    LAS unsigned short* outl = (LAS unsigned short*)(lds + IX_OUT) + wv * 256;
    int cntA = 0, cntB = 0; unsigned TA = 0x00800000u, TB = 0x00800000u;
    for (int s = 0; s < nslab; ++s) {
        LAS float* slab = (LAS float*)(lds + (s & 1) * IX_SLAB);
#pragma unroll
        for (int jt = 0; jt < 2; ++jt) { const int tl = 2 * wv + jt, key0 = s * 256 + tl * 16;
            f32x4 sc = {-INFINITY, -INFINITY, -INFINITY, -INFINITY};
            if (key0 < nkeys) {
                const h8 k0 = *(const h8*)(KI + (size_t)(key0 + q) * 64 + 8 * c), k1 = *(const h8*)(KI + (size_t)(key0 + q) * 64 + 32 + 8 * c);
                sc = (f32x4){0.f, 0.f, 0.f, 0.f};
#pragma unroll
                for (int h = 0; h < 8; ++h) { f32x4 a = {0.f, 0.f, 0.f, 0.f};
                    a = __builtin_amdgcn_mfma_f32_16x16x32_f16(k0, qf[h][0], a, 0, 0, 0); a = __builtin_amdgcn_mfma_f32_16x16x32_f16(k1, qf[h][1], a, 0, 0, 0);
#pragma unroll
                    for (int i = 0; i < 4; ++i) sc[i] += wvv[h] * fmaxf(a[i], 0.f); }
#pragma unroll
                for (int i = 0; i < 4; ++i) { sc[i] += 0.0f; if (key0 + 4 * c + i > t0 + q) sc[i] = -INFINITY; }
            }
            *(LAS f32x4*)(slab + q * IX_STR + tl * 16 + 4 * c) = sc; }
        __syncthreads();
        if (cntA > IX_CAP - 256) ix_compact(candA, hist, lane, cntA, TA);
        ix_filter(slab + (2 * wv) * IX_STR, candA, lane, s * 256, cntA, TA);
        if (cntB > IX_CAP - 256) ix_compact(candB, hist, lane, cntB, TB);
        ix_filter(slab + (2 * wv + 1) * IX_STR, candB, lane, s * 256, cntB, TB);
    }
    LDS_WAIT();
    unsigned short* IDX = (unsigned short*)(C.ws + WS_IDX); int* NV = (int*)(C.ws + WS_NV);
    ix_final(candA, hist, outl, lane, cntA, IDX + (m0 + 2 * wv) * 256, NV + m0 + 2 * wv);
    ix_final(candB, hist, outl, lane, cntB, IDX + (m0 + 2 * wv + 1) * 256, NV + m0 + 2 * wv + 1);
}

constexpr int AT_VSTR = 288;
constexpr int AT_WAVE = 32 * AT_VSTR + 512;
constexpr int AT_TAB = 8 * AT_WAVE;
constexpr int AT_END = AT_TAB + 129 * 8 * 4;
static_assert(AT_END <= MISC_OFF && (AT_WAVE % 16) == 0, "attention LDS");

__device__ __forceinline__ void attn_build_tab(const Ctx& C, LAS unsigned char* lds) {
    LAS float* tab = (LAS float*)(lds + AT_TAB);
    for (int e = threadIdx.x; e < 129 * 8; e += NTHR) { const int d = e >> 3, h = e & 7; int bk;
        if (d < 16) bk = d; else { bk = 16 + (int)(logf((float)d / 16.0f) / 2.0794415416798357f * 16.0f); if (bk > 31) bk = 31; }
        tab[e] = C.relb[bk * 8 + h]; }
}

__device__ __forceinline__ void attn_unit(const Ctx& C, LAS unsigned char* lds, int unit) {
    const int tid = threadIdx.x, lane = tid & 63, wv = __builtin_amdgcn_readfirstlane(tid >> 6);
    const int g = lane & 15, c = lane >> 4;
    const size_t m = (size_t)unit * 8 + wv; const int b = (int)(m >> 13), t = (int)(m & (SEQ - 1));
    LAS unsigned char* vbuf = lds + wv * AT_WAVE;
    LAS unsigned short* idl = (LAS unsigned short*)(vbuf + 32 * AT_VSTR);
    const LAS float* tab = (const LAS float*)(lds + AT_TAB);
    const unsigned short* IDX = (const unsigned short*)(C.ws + WS_IDX) + m * 256;
    const int nv = ((const int*)(C.ws + WS_NV))[m];
    const h16* Kb = (const h16*)(C.ws + WS_K) + (size_t)b * SEQ * 256; const h16* Vb = (const h16*)(C.ws + WS_V) + (size_t)b * SEQ * 256;
    h16* Q = (h16*)(C.ws + WS_Q) + m * DM;
    { u32x2 w = *(const u32x2*)(IDX + lane * 4); const int p0 = lane * 4;
      unsigned short s0 = (unsigned short)(w.x & 0xFFFFu), s1 = (unsigned short)(w.x >> 16), s2 = (unsigned short)(w.y & 0xFFFFu), s3 = (unsigned short)(w.y >> 16);
      if (p0 + 0 >= nv) s0 = 0; if (p0 + 1 >= nv) s1 = 0; if (p0 + 2 >= nv) s2 = 0; if (p0 + 3 >= nv) s3 = 0;
      u32x2 o; o.x = (unsigned)s0 | ((unsigned)s1 << 16); o.y = (unsigned)s2 | ((unsigned)s3 << 16);
      *(LAS u32x2*)(idl + lane * 4) = o; }
    LDS_WAIT();
    const int gq = g & 3;
#pragma unroll 1
    for (int n = 0; n < 2; ++n) {
        h8 qf[4];
        { float qv[4][8]; float ss = 0.f;
          const h16* qp = Q + (4 * n + gq) * 128 + 32 * c;
#pragma unroll
          for (int ks = 0; ks < 4; ++ks) { const h8 x = *(const h8*)(qp + 8 * ks);
#pragma unroll
              for (int e = 0; e < 8; ++e) { qv[ks][e] = (float)x[e]; ss += qv[ks][e] * qv[ks][e]; } }
          ss += __shfl_xor(ss, 16); ss += __shfl_xor(ss, 32);
          const float rs = __builtin_amdgcn_rsqf(ss * (1.0f / 128.0f) + EPS) * 0.08838834764831845f;
#pragma unroll
          for (int ks = 0; ks < 4; ++ks) { const f32x4 g0 = *(const f32x4*)(C.qn + 32 * c + 8 * ks), g1 = *(const f32x4*)(C.qn + 32 * c + 8 * ks + 4);
#pragma unroll
              for (int e = 0; e < 4; ++e) { qf[ks][e] = (h16)(g < 4 ? qv[ks][e] * rs * g0[e] : 0.f); qf[ks][4 + e] = (h16)(g < 4 ? qv[ks][4 + e] * rs * g1[e] : 0.f); } } }
        float S[16][4];
#pragma unroll
        for (int kg = 0; kg < 4; ++kg) {
            h8 kf[4][4];
#pragma unroll
            for (int k2 = 0; k2 < 4; ++k2) { const int kt = kg * 4 + k2; const int kidx = idl[16 * kt + g];
                const h16* kp = Kb + (size_t)kidx * 256 + n * 128 + 32 * c;
#pragma unroll
                for (int ks = 0; ks < 4; ++ks) kf[k2][ks] = *(const h8*)(kp + 8 * ks); }
#pragma unroll
            for (int k2 = 0; k2 < 4; ++k2) { f32x4 a = {0.f, 0.f, 0.f, 0.f};
#pragma unroll
                for (int ks = 0; ks < 4; ++ks) a = __builtin_amdgcn_mfma_f32_16x16x32_f16(kf[k2][ks], qf[ks], a, 0, 0, 0);
#pragma unroll
                for (int i = 0; i < 4; ++i) S[kg * 4 + k2][i] = a[i]; }
        }
        float mx = -INFINITY;
#pragma unroll
        for (int kt = 0; kt < 16; ++kt) { const u32x2 iw = *(const LAS u32x2*)(idl + 16 * kt + 4 * c);
            const int ki[4] = {(int)(iw.x & 0xFFFFu), (int)(iw.x >> 16), (int)(iw.y & 0xFFFFu), (int)(iw.y >> 16)};
#pragma unroll
            for (int i = 0; i < 4; ++i) { const int pos = 16 * kt + 4 * c + i; int dist = t - ki[i]; dist = dist < 0 ? 0 : (dist > 128 ? 128 : dist);
                const float bias = tab[dist * 8 + 4 * n + gq];
                const float s = pos < nv ? S[kt][i] + bias : -INFINITY; S[kt][i] = s; mx = fmaxf(mx, s); } }
        mx = fmaxf(mx, __shfl_xor(mx, 16)); mx = fmaxf(mx, __shfl_xor(mx, 32));
        float sum = 0.f;
#pragma unroll
        for (int kt = 0; kt < 16; ++kt)
#pragma unroll
            for (int i = 0; i < 4; ++i) { const float p = __builtin_amdgcn_exp2f((S[kt][i] - mx) * 1.4426950408889634f); S[kt][i] = p; sum += p; }
        sum += __shfl_xor(sum, 16); sum += __shfl_xor(sum, 32);
        h8 pf[8];
#pragma unroll
        for (int ks = 0; ks < 8; ++ks)
#pragma unroll
            for (int i = 0; i < 4; ++i) { pf[ks][i] = (h16)S[2 * ks][i]; pf[ks][4 + i] = (h16)S[2 * ks + 1][i]; }
        f32x4 oacc[8];
#pragma unroll
        for (int dt = 0; dt < 8; ++dt) oacc[dt] = (f32x4){0.f, 0.f, 0.f, 0.f};
        const int q4 = g >> 2, p4 = g & 3;
        const LAS unsigned char* tra = vbuf + (4 * c + q4) * AT_VSTR + p4 * 8;
#pragma unroll 1
        for (int ks = 0; ks < 8; ++ks) {
            u32x4 vr[8];
#pragma unroll
            for (int k2 = 0; k2 < 8; ++k2) { const int e = lane + 64 * k2, row = e >> 4, ch = e & 15; const int vidx = idl[32 * ks + row];
                vr[k2] = *(const u32x4*)(Vb + (size_t)vidx * 256 + n * 128 + ch * 8); }
#pragma unroll
            for (int k2 = 0; k2 < 8; ++k2) { const int e = lane + 64 * k2, row = e >> 4, ch = e & 15; *(LAS u32x4*)(vbuf + row * AT_VSTR + ch * 16) = vr[k2]; }
            LDS_WAIT();
#pragma unroll
            for (int dt = 0; dt < 8; ++dt) {
                const fh4 v0 = __builtin_amdgcn_ds_read_tr16_b64_v4f16((LAS fh4*)(tra + dt * 32));
                const fh4 v1 = __builtin_amdgcn_ds_read_tr16_b64_v4f16((LAS fh4*)(tra + 16 * AT_VSTR + dt * 32));
                h8 vb; const h4 a0 = __builtin_bit_cast(h4, v0), a1 = __builtin_bit_cast(h4, v1);
#pragma unroll
                for (int e = 0; e < 4; ++e) { vb[e] = a0[e]; vb[4 + e] = a1[e]; }
                oacc[dt] = __builtin_amdgcn_mfma_f32_16x16x32_f16(pf[ks], vb, oacc[dt], 0, 0, 0); }
            LDS_WAIT();
        }
        float inv[4];
#pragma unroll
        for (int i = 0; i < 4; ++i) inv[i] = 1.0f / __shfl(sum, i);
        if (c == 0) {
#pragma unroll
            for (int dt = 0; dt < 8; ++dt)
#pragma unroll
                for (int i = 0; i < 4; ++i) *(LAS h16*)(vbuf + (i * 128 + 16 * dt + g) * 2) = (h16)(oacc[dt][i] * inv[i]);
        }
        LDS_WAIT();
        *(u32x4*)(Q + n * 512 + lane * 8) = *(const LAS u32x4*)(vbuf + lane * 16);
        LDS_WAIT();
    }
}

__device__ __forceinline__ void act_phase(const Ctx& C, int gtid, int gthreads) {
    const h16* G = (const h16*)(C.ws + WS_UPG); h16* V = (h16*)(C.ws + WS_UPV);
    constexpr int NCG = DFF / 8, NITEM = (MTOK / 16) * NCG;
    for (int it = gtid; it < NITEM; it += gthreads) {
        const int cg = it % NCG, rb = it / NCG, c0 = cg * 8, r0 = rb * 16;
        float w[3][8], bb[8];
#pragma unroll
        for (int j = 0; j < 3; ++j) { const f32x4 a = *(const f32x4*)(C.fcw + j * DFF + c0), b2 = *(const f32x4*)(C.fcw + j * DFF + c0 + 4); for (int e = 0; e < 4; ++e) { w[j][e] = a[e]; w[j][4 + e] = b2[e]; } }
        { const f32x4 a = *(const f32x4*)(C.fcb + c0), b2 = *(const f32x4*)(C.fcb + c0 + 4); for (int e = 0; e < 4; ++e) { bb[e] = a[e]; bb[4 + e] = b2[e]; } }
        h8 gm2, gm1;
        const int tseq = r0 & (SEQ - 1);
        if (tseq >= 2) { gm2 = *(const h8*)(G + (size_t)(r0 - 2) * DFF + c0); gm1 = *(const h8*)(G + (size_t)(r0 - 1) * DFF + c0); }
        else { for (int e = 0; e < 8; ++e) { gm2[e] = (h16)0.f; gm1[e] = (h16)0.f; } }
#pragma unroll 4
        for (int r = 0; r < 16; ++r) { const size_t off = (size_t)(r0 + r) * DFF + c0;
            const h8 g0 = *(const h8*)(G + off), vv = *(const h8*)(V + off);
            float y[8];
#pragma unroll
            for (int e = 0; e < 8; ++e) { const float gf = bb[e] + w[0][e] * (float)gm2[e] + w[1][e] * (float)gm1[e] + w[2][e] * (float)g0[e]; y[e] = gelu_tanh(gf) * (float)vv[e]; }
            u32x4 o; o.x = pkh(y[0], y[1]); o.y = pkh(y[2], y[3]); o.z = pkh(y[4], y[5]); o.w = pkh(y[6], y[7]);
            *(u32x4*)(V + off) = o; gm2 = gm1; gm1 = g0; }
    }
}

__device__ __forceinline__ void p0_prologue(const Params& P, LAS unsigned char* lds) {
    const int tid = threadIdx.x, lane = tid & 63, wv = tid >> 6;
    LAS float* scr = (LAS float*)(lds + wv * 16384);
    const int gw = blockIdx.x * NWAVES + wv, NGW = gridDim.x * NWAVES;
    unsigned char* ws = P.ws;
    const float *w_in = P.in[3], *wa = P.in[6], *wx = P.in[8], *w_lru = P.in[14], *w_att = P.in[15], *w_out = P.in[16], *w_up = P.in[18], *w_down = P.in[21], *w_pg = P.in[23], *w_pp = P.in[24];
    constexpr int I_IN = 16 * 195, I_SQ = 16 * 32, I_UP = 16 * 192, I_DN = 48 * 32, I_PP = 4 * 32, I_G = 2 * 4;
    constexpr int NITEMS = I_IN + 4 * I_SQ + I_UP + I_DN + I_PP + 16 * I_G;
    for (int it = gw; it < NITEMS; it += NGW) {
        int r = it;
        if (r < I_IN) { p0_transpose_item<1>(w_in, DM, NIN, (h16*)(ws + W_IN), nullptr, scr, r, lane); continue; } r -= I_IN;
        if (r < I_SQ) { p0_transpose_item<0>(w_lru, DM, DM, (h16*)(ws + W_LRU), nullptr, scr, r, lane); continue; } r -= I_SQ;
        if (r < I_SQ) { p0_transpose_item<0>(w_att, DM, DM, (h16*)(ws + W_ATT), nullptr, scr, r, lane); continue; } r -= I_SQ;
        if (r < I_SQ) { p0_transpose_item<0>(w_out, DM, DM, (h16*)(ws + W_OUT), nullptr, scr, r, lane); continue; } r -= I_SQ;
        if (r < I_SQ) { p0_transpose_item<0>(w_pg, DM, DM, (h16*)(ws + W_PG), P.in[22], scr, r, lane); continue; } r -= I_SQ;
        if (r < I_UP) { p0_transpose_item<2>(w_up, DM, 2 * DFF, (h16*)(ws + W_UP), P.in[17], scr, r, lane); continue; } r -= I_UP;
        if (r < I_DN) { p0_transpose_item<0>(w_down, DFF, DM, (h16*)(ws + W_DOWN), nullptr, scr, r, lane); continue; } r -= I_DN;
        if (r < I_PP) { p0_transpose_item<0>(w_pp, PLE, DM, (h16*)(ws + W_PP), nullptr, scr, r, lane); continue; } r -= I_PP;
        { const int blk = r / (2 * I_G), rr = r % (2 * I_G), which = rr / I_G, item = rr % I_G;
          p0_transpose_item<0>((which ? wx : wa) + (size_t)blk * 128 * 128, 128, 128, (h16*)(ws + W_GATE) + (size_t)blk * 256 * 128 + (size_t)which * 128 * 128, nullptr, scr, item, lane); }
    }
    { u32x4* z = (u32x4*)((h16*)(ws + W_IN) + (size_t)4168 * DM); const int nz = 184 * DM * 2 / 16;
      for (int i = blockIdx.x * NTHR + tid; i < nz; i += gridDim.x * NTHR) z[i] = (u32x4){0u, 0u, 0u, 0u}; }
    { const float* x = P.in[0]; const float* gn = P.in[2]; h16* A0 = (h16*)(ws + WS_A0);
      f32x4 gv[4];
#pragma unroll
      for (int j = 0; j < 4; ++j) gv[j] = *(const f32x4*)(gn + 4 * lane + 256 * j);
      for (int m = gw; m < MTOK; m += NGW) { const f32x4* xr = (const f32x4*)(x + (size_t)m * DM) + lane; f32x4 v[4]; float s = 0.f;
#pragma unroll
          for (int j = 0; j < 4; ++j) { v[j] = xr[64 * j]; s += (v[j].x * v[j].x + v[j].y * v[j].y) + (v[j].z * v[j].z + v[j].w * v[j].w); }
          const float rs = __builtin_amdgcn_rsqf(wave_sum(s) * (1.0f / DM) + EPS);
          u32x2* o8 = (u32x2*)(A0 + (size_t)m * DM) + lane;
#pragma unroll
          for (int j = 0; j < 4; ++j) { u32x2 w; w.x = pkh(v[j].x * rs * gv[j].x, v[j].y * rs * gv[j].y); w.y = pkh(v[j].z * rs * gv[j].z, v[j].w * rs * gv[j].w); o8[64 * j] = w; } } }
    { const f32x4* p4 = (const f32x4*)P.in[1]; u32x2* o = (u32x2*)(ws + WS_PH); const int n4 = MTOK * PLE / 4;
      for (int i = blockIdx.x * NTHR + tid; i < n4; i += gridDim.x * NTHR) { const f32x4 v = p4[i]; u32x2 w; w.x = pkh(v.x, v.y); w.y = pkh(v.z, v.w); o[i] = w; } }
}

__device__ __forceinline__ int next_unit(unsigned* head, volatile LAS unsigned* slot) {
    __syncthreads();
    if (threadIdx.x == 0) *slot = __hip_atomic_fetch_add(head, 1u, __ATOMIC_RELAXED, __HIP_MEMORY_SCOPE_AGENT);
    __syncthreads();
    return (int)*slot;
}

constexpr int NPHASE = 10;
__global__ void __launch_bounds__(NTHR, 2) fwd(Params P) {
    extern __shared__ __attribute__((aligned(16))) unsigned char lds_raw[];
    LAS unsigned char* lds = (LAS unsigned char*)lds_raw;
    volatile LAS unsigned* MISC = (volatile LAS unsigned*)(lds + MISC_OFF);
    const int tid = threadIdx.x;
    if (tid < 64) MISC[tid] = 0u;
    __syncthreads();
    unsigned char* ws = P.ws;
    unsigned* ctl = (unsigned*)(ws + WS_CTL);
    const int lo = P.ph_lo, hi = P.ph_hi;
    XcdBarrier bar; bar.bar = ctl + CW_BAR; bar.x = 0; bar.st = MISC;
    if (hi - lo > 1) bar = xcd_barrier_post(ctl + CW_BAR, MISC);
    Ctx C; C.ws = ws; C.out = P.out; C.conv_w = P.in[4]; C.conv_b = P.in[5]; C.ba = P.in[7]; C.bx = P.in[9]; C.lam = P.in[10]; C.qn = P.in[11]; C.kn = P.in[12]; C.relb = P.in[13]; C.fcw = P.in[19]; C.fcb = P.in[20];
    float* SSQ1 = (float*)(ws + CTL_SSQ1); float* SSQ2 = (float*)(ws + CTL_SSQ2);
#ifdef ONLY_PHASE
#define IN(k) ((k) == ONLY_PHASE)
#else
#define IN(k) (lo <= (k) && (k) < hi)
#endif
#define SEAM(k) do { if (IN(k) && IN((k) + 1)) xcd_barrier(bar); } while (0)

    if (IN(0)) { p0_prologue(P, lds); } SEAM(0);

    if (IN(1)) {
        pg8::Gemm g{(const h16*)(ws + WS_A0), (const h16*)(ws + W_IN), MTOK, NIN_PAD, DM}; pg8::StaticOrder S; S.init(MTOK, NIN_PAD, gridDim.x, blockIdx.x);
        EpiIn E{(h16*)(ws + WS_LX), (h16*)(ws + WS_GG), (h16*)(ws + WS_Q), (h16*)(ws + WS_K), (h16*)(ws + WS_V), (h16*)(ws + WS_QI), (h16*)(ws + WS_KI), (h16*)(ws + WS_SGA), (h16*)(ws + WS_SGB), (float*)(ws + WS_WI)};
        pg8::gemm_phase<EpiIn>(lds, g, S, E);
    } SEAM(1);

    if (IN(2)) {
        constexpr int N_IX = NB * (SEQ / 16), N_L1 = NB * 64 * 8, N_KN = MTOK / 128;
        for (;;) { const int u = next_unit(ctl + CW_Q2, MISC + 4);
            if (u >= N_IX + N_L1 + N_KN) break;
            if (u < N_IX) indexer_unit(C, lds, u); else if (u < N_IX + N_L1) lru1_unit(C, lds, u - N_IX); else knorm_unit(C, u - N_IX - N_L1); }
    } SEAM(2);

    if (IN(3)) {
        constexpr int N_AT = MTOK / 8, N_L2 = NB * 64 * 8;
        attn_build_tab(C, lds);
        for (;;) { const int u = next_unit(ctl + CW_Q3, MISC + 4);
            if (u >= N_AT + N_L2) break;
            if (u < N_AT) attn_unit(C, lds, u); else lru2_unit(C, lds + AT_END, u - N_AT); }
    } SEAM(3);

    if (IN(4)) {
        pg8::StaticOrder S; S.init(MTOK, DM, gridDim.x, blockIdx.x);
        { pg8::Gemm g{(const h16*)(ws + WS_LX), (const h16*)(ws + W_LRU), MTOK, DM, DM}; EpiMerge<0> E{(const h16*)(ws + WS_SGA), (h16*)(ws + WS_T1), nullptr}; pg8::gemm_phase<EpiMerge<0>>(lds, g, S, E); }
        { pg8::Gemm g{(const h16*)(ws + WS_Q), (const h16*)(ws + W_ATT), MTOK, DM, DM}; EpiMerge<1> E{(const h16*)(ws + WS_SGB), (h16*)(ws + WS_T1), (h16*)(ws + WS_GG)}; pg8::gemm_phase<EpiMerge<1>>(lds, g, S, E); }
    } SEAM(4);

    if (IN(5)) {
        pg8::Gemm g{(const h16*)(ws + WS_GG), (const h16*)(ws + W_OUT), MTOK, DM, DM}; pg8::StaticOrder S; S.init(MTOK, DM, gridDim.x, blockIdx.x);
        EpiResid<true> E{P.in[0], nullptr, (h16*)(ws + WS_X1H), SSQ1}; pg8::gemm_phase<EpiResid<true>>(lds, g, S, E);
    } SEAM(5);

    if (IN(6)) {
        pg8::Gemm g{(const h16*)(ws + WS_X1H), (const h16*)(ws + W_UP), MTOK, 2 * DFF, DM}; pg8::StaticOrder S; S.init(MTOK, 2 * DFF, gridDim.x, blockIdx.x);
        EpiUp E{SSQ1, (h16*)(ws + WS_UPG), (h16*)(ws + WS_UPV)}; pg8::gemm_phase<EpiUp>(lds, g, S, E);
    } SEAM(6);

    if (IN(7)) { act_phase(C, blockIdx.x * NTHR + tid, gridDim.x * NTHR); } SEAM(7);

    if (IN(8)) {
        pg8::Gemm g{(const h16*)(ws + WS_UPV), (const h16*)(ws + W_DOWN), MTOK, DM, DFF}; pg8::StaticOrder S; S.init(MTOK, DM, gridDim.x, blockIdx.x);
        EpiResid<false> E{nullptr, (const h16*)(ws + WS_X1H), (h16*)(ws + WS_X2H), SSQ2}; pg8::gemm_phase<EpiResid<false>>(lds, g, S, E);
    } SEAM(8);

    if (IN(9)) {
        pg8::StaticOrder S; S.init(MTOK, DM, gridDim.x, blockIdx.x);
        { pg8::Gemm g{(const h16*)(ws + WS_PH), (const h16*)(ws + W_PP), MTOK, DM, P.k_ple}; EpiF32 E{P.out}; pg8::gemm_phase<EpiF32>(lds, g, S, E); }
        { pg8::Gemm g{(const h16*)(ws + WS_X2H), (const h16*)(ws + W_PG), MTOK, DM, DM}; EpiPle E{SSQ2, (const h16*)(ws + WS_X2H), P.out}; pg8::gemm_phase<EpiPle>(lds, g, S, E); }
    }
#undef IN
#undef SEAM
}

#ifndef N_LAUNCHES
#define N_LAUNCHES 10
#endif
extern "C" void kernel_launch(void* const* d_in, const int* in_sizes, int n_in, void* d_out, int out_size, void* d_ws, size_t ws_size, hipStream_t stream) {
    static int grid = 0;
    if (grid == 0) {
        if (n_in != 25 || out_size != MTOK * DM || ws_size < WS_END) { fprintf(stderr, "kernel_launch: unexpected shapes (n_in %d out %d ws %zu)\n", n_in, out_size, ws_size); grid = -1; return; }
        int dev = 0, cus = 0, per_cu = 0;
        hipGetDevice(&dev); hipDeviceGetAttribute(&cus, hipDeviceAttributeMultiprocessorCount, dev);
        if (hipFuncSetAttribute((const void*)fwd, hipFuncAttributeMaxDynamicSharedMemorySize, LDS_BYTES) != hipSuccess) { fprintf(stderr, "kernel_launch: hipFuncSetAttribute failed\n"); grid = -1; return; }
        if (hipOccupancyMaxActiveBlocksPerMultiprocessor(&per_cu, (const void*)fwd, NTHR, LDS_BYTES) != hipSuccess || per_cu < 1) { fprintf(stderr, "kernel_launch: occupancy query says %d\n", per_cu); }
        (void)hipGetLastError();
        grid = cus > 0 ? cus : 256;
    }
    if (grid < 0) return;
    hipMemsetAsync((char*)d_ws + WS_CTL, 0, CTL_ZERO_BYTES, stream);
    Params p{};
    for (int i = 0; i < 25; ++i) p.in[i] = (const float*)d_in[i];
    p.out = (float*)d_out; p.ws = (unsigned char*)d_ws; p.k_ple = PLE; p.pad = 0;
    if (N_LAUNCHES == 1) { p.ph_lo = 0; p.ph_hi = NPHASE; hipLaunchKernelGGL(fwd, dim3(grid), dim3(NTHR), LDS_BYTES, stream, p); }
    else for (int ph = 0; ph < NPHASE; ++ph) { p.ph_lo = ph; p.ph_hi = ph + 1; hipLaunchKernelGGL(fwd, dim3(grid), dim3(NTHR), LDS_BYTES, stream, p); }
}
```

```cpp
#include <hip/hip_runtime.h>
#include <cstdio>
#include <cstdint>

#define GAS __attribute__((address_space(1)))
#define LAS __attribute__((address_space(3)))
typedef _Float16 h16;
typedef _Float16 h8 __attribute__((ext_vector_type(8)));
typedef _Float16 h4 __attribute__((ext_vector_type(4)));
typedef _Float16 h2 __attribute__((ext_vector_type(2)));
typedef __fp16 fh4 __attribute__((__vector_size__(4 * sizeof(__fp16))));
typedef float f32x4 __attribute__((ext_vector_type(4)));
typedef float f32x2 __attribute__((ext_vector_type(2)));
typedef unsigned u32x4 __attribute__((ext_vector_type(4)));
typedef unsigned u32x2 __attribute__((ext_vector_type(2)));
typedef unsigned long long u64;

__device__ __forceinline__ unsigned pkh(float a, float b) { h2 r; r.x = (h16)a; r.y = (h16)b; return __builtin_bit_cast(unsigned, r); }
__device__ __forceinline__ float sigmoid_f(float x) { return __builtin_amdgcn_rcpf(1.0f + __builtin_amdgcn_exp2f(-1.4426950408889634f * x)); }
__device__ __forceinline__ float gelu_tanh(float x) { const float u = 1.5957691216057308f * (x + 0.044715f * x * x * x); return x * sigmoid_f(u); }
#define LDS_WAIT() asm volatile("s_waitcnt lgkmcnt(0)" ::: "memory")
#define VM_WAIT() asm volatile("s_waitcnt vmcnt(0)" ::: "memory")

namespace pg8 {
constexpr int BM = 256, BK = 64, HALF = 128, HTB = HALF * BK * 2, STAGE_BYTES = 8 * HTB, NXCD = 8, WGM = 8;
__host__ __device__ __forceinline__ int lds_byte(int r, int c) { const int st = (r >> 4) * 2 + (c >> 5), rr = r & 15, cc = c & 31, ob = rr * 64 + cc * 2; return st * 1024 + (ob ^ (((ob >> 9) & 1) << 5)); }
__host__ __device__ __forceinline__ void stage_rc(int b, int& R, int& C) { const int st = b / 1024, sb = b % 1024, swz = sb ^ (((sb >> 9) & 1) << 5); R = (st >> 1) * 16 + swz / 64; C = (st & 1) * 32 + (swz % 64) / 2; }
__host__ __device__ __forceinline__ int perm32(int rho) { const int n = rho >> 4, i = rho & 15; return 8 * (i >> 2) + 4 * n + (i & 3); }

struct Unit { int pm, pn; };
struct Gemm { const h16* A; const h16* Bt; int M, N, K; };

struct StaticOrder {
    int nM, nN, nwg, G, c;
    __host__ __device__ void init(int M, int N, int G_, int c_) { nM = M / BM; nN = N / BM; nwg = nM * nN; G = G_; c = c_; }
    __host__ __device__ __forceinline__ bool next(int i, Unit& u) const {
        const long L = (long)i * G + c; if (L >= nwg) return false;
        int wgid = (int)L; { const int q = nwg / NXCD, r = nwg % NXCD, xcd = wgid % NXCD, off = wgid / NXCD; wgid = (xcd < r ? xcd * (q + 1) : r * (q + 1) + (xcd - r) * q) + off; }
        const int nig = WGM * nN, gid = wgid / nig, fm = gid * WGM, gsz = (nM - fm) < WGM ? (nM - fm) : WGM;
        u.pm = fm + ((wgid % nig) % gsz); u.pn = (wgid % nig) / gsz; return true;
    }
};

template <class Epi, bool ALIGN_EPI = true, bool SP2 = true>
__device__ __forceinline__ void gemm_phase(LAS unsigned char* lds, const Gemm g, const StaticOrder& S, const Epi& E) {
    const int tid = threadIdx.x, wid = __builtin_amdgcn_readfirstlane(tid >> 6), lane = tid & 63, wr = wid >> 2, wc = wid & 3, fr = lane & 15, fq = lane >> 4;
    const int K = g.K, nt = K / BK;
    unsigned voffA[2], voffB[2];
#pragma unroll
    for (int i = 0; i < 2; ++i) { int R, C; stage_rc(tid * 16 + i * 8192, R, C); const int Rb = Epi::PERM ? ((R & ~31) + perm32(R & 31)) : R;
        voffA[i] = (unsigned)(R * K + C) * 2u; voffB[i] = (unsigned)(Rb * K + C) * 2u; }
    const size_t kstep = (size_t)(BK * 2);
    const size_t hstep = (size_t)HALF * K * 2;
    const size_t tstep = 2 * hstep;
    const unsigned ldsw = (unsigned)wid * 1024u;
    const int aoff = lds_byte(wr * 64 + fr, fq * 8), boff = lds_byte(wc * 32 + fr, fq * 8);
#define PG8_SA(b, h) (((b) * 2 + (h)) * HTB)
#define PG8_SB(b, h) ((4 + (b) * 2 + (h)) * HTB)
#define PG8_STAGE(bufoff, gbase, voff) do { _Pragma("unroll") for (int _i = 0; _i < 2; ++_i) \
        __builtin_amdgcn_global_load_lds((const unsigned*)((const char*)(gbase) + (voff)[_i]), (LAS unsigned*)(lds + (bufoff) + ldsw + _i * 8192), 16, 0, 0); } while (0)
#define PG8_LDA(dst, b, h) do { _Pragma("unroll") for (int m = 0; m < 4; ++m) _Pragma("unroll") for (int k = 0; k < 2; ++k) dst[m][k] = *(const LAS h8*)(lds + PG8_SA(b, h) + aoff + m * 2048 + k * 1024); } while (0)
#define PG8_LDB(dst, b, h) do { _Pragma("unroll") for (int n = 0; n < 2; ++n) _Pragma("unroll") for (int k = 0; k < 2; ++k) dst[n][k] = *(const LAS h8*)(lds + PG8_SB(b, h) + boff + n * 2048 + k * 1024); } while (0)
#define PG8_MMA(ai, bj, At, Bt) do { __builtin_amdgcn_s_setprio(1); _Pragma("unroll") for (int m = 0; m < 4; ++m) _Pragma("unroll") for (int n = 0; n < 2; ++n) _Pragma("unroll") for (int k = 0; k < 2; ++k) \
        acc[ai][bj][m][n] = __builtin_amdgcn_mfma_f32_16x16x32_f16(Bt[n][k], At[m][k], acc[ai][bj][m][n], 0, 0, 0); __builtin_amdgcn_s_setprio(0); } while (0)
#define PG8_WAIT_V(n) asm volatile("s_waitcnt vmcnt(" #n ")" ::: "memory")
#define PG8_WAIT_L(n) asm volatile("s_waitcnt lgkmcnt(" #n ")" ::: "memory")
#define PG8_BAR __builtin_amdgcn_s_barrier()
#define PG8_SCHED __builtin_amdgcn_sched_barrier(0)
    Unit cur, nxt; int ui = 0;
    if (!S.next(0, cur)) return;
    f32x4 acc[2][2][4][2];
#pragma unroll
    for (int a = 0; a < 2; ++a)
#pragma unroll
        for (int b = 0; b < 2; ++b)
#pragma unroll
            for (int m = 0; m < 4; ++m)
#pragma unroll
                for (int n = 0; n < 2; ++n) acc[a][b][m][n] = (f32x4){0.f, 0.f, 0.f, 0.f};
    h8 At[4][2], B0[2][2], B1[2][2];
    const char* cA = (const char*)g.A + (size_t)cur.pm * tstep; const char* cB = (const char*)g.Bt + (size_t)cur.pn * tstep;
    if constexpr (SP2) {
        PG8_STAGE(PG8_SB(0, 0), cB, voffB); PG8_STAGE(PG8_SB(0, 1), cB + hstep, voffB); PG8_STAGE(PG8_SA(0, 0), cA, voffA); PG8_STAGE(PG8_SA(0, 1), cA + hstep, voffA);
        if (wr == 1) PG8_BAR;
        PG8_WAIT_V(2); PG8_BAR;
        PG8_STAGE(PG8_SB(1, 0), cB + kstep, voffB); PG8_STAGE(PG8_SA(1, 0), cA + kstep, voffA); PG8_STAGE(PG8_SB(1, 1), cB + hstep + kstep, voffB);
        PG8_WAIT_V(6); PG8_BAR;
    } else {
        PG8_STAGE(PG8_SB(0, 0), cB, voffB); PG8_STAGE(PG8_SA(0, 0), cA, voffA); PG8_STAGE(PG8_SB(0, 1), cB + hstep, voffB); PG8_STAGE(PG8_SA(0, 1), cA + hstep, voffA);
        if (wr == 1) PG8_BAR;
        PG8_WAIT_V(4); PG8_BAR;
        PG8_STAGE(PG8_SB(1, 0), cB + kstep, voffB); PG8_STAGE(PG8_SA(1, 0), cA + kstep, voffA); PG8_STAGE(PG8_SB(1, 1), cB + hstep + kstep, voffB);
        PG8_WAIT_V(6); PG8_BAR;
    }
    for (;;) {
        const bool has_next = S.next(ui + 1, nxt);
        const char* nA = has_next ? (const char*)g.A + (size_t)nxt.pm * tstep : cA; const char* nB = has_next ? (const char*)g.Bt + (size_t)nxt.pn * tstep : cB;
        for (int t = 0; t < nt; t += 2) {
            const bool last = (t == nt - 2);
            const char* a1 = cA + (size_t)(t + 1) * kstep;
            const char* a2 = last ? nA : cA + (size_t)(t + 2) * kstep; const char* b2 = last ? nB : cB + (size_t)(t + 2) * kstep;
            const char* a3 = a2 + kstep; const char* b3 = b2 + kstep;
            if constexpr (SP2) {
            PG8_LDB(B0, 0, 0); PG8_LDB(B1, 0, 1); PG8_SCHED; PG8_LDA(At, 0, 0); PG8_STAGE(PG8_SA(1, 1), a1 + hstep, voffA);
            PG8_WAIT_V(8); PG8_WAIT_L(0); PG8_BAR; PG8_MMA(0, 0, At, B0); PG8_MMA(0, 1, At, B1); PG8_BAR; PG8_SCHED;
            PG8_LDA(At, 0, 1); PG8_STAGE(PG8_SB(0, 0), b2, voffB); PG8_STAGE(PG8_SB(0, 1), b2 + hstep, voffB); PG8_STAGE(PG8_SA(0, 0), a2, voffA);
            PG8_WAIT_V(8); PG8_WAIT_L(0); PG8_BAR; PG8_MMA(1, 0, At, B0); PG8_MMA(1, 1, At, B1); PG8_BAR; PG8_SCHED;
            PG8_LDB(B0, 1, 0); PG8_LDB(B1, 1, 1); PG8_SCHED; PG8_LDA(At, 1, 0); PG8_STAGE(PG8_SA(0, 1), a2 + hstep, voffA);
            PG8_WAIT_V(8); PG8_WAIT_L(0); PG8_BAR; PG8_MMA(0, 0, At, B0); PG8_MMA(0, 1, At, B1); PG8_BAR; PG8_SCHED;
            PG8_LDA(At, 1, 1); PG8_STAGE(PG8_SB(1, 0), b3, voffB); PG8_STAGE(PG8_SB(1, 1), b3 + hstep, voffB); PG8_STAGE(PG8_SA(1, 0), a3, voffA);
            PG8_WAIT_V(8); PG8_WAIT_L(0); PG8_BAR; PG8_MMA(1, 0, At, B0); PG8_MMA(1, 1, At, B1); PG8_BAR; PG8_SCHED;
            } else {
            PG8_LDB(B0, 0, 0); PG8_SCHED; PG8_LDA(At, 0, 0); PG8_STAGE(PG8_SA(1, 1), a1 + hstep, voffA);
            PG8_WAIT_L(8); PG8_BAR; PG8_WAIT_L(0); PG8_MMA(0, 0, At, B0); PG8_BAR; PG8_SCHED;
            PG8_LDB(B1, 0, 1); PG8_STAGE(PG8_SB(0, 0), b2, voffB);
            PG8_BAR; PG8_WAIT_L(0); PG8_MMA(0, 1, At, B1); PG8_BAR;
            PG8_LDA(At, 0, 1); PG8_STAGE(PG8_SA(0, 0), a2, voffA);
            PG8_BAR; PG8_WAIT_L(0); PG8_MMA(1, 0, At, B0); PG8_BAR; PG8_SCHED;
            PG8_STAGE(PG8_SB(0, 1), b2 + hstep, voffB);
            PG8_WAIT_V(6); PG8_BAR; PG8_MMA(1, 1, At, B1); PG8_BAR;
            PG8_LDB(B0, 1, 0); PG8_SCHED; PG8_LDA(At, 1, 0); PG8_STAGE(PG8_SA(0, 1), a2 + hstep, voffA);
            PG8_WAIT_L(8); PG8_BAR; PG8_WAIT_L(0); PG8_MMA(0, 0, At, B0); PG8_BAR; PG8_SCHED;
            PG8_LDB(B1, 1, 1); PG8_STAGE(PG8_SB(1, 0), b3, voffB);
            PG8_BAR; PG8_WAIT_L(0); PG8_MMA(0, 1, At, B1); PG8_BAR;
            PG8_LDA(At, 1, 1); PG8_STAGE(PG8_SA(1, 0), a3, voffA);
            PG8_BAR; PG8_WAIT_L(0); PG8_MMA(1, 0, At, B0); PG8_BAR; PG8_SCHED;
            PG8_STAGE(PG8_SB(1, 1), b3 + hstep, voffB);
            PG8_WAIT_V(6); PG8_BAR; PG8_MMA(1, 1, At, B1); PG8_BAR;
            }
        }
        if constexpr (ALIGN_EPI) { if (wr == 0) PG8_BAR; }
        E(acc, cur, wr, wc, fr, fq);
        if (!has_next) break;
#pragma unroll
        for (int a = 0; a < 2; ++a)
#pragma unroll
            for (int b = 0; b < 2; ++b)
#pragma unroll
                for (int m = 0; m < 4; ++m)
#pragma unroll
                    for (int n = 0; n < 2; ++n) acc[a][b][m][n] = (f32x4){0.f, 0.f, 0.f, 0.f};
        cur = nxt; cA = nA; cB = nB; ++ui;
        if constexpr (ALIGN_EPI) { if (wr == 1) PG8_BAR; }
    }
    PG8_WAIT_V(0);
    if constexpr (!ALIGN_EPI) { if (wr == 0) PG8_BAR; }
    PG8_BAR;
#undef PG8_SA
#undef PG8_SB
#undef PG8_STAGE
#undef PG8_LDA
#undef PG8_LDB
#undef PG8_MMA
#undef PG8_WAIT_V
#undef PG8_WAIT_L
#undef PG8_BAR
#undef PG8_SCHED
}
}

constexpr int NB = 4, SEQ = 8192, MTOK = NB * SEQ, DM = 1024, DFF = 3072, PLE = 256;
constexpr int NIN = 6216, NIN_PAD = 6400;
constexpr float EPS = 1e-6f;
constexpr int NWAVES = 8, NTHR = 512;

typedef const f32x4 (&AccRef)[2][2][4][2];

template <int ACT> __device__ __forceinline__ float act_f(float v) {
    if (ACT == 1) return gelu_tanh(v);
    if (ACT == 2) return sigmoid_f(v);
    if (ACT == 3) return v * 0.125f;
    return v;
}
template <int ACT> __device__ __forceinline__ void store_tile_h(AccRef acc, h16* base, int ldc, int row0, int col0, int dry) {
    const unsigned bo0 = ((unsigned)row0 * (unsigned)ldc + (unsigned)col0) * 2u;
#pragma unroll
    for (int ai = 0; ai < 2; ++ai)
#pragma unroll
        for (int m = 0; m < 4; ++m) { const unsigned bo = bo0 + (unsigned)((ai * 128 + m * 16) * ldc * 2);
#pragma unroll
            for (int bj = 0; bj < 2; ++bj) { const f32x4 v0 = acc[ai][bj][m][0], v1 = acc[ai][bj][m][1];
                u32x4 w; w.x = pkh(act_f<ACT>(v0[0]), act_f<ACT>(v0[1])); w.y = pkh(act_f<ACT>(v0[2]), act_f<ACT>(v0[3]));
                w.z = pkh(act_f<ACT>(v1[0]), act_f<ACT>(v1[1])); w.w = pkh(act_f<ACT>(v1[2]), act_f<ACT>(v1[3]));
                if (!dry) *(u32x4*)((char*)base + bo + bj * 256) = w; }
            if (ACT == 1 || ACT == 2) __builtin_amdgcn_sched_barrier(0); }
}

struct EpiIn {
    static constexpr bool PERM = true;
    h16 *LX, *GG, *Q, *K, *V, *QI, *KI, *SGA, *SGB; float* WI; int dry;
    __device__ __forceinline__ void operator()(AccRef acc, const pg8::Unit& u, int wr, int wc, int fr, int fq) const {
        const int pn = u.pn, row0 = u.pm * 256 + wr * 64 + fr, cw = wc * 32 + 8 * fq;
        if (pn < 4 || (pn >= 8 && pn < 14)) {
            h16* base = pn < 4 ? LX : (pn < 12 ? Q : (pn == 12 ? K : V)); const int ldc = pn < 12 ? DM : 256; const int ct = pn < 4 ? pn * 256 : (pn < 12 ? (pn - 8) * 256 : 0);
            if (pn < 12) store_tile_h<0>(acc, base, DM, row0, ct + cw, dry); else store_tile_h<0>(acc, base, 256, row0, cw, dry);
            (void)ldc;
        }
        else if (pn < 8) store_tile_h<1>(acc, GG, DM, row0, (pn - 4) * 256 + cw, dry);
        else if (pn < 16) {
#pragma unroll
            for (int ai = 0; ai < 2; ++ai)
#pragma unroll
                for (int m = 0; m < 4; ++m) { const unsigned t16 = (unsigned)(u.pm * 16 + wr * 4 + ai * 8 + m);
#pragma unroll
                    for (int bj = 0; bj < 2; ++bj) { const f32x4 v0 = acc[ai][bj][m][0] * 0.125f, v1 = acc[ai][bj][m][1] * 0.125f;
                        const unsigned hh = (unsigned)((pn - 14) * 4 + bj * 2 + (wc >> 1)), slot = ((t16 * 8u + hh) * 2u + (unsigned)(wc & 1)) * 64u + (unsigned)(fq * 16 + fr);
                        u32x4 w; w.x = pkh(v0[0], v0[1]); w.y = pkh(v0[2], v0[3]); w.z = pkh(v1[0], v1[1]); w.w = pkh(v1[2], v1[3]);
                        if (!dry) *(u32x4*)((char*)QI + slot * 16u) = w; } }
        }
        else if (pn == 16) {
            if (wc < 2) {
#pragma unroll
                for (int ai = 0; ai < 2; ++ai)
#pragma unroll
                    for (int m = 0; m < 4; ++m) { const f32x4 v0 = acc[ai][0][m][0], v1 = acc[ai][0][m][1];
                        u32x4 w; w.x = pkh(v0[0], v0[1]); w.y = pkh(v0[2], v0[3]); w.z = pkh(v1[0], v1[1]); w.w = pkh(v1[2], v1[3]);
                        if (!dry) *(u32x4*)((char*)KI + ((unsigned)((u.pm * 16 + wr * 4 + ai * 8 + m) * 2 + wc) * 64u + (unsigned)(fq * 16 + fr)) * 16u) = w; }
            } else if (wc == 2 && fq == 0) {
#pragma unroll
                for (int ai = 0; ai < 2; ++ai)
#pragma unroll
                    for (int m = 0; m < 4; ++m) { float* p = WI + (size_t)(row0 + ai * 128 + m * 16) * 8;
                        if (!dry) { *(f32x4*)p = acc[ai][0][m][0] * 0.35355339059327373f; *(f32x4*)(p + 4) = acc[ai][0][m][1] * 0.35355339059327373f; } }
            }
        }
        else { h16* base = pn < 21 ? SGA : SGB; const int ct = pn < 21 ? (pn - 17) * 256 : (pn - 21) * 256; store_tile_h<2>(acc, base, DM, row0, ct + cw, dry); }
    }
};

template <int SECOND> struct EpiMerge {
    static constexpr bool PERM = true;
    const h16* SG; h16* T1; h16* OUT; int dry;
    __device__ __forceinline__ void operator()(AccRef acc, const pg8::Unit& u, int wr, int wc, int fr, int fq) const {
        const int row0 = u.pm * 256 + wr * 64 + fr, col0 = u.pn * 256 + wc * 32 + 8 * fq;
#pragma unroll
        for (int ai = 0; ai < 2; ++ai)
#pragma unroll
            for (int m = 0; m < 4; ++m) { const size_t off = (size_t)(row0 + ai * 128 + m * 16) * DM + col0;
#pragma unroll
                for (int bj = 0; bj < 2; ++bj) { const f32x4 v0 = acc[ai][bj][m][0], v1 = acc[ai][bj][m][1];
                    const h8 sg = *(const h8*)(SG + off + bj * 128);
                    float r[8];
#pragma unroll
                    for (int j = 0; j < 4; ++j) { r[j] = (float)sg[j] * v0[j]; r[4 + j] = (float)sg[4 + j] * v1[j]; }
                    if (SECOND) { const h8 t1 = *(const h8*)(T1 + off + bj * 128);
#pragma unroll
                        for (int j = 0; j < 8; ++j) r[j] += (float)t1[j]; }
                    u32x4 w; w.x = pkh(r[0], r[1]); w.y = pkh(r[2], r[3]); w.z = pkh(r[4], r[5]); w.w = pkh(r[6], r[7]);
                    if (!dry) *(u32x4*)((SECOND ? OUT : T1) + off + bj * 128) = w; }
                asm volatile("" ::: "memory"); }
    }
};

template <bool BASE_F32> struct EpiResid {
    static constexpr bool PERM = true;
    const float* BF; const h16* BH; h16* XOUT; float* SSQ; int dry;
    __device__ __forceinline__ void operator()(AccRef acc, const pg8::Unit& u, int wr, int wc, int fr, int fq) const {
        const int row0 = u.pm * 256 + wr * 64 + fr, col0 = u.pn * 256 + wc * 32 + 8 * fq;
#pragma unroll
        for (int ai = 0; ai < 2; ++ai)
#pragma unroll
            for (int m = 0; m < 4; ++m) { const int row = row0 + ai * 128 + m * 16; const size_t off = (size_t)row * DM + col0; float ss = 0.f;
#pragma unroll
                for (int bj = 0; bj < 2; ++bj) { const f32x4 v0 = acc[ai][bj][m][0], v1 = acc[ai][bj][m][1];
                    float r[8];
                    if (BASE_F32) { const f32x4 b0 = *(const f32x4*)(BF + off + bj * 128), b1 = *(const f32x4*)(BF + off + bj * 128 + 4);
#pragma unroll
                        for (int j = 0; j < 4; ++j) { r[j] = b0[j] + v0[j]; r[4 + j] = b1[j] + v1[j]; } }
                    else { const h8 b = *(const h8*)(BH + off + bj * 128);
#pragma unroll
                        for (int j = 0; j < 4; ++j) { r[j] = (float)b[j] + v0[j]; r[4 + j] = (float)b[4 + j] + v1[j]; } }
#pragma unroll
                    for (int j = 0; j < 8; ++j) ss += r[j] * r[j];
                    u32x4 w; w.x = pkh(r[0], r[1]); w.y = pkh(r[2], r[3]); w.z = pkh(r[4], r[5]); w.w = pkh(r[6], r[7]);
                    if (!dry) *(u32x4*)(XOUT + off + bj * 128) = w; }
                ss += __shfl_xor(ss, 16); ss += __shfl_xor(ss, 32);
                if (fq == 0 && !dry) unsafeAtomicAdd(SSQ + row, ss);
                asm volatile("" ::: "memory"); }
    }
};

struct EpiUp {
    static constexpr bool PERM = true;
    const float* SSQ; h16* UPG; h16* UPV; int dry;
    __device__ __forceinline__ void operator()(AccRef acc, const pg8::Unit& u, int wr, int wc, int fr, int fq) const {
        const int row0 = u.pm * 256 + wr * 64 + fr, col0 = u.pn * 128 + wc * 32 + 8 * fq;
#pragma unroll
        for (int ai = 0; ai < 2; ++ai)
#pragma unroll
            for (int m = 0; m < 4; ++m) { const int row = row0 + ai * 128 + m * 16; const size_t off = (size_t)row * DFF + col0;
                const float r = __builtin_amdgcn_rsqf(SSQ[row] * (1.0f / DM) + EPS);
#pragma unroll
                for (int bj = 0; bj < 2; ++bj) { const f32x4 v0 = acc[ai][bj][m][0] * r, v1 = acc[ai][bj][m][1] * r;
                    u32x4 w; w.x = pkh(v0[0], v0[1]); w.y = pkh(v0[2], v0[3]); w.z = pkh(v1[0], v1[1]); w.w = pkh(v1[2], v1[3]);
                    if (!dry) *(u32x4*)((bj ? UPV : UPG) + off) = w; } }
    }
};

__device__ __forceinline__ float dpp_ror1(float v) { return __builtin_bit_cast(float, __builtin_amdgcn_update_dpp(0, __builtin_bit_cast(int, v), 0x121, 0xf, 0xf, false)); }
__device__ __forceinline__ float dpp_ror2(float v) { return __builtin_bit_cast(float, __builtin_amdgcn_update_dpp(0, __builtin_bit_cast(int, v), 0x122, 0xf, 0xf, false)); }
struct EpiUpAct {
    static constexpr bool PERM = true;
    const float* SSQ; h16* ACT; float* SG; float* SV; float* SL; const float* fcw; const float* fcb; LAS unsigned char* xl; int dry;
    __device__ __forceinline__ void operator()(AccRef acc, const pg8::Unit& u, int wr, int wc, int fr, int fq) const {
        const int row0 = u.pm * 256 + wr * 64 + fr, colg = u.pn * 128 + wc * 32 + 8 * fq, coll = wc * 32 + 8 * fq;
        float w0[8], w1[8], w2[8], bb[8];
        { const f32x4 a0 = *(const f32x4*)(fcw + colg), a1 = *(const f32x4*)(fcw + colg + 4), b0 = *(const f32x4*)(fcw + DFF + colg), b1 = *(const f32x4*)(fcw + DFF + colg + 4),
                      c0 = *(const f32x4*)(fcw + 2 * DFF + colg), c1 = *(const f32x4*)(fcw + 2 * DFF + colg + 4), d0 = *(const f32x4*)(fcb + colg), d1 = *(const f32x4*)(fcb + colg + 4);
#pragma unroll
          for (int e = 0; e < 4; ++e) { w0[e] = a0[e]; w0[4 + e] = a1[e]; w1[e] = b0[e]; w1[4 + e] = b1[e]; w2[e] = c0[e]; w2[4 + e] = c1[e]; bb[e] = d0[e]; bb[4 + e] = d1[e]; } }
        LAS float* X = (LAS float*)xl;
#pragma unroll
        for (int ai = 0; ai < 2; ++ai) { const float r3 = __builtin_amdgcn_rsqf(SSQ[row0 + ai * 128 + 48] * (1.0f / DM) + EPS);
            if (fr >= 14) { LAS float* p = X + ((ai * 2 + wr) * 2 + (fr - 14)) * 128 + coll; *(LAS f32x4*)p = acc[ai][0][3][0] * r3; *(LAS f32x4*)(p + 4) = acc[ai][0][3][1] * r3; } }
        LDS_WAIT(); __builtin_amdgcn_s_barrier(); asm volatile("" ::: "memory");
#pragma unroll
        for (int ai = 0; ai < 2; ++ai) {
            float L0[8], L1[8];
            if (ai == 0 && wr == 0) {
#pragma unroll
                for (int e = 0; e < 8; ++e) { L0[e] = 0.f; L1[e] = 0.f; } }
            else { const int pb = wr == 1 ? ai * 2 : 1; const LAS float* p = X + (pb * 2) * 128 + coll;
                const f32x4 x0 = *(const LAS f32x4*)p, x1 = *(const LAS f32x4*)(p + 4), y0 = *(const LAS f32x4*)(p + 128), y1 = *(const LAS f32x4*)(p + 132);
#pragma unroll
                for (int e = 0; e < 4; ++e) { L0[e] = x0[e]; L0[4 + e] = x1[e]; L1[e] = y0[e]; L1[4 + e] = y1[e]; } }
            float q1[8], q2[8];
#pragma unroll
            for (int e = 0; e < 8; ++e) { q1[e] = L1[e]; q2[e] = fr == 0 ? L0[e] : L1[e]; }
#pragma unroll
            for (int m = 0; m < 4; ++m) { const int row = row0 + ai * 128 + m * 16;
                const float rr = __builtin_amdgcn_rsqf(SSQ[row] * (1.0f / DM) + EPS);
                float g[8], a[8];
#pragma unroll
                for (int e = 0; e < 4; ++e) { g[e] = acc[ai][0][m][0][e] * rr; g[4 + e] = acc[ai][0][m][1][e] * rr; }
#pragma unroll
                for (int e = 0; e < 8; ++e) { const float r1 = dpp_ror1(g[e]), r2 = dpp_ror2(g[e]);
                    const float p1 = fr >= 1 ? r1 : q1[e], p2 = fr >= 2 ? r2 : q2[e];
                    const float y = bb[e] + w0[e] * p2 + w1[e] * p1 + w2[e] * g[e];
                    const float vv = (e < 4 ? acc[ai][1][m][0][e] : acc[ai][1][m][1][e - 4]) * rr;
                    a[e] = gelu_tanh(y) * vv; q1[e] = r1; q2[e] = r2; }
                const bool deferred = (ai == 0 && m == 0) && wr == 0 && fr < 2;
                if (!dry) {
                    if (!deferred) { u32x4 w; w.x = pkh(a[0], a[1]); w.y = pkh(a[2], a[3]); w.z = pkh(a[4], a[5]); w.w = pkh(a[6], a[7]); *(u32x4*)(ACT + (size_t)row * DFF + colg) = w; }
                    else { float* pg = SG + (size_t)(u.pm * 2 + fr) * DFF + colg; float* pv = SV + (size_t)(u.pm * 2 + fr) * DFF + colg;
                        *(f32x4*)pg = (f32x4){g[0], g[1], g[2], g[3]}; *(f32x4*)(pg + 4) = (f32x4){g[4], g[5], g[6], g[7]};
                        *(f32x4*)pv = acc[ai][1][m][0] * rr; *(f32x4*)(pv + 4) = acc[ai][1][m][1] * rr; }
                    if ((ai == 1 && m == 3) && wr == 1 && fr >= 14) { float* pl = SL + (size_t)(u.pm * 2 + fr - 14) * DFF + colg;
                        *(f32x4*)pl = (f32x4){g[0], g[1], g[2], g[3]}; *(f32x4*)(pl + 4) = (f32x4){g[4], g[5], g[6], g[7]}; } }
                __builtin_amdgcn_sched_barrier(0); }
        }
    }
};
__device__ __forceinline__ void act_fix_tile(const float* SG, const float* SV, const float* SL, const float* fcw, const float* fcb, h16* ACT, int pm, int tid, int dry) {
    constexpr int NCG = DFF / 8; const bool bs = (pm & 31) == 0;
    for (int it = tid; it < 2 * NCG; it += NTHR) { const int cg = it % NCG, rr = it / NCG, c0 = cg * 8;
        float y[8];
#pragma unroll
        for (int h = 0; h < 2; ++h) { const int c = c0 + 4 * h;
            const f32x4 g = *(const f32x4*)(SG + (size_t)(pm * 2 + rr) * DFF + c), v = *(const f32x4*)(SV + (size_t)(pm * 2 + rr) * DFF + c);
            f32x4 g1, g2; const f32x4 z = {0.f, 0.f, 0.f, 0.f};
            if (rr == 0) { g1 = bs ? z : *(const f32x4*)(SL + (size_t)((pm - 1) * 2 + 1) * DFF + c); g2 = bs ? z : *(const f32x4*)(SL + (size_t)((pm - 1) * 2) * DFF + c); }
            else { g1 = *(const f32x4*)(SG + (size_t)(pm * 2) * DFF + c); g2 = bs ? z : *(const f32x4*)(SL + (size_t)((pm - 1) * 2 + 1) * DFF + c); }
            const f32x4 a0 = *(const f32x4*)(fcw + c), a1 = *(const f32x4*)(fcw + DFF + c), a2 = *(const f32x4*)(fcw + 2 * DFF + c), b = *(const f32x4*)(fcb + c);
#pragma unroll
            for (int e = 0; e < 4; ++e) y[4 * h + e] = gelu_tanh(b[e] + a0[e] * g2[e] + a1[e] * g1[e] + a2[e] * g[e]) * v[e]; }
        u32x4 w; w.x = pkh(y[0], y[1]); w.y = pkh(y[2], y[3]); w.z = pkh(y[4], y[5]); w.w = pkh(y[6], y[7]);
        if (!dry) *(u32x4*)(ACT + (size_t)(pm * 256 + rr) * DFF + c0) = w; }
}

struct EpiGateSig {
    static constexpr bool PERM = true;
    const float* SSQ; h16* GS; int dry;
    __device__ __forceinline__ void operator()(AccRef acc, const pg8::Unit& u, int wr, int wc, int fr, int fq) const {
        const int row0 = u.pm * 256 + wr * 64 + fr, col0 = u.pn * 256 + wc * 32 + 8 * fq;
#pragma unroll
        for (int ai = 0; ai < 2; ++ai)
#pragma unroll
            for (int m = 0; m < 4; ++m) { const int row = row0 + ai * 128 + m * 16; const float r = __builtin_amdgcn_rsqf(SSQ[row] * (1.0f / DM) + EPS);
#pragma unroll
                for (int bj = 0; bj < 2; ++bj) { const f32x4 v0 = acc[ai][bj][m][0] * r, v1 = acc[ai][bj][m][1] * r;
                    u32x4 w; w.x = pkh(sigmoid_f(v0[0]), sigmoid_f(v0[1])); w.y = pkh(sigmoid_f(v0[2]), sigmoid_f(v0[3])); w.z = pkh(sigmoid_f(v1[0]), sigmoid_f(v1[1])); w.w = pkh(sigmoid_f(v1[2]), sigmoid_f(v1[3]));
                    if (!dry) *(u32x4*)(GS + (size_t)row * DM + col0 + bj * 128) = w; }
                __builtin_amdgcn_sched_barrier(0); }
    }
};
struct EpiPleOut {
    static constexpr bool PERM = true;
    const h16* GS; const h16* X2; float* C; int dry;
    __device__ __forceinline__ void operator()(AccRef acc, const pg8::Unit& u, int wr, int wc, int fr, int fq) const {
        const int row0 = u.pm * 256 + wr * 64 + fr, col0 = u.pn * 256 + wc * 32 + 8 * fq;
        const unsigned e0 = (unsigned)row0 * DM + (unsigned)col0;
#pragma unroll
        for (int ai = 0; ai < 2; ++ai)
#pragma unroll
            for (int m = 0; m < 4; ++m) { const unsigned eo = e0 + (unsigned)((ai * 128 + m * 16) * DM);
#pragma unroll
                for (int bj = 0; bj < 2; ++bj) { const unsigned o2 = eo + bj * 128;
                    const h8 gs = *(const h8*)((const char*)GS + (size_t)o2 * 2u), xb = *(const h8*)((const char*)X2 + (size_t)o2 * 2u); const f32x4 a0 = acc[ai][bj][m][0], a1 = acc[ai][bj][m][1];
                    f32x4 o0, o1;
#pragma unroll
                    for (int j = 0; j < 4; ++j) { o0[j] = (float)xb[j] + (float)gs[j] * a0[j]; o1[j] = (float)xb[4 + j] + (float)gs[4 + j] * a1[j]; }
                    if (!dry) { *(f32x4*)((char*)C + (size_t)o2 * 4u) = o0; *(f32x4*)((char*)C + (size_t)o2 * 4u + 16) = o1; } }
                asm volatile("" ::: "memory"); }
    }
};


#define XB_TMO      128
#define XB_XCNT(j)  (256  + 64 * (j))
#define XB_XSUB(j)  (1280 + 64 * (j))
#define XB_XGEN(j)  (2304 + 64 * (j))
#define XB_TOP      3328
#define XB_TOPGEN   3392
#define XCD_BAR_WORDS 3456
#define XB_SPIN_CAP (1u << 20)

__device__ __forceinline__ unsigned xb_ld(unsigned* p)              { return __hip_atomic_load(p, __ATOMIC_RELAXED, __HIP_MEMORY_SCOPE_AGENT); }
__device__ __forceinline__ unsigned xb_add(unsigned* p, unsigned v) { return __hip_atomic_fetch_add(p, v, __ATOMIC_RELAXED, __HIP_MEMORY_SCOPE_AGENT); }
__device__ __forceinline__ unsigned xb_xcc_id() { return (unsigned)__builtin_amdgcn_s_getreg((3 << 11) | 20) & 0xFu; }
#define XB_SPIN(cond, bar) do { unsigned _sp = 0; while (cond) { __builtin_amdgcn_s_sleep(1); \
    if ((++_sp & 255u) == 0u) { if (xb_ld(&(bar)[XB_TMO])) break; if (_sp > XB_SPIN_CAP) { atomicAdd(&(bar)[XB_TMO], 1u); break; } } } } while (0)

struct XcdBarrier { unsigned* bar; unsigned x; volatile LAS unsigned* st; };

__device__ __forceinline__ XcdBarrier xcd_barrier_post(unsigned* bar, volatile LAS unsigned* st) {
    XcdBarrier b; b.bar = bar; b.x = xb_xcc_id(); b.st = st;
    if (threadIdx.x == 0) (void)xb_add(&bar[XB_XCNT(b.x)], 1u);
    return b;
}
__device__ __forceinline__ void xcd_barrier_complete(unsigned* bar, unsigned x, unsigned& nloc, unsigned& nx) {
    const unsigned G = gridDim.x * gridDim.y * gridDim.z;
    unsigned sum, cnt, mine, sp = 0u;
    for (;;) {
        sum = 0u; cnt = 0u; mine = 0u;
#pragma unroll
        for (unsigned j = 0; j < 16; ++j) { const unsigned c = xb_ld(&bar[XB_XCNT(j)]); sum += c; cnt += (c > 0u) ? 1u : 0u; mine = (j == x) ? c : mine; }
        if (sum == G) break;
        __builtin_amdgcn_s_sleep(1);
        if ((++sp & 255u) == 0u) { if (xb_ld(&bar[XB_TMO])) break; if (sp > XB_SPIN_CAP) { atomicAdd(&bar[XB_TMO], 1u); break; } }
    }
    nloc = mine > 0u ? mine : 1u; nx = cnt > 0u ? cnt : 1u;
}
__device__ __forceinline__ void xcd_barrier(const XcdBarrier& b) {
    asm volatile("s_waitcnt vmcnt(0)" ::: "memory");
    __syncthreads();
    if (threadIdx.x == 0) {
        unsigned* bar = b.bar;
        __builtin_amdgcn_s_waitcnt(0);
        unsigned nloc = b.st[0], nx = b.st[1];
        if (nloc == 0u) { xcd_barrier_complete(bar, b.x, nloc, nx); b.st[0] = nloc; b.st[1] = nx; }
        const unsigned old = xb_add(&bar[XB_XSUB(b.x)], 1u);
        const unsigned gen = old / nloc;
        if (old + 1u == (gen + 1u) * nloc) {
            __builtin_amdgcn_fence(__ATOMIC_RELEASE, "agent");
            asm volatile("s_waitcnt vmcnt(0)" ::: "memory");
            const unsigned og = xb_add(&bar[XB_TOP], 1u);
            const unsigned tg = og / nx;
            if (og + 1u == (tg + 1u) * nx) xb_add(&bar[XB_TOPGEN], 1u);
            else XB_SPIN(xb_ld(&bar[XB_TOPGEN]) == tg, bar);
            __builtin_amdgcn_fence(__ATOMIC_ACQUIRE, "agent");
            xb_add(&bar[XB_XGEN(b.x)], 1u);
            asm volatile("s_waitcnt vmcnt(0)" ::: "memory");
        } else {
            XB_SPIN(xb_ld(&bar[XB_XGEN(b.x)]) == gen, bar);
            __builtin_amdgcn_fence(__ATOMIC_ACQUIRE, "agent");
            asm volatile("s_waitcnt vmcnt(0)" ::: "memory");
        }
    }
    __syncthreads();
}

constexpr size_t MiB = 1u << 20;
constexpr size_t WS_CTL = 0, CTL_ZERO_BYTES = 1 * MiB;
constexpr size_t WS_SA = 1 * MiB, WS_SH = 2 * MiB;
constexpr size_t WS_WI = 3 * MiB;
constexpr size_t WS_KI = 4 * MiB;
constexpr size_t WS_W = 8 * MiB;
constexpr size_t W_IN = WS_W, W_LRU = W_IN + (size_t)NIN_PAD * DM * 2, W_ATT = W_LRU + 2 * MiB, W_OUT = W_ATT + 2 * MiB, W_PG = W_OUT + 2 * MiB,
                 W_UP = W_PG + 2 * MiB, W_DOWN = W_UP + 12 * MiB, W_PP = W_DOWN + 6 * MiB, W_GATE = W_PP + MiB / 2, W_END = W_GATE + MiB / 2;
static_assert(W_END <= 48 * MiB, "weights region");
constexpr size_t WS_A0 = 48 * MiB;
constexpr size_t WS_IDX = 48 * MiB, WS_NV = 64 * MiB;
constexpr size_t WS_K8 = 72 * MiB, WS_V8 = 80 * MiB;
constexpr size_t WS_T1 = 48 * MiB;
constexpr size_t WS_X1H = 48 * MiB;
constexpr size_t WS_PH = 112 * MiB;
constexpr size_t WS_LX = 128 * MiB;
constexpr size_t WS_GG = 192 * MiB;
constexpr size_t WS_Q = 256 * MiB;
constexpr size_t WS_K = 320 * MiB, WS_V = 336 * MiB;
constexpr size_t WS_QI = 352 * MiB;
constexpr size_t WS_SGA = 384 * MiB, WS_SGB = 448 * MiB;
constexpr size_t WS_UPG = 128 * MiB, WS_UPV = 320 * MiB;
constexpr size_t WS_X2H = 128 * MiB;
constexpr size_t WS_GS = 320 * MiB;
constexpr size_t WS_END = 512 * MiB;
constexpr int CW_BAR = 1024;
constexpr int CW_Q2 = 8192, CW_Q3 = 8192 + 256;
constexpr size_t CTL_SSQ1 = 256 * 1024, CTL_SSQ2 = 512 * 1024;
static_assert((CW_BAR + XCD_BAR_WORDS) * 4 <= 32768 && CTL_SSQ2 + MTOK * 4 <= CTL_ZERO_BYTES, "ctl map");

constexpr int LDS_BYTES = 159744;
constexpr int MISC_OFF = LDS_BYTES - 256;

struct Params {
    const float* in[25]; float* out; unsigned char* ws; int ph_lo, ph_hi, k_ple, pad;
};

__device__ __forceinline__ float wave_sum(float v) {
#pragma unroll
    for (int o = 1; o < 64; o <<= 1) v += __shfl_xor(v, o);
    return v;
}
template <int MAP> __device__ __forceinline__ int rowmap(int n) {
    if (MAP == 1) return n < 4168 ? n : n + 184;
    if (MAP == 2) return n < DFF ? ((n >> 7) * 256 + (n & 127)) : (((n - DFF) >> 7) * 256 + 128 + ((n - DFF) & 127));
    return n;
}
template <int MAP> __device__ __forceinline__ void p0_transpose_item(const float* W, int K, int N, h16* WT, const float* gain, LAS float* scr, int item, int lane) {
    const int nblk = (N + 31) / 32, kb = item / nblk, nb = item % nblk, k0 = 64 * kb, n0 = 32 * nb;
    const int nn = n0 + (lane & 31);
#pragma unroll 8
    for (int i = 0; i < 32; ++i) { const int kk = 2 * i + (lane >> 5); float v = 0.f; if (nn < N) v = W[(size_t)(k0 + kk) * N + nn]; if (gain) v *= gain[k0 + kk]; scr[kk * 33 + (lane & 31)] = v; }
    LDS_WAIT(); asm volatile("" ::: "memory");
    const int c = lane & 7;
#pragma unroll
    for (int j = 0; j < 4; ++j) { const int n = (lane >> 3) + 8 * j; const LAS float* s = scr + (8 * c) * 33 + n;
        u32x4 o; o.x = pkh(s[0 * 33], s[1 * 33]); o.y = pkh(s[2 * 33], s[3 * 33]); o.z = pkh(s[4 * 33], s[5 * 33]); o.w = pkh(s[6 * 33], s[7 * 33]);
        if (n0 + n < N) *(u32x4*)(WT + (size_t)rowmap<MAP>(n0 + n) * K + k0 + 8 * c) = o; }
    LDS_WAIT(); asm volatile("" ::: "memory");
}

struct Ctx {
    unsigned char* ws; float* out; int dry;
    const float *conv_w, *conv_b, *ba, *bx, *lam, *qn, *kn, *relb, *fcw, *fcb;
};
__device__ __forceinline__ unsigned ordered_u32(float v) { const unsigned u = __builtin_bit_cast(unsigned, v); return u ^ ((unsigned)((int)u >> 31) | 0x80000000u); }

constexpr int UA_STR = 272;
constexpr int LRU_UA = 0, LRU_HL = 128 * UA_STR, LRU_PP = 2 * 128 * UA_STR;
__device__ __forceinline__ void lru1_item(const Ctx& C, LAS unsigned char* lds, int item) {
    int tid = threadIdx.x; asm volatile("" : "+v"(tid));
    const int lane = tid & 63, wv = tid >> 6;
    const int b = item >> 7, n = (item >> 4) & 7, jg = item & 15;
    const h16* LX = (const h16*)(C.ws + WS_LX);
    const int cg = tid & 15, rg = tid >> 4, ch0 = n * 128 + cg * 8, tl = rg * 4;
    float cb[8], cw[4][8];
    { const f32x4 t0 = *(const f32x4*)(C.conv_b + ch0), t1 = *(const f32x4*)(C.conv_b + ch0 + 4); for (int e = 0; e < 4; ++e) { cb[e] = t0[e]; cb[4 + e] = t1[e]; } }
#pragma unroll
    for (int jj = 0; jj < 4; ++jj) { const f32x4 w0 = *(const f32x4*)(C.conv_w + jj * DM + ch0), w1 = *(const f32x4*)(C.conv_w + jj * DM + ch0 + 4); for (int e = 0; e < 4; ++e) { cw[jj][e] = w0[e]; cw[jj][4 + e] = w1[e]; } }
    const int q = lane & 15, c = lane >> 4, oc = wv * 16 + q, ch = n * 128 + oc;
    const h16* WG = (const h16*)(C.ws + W_GATE) + (size_t)n * 256 * 128;
    h8 Ba[4], Bx[4];
#pragma unroll
    for (int ks = 0; ks < 4; ++ks) { Ba[ks] = *(const h8*)(WG + (size_t)oc * 128 + 32 * ks + 8 * c); Bx[ks] = *(const h8*)(WG + (size_t)(128 + oc) * 128 + 32 * ks + 8 * c); }
    const float bav = C.ba[ch], bxv = C.bx[ch], m8sp = -8.0f * 1.4426950408889634f * log1pf(expf(-C.lam[ch]));
#pragma unroll 1
    for (int j4 = 0; j4 < 4; ++j4) {
    const int j = jg * 4 + j4;
    const size_t mrow0 = (size_t)b * SEQ + (size_t)j * 128;
    {
        const int tseq = j * 128 + tl;
        h8 xr[7];
#pragma unroll
        for (int i = 0; i < 7; ++i) { const int tt = tseq - 3 + i; if (tt >= 0) xr[i] = *(const h8*)(LX + ((size_t)b * SEQ + tt) * DM + ch0); else { for (int e = 0; e < 8; ++e) xr[i][e] = (h16)0.f; } }
        float y[4][8];
#pragma unroll
        for (int r = 0; r < 4; ++r)
#pragma unroll
            for (int e = 0; e < 8; ++e) y[r][e] = cb[e];
#pragma unroll
        for (int jj = 0; jj < 4; ++jj)
#pragma unroll
            for (int r = 0; r < 4; ++r)
#pragma unroll
                for (int e = 0; e < 8; ++e) y[r][e] += cw[jj][e] * (float)xr[r + jj][e];
#pragma unroll
        for (int r = 0; r < 4; ++r) { u32x4 w; w.x = pkh(y[r][0], y[r][1]); w.y = pkh(y[r][2], y[r][3]); w.z = pkh(y[r][4], y[r][5]); w.w = pkh(y[r][6], y[r][7]);
            *(LAS u32x4*)(lds + LRU_UA + (tl + r) * UA_STR + cg * 16) = w; }
    }
    __syncthreads();
    {
        float cH = 0.f, cP = 1.f;
        for (int tt = 0; tt < 8; ++tt) {
            f32x4 aa = {0.f, 0.f, 0.f, 0.f}, ax = {0.f, 0.f, 0.f, 0.f};
#pragma unroll
            for (int ks = 0; ks < 4; ++ks) { const h8 A = *(const LAS h8*)(lds + LRU_UA + (16 * tt + q) * UA_STR + (32 * ks + 8 * c) * 2);
                aa = __builtin_amdgcn_mfma_f32_16x16x32_f16(A, Ba[ks], aa, 0, 0, 0); ax = __builtin_amdgcn_mfma_f32_16x16x32_f16(A, Bx[ks], ax, 0, 0, 0); }
            float hl[4], pl[4]; float h = 0.f, p = 1.f;
#pragma unroll
            for (int i = 0; i < 4; ++i) { const int t = 16 * tt + 4 * c + i;
                const float uav = (float)*(const LAS h16*)(lds + LRU_UA + t * UA_STR + oc * 2);
                const float ra = sigmoid_f(aa[i] + bav), ix = sigmoid_f(ax[i] + bxv);
                const float a = __builtin_amdgcn_exp2f(m8sp * ra);
                const float mult = __builtin_amdgcn_sqrtf(fmaxf(1.0f - a * a, 0.f));
                const float u = mult * ix * uav;
                h = a * h + u; p *= a; hl[i] = h; pl[i] = p; }
            float Ak[4], Hk[4];
#pragma unroll
            for (int k = 0; k < 4; ++k) { Ak[k] = __shfl(p, q + 16 * k); Hk[k] = __shfl(h, q + 16 * k); }
            float PA = 1.f, PH = 0.f;
#pragma unroll
            for (int k = 0; k < 3; ++k) if (k < c) { PH = PH * Ak[k] + Hk[k]; PA *= Ak[k]; }
            const float hin = cH * PA + PH, pin = cP * PA;
#pragma unroll
            for (int i = 0; i < 4; ++i) { const int t = 16 * tt + 4 * c + i;
                *(LAS h16*)(lds + LRU_HL + t * UA_STR + oc * 2) = (h16)(hl[i] + pl[i] * hin);
                *(LAS h16*)(lds + LRU_PP + t * UA_STR + oc * 2) = (h16)(pin * pl[i]); }
            const float AT = Ak[0] * Ak[1] * Ak[2] * Ak[3], HT = ((Hk[0] * Ak[1] + Hk[1]) * Ak[2] + Hk[2]) * Ak[3] + Hk[3];
            cH = cH * AT + HT; cP = cP * AT;
        }
        if (c == 0 && !C.dry) { const size_t so = ((size_t)b * 64 + j) * DM + ch; ((float*)(C.ws + WS_SA))[so] = cP; ((float*)(C.ws + WS_SH))[so] = cH; }
    }
    __syncthreads();
    {
        h16* HLOC = (h16*)C.out; h16* PPRD = (h16*)C.out + (size_t)MTOK * DM;
#pragma unroll
        for (int r = 0; r < 4; ++r) { const int t = rg * 4 + r; const size_t go = (mrow0 + t) * DM + n * 128 + cg * 8;
            const u32x4 w0 = *(const LAS u32x4*)(lds + LRU_HL + t * UA_STR + cg * 16), w1 = *(const LAS u32x4*)(lds + LRU_PP + t * UA_STR + cg * 16);
            if (!C.dry) { *(u32x4*)(HLOC + go) = w0; *(u32x4*)(PPRD + go) = w1; } }
    }
    __syncthreads();
    }
}

__device__ __forceinline__ void lru2_item(const Ctx& C, LAS unsigned char* lds, int item) {
    int tid = threadIdx.x; asm volatile("" : "+v"(tid));
    const int b = item >> 7, n = (item >> 4) & 7, jg = item & 15, j0 = jg * 4;
    LAS float* carry = (LAS float*)lds;
    if (tid < 128) { const int ch = n * 128 + tid; const float* SA = (const float*)(C.ws + WS_SA) + (size_t)b * 64 * DM + ch; const float* SH = (const float*)(C.ws + WS_SH) + (size_t)b * 64 * DM + ch;
        float cr = 0.f; int jj = 0;
        for (; jj + 8 <= j0; jj += 8) { float a8[8], h8v[8];
#pragma unroll
            for (int k = 0; k < 8; ++k) { a8[k] = SA[(size_t)(jj + k) * DM]; h8v[k] = SH[(size_t)(jj + k) * DM]; }
#pragma unroll
            for (int k = 0; k < 8; ++k) cr = a8[k] * cr + h8v[k]; }
        for (; jj < j0; ++jj) cr = SA[(size_t)jj * DM] * cr + SH[(size_t)jj * DM];
        float a4[4], h4[4];
#pragma unroll
        for (int k = 0; k < 4; ++k) { a4[k] = SA[(size_t)(j0 + k) * DM]; h4[k] = SH[(size_t)(j0 + k) * DM]; }
#pragma unroll
        for (int k = 0; k < 4; ++k) { carry[k * 128 + tid] = cr; cr = a4[k] * cr + h4[k]; } }
    __syncthreads();
    const int cg = tid & 15, rg = tid >> 4; const h16* HLOC = (const h16*)C.out; const h16* PPRD = (const h16*)C.out + (size_t)MTOK * DM;
    const h16* GG = (const h16*)(C.ws + WS_GG); h16* YA = (h16*)(C.ws + WS_LX);
#pragma unroll 1
    for (int k = 0; k < 4; ++k) {
        float cr[8];
#pragma unroll
        for (int e = 0; e < 8; ++e) cr[e] = carry[k * 128 + cg * 8 + e];
#pragma unroll
        for (int r = 0; r < 4; ++r) { const size_t go = ((size_t)b * SEQ + (j0 + k) * 128 + rg * 4 + r) * DM + n * 128 + cg * 8;
            const h8 hl = *(const h8*)(HLOC + go), pp = *(const h8*)(PPRD + go), gg = *(const h8*)(GG + go);
            float y[8];
#pragma unroll
            for (int e = 0; e < 8; ++e) y[e] = ((float)hl[e] + (float)pp[e] * cr[e]) * (float)gg[e];
            u32x4 w; w.x = pkh(y[0], y[1]); w.y = pkh(y[2], y[3]); w.z = pkh(y[4], y[5]); w.w = pkh(y[6], y[7]);
            if (!C.dry) *(u32x4*)(YA + go) = w; } }
}

__device__ __forceinline__ unsigned pk4_fp8_k(float a, float b, float c, float d) { int w = 0; w = __builtin_amdgcn_cvt_pk_fp8_f32(a, b, w, false); w = __builtin_amdgcn_cvt_pk_fp8_f32(c, d, w, true); return (unsigned)w; }
__device__ __forceinline__ void knorm_unit(const Ctx& C, int unit) {
    int tid = threadIdx.x; asm volatile("" : "+v"(tid));
    const int lane = tid & 63, wv = tid >> 6;
    const h16* K = (const h16*)(C.ws + WS_K); const h16* V = (const h16*)(C.ws + WS_V);
    unsigned* K8 = (unsigned*)(C.ws + WS_K8); unsigned* V8 = (unsigned*)(C.ws + WS_V8);
    const int col = lane * 4, d0 = col & 127;
    const f32x4 g = *(const f32x4*)(C.kn + d0);
    for (int r = 0; r < 16; ++r) { const size_t row = (size_t)unit * 128 + wv * 16 + r;
        const h4 v = *(const h4*)(K + row * 256 + col), vv = *(const h4*)(V + row * 256 + col);
        float ss = 0.f, f[4];
#pragma unroll
        for (int e = 0; e < 4; ++e) { f[e] = (float)v[e]; ss += f[e] * f[e]; }
#pragma unroll
        for (int o = 1; o < 32; o <<= 1) ss += __shfl_xor(ss, o);
        const float rs = __builtin_amdgcn_rsqf(ss * (1.0f / 128.0f) + EPS);
        const unsigned wk = pk4_fp8_k(f[0] * rs * g[0], f[1] * rs * g[1], f[2] * rs * g[2], f[3] * rs * g[3]);
        const unsigned wvv = pk4_fp8_k((float)vv[0], (float)vv[1], (float)vv[2], (float)vv[3]);
        if (!C.dry) { K8[row * 64 + lane] = wk; V8[row * 64 + lane] = wvv; } }
}

#ifdef IX_PROBE
#define IX_PROBE_FINAL (C.dry && (IX_PROBE & 2))
#define IX_PROBE_NOFILT (C.dry && (IX_PROBE & 1))
#else
#define IX_PROBE_FINAL 0
#define IX_PROBE_NOFILT 0
#endif
constexpr int IX_SK = 256;
constexpr int IX_CAP = 1024;
constexpr int IX_ORD = 0;
constexpr int IX_KEY = IX_ORD + 16 * IX_CAP * 4;
constexpr int IX_HIST = IX_KEY + 16 * IX_CAP * 2;
constexpr int IX_CTR = IX_HIST + 8 * 512;
constexpr int IX_END = IX_CTR + 128;
static_assert(IX_END <= MISC_OFF, "indexer LDS");
constexpr int IX_NE = IX_CAP / 64;

struct IxBuf { LAS unsigned* ord; LAS unsigned short* key; };
#define IX_DPPMAX(v, ctl, rm) { const unsigned t_ = (unsigned)__builtin_amdgcn_update_dpp((int)(v), (int)(v), ctl, rm, 0xf, false); v = t_ > v ? t_ : v; }
__device__ __forceinline__ unsigned ix_rowmax(unsigned v) { IX_DPPMAX(v, 0xB1, 0xf) IX_DPPMAX(v, 0x4E, 0xf) IX_DPPMAX(v, 0x141, 0xf) IX_DPPMAX(v, 0x140, 0xf) return v; }
__device__ __forceinline__ unsigned ix_wavemax(unsigned v) { v = ix_rowmax(v); IX_DPPMAX(v, 0x142, 0xa) IX_DPPMAX(v, 0x143, 0xc) return (unsigned)__builtin_amdgcn_readlane((int)v, 63); }
__device__ __forceinline__ void ix_load_ord(const IxBuf& B, int cnt, int lane, unsigned (&o)[IX_NE]) {
#pragma unroll
    for (int k = 0; k < IX_NE; ++k) { const int idx = k * 64 + lane; o[k] = idx < cnt ? B.ord[idx] : 0u; }
}
__device__ __forceinline__ int ix_count_ge(const unsigned (&o)[IX_NE], unsigned x) {
    int c = 0;
#pragma unroll
    for (int k = 0; k < IX_NE; ++k) c += (int)__builtin_popcountll(__ballot(o[k] >= x));
    return c;
}
__device__ __forceinline__ unsigned ix_max(const unsigned (&o)[IX_NE]) {
    unsigned m = 0u;
#pragma unroll
    for (int k = 0; k < IX_NE; ++k) m = o[k] > m ? o[k] : m;
    return ix_wavemax(m);
}
__device__ __forceinline__ unsigned ix_tie_thr(const unsigned (&o)[IX_NE], const unsigned short (&kk)[IX_NE], unsigned x, int need) {
    unsigned lo = 0u, hi = 0x10000u;
    while (hi - lo > 1u) { const unsigned mid = (lo + hi) >> 1; int c = 0;
#pragma unroll
        for (int k = 0; k < IX_NE; ++k) c += (int)__builtin_popcountll(__ballot(o[k] == x && (unsigned)kk[k] >= mid));
        if (c >= need) lo = mid; else hi = mid; }
    return lo;
}
__device__ __forceinline__ int ix_rewrite(const IxBuf& B, const unsigned (&o)[IX_NE], const unsigned short (&kk)[IX_NE], int lane, unsigned x, unsigned th) {
    int base = 0;
#pragma unroll
    for (int k = 0; k < IX_NE; ++k) { const bool keep = o[k] > x || (o[k] == x && (unsigned)kk[k] >= th);
        const u64 m = __ballot(keep); const int pos = base + (int)__builtin_amdgcn_mbcnt_hi((unsigned)(m >> 32), __builtin_amdgcn_mbcnt_lo((unsigned)m, 0u));
        if (keep) { B.ord[pos] = o[k]; B.key[pos] = kk[k]; }
        base += (int)__builtin_popcountll(m); }
    LDS_WAIT();
    return base;
}
__device__ __forceinline__ unsigned ix_sample_pivot(unsigned s0, int rank) {
    int r = 0;
#define IX_ROT(n) { const unsigned t_ = (unsigned)__builtin_amdgcn_update_dpp(0, (int)s0, 0x120 + n, 0xf, 0xf, false); r += t_ > s0 ? 1 : 0; }
    IX_ROT(1) IX_ROT(2) IX_ROT(3) IX_ROT(4) IX_ROT(5) IX_ROT(6) IX_ROT(7) IX_ROT(8) IX_ROT(9) IX_ROT(10) IX_ROT(11) IX_ROT(12) IX_ROT(13) IX_ROT(14) IX_ROT(15)
#undef IX_ROT
    unsigned v = r >= rank ? s0 : 0u;
    v = ix_rowmax(v);
    return ((unsigned)__builtin_amdgcn_readlane((int)v, 0) >> 2) + ((unsigned)__builtin_amdgcn_readlane((int)v, 16) >> 2) + ((unsigned)__builtin_amdgcn_readlane((int)v, 32) >> 2) + ((unsigned)__builtin_amdgcn_readlane((int)v, 48) >> 2);
}
__device__ __forceinline__ unsigned ix_find_window(const unsigned (&o)[IX_NE], unsigned lo, unsigned hi, int cnt, int cmin, int cmax, bool& tie) {
    tie = false;
    int rank = (16 * ((cmin + cmax) / 2)) / cnt; rank = rank > 14 ? 14 : rank;
    unsigned x = ix_sample_pivot(o[0], rank);
    if (x <= lo || x >= hi) x = lo + ((hi - lo) >> 1);
    for (;;) { const int c = ix_count_ge(o, x);
        if (c > cmax) lo = x; else if (c < cmin) hi = x; else return x - 1u;
        if (hi - lo <= 1u) { tie = true; return lo; }
        x = lo + ((hi - lo) >> 1); }
}
__device__ __forceinline__ unsigned ix_compact(const IxBuf& B, int lane, int& cnt, unsigned T) {
    unsigned o[IX_NE]; ix_load_ord(B, cnt, lane, o);
    unsigned short kk[IX_NE];
#pragma unroll
    for (int k = 0; k < IX_NE; ++k) kk[k] = B.key[k * 64 + lane];
    LDS_WAIT();
    bool tie; unsigned th = 0x10000u;
    const unsigned x = ix_find_window(o, T, ix_max(o) + 1u, cnt, 256, 512, tie);
    if (tie) th = ix_tie_thr(o, kk, x, 512 - ix_count_ge(o, x + 1u));
    cnt = ix_rewrite(B, o, kk, lane, x, th); return x + 1u;
}
__device__ __forceinline__ unsigned ix_compact_to(const IxBuf& B, int lane, int& cnt, unsigned T) {
    unsigned o[IX_NE]; ix_load_ord(B, cnt, lane, o);
    unsigned short kk[IX_NE];
#pragma unroll
    for (int k = 0; k < IX_NE; ++k) kk[k] = B.key[k * 64 + lane];
    LDS_WAIT();
    bool tie; unsigned th = 0x10000u;
    const unsigned x = ix_find_window(o, T, ix_max(o) + 1u, cnt, 256, 320, tie);
    if (tie) th = ix_tie_thr(o, kk, x, 320 - ix_count_ge(o, x + 1u));
    cnt = ix_rewrite(B, o, kk, lane, x, th); return x + 1u;
}
__device__ __forceinline__ void ix_final(const IxBuf& B, LAS unsigned short* outl, int lane, int cnt, unsigned T, unsigned short* idx_row, int* nv_ptr, int dry) {
    if (cnt > 320) { cnt = cnt < IX_CAP ? cnt : IX_CAP; T = ix_compact_to(B, lane, cnt, T); }
    unsigned o[5]; unsigned short kk[5];
#pragma unroll
    for (int k = 0; k < 5; ++k) { const int idx = k * 64 + lane; o[k] = idx < cnt ? B.ord[idx] : 0u; kk[k] = B.key[idx]; }
    LDS_WAIT();
    unsigned x = 0u, th = 0u;
    if (cnt > 256) { unsigned mxv = 0u;
#pragma unroll
        for (int k = 0; k < 5; ++k) mxv = o[k] > mxv ? o[k] : mxv;
        mxv = ix_wavemax(mxv);
        unsigned lo = T, hi = mxv + 1u;
        for (;;) { if (hi - lo <= 1u) { x = lo; int ca = 0, need;
#pragma unroll
                for (int k = 0; k < 5; ++k) ca += (int)__builtin_popcountll(__ballot(o[k] >= lo + 1u));
                need = 256 - ca; unsigned tl = 0u, thh = 0x10000u;
                while (thh - tl > 1u) { const unsigned mid = (tl + thh) >> 1; int c = 0;
#pragma unroll
                    for (int k = 0; k < 5; ++k) c += (int)__builtin_popcountll(__ballot(o[k] == x && (unsigned)kk[k] >= mid));
                    if (c >= need) tl = mid; else thh = mid; }
                th = tl; break; }
            const unsigned mid = lo + ((hi - lo) >> 1); int c = 0;
#pragma unroll
            for (int k = 0; k < 5; ++k) c += (int)__builtin_popcountll(__ballot(o[k] >= mid));
            if (c == 256) { x = mid - 1u; th = 0x10000u; break; }
            if (c > 256) lo = mid; else hi = mid; } }
    int base = 0;
#pragma unroll
    for (int k = 0; k < 5; ++k) { const bool valid = k * 64 + lane < cnt; const bool sel = valid && (o[k] > x || (o[k] == x && (unsigned)kk[k] >= th));
        const u64 m = __ballot(sel); const int pos = base + (int)__builtin_amdgcn_mbcnt_hi((unsigned)(m >> 32), __builtin_amdgcn_mbcnt_lo((unsigned)m, 0u));
        if (sel && pos < 256) outl[pos] = (unsigned short)(0xFFFFu - (unsigned)kk[k]);
        base += (int)__builtin_popcountll(m); }
    LDS_WAIT();
    const int nsel = base < 256 ? base : 256;
    const u32x2 ow = *(const LAS u32x2*)(outl + lane * 4);
    if (!dry) { *(u32x2*)(idx_row + lane * 4) = ow; if (lane == 0) *nv_ptr = nsel; }
    LDS_WAIT();
}
__device__ __forceinline__ float ix_unordered(unsigned T) { const unsigned u = (T & 0x80000000u) ? (T ^ 0x80000000u) : ~T; return __builtin_bit_cast(float, u); }

__device__ __forceinline__ void indexer_unit(const Ctx& C, LAS unsigned char* lds, int unit) {
    int tid = threadIdx.x; asm volatile("" : "+v"(tid));
    const int lane = tid & 63, wv = __builtin_amdgcn_readfirstlane(tid >> 6);
    const int b = unit & 3, qt = 511 - (unit >> 2), t0 = qt * 16;
    const int q = lane & 15, c = lane >> 4;
    const size_t m0 = (size_t)b * SEQ + t0;
    const h16* QI = (const h16*)(C.ws + WS_QI); const h16* KI = (const h16*)(C.ws + WS_KI) + (size_t)b * SEQ * 64; const float* WI = (const float*)(C.ws + WS_WI);
    LAS unsigned* cntl = (LAS unsigned*)(lds + IX_CTR); volatile LAS float* taul = (volatile LAS float*)(lds + IX_CTR + 64);
    if (tid < 16) { cntl[tid] = 0u; taul[tid] = -3.402823466e38f; }
    h8 qf[8][2];
#pragma unroll
    for (int h = 0; h < 8; ++h)
#pragma unroll
        for (int ks = 0; ks < 2; ++ks) qf[h][ks] = *(const h8*)(QI + ((((m0 >> 4) * 8 + h) * 2 + ks) * 64 + lane) * 8);
    float wvv[8]; { const f32x4 w0 = *(const f32x4*)(WI + (m0 + q) * 8), w1 = *(const f32x4*)(WI + (m0 + q) * 8 + 4); for (int e = 0; e < 4; ++e) { wvv[e] = w0[e]; wvv[4 + e] = w1[e]; } }
#pragma unroll
    for (int h = 0; h < 8; ++h) wvv[h] *= 0.5f;
    h8 qs[2];
#pragma unroll
    for (int ks = 0; ks < 2; ++ks)
#pragma unroll
        for (int j = 0; j < 8; ++j) { float a = 0.f;
#pragma unroll
            for (int h = 0; h < 8; ++h) a += wvv[h] * (float)qf[h][ks][j];
            qs[ks][j] = (h16)a; }
    const int nkeys = t0 + 16, nslab = (nkeys + IX_SK - 1) / IX_SK;
    LAS unsigned* ordq = (LAS unsigned*)(lds + IX_ORD) + (size_t)q * IX_CAP; LAS unsigned short* keyq = (LAS unsigned short*)(lds + IX_KEY) + (size_t)q * IX_CAP;
    IxBuf BA, BB;
    BA.ord = (LAS unsigned*)(lds + IX_ORD) + (size_t)(2 * wv) * IX_CAP; BA.key = (LAS unsigned short*)(lds + IX_KEY) + (size_t)(2 * wv) * IX_CAP;
    BB.ord = BA.ord + IX_CAP; BB.key = BA.key + IX_CAP;
    LAS unsigned short* outl = (LAS unsigned short*)(lds + IX_HIST) + wv * 256;
    unsigned TA = 0x00800000u, TB = 0x00800000u; float tq = -3.402823466e38f;
    __syncthreads();
#define IX_LOADK(dst, s_) do { const int sc_ = (s_) < nslab - 1 ? (s_) : nslab - 1; _Pragma("unroll") for (int jt_ = 0; jt_ < 2; ++jt_) { int key0_ = sc_ * IX_SK + 32 * wv + 16 * jt_; key0_ = key0_ < nkeys ? key0_ : nkeys - 16; \
        const h16* p_ = KI + ((size_t)(key0_ >> 4) * 128 + lane) * 8;        \
        asm volatile("global_load_dwordx4 %0, %2, off\n\tglobal_load_dwordx4 %1, %2, off offset:1024" : "=&v"(dst[jt_][0]), "=&v"(dst[jt_][1]) : "v"(p_) : "memory"); } } while (0)
#define IX_WAITK(KF) asm volatile("s_waitcnt vmcnt(4)" : "+v"(KF[0][0]), "+v"(KF[0][1]), "+v"(KF[1][0]), "+v"(KF[1][1]) :: "memory")
#define IX_MM2(KF, A_, B_, Q0, Q1) do { A_ = __builtin_amdgcn_mfma_f32_16x16x32_f16(KF[0][0], Q0, (f32x4){0.f, 0.f, 0.f, 0.f}, 0, 0, 0); B_ = __builtin_amdgcn_mfma_f32_16x16x32_f16(KF[1][0], Q0, (f32x4){0.f, 0.f, 0.f, 0.f}, 0, 0, 0); \
        A_ = __builtin_amdgcn_mfma_f32_16x16x32_f16(KF[0][1], Q1, A_, 0, 0, 0); B_ = __builtin_amdgcn_mfma_f32_16x16x32_f16(KF[1][1], Q1, B_, 0, 0, 0); } while (0)
#define IX_SCORE2(KF, sca, scb) do { \
        f32x4 ta_[2], tb_[2]; \
        IX_MM2(KF, sca, scb, qs[0], qs[1]); IX_MM2(KF, ta_[0], tb_[0], qf[0][0], qf[0][1]); \
        _Pragma("unroll") for (int h = 0; h < 8; ++h) {        \
            __builtin_amdgcn_sched_barrier(0); \
            if (h < 7) IX_MM2(KF, ta_[(h + 1) & 1], tb_[(h + 1) & 1], qf[h + 1][0], qf[h + 1][1]); \
            __builtin_amdgcn_sched_barrier(0); \
            _Pragma("unroll") for (int i = 0; i < 4; ++i) { sca[i] = __builtin_fmaf(wvv[h], __builtin_fabsf(ta_[h & 1][i]), sca[i]); asm("" : "+v"(sca[i])); }   \
            _Pragma("unroll") for (int i = 0; i < 4; ++i) { scb[i] = __builtin_fmaf(wvv[h], __builtin_fabsf(tb_[h & 1][i]), scb[i]); asm("" : "+v"(scb[i])); } } \
        __builtin_amdgcn_sched_barrier(0); } while (0)
#define IX_SCORE(KF, sc, jt, key0) do { \
        sc = __builtin_amdgcn_mfma_f32_16x16x32_f16(KF[jt][0], qs[0], (f32x4){0.f, 0.f, 0.f, 0.f}, 0, 0, 0); sc = __builtin_amdgcn_mfma_f32_16x16x32_f16(KF[jt][1], qs[1], sc, 0, 0, 0); \
        _Pragma("unroll") for (int h = 0; h < 8; ++h) { f32x4 a = {0.f, 0.f, 0.f, 0.f}; \
            a = __builtin_amdgcn_mfma_f32_16x16x32_f16(KF[jt][0], qf[h][0], a, 0, 0, 0); a = __builtin_amdgcn_mfma_f32_16x16x32_f16(KF[jt][1], qf[h][1], a, 0, 0, 0); \
            _Pragma("unroll") for (int i = 0; i < 4; ++i) { sc[i] = __builtin_fmaf(wvv[h], __builtin_fabsf(a[i]), sc[i]); asm("" : "+v"(sc[i])); } } } while (0)
#define IX_MASK(sc, key0) do { if ((key0) + 15 > t0) {        \
            _Pragma("unroll") for (int i = 0; i < 4; ++i) if ((key0) + 4 * c + i > t0 + q) sc[i] = -INFINITY; } } while (0)
#define IX_ASK(sc, ps, pos) do { _Pragma("unroll") for (int i = 0; i < 4; ++i) { ps[i] = sc[i] >= tq; pos[i] = 0u; if (ps[i]) pos[i] = __hip_atomic_fetch_add(cntl + q, 1u, __ATOMIC_RELAXED, __HIP_MEMORY_SCOPE_WORKGROUP); } } while (0)
#define IX_PUT(sc, ps, pos, key0) do { _Pragma("unroll") for (int i = 0; i < 4; ++i) if (ps[i]) { ordq[pos[i]] = ordered_u32(sc[i] + 0.0f); keyq[pos[i]] = (unsigned short)(0xFFFFu - (unsigned)((key0) + 4 * c + i)); } } while (0)
#define IX_STEP(sv, KF) do { const int s_ = (sv); if (s_ < nslab) { \
        IX_WAITK(KF); \
        const int key0a = s_ * IX_SK + (2 * wv) * 16, key0b = key0a + 16; \
        const bool hb = key0b < nkeys;                                 \
        if (key0a < nkeys) { \
            f32x4 sca, scb; bool psa[4], psb[4]; unsigned posa[4], posb[4]; \
            if (hb) { IX_SCORE2(KF, sca, scb); IX_MASK(sca, key0a); IX_MASK(scb, key0b); \
                if (!IX_PROBE_NOFILT) { IX_ASK(sca, psa, posa); IX_ASK(scb, psb, posb); IX_PUT(sca, psa, posa, key0a); IX_PUT(scb, psb, posb, key0b); } } \
            else { IX_SCORE(KF, sca, 0, key0a); IX_MASK(sca, key0a); if (!IX_PROBE_NOFILT) { IX_ASK(sca, psa, posa); IX_PUT(sca, psa, posa, key0a); } } \
        } \
        IX_LOADK(KF, s_ + 2);                                         \
        LDS_WAIT(); \
        __syncthreads(); \
        const unsigned mycnt = cntl[q];                               \
        if (__ballot(mycnt > (unsigned)(IX_CAP - IX_SK)) != 0ull) {       \
            int ca = (int)cntl[2 * wv], cb = (int)cntl[2 * wv + 1]; ca = ca < IX_CAP ? ca : IX_CAP; cb = cb < IX_CAP ? cb : IX_CAP; \
            if (ca > 512) { TA = ix_compact(BA, lane, ca, TA); if (lane == 0) { cntl[2 * wv] = (unsigned)ca; taul[2 * wv] = ix_unordered(TA); } } \
            if (cb > 512) { TB = ix_compact(BB, lane, cb, TB); if (lane == 0) { cntl[2 * wv + 1] = (unsigned)cb; taul[2 * wv + 1] = ix_unordered(TB); } } \
            LDS_WAIT(); \
            __syncthreads(); \
            tq = taul[q]; } \
        } } while (0)
    h8 ka[2][2], kb[2][2];
    asm volatile("s_waitcnt vmcnt(0)" ::: "memory");
    IX_LOADK(ka, 0); IX_LOADK(kb, 1);
    for (int s = 0; s < nslab; s += 2) { IX_STEP(s, ka); IX_STEP(s + 1, kb); }
    asm volatile("s_waitcnt vmcnt(0)" : "+v"(ka[0][0]), "+v"(ka[0][1]), "+v"(ka[1][0]), "+v"(ka[1][1]), "+v"(kb[0][0]), "+v"(kb[0][1]), "+v"(kb[1][0]), "+v"(kb[1][1]) :: "memory");
#undef IX_STEP
#undef IX_SCORE
#undef IX_SCORE2
#undef IX_MM2
#undef IX_MASK
#undef IX_ASK
#undef IX_PUT
#undef IX_LOADK
#undef IX_WAITK
    LDS_WAIT();
    if (IX_PROBE_FINAL) return;
    unsigned short* IDX = (unsigned short*)(C.ws + WS_IDX); int* NV = (int*)(C.ws + WS_NV);
    int ca = (int)cntl[2 * wv], cb = (int)cntl[2 * wv + 1]; ca = ca < IX_CAP ? ca : IX_CAP; cb = cb < IX_CAP ? cb : IX_CAP;
    ix_final(BA, outl, lane, ca, TA, IDX + (m0 + 2 * wv) * 256, NV + m0 + 2 * wv, C.dry);
    ix_final(BB, outl, lane, cb, TB, IDX + (m0 + 2 * wv + 1) * 256, NV + m0 + 2 * wv + 1, C.dry);
}


constexpr int AT_CH = 4096;
constexpr int AT_NR = 4;
constexpr int AT_WAVE = AT_NR * AT_CH + 1024;
constexpr int AT_TAB = 8 * AT_WAVE;
constexpr int AT_QN = AT_TAB + 129 * 8 * 4;
constexpr int AT_END = AT_QN + 512;
static_assert(AT_END + 1024 <= MISC_OFF && (AT_WAVE % 16) == 0 && (AT_QN % 16) == 0, "attention LDS");
constexpr int AT_QPW = 8;
__device__ __forceinline__ int at_f(int row) { return 2 * ((row >> 1) & 3) | ((row >> 3) & 1); }

__device__ __forceinline__ void attn_build_tab(const Ctx& C, LAS unsigned char* lds) {
    LAS float* tab = (LAS float*)(lds + AT_TAB);
    for (int e = threadIdx.x; e < 129 * 8; e += NTHR) { const int d = e >> 3, h = e & 7; int bk;
        if (d < 16) bk = d; else { bk = 16 + (int)(logf((float)d / 16.0f) / 2.0794415416798357f * 16.0f); if (bk > 31) bk = 31; }
        tab[e] = C.relb[bk * 8 + h]; }
    if (threadIdx.x < 128) ((LAS float*)(lds + AT_QN))[threadIdx.x] = C.qn[threadIdx.x];
}
__device__ __forceinline__ void at_issue(const unsigned char* base, const LAS unsigned short* idl, int pos0, LAS unsigned char* buf, int lane) {
#pragma unroll
    for (int k2 = 0; k2 < 4; ++k2) { const int row = (lane >> 3) + 8 * k2, slot = lane & 7; const int idx = idl[pos0 + row];
        __builtin_amdgcn_global_load_lds((const unsigned*)(base + (size_t)idx * 256 + ((slot ^ at_f(row)) << 4)), (LAS unsigned*)(buf + k2 * 1024), 16, 0, 0); }
}
__device__ __forceinline__ unsigned pk4_fp8(float a, float b, float c, float d) { int w = 0; w = __builtin_amdgcn_cvt_pk_fp8_f32(a, b, w, false); w = __builtin_amdgcn_cvt_pk_fp8_f32(c, d, w, true); return (unsigned)w; }
__device__ __forceinline__ long mk64(unsigned lo, unsigned hi) { return (long)(((u64)hi << 32) | (u64)lo); }
#define AT_WAITN(n) asm volatile("s_waitcnt vmcnt(" #n ")" ::: "memory")

__device__ __forceinline__ void attn_item(const Ctx& C, LAS unsigned char* lds, int item) {
    int tid = threadIdx.x; asm volatile("" : "+v"(tid));
    const int lane = tid & 63, wv = __builtin_amdgcn_readfirstlane(tid >> 6);
    const int g = lane & 15, c = lane >> 4, gq = g & 3;
    const int qsel = item / (SEQ / (8 * AT_QPW)), b = qsel >> 1, n = qsel & 1, tbase = (item % (SEQ / (8 * AT_QPW))) * (8 * AT_QPW) + wv;
    LAS unsigned char* ring = lds + wv * AT_WAVE;
    LAS unsigned short* idlb = (LAS unsigned short*)(ring + AT_NR * AT_CH);
    const LAS float* tab = (const LAS float*)(lds + AT_TAB);
    const LAS float* qnl = (const LAS float*)(lds + AT_QN);
    const unsigned char* Kb = (const unsigned char*)(C.ws + WS_K8) + (size_t)b * SEQ * 256 + n * 128; const unsigned char* Vb = (const unsigned char*)(C.ws + WS_V8) + (size_t)b * SEQ * 256 + n * 128;
    const unsigned short* IDXb = (const unsigned short*)(C.ws + WS_IDX) + (size_t)b * SEQ * 256; const int* NVb = (const int*)(C.ws + WS_NV) + (size_t)b * SEQ;
    h16* Qb = (h16*)(C.ws + WS_Q) + (size_t)b * SEQ * DM + n * 512;
    const int fg = at_f(g), q4 = g >> 2, p4 = g & 3, rowA = 4 * c + q4, fr = at_f(rowA);
    u32x2 a_idx; int a_nv; h8 a_q[4];
#define AT_STAGE_A(tq) do { const size_t m_ = (size_t)(tq); a_idx = *(const u32x2*)(IDXb + m_ * 256 + lane * 4); a_nv = NVb[m_]; \
        _Pragma("unroll") for (int ks = 0; ks < 4; ++ks) a_q[ks] = *(const h8*)(Qb + m_ * DM + gq * 128 + 32 * c + 8 * ks); } while (0)
#define AT_STAGE_B(idl_, qf_, nv_) do { nv_ = a_nv; { const int p0 = lane * 4; unsigned s0 = a_idx.x & 0xFFFFu, s1 = a_idx.x >> 16, s2 = a_idx.y & 0xFFFFu, s3 = a_idx.y >> 16; \
          if (p0 + 0 >= nv_) s0 = 0; if (p0 + 1 >= nv_) s1 = 0; if (p0 + 2 >= nv_) s2 = 0; if (p0 + 3 >= nv_) s3 = 0; \
          u32x2 o_; o_.x = s0 | (s1 << 16); o_.y = s2 | (s3 << 16); *(LAS u32x2*)((idl_) + lane * 4) = o_; } \
        float ss_ = 0.f; _Pragma("unroll") for (int ks = 0; ks < 4; ++ks) _Pragma("unroll") for (int e = 0; e < 8; ++e) { const float x_ = (float)a_q[ks][e]; ss_ += x_ * x_; } \
        ss_ += __shfl_xor(ss_, 16); ss_ += __shfl_xor(ss_, 32); \
        const float rs_ = g < 4 ? __builtin_amdgcn_rsqf(ss_ * (1.0f / 128.0f) + EPS) : 0.f; \
        _Pragma("unroll") for (int ks = 0; ks < 4; ++ks) { const f32x4 g0 = *(const LAS f32x4*)(qnl + 32 * c + 8 * ks), g1 = *(const LAS f32x4*)(qnl + 32 * c + 8 * ks + 4); \
            qf_[ks] = mk64(pk4_fp8((float)a_q[ks][0] * rs_ * g0[0], (float)a_q[ks][1] * rs_ * g0[1], (float)a_q[ks][2] * rs_ * g0[2], (float)a_q[ks][3] * rs_ * g0[3]), \
                           pk4_fp8((float)a_q[ks][4] * rs_ * g1[0], (float)a_q[ks][5] * rs_ * g1[1], (float)a_q[ks][6] * rs_ * g1[2], (float)a_q[ks][7] * rs_ * g1[3])); } \
        LDS_WAIT(); } while (0)
    long qf[4]; int nv;
    AT_STAGE_A(tbase);
    AT_STAGE_B(idlb, qf, nv);
    AT_WAITN(0);
#pragma unroll
    for (int i = 0; i < AT_NR; ++i) at_issue(Kb, idlb, 32 * i, ring + i * AT_CH, lane);
#pragma unroll 1
    for (int k = 0; k < AT_QPW; ++k) {
        const int t = tbase + 8 * k, tn = k + 1 < AT_QPW ? t + 8 : t;
        const LAS unsigned short* idl = idlb + (k & 1) * 256; LAS unsigned short* idln = idlb + ((k + 1) & 1) * 256;
        float S[16][4];
#pragma unroll
        for (int kc = 0; kc < 8; ++kc) {
            LAS unsigned char* buf = ring + (kc & 3) * AT_CH;
            if (kc <= 4) AT_WAITN(12); else AT_WAITN(18);
#pragma unroll
            for (int j = 0; j < 2; ++j) { f32x4 a = {0.f, 0.f, 0.f, 0.f};
                const u32x4 A0 = *(const LAS u32x4*)(buf + (16 * j + g) * 128 + (((2 * c) ^ fg) << 4)), A1 = *(const LAS u32x4*)(buf + (16 * j + g) * 128 + (((2 * c + 1) ^ fg) << 4));
                a = __builtin_amdgcn_mfma_f32_16x16x32_fp8_fp8(mk64(A0.x, A0.y), qf[0], a, 0, 0, 0); a = __builtin_amdgcn_mfma_f32_16x16x32_fp8_fp8(mk64(A0.z, A0.w), qf[1], a, 0, 0, 0);
                a = __builtin_amdgcn_mfma_f32_16x16x32_fp8_fp8(mk64(A1.x, A1.y), qf[2], a, 0, 0, 0); a = __builtin_amdgcn_mfma_f32_16x16x32_fp8_fp8(mk64(A1.z, A1.w), qf[3], a, 0, 0, 0);
#pragma unroll
                for (int i = 0; i < 4; ++i) S[2 * kc + j][i] = a[i]; }
            LDS_WAIT();
            if (kc < 4) at_issue(Kb, idl, 32 * (kc + 4), buf, lane); else at_issue(Vb, idl, 32 * (kc - 4), buf, lane);
            if (kc == 4) AT_STAGE_A(tn);
        }
        const int rq = g >> 2;
        float V[4][4];
#pragma unroll
        for (int kk = 0; kk < 4; ++kk)
#pragma unroll
            for (int i = 0; i < 4; ++i) { int v = __builtin_bit_cast(int, S[kk][i]);
                v = __builtin_amdgcn_update_dpp(v, __builtin_bit_cast(int, S[4 + kk][i]), 0x114, 0xf, 0x2, false);
                v = __builtin_amdgcn_update_dpp(v, __builtin_bit_cast(int, S[8 + kk][i]), 0x118, 0xf, 0x4, false);
                v = __builtin_amdgcn_update_dpp(v, __builtin_bit_cast(int, S[12 + kk][i]), 0x11c, 0xf, 0x8, false);
                V[kk][i] = __builtin_bit_cast(float, v); }
        float mx = -INFINITY; const int nvc = nv - 4 * c - 64 * rq;
#pragma unroll
        for (int kk = 0; kk < 4; ++kk) { const u32x2 iw = *(const LAS u32x2*)(idl + 64 * rq + 16 * kk + 4 * c);
            const int ki[4] = {(int)(iw.x & 0xFFFFu), (int)(iw.x >> 16), (int)(iw.y & 0xFFFFu), (int)(iw.y >> 16)};
#pragma unroll
            for (int i = 0; i < 4; ++i) { int dist = t - ki[i]; dist = dist < 0 ? 0 : (dist > 128 ? 128 : dist);
                const float sv = V[kk][i] * 0.08838834764831845f + tab[dist * 8 + 4 * n + gq];
                const float s = (16 * kk + i) < nvc ? sv : -INFINITY; V[kk][i] = s; mx = fmaxf(mx, s); } }
        mx = fmaxf(mx, __builtin_bit_cast(float, __builtin_amdgcn_update_dpp(0, __builtin_bit_cast(int, mx), 0x124, 0xf, 0xf, false)));
        mx = fmaxf(mx, __builtin_bit_cast(float, __builtin_amdgcn_update_dpp(0, __builtin_bit_cast(int, mx), 0x128, 0xf, 0xf, false)));
        mx = fmaxf(mx, __shfl_xor(mx, 16)); mx = fmaxf(mx, __shfl_xor(mx, 32));
        float sum = 0.f; unsigned Pq[4];
#pragma unroll
        for (int kk = 0; kk < 4; ++kk) { float p[4];
#pragma unroll
            for (int i = 0; i < 4; ++i) { p[i] = __builtin_amdgcn_exp2f((V[kk][i] - mx) * 1.4426950408889634f); sum += p[i]; }
            Pq[kk] = pk4_fp8(p[0] * 256.0f, p[1] * 256.0f, p[2] * 256.0f, p[3] * 256.0f); }
        sum += __builtin_bit_cast(float, __builtin_amdgcn_update_dpp(0, __builtin_bit_cast(int, sum), 0x124, 0xf, 0xf, false));
        sum += __builtin_bit_cast(float, __builtin_amdgcn_update_dpp(0, __builtin_bit_cast(int, sum), 0x128, 0xf, 0xf, false));
        sum += __shfl_xor(sum, 16); sum += __shfl_xor(sum, 32);
        unsigned P8[16];
#pragma unroll
        for (int kk = 0; kk < 4; ++kk) { P8[kk] = Pq[kk];
            P8[4 + kk] = (unsigned)__builtin_amdgcn_update_dpp(0, (int)Pq[kk], 0x104, 0xf, 0xf, true);
            P8[8 + kk] = (unsigned)__builtin_amdgcn_update_dpp(0, (int)Pq[kk], 0x108, 0xf, 0xf, true);
            P8[12 + kk] = (unsigned)__builtin_amdgcn_update_dpp(0, (int)Pq[kk], 0x10c, 0xf, 0xf, true); }
        long qfn[4]; int nvn;
        AT_STAGE_B(idln, qfn, nvn);
        f32x4 oe[4], oo[4];
#pragma unroll
        for (int dt = 0; dt < 4; ++dt) { oe[dt] = (f32x4){0.f, 0.f, 0.f, 0.f}; oo[dt] = (f32x4){0.f, 0.f, 0.f, 0.f}; }
#pragma unroll
        for (int vc = 0; vc < 8; ++vc) {
            LAS unsigned char* buf = ring + (vc & 3) * AT_CH;
            if (vc == 0) AT_WAITN(18); else AT_WAITN(12);
            const long pf = mk64(P8[2 * vc], P8[2 * vc + 1]);
            u32x2 t0[4], t1[4];
            const unsigned ba = (unsigned)(size_t)buf;
#pragma unroll
            for (int dt = 0; dt < 4; ++dt) { const unsigned ad = ba + (unsigned)(rowA * 128 + (((2 * dt + (p4 >> 1)) ^ fr) << 4) + 8 * (p4 & 1));
                asm volatile("ds_read_b64_tr_b16 %0, %1" : "=&v"(t0[dt]) : "v"(ad) : "memory");
                asm volatile("ds_read_b64_tr_b16 %0, %1 offset:2048" : "=&v"(t1[dt]) : "v"(ad) : "memory"); }
            asm volatile("s_waitcnt lgkmcnt(0)" : "+v"(t0[0]), "+v"(t0[1]), "+v"(t0[2]), "+v"(t0[3]), "+v"(t1[0]), "+v"(t1[1]), "+v"(t1[2]), "+v"(t1[3]) :: "memory");
#pragma unroll
            for (int dt = 0; dt < 4; ++dt) {
                const long be = mk64(__builtin_amdgcn_perm(t0[dt].y, t0[dt].x, 0x06040200u), __builtin_amdgcn_perm(t1[dt].y, t1[dt].x, 0x06040200u));
                const long bo = mk64(__builtin_amdgcn_perm(t0[dt].y, t0[dt].x, 0x07050301u), __builtin_amdgcn_perm(t1[dt].y, t1[dt].x, 0x07050301u));
                oe[dt] = __builtin_amdgcn_mfma_f32_16x16x32_fp8_fp8(pf, be, oe[dt], 0, 0, 0); oo[dt] = __builtin_amdgcn_mfma_f32_16x16x32_fp8_fp8(pf, bo, oo[dt], 0, 0, 0); }
            if (vc < 4) at_issue(Vb, idl, 32 * (vc + 4), buf, lane); else at_issue(Kb, idln, 32 * (vc - 4), buf, lane);
        }
        float inv[4];
#pragma unroll
        for (int i = 0; i < 4; ++i) inv[i] = 1.0f / (256.0f * __shfl(sum, i));
        h16* Qo = Qb + (size_t)t * DM;
        LAS unsigned char* st = (LAS unsigned char*)(idlb + (k & 1) * 256);
#pragma unroll
        for (int hp = 0; hp < 2; ++hp) {
            if (c == 0) {
#pragma unroll
                for (int dt = 0; dt < 4; ++dt)
#pragma unroll
                    for (int i2 = 0; i2 < 2; ++i2) *(LAS unsigned*)(st + (i2 * 128 + 32 * dt + 2 * g) * 2) = pkh(oe[dt][2 * hp + i2] * inv[2 * hp + i2], oo[dt][2 * hp + i2] * inv[2 * hp + i2]);
            }
            LDS_WAIT();
            if (lane < 32) { const u32x4 ow = *(const LAS u32x4*)(st + lane * 16); if (!C.dry) *(u32x4*)(Qo + hp * 256 + lane * 8) = ow; }
            LDS_WAIT();
        }
#pragma unroll
        for (int ks = 0; ks < 4; ++ks) qf[ks] = qfn[ks];
        nv = nvn;
    }
    AT_WAITN(0);
#undef AT_STAGE_A
#undef AT_STAGE_B
}

__device__ __forceinline__ void act_phase(const Ctx& C, int gtid, int gthreads) {
    const h16* G = (const h16*)(C.ws + WS_UPG); h16* V = (h16*)(C.ws + WS_UPV);
    constexpr int NCG = DFF / 8, NITEM = (MTOK / 16) * NCG;
    for (int it = gtid; it < NITEM; it += gthreads) {
        const int cg = it % NCG, rb = it / NCG, c0 = cg * 8, r0 = rb * 16;
        float w[3][8], bb[8];
#pragma unroll
        for (int j = 0; j < 3; ++j) { const f32x4 a = *(const f32x4*)(C.fcw + j * DFF + c0), b2 = *(const f32x4*)(C.fcw + j * DFF + c0 + 4); for (int e = 0; e < 4; ++e) { w[j][e] = a[e]; w[j][4 + e] = b2[e]; } }
        { const f32x4 a = *(const f32x4*)(C.fcb + c0), b2 = *(const f32x4*)(C.fcb + c0 + 4); for (int e = 0; e < 4; ++e) { bb[e] = a[e]; bb[4 + e] = b2[e]; } }
        h8 gm2, gm1;
        const int tseq = r0 & (SEQ - 1);
        if (tseq >= 2) { gm2 = *(const h8*)(G + (size_t)(r0 - 2) * DFF + c0); gm1 = *(const h8*)(G + (size_t)(r0 - 1) * DFF + c0); }
        else { for (int e = 0; e < 8; ++e) { gm2[e] = (h16)0.f; gm1[e] = (h16)0.f; } }
#pragma unroll 4
        for (int r = 0; r < 16; ++r) { const size_t off = (size_t)(r0 + r) * DFF + c0;
            const h8 g0 = *(const h8*)(G + off), vv = *(const h8*)(V + off);
            float y[8];
#pragma unroll
            for (int e = 0; e < 8; ++e) { const float gf = bb[e] + w[0][e] * (float)gm2[e] + w[1][e] * (float)gm1[e] + w[2][e] * (float)g0[e]; y[e] = gelu_tanh(gf) * (float)vv[e]; }
            u32x4 o; o.x = pkh(y[0], y[1]); o.y = pkh(y[2], y[3]); o.z = pkh(y[4], y[5]); o.w = pkh(y[6], y[7]);
            if (!C.dry) *(u32x4*)(V + off) = o; gm2 = gm1; gm1 = g0; }
    }
}

__device__ __forceinline__ void p0_prologue(const Params& P, LAS unsigned char* lds) {
    const int tid = threadIdx.x, lane = tid & 63, wv = tid >> 6;
    LAS float* scr = (LAS float*)(lds + wv * 16384);
    const int gw = blockIdx.x * NWAVES + wv, NGW = gridDim.x * NWAVES;
    unsigned char* ws = P.ws;
    const float* w_in = P.in[3];
    constexpr int I_IN = 16 * 195;
    for (int it = gw; it < I_IN + 16 * 8; it += NGW) {
        if (it < I_IN) { p0_transpose_item<1>(w_in, DM, NIN, (h16*)(ws + W_IN), nullptr, scr, it, lane); continue; }
        const int r = it - I_IN, blk = r / 16, rr = r % 16, which = rr / 8, it2 = rr % 8;
        p0_transpose_item<0>((which ? P.in[8] : P.in[6]) + (size_t)blk * 128 * 128, 128, 128, (h16*)(ws + W_GATE) + (size_t)blk * 256 * 128 + (size_t)which * 128 * 128, nullptr, scr, it2, lane); }
    { u32x4* z = (u32x4*)((h16*)(ws + W_IN) + (size_t)4168 * DM); const int nz = 184 * DM * 2 / 16;
      for (int i = blockIdx.x * NTHR + tid; i < nz; i += gridDim.x * NTHR) z[i] = (u32x4){0u, 0u, 0u, 0u}; }
    { const float* x = P.in[0]; const float* gn = P.in[2]; h16* A0 = (h16*)(ws + WS_A0);
      f32x4 gv[4];
#pragma unroll
      for (int j = 0; j < 4; ++j) gv[j] = *(const f32x4*)(gn + 4 * lane + 256 * j);
      for (int m = gw; m < MTOK; m += NGW) { const f32x4* xr = (const f32x4*)(x + (size_t)m * DM) + lane; f32x4 v[4]; float s = 0.f;
#pragma unroll
          for (int j = 0; j < 4; ++j) { v[j] = xr[64 * j]; s += (v[j].x * v[j].x + v[j].y * v[j].y) + (v[j].z * v[j].z + v[j].w * v[j].w); }
          const float rs = __builtin_amdgcn_rsqf(wave_sum(s) * (1.0f / DM) + EPS);
          u32x2* o8 = (u32x2*)(A0 + (size_t)m * DM) + lane;
#pragma unroll
          for (int j = 0; j < 4; ++j) { u32x2 w; w.x = pkh(v[j].x * rs * gv[j].x, v[j].y * rs * gv[j].y); w.y = pkh(v[j].z * rs * gv[j].z, v[j].w * rs * gv[j].w); o8[64 * j] = w; } } }
}
constexpr int PD_SQ = 16 * 32, PD_UP = 16 * 192, PD_DN = 48 * 32, PD_PP = 4 * 32, PD_NTR = 4 * PD_SQ + PD_UP + PD_DN + PD_PP, PD_NT = PD_NTR / 32, PD_NP = MTOK * PLE / 4 / 8192;
static_assert(PD_NTR % 32 == 0, "deferred transposes");
__device__ __forceinline__ void p0_deferred_item(const Params& P, LAS unsigned char* lds, int item) {
    int tid = threadIdx.x; asm volatile("" : "+v"(tid));
    const int lane = tid & 63, wv = tid >> 6;
    unsigned char* ws = P.ws;
    if (item >= PD_NT) { const f32x4* p4 = (const f32x4*)P.in[1] + (size_t)(item - PD_NT) * 8192; u32x2* o = (u32x2*)(ws + WS_PH) + (size_t)(item - PD_NT) * 8192;
#pragma unroll 4
        for (int i = tid; i < 8192; i += NTHR) { const f32x4 v = p4[i]; u32x2 w; w.x = pkh(v.x, v.y); w.y = pkh(v.z, v.w); o[i] = w; }
        return; }
    LAS float* scr = (LAS float*)(lds + wv * 16384);
    const float *w_lru = P.in[14], *w_att = P.in[15], *w_out = P.in[16], *w_up = P.in[18], *w_down = P.in[21], *w_pg = P.in[23], *w_pp = P.in[24];
    for (int k = 0; k < 4; ++k) {
        int r = item * 32 + wv * 4 + k;
        if (r < PD_SQ) { p0_transpose_item<0>(w_lru, DM, DM, (h16*)(ws + W_LRU), nullptr, scr, r, lane); continue; } r -= PD_SQ;
        if (r < PD_SQ) { p0_transpose_item<0>(w_att, DM, DM, (h16*)(ws + W_ATT), nullptr, scr, r, lane); continue; } r -= PD_SQ;
        if (r < PD_SQ) { p0_transpose_item<0>(w_out, DM, DM, (h16*)(ws + W_OUT), nullptr, scr, r, lane); continue; } r -= PD_SQ;
        if (r < PD_SQ) { p0_transpose_item<0>(w_pg, DM, DM, (h16*)(ws + W_PG), P.in[22], scr, r, lane); continue; } r -= PD_SQ;
        if (r < PD_UP) { p0_transpose_item<2>(w_up, DM, 2 * DFF, (h16*)(ws + W_UP), P.in[17], scr, r, lane); continue; } r -= PD_UP;
        if (r < PD_DN) { p0_transpose_item<0>(w_down, DFF, DM, (h16*)(ws + W_DOWN), nullptr, scr, r, lane); continue; } r -= PD_DN;
        p0_transpose_item<0>(w_pp, PLE, DM, (h16*)(ws + W_PP), nullptr, scr, r, lane);
    }
}

__device__ __forceinline__ int next_unit(unsigned* head, volatile LAS unsigned* slot) {
    __syncthreads();
    if (threadIdx.x == 0) *slot = __hip_atomic_fetch_add(head, 1u, __ATOMIC_RELAXED, __HIP_MEMORY_SCOPE_AGENT);
    __syncthreads();
    return (int)*slot;
}

constexpr int NPHASE = 10;
__global__ void __launch_bounds__(NTHR, 2) fwd(Params P) {
    extern __shared__ __attribute__((aligned(16))) unsigned char lds_raw[];
    LAS unsigned char* lds = (LAS unsigned char*)lds_raw;
    volatile LAS unsigned* MISC = (volatile LAS unsigned*)(lds + MISC_OFF);
    const int tid = threadIdx.x;
    if (tid < 64) MISC[tid] = 0u;
    __syncthreads();
    unsigned char* ws = P.ws;
    unsigned* ctl = (unsigned*)(ws + WS_CTL);
    const int lo = P.ph_lo, hi = P.ph_hi;
    XcdBarrier bar; bar.bar = ctl + CW_BAR; bar.x = 0; bar.st = MISC;
    if (hi - lo > 1) bar = xcd_barrier_post(ctl + CW_BAR, MISC);
    const int dry = P.pad;
    Ctx C; C.ws = ws; C.out = P.out; C.dry = dry; C.conv_w = P.in[4]; C.conv_b = P.in[5]; C.ba = P.in[7]; C.bx = P.in[9]; C.lam = P.in[10]; C.qn = P.in[11]; C.kn = P.in[12]; C.relb = P.in[13]; C.fcw = P.in[19]; C.fcb = P.in[20];
    float* SSQ1 = (float*)(ws + CTL_SSQ1); float* SSQ2 = (float*)(ws + CTL_SSQ2);
#ifdef ONLY_PHASE
#define IN(k) ((k) == ONLY_PHASE)
#else
#define IN(k) (lo <= (k) && (k) < hi)
#endif
#define SEAM(k) do { if (IN(k) && IN((k) + 1)) xcd_barrier(bar); } while (0)

    if (IN(0)) { p0_prologue(P, lds); } SEAM(0);

    if (IN(1)) {
        pg8::Gemm g{(const h16*)(ws + WS_A0), (const h16*)(ws + W_IN), MTOK, NIN_PAD, DM}; pg8::StaticOrder S; S.init(MTOK, NIN_PAD, gridDim.x, blockIdx.x);
        EpiIn E{(h16*)(ws + WS_LX), (h16*)(ws + WS_GG), (h16*)(ws + WS_Q), (h16*)(ws + WS_K), (h16*)(ws + WS_V), (h16*)(ws + WS_QI), (h16*)(ws + WS_KI), (h16*)(ws + WS_SGA), (h16*)(ws + WS_SGB), (float*)(ws + WS_WI), dry};
        pg8::gemm_phase<EpiIn>(lds, g, S, E);
    } SEAM(1);

    if (IN(2)) {
        constexpr int N_IX = NB * (SEQ / 16), N_L1 = NB * 64 * 8 / 4, N_KN = MTOK / 128 / 4, N_PD = PD_NT + PD_NP, N_ALL = N_IX + N_L1 + N_KN + N_PD;
        unsigned* head = ctl + CW_Q2 + 128 * dry;
        int u = next_unit(head, MISC + 4);
        for (int it = 0; u < N_ALL; ++it) {
            unsigned nxt = 0u;
            if (tid == 0) nxt = __hip_atomic_fetch_add(head, 1u, __ATOMIC_RELAXED, __HIP_MEMORY_SCOPE_AGENT);
#ifdef PROBE_P2_KIND
            if (!(dry && (u < N_IX ? 0 : (u < N_IX + N_L1 ? 1 : (u < N_IX + N_L1 + N_KN ? 2 : 3))) != PROBE_P2_KIND))
#endif
            {
            if (u < N_IX) indexer_unit(C, lds, u);
            else if (u < N_IX + N_L1) lru1_item(C, lds, u - N_IX);
            else if (u < N_IX + N_L1 + N_KN) { for (int k = 0; k < 4; ++k) knorm_unit(C, (u - N_IX - N_L1) * 4 + k); }
            else p0_deferred_item(P, lds, u - N_IX - N_L1 - N_KN);
            }
            if (tid == 0) MISC[6 + (it & 1)] = nxt;
            __syncthreads();
            u = (int)MISC[6 + (it & 1)];
        }
    } SEAM(2);

    if (IN(3)) {
        constexpr int N_AQ = SEQ / (8 * AT_QPW), N_L2 = NB * 64 * 8 / 4;
        attn_build_tab(C, lds);
        unsigned* qh = ctl + CW_Q3 + 2048 * dry;
        if (tid == 0) MISC[5] = 0u;
        for (;;) {
            __syncthreads();
            if (tid == 0) { const unsigned x = xb_xcc_id() & 7u; unsigned k = MISC[5]; int u = -1;
                for (; k < 8u; ++k) { const unsigned q = (x + k) & 7u; const unsigned v = __hip_atomic_fetch_add(qh + 64 * q, 1u, __ATOMIC_RELAXED, __HIP_MEMORY_SCOPE_AGENT); if (v < (unsigned)N_AQ) { u = (int)(q * N_AQ + v); break; } }
                MISC[5] = k;
                if (u < 0) { const unsigned v = __hip_atomic_fetch_add(qh + 64 * 8, 1u, __ATOMIC_RELAXED, __HIP_MEMORY_SCOPE_AGENT); u = v < (unsigned)N_L2 ? (int)(8 * N_AQ + v) : -1; }
                MISC[4] = (unsigned)u; }
            __syncthreads();
            const int u = (int)MISC[4];
            if (u < 0) break;
            if (u < 8 * N_AQ) attn_item(C, lds, u);
            else lru2_item(C, lds + AT_END, u - 8 * N_AQ);
        }
    } SEAM(3);

    if (IN(4)) {
        pg8::StaticOrder S; S.init(MTOK, DM, gridDim.x, blockIdx.x);
        { pg8::Gemm g{(const h16*)(ws + WS_LX), (const h16*)(ws + W_LRU), MTOK, DM, DM}; EpiMerge<0> E{(const h16*)(ws + WS_SGA), (h16*)(ws + WS_T1), nullptr, dry}; pg8::gemm_phase<EpiMerge<0>>(lds, g, S, E); }
        { pg8::Gemm g{(const h16*)(ws + WS_Q), (const h16*)(ws + W_ATT), MTOK, DM, DM}; EpiMerge<1> E{(const h16*)(ws + WS_SGB), (h16*)(ws + WS_T1), (h16*)(ws + WS_GG), dry}; pg8::gemm_phase<EpiMerge<1>>(lds, g, S, E); }
    } SEAM(4);

    if (IN(5)) {
        pg8::Gemm g{(const h16*)(ws + WS_GG), (const h16*)(ws + W_OUT), MTOK, DM, DM}; pg8::StaticOrder S; S.init(MTOK, DM, gridDim.x, blockIdx.x);
        EpiResid<true> E{P.in[0], nullptr, (h16*)(ws + WS_X1H), SSQ1, dry}; pg8::gemm_phase<EpiResid<true>>(lds, g, S, E);
    } SEAM(5);

    if (IN(6)) {
        pg8::Gemm g{(const h16*)(ws + WS_X1H), (const h16*)(ws + W_UP), MTOK, 2 * DFF, DM}; pg8::StaticOrder S; S.init(MTOK, 2 * DFF, gridDim.x, blockIdx.x);
        EpiUpAct E{SSQ1, (h16*)(ws + WS_UPV), (float*)(ws + WS_UPG), (float*)(ws + WS_UPG + 4 * MiB), (float*)(ws + WS_UPG + 8 * MiB), C.fcw, C.fcb, lds + pg8::STAGE_BYTES, dry}; pg8::gemm_phase<EpiUpAct>(lds, g, S, E);
    } SEAM(6);


    if (IN(8)) {
        pg8::Gemm g{(const h16*)(ws + WS_UPV), (const h16*)(ws + W_DOWN), MTOK, DM, DFF}; pg8::StaticOrder S; S.init(MTOK, DM, gridDim.x, blockIdx.x);
        {
#pragma unroll
          for (int i = 0; i < 2; ++i) { pg8::Unit uu; if (S.next(i, uu)) act_fix_tile((const float*)(ws + WS_UPG), (const float*)(ws + WS_UPG + 4 * MiB), (const float*)(ws + WS_UPG + 8 * MiB), C.fcw, C.fcb, (h16*)(ws + WS_UPV), uu.pm, tid, dry); }
          static_assert((MTOK / 256) * (DM / 256) == 2 * 256, "two units per workgroup on a 256-workgroup grid");
          VM_WAIT(); __syncthreads(); }
        EpiResid<false> E{nullptr, (const h16*)(ws + WS_X1H), (h16*)(ws + WS_X2H), SSQ2, dry}; pg8::gemm_phase<EpiResid<false>>(lds, g, S, E);
    } SEAM(8);

    if (IN(9)) {
        pg8::StaticOrder S; S.init(MTOK, DM, gridDim.x, blockIdx.x);
        { pg8::Gemm g{(const h16*)(ws + WS_X2H), (const h16*)(ws + W_PG), MTOK, DM, DM}; EpiGateSig E{SSQ2, (h16*)(ws + WS_GS), dry}; pg8::gemm_phase<EpiGateSig>(lds, g, S, E); }
        { pg8::Gemm g{(const h16*)(ws + WS_PH), (const h16*)(ws + W_PP), MTOK, DM, P.k_ple}; EpiPleOut E{(const h16*)(ws + WS_GS), (const h16*)(ws + WS_X2H), P.out, dry}; pg8::gemm_phase<EpiPleOut>(lds, g, S, E); }
    }
#undef IN
#undef SEAM
}

#ifndef N_LAUNCHES
#define N_LAUNCHES 1
#endif
extern "C" void kernel_launch(void* const* d_in, const int* in_sizes, int n_in, void* d_out, int out_size, void* d_ws, size_t ws_size, hipStream_t stream) {
    static int grid = 0;
    if (grid == 0) {
        if (n_in != 25 || out_size != MTOK * DM || ws_size < WS_END) { fprintf(stderr, "kernel_launch: unexpected shapes (n_in %d out %d ws %zu)\n", n_in, out_size, ws_size); grid = -1; return; }
        int dev = 0, cus = 0, per_cu = 0;
        hipGetDevice(&dev); hipDeviceGetAttribute(&cus, hipDeviceAttributeMultiprocessorCount, dev);
        if (hipFuncSetAttribute((const void*)fwd, hipFuncAttributeMaxDynamicSharedMemorySize, LDS_BYTES) != hipSuccess) { fprintf(stderr, "kernel_launch: hipFuncSetAttribute failed\n"); grid = -1; return; }
        if (hipOccupancyMaxActiveBlocksPerMultiprocessor(&per_cu, (const void*)fwd, NTHR, LDS_BYTES) != hipSuccess || per_cu < 1) { fprintf(stderr, "kernel_launch: occupancy query says %d\n", per_cu); }
        (void)hipGetLastError();
        grid = cus > 0 ? cus : 256;
    }
    if (grid < 0) return;
    hipMemsetAsync((char*)d_ws + WS_CTL, 0, CTL_ZERO_BYTES, stream);
    Params p{};
    for (int i = 0; i < 25; ++i) p.in[i] = (const float*)d_in[i];
    p.out = (float*)d_out; p.ws = (unsigned char*)d_ws; p.k_ple = PLE; p.pad = 0;
    if (N_LAUNCHES == 1) { p.ph_lo = 0; p.ph_hi = NPHASE; hipLaunchKernelGGL(fwd, dim3(grid), dim3(NTHR), LDS_BYTES, stream, p); }
    else for (int ph = 0; ph < NPHASE; ++ph) { p.ph_lo = ph; p.ph_hi = ph + 1;
#ifdef PROBE_MASK
        if ((PROBE_MASK >> ph) & 1) { p.pad = 1; hipLaunchKernelGGL(fwd, dim3(grid), dim3(NTHR), LDS_BYTES, stream, p); p.pad = 0; }
#endif
        hipLaunchKernelGGL(fwd, dim3(grid), dim3(NTHR), LDS_BYTES, stream, p); }
}
```

```cpp
#include <hip/hip_runtime.h>
#include <cstdio>
#include <cstdint>

#define GAS __attribute__((address_space(1)))
#define LAS __attribute__((address_space(3)))
typedef _Float16 h16;
typedef _Float16 h8 __attribute__((ext_vector_type(8)));
typedef _Float16 h4 __attribute__((ext_vector_type(4)));
typedef _Float16 h2 __attribute__((ext_vector_type(2)));
typedef __fp16 fh4 __attribute__((__vector_size__(4 * sizeof(__fp16))));
typedef float f32x4 __attribute__((ext_vector_type(4)));
typedef float f32x2 __attribute__((ext_vector_type(2)));
typedef unsigned u32x4 __attribute__((ext_vector_type(4)));
typedef unsigned u32x2 __attribute__((ext_vector_type(2)));
typedef unsigned long long u64;

__device__ __forceinline__ unsigned pkh(float a, float b) { h2 r; r.x = (h16)a; r.y = (h16)b; return __builtin_bit_cast(unsigned, r); }
__device__ __forceinline__ float sigmoid_f(float x) { return __builtin_amdgcn_rcpf(1.0f + __builtin_amdgcn_exp2f(-1.4426950408889634f * x)); }
__device__ __forceinline__ float gelu_tanh(float x) { const float u = 1.5957691216057308f * (x + 0.044715f * x * x * x); return x * sigmoid_f(u); }
#define LDS_WAIT() asm volatile("s_waitcnt lgkmcnt(0)" ::: "memory")
#define VM_WAIT() asm volatile("s_waitcnt vmcnt(0)" ::: "memory")

namespace pg8 {
constexpr int BM = 256, BK = 64, HALF = 128, HTB = HALF * BK * 2, STAGE_BYTES = 8 * HTB, NXCD = 8, WGM = 8;
__host__ __device__ __forceinline__ int lds_byte(int r, int c) { const int st = (r >> 4) * 2 + (c >> 5), rr = r & 15, cc = c & 31, ob = rr * 64 + cc * 2; return st * 1024 + (ob ^ (((ob >> 9) & 1) << 5)); }
__host__ __device__ __forceinline__ void stage_rc(int b, int& R, int& C) { const int st = b / 1024, sb = b % 1024, swz = sb ^ (((sb >> 9) & 1) << 5); R = (st >> 1) * 16 + swz / 64; C = (st & 1) * 32 + (swz % 64) / 2; }
__host__ __device__ __forceinline__ int perm32(int rho) { const int n = rho >> 4, i = rho & 15; return 8 * (i >> 2) + 4 * n + (i & 3); }

struct Unit { int pm, pn; };
struct Gemm { const h16* A; const h16* Bt; int M, N, K; };

struct StaticOrder {
    int nM, nN, nwg, G, c;
    __host__ __device__ void init(int M, int N, int G_, int c_) { nM = M / BM; nN = N / BM; nwg = nM * nN; G = G_; c = c_; }
    __host__ __device__ __forceinline__ bool next(int i, Unit& u) const {
        const long L = (long)i * G + c; if (L >= nwg) return false;
        int wgid = (int)L; { const int q = nwg / NXCD, r = nwg % NXCD, xcd = wgid % NXCD, off = wgid / NXCD; wgid = (xcd < r ? xcd * (q + 1) : r * (q + 1) + (xcd - r) * q) + off; }
        const int nig = WGM * nN, gid = wgid / nig, fm = gid * WGM, gsz = (nM - fm) < WGM ? (nM - fm) : WGM;
        u.pm = fm + ((wgid % nig) % gsz); u.pn = (wgid % nig) / gsz; return true;
    }
};

template <class Epi, bool ALIGN_EPI = true, bool SP2 = true>
__device__ __forceinline__ void gemm_phase(LAS unsigned char* lds, const Gemm g, const StaticOrder& S, const Epi& E) {
    const int tid = threadIdx.x, wid = __builtin_amdgcn_readfirstlane(tid >> 6), lane = tid & 63, wr = wid >> 2, wc = wid & 3, fr = lane & 15, fq = lane >> 4;
    const int K = g.K, nt = K / BK;
    unsigned voffA[2], voffB[2];
#pragma unroll
    for (int i = 0; i < 2; ++i) { int R, C; stage_rc(tid * 16 + i * 8192, R, C); const int Rb = Epi::PERM ? ((R & ~31) + perm32(R & 31)) : R;
        voffA[i] = (unsigned)(R * K + C) * 2u; voffB[i] = (unsigned)(Rb * K + C) * 2u; }
    const size_t kstep = (size_t)(BK * 2);
    const size_t hstep = (size_t)HALF * K * 2;
    const size_t tstep = 2 * hstep;
    const unsigned ldsw = (unsigned)wid * 1024u;
    const int aoff = lds_byte(wr * 64 + fr, fq * 8), boff = lds_byte(wc * 32 + fr, fq * 8);
#define PG8_SA(b, h) (((b) * 2 + (h)) * HTB)
#define PG8_SB(b, h) ((4 + (b) * 2 + (h)) * HTB)
#define PG8_STAGE(bufoff, gbase, voff) do { _Pragma("unroll") for (int _i = 0; _i < 2; ++_i) \
        __builtin_amdgcn_global_load_lds((const unsigned*)((const char*)(gbase) + (voff)[_i]), (LAS unsigned*)(lds + (bufoff) + ldsw + _i * 8192), 16, 0, 0); } while (0)
#define PG8_LDA(dst, b, h) do { _Pragma("unroll") for (int m = 0; m < 4; ++m) _Pragma("unroll") for (int k = 0; k < 2; ++k) dst[m][k] = *(const LAS h8*)(lds + PG8_SA(b, h) + aoff + m * 2048 + k * 1024); } while (0)
#define PG8_LDB(dst, b, h) do { _Pragma("unroll") for (int n = 0; n < 2; ++n) _Pragma("unroll") for (int k = 0; k < 2; ++k) dst[n][k] = *(const LAS h8*)(lds + PG8_SB(b, h) + boff + n * 2048 + k * 1024); } while (0)
#define PG8_MMA(ai, bj, At, Bt) do { __builtin_amdgcn_s_setprio(1); _Pragma("unroll") for (int m = 0; m < 4; ++m) _Pragma("unroll") for (int n = 0; n < 2; ++n) _Pragma("unroll") for (int k = 0; k < 2; ++k) \
        acc[ai][bj][m][n] = __builtin_amdgcn_mfma_f32_16x16x32_f16(Bt[n][k], At[m][k], acc[ai][bj][m][n], 0, 0, 0); __builtin_amdgcn_s_setprio(0); } while (0)
#define PG8_WAIT_V(n) asm volatile("s_waitcnt vmcnt(" #n ")" ::: "memory")
#define PG8_WAIT_L(n) asm volatile("s_waitcnt lgkmcnt(" #n ")" ::: "memory")
#define PG8_BAR __builtin_amdgcn_s_barrier()
#define PG8_SCHED __builtin_amdgcn_sched_barrier(0)
    Unit cur, nxt; int ui = 0;
    if (!S.next(0, cur)) return;
    f32x4 acc[2][2][4][2];
#pragma unroll
    for (int a = 0; a < 2; ++a)
#pragma unroll
        for (int b = 0; b < 2; ++b)
#pragma unroll
            for (int m = 0; m < 4; ++m)
#pragma unroll
                for (int n = 0; n < 2; ++n) acc[a][b][m][n] = (f32x4){0.f, 0.f, 0.f, 0.f};
    h8 At[4][2], B0[2][2], B1[2][2];
    const char* cA = (const char*)g.A + (size_t)cur.pm * tstep; const char* cB = (const char*)g.Bt + (size_t)cur.pn * tstep;
    if constexpr (SP2) {
        PG8_STAGE(PG8_SB(0, 0), cB, voffB); PG8_STAGE(PG8_SB(0, 1), cB + hstep, voffB); PG8_STAGE(PG8_SA(0, 0), cA, voffA); PG8_STAGE(PG8_SA(0, 1), cA + hstep, voffA);
        if (wr == 1) PG8_BAR;
        PG8_WAIT_V(2); PG8_BAR;
        PG8_STAGE(PG8_SB(1, 0), cB + kstep, voffB); PG8_STAGE(PG8_SA(1, 0), cA + kstep, voffA); PG8_STAGE(PG8_SB(1, 1), cB + hstep + kstep, voffB);
        PG8_WAIT_V(6); PG8_BAR;
    } else {
        PG8_STAGE(PG8_SB(0, 0), cB, voffB); PG8_STAGE(PG8_SA(0, 0), cA, voffA); PG8_STAGE(PG8_SB(0, 1), cB + hstep, voffB); PG8_STAGE(PG8_SA(0, 1), cA + hstep, voffA);
        if (wr == 1) PG8_BAR;
        PG8_WAIT_V(4); PG8_BAR;
        PG8_STAGE(PG8_SB(1, 0), cB + kstep, voffB); PG8_STAGE(PG8_SA(1, 0), cA + kstep, voffA); PG8_STAGE(PG8_SB(1, 1), cB + hstep + kstep, voffB);
        PG8_WAIT_V(6); PG8_BAR;
    }
    for (;;) {
        const bool has_next = S.next(ui + 1, nxt);
        const char* nA = has_next ? (const char*)g.A + (size_t)nxt.pm * tstep : cA; const char* nB = has_next ? (const char*)g.Bt + (size_t)nxt.pn * tstep : cB;
        for (int t = 0; t < nt; t += 2) {
            const bool last = (t == nt - 2);
            const char* a1 = cA + (size_t)(t + 1) * kstep;
            const char* a2 = last ? nA : cA + (size_t)(t + 2) * kstep; const char* b2 = last ? nB : cB + (size_t)(t + 2) * kstep;
            const char* a3 = a2 + kstep; const char* b3 = b2 + kstep;
            if constexpr (SP2) {
            PG8_LDB(B0, 0, 0); PG8_LDB(B1, 0, 1); PG8_SCHED; PG8_LDA(At, 0, 0); PG8_STAGE(PG8_SA(1, 1), a1 + hstep, voffA);
            PG8_WAIT_V(8); PG8_WAIT_L(0); PG8_BAR; PG8_MMA(0, 0, At, B0); PG8_MMA(0, 1, At, B1); PG8_BAR; PG8_SCHED;
            PG8_LDA(At, 0, 1); PG8_STAGE(PG8_SB(0, 0), b2, voffB); PG8_STAGE(PG8_SB(0, 1), b2 + hstep, voffB); PG8_STAGE(PG8_SA(0, 0), a2, voffA);
            PG8_WAIT_V(8); PG8_WAIT_L(0); PG8_BAR; PG8_MMA(1, 0, At, B0); PG8_MMA(1, 1, At, B1); PG8_BAR; PG8_SCHED;
            PG8_LDB(B0, 1, 0); PG8_LDB(B1, 1, 1); PG8_SCHED; PG8_LDA(At, 1, 0); PG8_STAGE(PG8_SA(0, 1), a2 + hstep, voffA);
            PG8_WAIT_V(8); PG8_WAIT_L(0); PG8_BAR; PG8_MMA(0, 0, At, B0); PG8_MMA(0, 1, At, B1); PG8_BAR; PG8_SCHED;
            PG8_LDA(At, 1, 1); PG8_STAGE(PG8_SB(1, 0), b3, voffB); PG8_STAGE(PG8_SB(1, 1), b3 + hstep, voffB); PG8_STAGE(PG8_SA(1, 0), a3, voffA);
            PG8_WAIT_V(8); PG8_WAIT_L(0); PG8_BAR; PG8_MMA(1, 0, At, B0); PG8_MMA(1, 1, At, B1); PG8_BAR; PG8_SCHED;
            } else {
            PG8_LDB(B0, 0, 0); PG8_SCHED; PG8_LDA(At, 0, 0); PG8_STAGE(PG8_SA(1, 1), a1 + hstep, voffA);
            PG8_WAIT_L(8); PG8_BAR; PG8_WAIT_L(0); PG8_MMA(0, 0, At, B0); PG8_BAR; PG8_SCHED;
            PG8_LDB(B1, 0, 1); PG8_STAGE(PG8_SB(0, 0), b2, voffB);
            PG8_BAR; PG8_WAIT_L(0); PG8_MMA(0, 1, At, B1); PG8_BAR;
            PG8_LDA(At, 0, 1); PG8_STAGE(PG8_SA(0, 0), a2, voffA);
            PG8_BAR; PG8_WAIT_L(0); PG8_MMA(1, 0, At, B0); PG8_BAR; PG8_SCHED;
            PG8_STAGE(PG8_SB(0, 1), b2 + hstep, voffB);
            PG8_WAIT_V(6); PG8_BAR; PG8_MMA(1, 1, At, B1); PG8_BAR;
            PG8_LDB(B0, 1, 0); PG8_SCHED; PG8_LDA(At, 1, 0); PG8_STAGE(PG8_SA(0, 1), a2 + hstep, voffA);
            PG8_WAIT_L(8); PG8_BAR; PG8_WAIT_L(0); PG8_MMA(0, 0, At, B0); PG8_BAR; PG8_SCHED;
            PG8_LDB(B1, 1, 1); PG8_STAGE(PG8_SB(1, 0), b3, voffB);
            PG8_BAR; PG8_WAIT_L(0); PG8_MMA(0, 1, At, B1); PG8_BAR;
            PG8_LDA(At, 1, 1); PG8_STAGE(PG8_SA(1, 0), a3, voffA);
            PG8_BAR; PG8_WAIT_L(0); PG8_MMA(1, 0, At, B0); PG8_BAR; PG8_SCHED;
            PG8_STAGE(PG8_SB(1, 1), b3 + hstep, voffB);
            PG8_WAIT_V(6); PG8_BAR; PG8_MMA(1, 1, At, B1); PG8_BAR;
            }
        }
        if constexpr (ALIGN_EPI) { if (wr == 0) PG8_BAR; }
        E(acc, cur, wr, wc, fr, fq);
        if (!has_next) break;
#pragma unroll
        for (int a = 0; a < 2; ++a)
#pragma unroll
            for (int b = 0; b < 2; ++b)
#pragma unroll
                for (int m = 0; m < 4; ++m)
#pragma unroll
                    for (int n = 0; n < 2; ++n) acc[a][b][m][n] = (f32x4){0.f, 0.f, 0.f, 0.f};
        cur = nxt; cA = nA; cB = nB; ++ui;
        if constexpr (ALIGN_EPI) { if (wr == 1) PG8_BAR; }
    }
    PG8_WAIT_V(0);
    if constexpr (!ALIGN_EPI) { if (wr == 0) PG8_BAR; }
    PG8_BAR;
#undef PG8_SA
#undef PG8_SB
#undef PG8_STAGE
#undef PG8_LDA
#undef PG8_LDB
#undef PG8_MMA
#undef PG8_WAIT_V
#undef PG8_WAIT_L
#undef PG8_BAR
#undef PG8_SCHED
}
}

constexpr int NB = 4, SEQ = 8192, MTOK = NB * SEQ, DM = 1024, DFF = 3072, PLE = 256;
constexpr int NIN = 6216, NIN_PAD = 6400;
constexpr float EPS = 1e-6f;
constexpr int NWAVES = 8, NTHR = 512;

typedef const f32x4 (&AccRef)[2][2][4][2];

template <int ACT> __device__ __forceinline__ float act_f(float v) {
    if (ACT == 1) return gelu_tanh(v);
    if (ACT == 2) return sigmoid_f(v);
    if (ACT == 3) return v * 0.125f;
    return v;
}
template <int ACT> __device__ __forceinline__ void store_tile_h(AccRef acc, h16* base, int ldc, int row0, int col0, int dry) {
    const unsigned bo0 = ((unsigned)row0 * (unsigned)ldc + (unsigned)col0) * 2u;
#pragma unroll
    for (int ai = 0; ai < 2; ++ai)
#pragma unroll
        for (int m = 0; m < 4; ++m) { const unsigned bo = bo0 + (unsigned)((ai * 128 + m * 16) * ldc * 2);
#pragma unroll
            for (int bj = 0; bj < 2; ++bj) { const f32x4 v0 = acc[ai][bj][m][0], v1 = acc[ai][bj][m][1];
                u32x4 w; w.x = pkh(act_f<ACT>(v0[0]), act_f<ACT>(v0[1])); w.y = pkh(act_f<ACT>(v0[2]), act_f<ACT>(v0[3]));
                w.z = pkh(act_f<ACT>(v1[0]), act_f<ACT>(v1[1])); w.w = pkh(act_f<ACT>(v1[2]), act_f<ACT>(v1[3]));
                if (!dry) *(u32x4*)((char*)base + bo + bj * 256) = w; }
            if (ACT == 1 || ACT == 2) __builtin_amdgcn_sched_barrier(0); }
}

__device__ __forceinline__ unsigned frag_off(int pm, int pn, int wid, int lane) { return ((unsigned)((pm * 4 + pn) * 8 + wid) * 1024u + (unsigned)lane) * 16u; }
#define FRAG_SUB(ai, m, bj) ((unsigned)((((ai) * 4 + (m)) * 2 + (bj)) * 1024))
template <int ACT> __device__ __forceinline__ void store_tile_frag(AccRef acc, h16* base, unsigned fo, int dry) {
#pragma unroll
    for (int ai = 0; ai < 2; ++ai)
#pragma unroll
        for (int m = 0; m < 4; ++m) {
#pragma unroll
            for (int bj = 0; bj < 2; ++bj) { const f32x4 v0 = acc[ai][bj][m][0], v1 = acc[ai][bj][m][1];
                u32x4 w; w.x = pkh(act_f<ACT>(v0[0]), act_f<ACT>(v0[1])); w.y = pkh(act_f<ACT>(v0[2]), act_f<ACT>(v0[3]));
                w.z = pkh(act_f<ACT>(v1[0]), act_f<ACT>(v1[1])); w.w = pkh(act_f<ACT>(v1[2]), act_f<ACT>(v1[3]));
                if (!dry) *(u32x4*)((char*)base + fo + FRAG_SUB(ai, m, bj)) = w; }
            if (ACT == 1 || ACT == 2) __builtin_amdgcn_sched_barrier(0); }
}

struct EpiIn {
    static constexpr bool PERM = true;
    h16 *LX, *GG, *Q, *K, *V, *QI, *KI, *SGA, *SGB; float* WI; int dry;
    __device__ __forceinline__ void operator()(AccRef acc, const pg8::Unit& u, int wr, int wc, int fr, int fq) const {
        const int pn = u.pn, row0 = u.pm * 256 + wr * 64 + fr, cw = wc * 32 + 8 * fq;
        if (pn < 4 || (pn >= 8 && pn < 14)) {
            h16* base = pn < 4 ? LX : (pn < 12 ? Q : (pn == 12 ? K : V)); const int ldc = pn < 12 ? DM : 256; const int ct = pn < 4 ? pn * 256 : (pn < 12 ? (pn - 8) * 256 : 0);
            if (pn < 12) store_tile_h<0>(acc, base, DM, row0, ct + cw, dry); else store_tile_h<0>(acc, base, 256, row0, cw, dry);
            (void)ldc;
        }
        else if (pn < 8) store_tile_h<1>(acc, GG, DM, row0, (pn - 4) * 256 + cw, dry);
        else if (pn < 16) {
#pragma unroll
            for (int ai = 0; ai < 2; ++ai)
#pragma unroll
                for (int m = 0; m < 4; ++m) { const unsigned t16 = (unsigned)(u.pm * 16 + wr * 4 + ai * 8 + m);
#pragma unroll
                    for (int bj = 0; bj < 2; ++bj) { const f32x4 v0 = acc[ai][bj][m][0] * 0.125f, v1 = acc[ai][bj][m][1] * 0.125f;
                        const unsigned hh = (unsigned)((pn - 14) * 4 + bj * 2 + (wc >> 1)), slot = ((t16 * 8u + hh) * 2u + (unsigned)(wc & 1)) * 64u + (unsigned)(fq * 16 + fr);
                        u32x4 w; w.x = pkh(v0[0], v0[1]); w.y = pkh(v0[2], v0[3]); w.z = pkh(v1[0], v1[1]); w.w = pkh(v1[2], v1[3]);
                        if (!dry) *(u32x4*)((char*)QI + slot * 16u) = w; } }
        }
        else if (pn == 16) {
            if (wc < 2) {
#pragma unroll
                for (int ai = 0; ai < 2; ++ai)
#pragma unroll
                    for (int m = 0; m < 4; ++m) { const f32x4 v0 = acc[ai][0][m][0], v1 = acc[ai][0][m][1];
                        u32x4 w; w.x = pkh(v0[0], v0[1]); w.y = pkh(v0[2], v0[3]); w.z = pkh(v1[0], v1[1]); w.w = pkh(v1[2], v1[3]);
                        if (!dry) *(u32x4*)((char*)KI + ((unsigned)((u.pm * 16 + wr * 4 + ai * 8 + m) * 2 + wc) * 64u + (unsigned)(fq * 16 + fr)) * 16u) = w; }
            } else if (wc == 2 && fq == 0) {
#pragma unroll
                for (int ai = 0; ai < 2; ++ai)
#pragma unroll
                    for (int m = 0; m < 4; ++m) { float* p = WI + (size_t)(row0 + ai * 128 + m * 16) * 8;
                        if (!dry) { *(f32x4*)p = acc[ai][0][m][0] * 0.35355339059327373f; *(f32x4*)(p + 4) = acc[ai][0][m][1] * 0.35355339059327373f; } }
            }
        }
        else { h16* base = pn < 21 ? SGA : SGB; const int pl = pn < 21 ? pn - 17 : pn - 21; store_tile_frag<2>(acc, base, frag_off(u.pm, pl, wr * 4 + wc, fq * 16 + fr), dry); }
    }
};

template <int SECOND> struct EpiMerge {
    static constexpr bool PERM = true;
    const h16* SG; h16* T1; h16* OUT; int dry;
    __device__ __forceinline__ void operator()(AccRef acc, const pg8::Unit& u, int wr, int wc, int fr, int fq) const {
        const int row0 = u.pm * 256 + wr * 64 + fr, col0 = u.pn * 256 + wc * 32 + 8 * fq;
        const unsigned fo = frag_off(u.pm, u.pn, wr * 4 + wc, fq * 16 + fr);
#pragma unroll
        for (int ai = 0; ai < 2; ++ai)
#pragma unroll
            for (int m = 0; m < 4; ++m) { const size_t off = (size_t)(row0 + ai * 128 + m * 16) * DM + col0;
#pragma unroll
                for (int bj = 0; bj < 2; ++bj) { const f32x4 v0 = acc[ai][bj][m][0], v1 = acc[ai][bj][m][1];
                    const h8 sg = *(const h8*)((const char*)SG + fo + FRAG_SUB(ai, m, bj));
                    float r[8];
#pragma unroll
                    for (int j = 0; j < 4; ++j) { r[j] = (float)sg[j] * v0[j]; r[4 + j] = (float)sg[4 + j] * v1[j]; }
                    if (SECOND) { const h8 t1 = *(const h8*)((const char*)T1 + fo + FRAG_SUB(ai, m, bj));
#pragma unroll
                        for (int j = 0; j < 8; ++j) r[j] += (float)t1[j]; }
                    u32x4 w; w.x = pkh(r[0], r[1]); w.y = pkh(r[2], r[3]); w.z = pkh(r[4], r[5]); w.w = pkh(r[6], r[7]);
                    if (!dry) { if (SECOND) *(u32x4*)(OUT + off + bj * 128) = w; else *(u32x4*)((char*)T1 + fo + FRAG_SUB(ai, m, bj)) = w; } }
                asm volatile("" ::: "memory"); }
    }
};

template <bool BASE_F32> struct EpiResid {
    static constexpr bool PERM = true;
    const float* BF; const h16* BH; h16* XOUT; float* SSQ; int dry;
    __device__ __forceinline__ void operator()(AccRef acc, const pg8::Unit& u, int wr, int wc, int fr, int fq) const {
        const int row0 = u.pm * 256 + wr * 64 + fr, col0 = u.pn * 256 + wc * 32 + 8 * fq;
#pragma unroll
        for (int ai = 0; ai < 2; ++ai)
#pragma unroll
            for (int m = 0; m < 4; ++m) { const int row = row0 + ai * 128 + m * 16; const size_t off = (size_t)row * DM + col0; float ss = 0.f;
#pragma unroll
                for (int bj = 0; bj < 2; ++bj) { const f32x4 v0 = acc[ai][bj][m][0], v1 = acc[ai][bj][m][1];
                    float r[8];
                    if (BASE_F32) { const f32x4 b0 = *(const f32x4*)(BF + off + bj * 128), b1 = *(const f32x4*)(BF + off + bj * 128 + 4);
#pragma unroll
                        for (int j = 0; j < 4; ++j) { r[j] = b0[j] + v0[j]; r[4 + j] = b1[j] + v1[j]; } }
                    else { const h8 b = *(const h8*)(BH + off + bj * 128);
#pragma unroll
                        for (int j = 0; j < 4; ++j) { r[j] = (float)b[j] + v0[j]; r[4 + j] = (float)b[4 + j] + v1[j]; } }
#pragma unroll
                    for (int j = 0; j < 8; ++j) ss += r[j] * r[j];
                    u32x4 w; w.x = pkh(r[0], r[1]); w.y = pkh(r[2], r[3]); w.z = pkh(r[4], r[5]); w.w = pkh(r[6], r[7]);
                    if (!dry) *(u32x4*)(XOUT + off + bj * 128) = w; }
                ss += __shfl_xor(ss, 16); ss += __shfl_xor(ss, 32);
                if (fq == 0 && !dry) unsafeAtomicAdd(SSQ + row, ss);
                asm volatile("" ::: "memory"); }
    }
};

struct EpiUp {
    static constexpr bool PERM = true;
    const float* SSQ; h16* UPG; h16* UPV; int dry;
    __device__ __forceinline__ void operator()(AccRef acc, const pg8::Unit& u, int wr, int wc, int fr, int fq) const {
        const int row0 = u.pm * 256 + wr * 64 + fr, col0 = u.pn * 128 + wc * 32 + 8 * fq;
#pragma unroll
        for (int ai = 0; ai < 2; ++ai)
#pragma unroll
            for (int m = 0; m < 4; ++m) { const int row = row0 + ai * 128 + m * 16; const size_t off = (size_t)row * DFF + col0;
                const float r = __builtin_amdgcn_rsqf(SSQ[row] * (1.0f / DM) + EPS);
#pragma unroll
                for (int bj = 0; bj < 2; ++bj) { const f32x4 v0 = acc[ai][bj][m][0] * r, v1 = acc[ai][bj][m][1] * r;
                    u32x4 w; w.x = pkh(v0[0], v0[1]); w.y = pkh(v0[2], v0[3]); w.z = pkh(v1[0], v1[1]); w.w = pkh(v1[2], v1[3]);
                    if (!dry) *(u32x4*)((bj ? UPV : UPG) + off) = w; } }
    }
};

__device__ __forceinline__ float dpp_ror1(float v) { return __builtin_bit_cast(float, __builtin_amdgcn_update_dpp(0, __builtin_bit_cast(int, v), 0x121, 0xf, 0xf, false)); }
__device__ __forceinline__ float dpp_ror2(float v) { return __builtin_bit_cast(float, __builtin_amdgcn_update_dpp(0, __builtin_bit_cast(int, v), 0x122, 0xf, 0xf, false)); }
struct EpiUpAct {
    static constexpr bool PERM = true;
    const float* SSQ; h16* ACT; float* SG; float* SV; float* SL; const float* fcw; const float* fcb; LAS unsigned char* xl; int dry;
    __device__ __forceinline__ void operator()(AccRef acc, const pg8::Unit& u, int wr, int wc, int fr, int fq) const {
        const int row0 = u.pm * 256 + wr * 64 + fr, colg = u.pn * 128 + wc * 32 + 8 * fq, coll = wc * 32 + 8 * fq;
        float w0[8], w1[8], w2[8], bb[8];
        { const f32x4 a0 = *(const f32x4*)(fcw + colg), a1 = *(const f32x4*)(fcw + colg + 4), b0 = *(const f32x4*)(fcw + DFF + colg), b1 = *(const f32x4*)(fcw + DFF + colg + 4),
                      c0 = *(const f32x4*)(fcw + 2 * DFF + colg), c1 = *(const f32x4*)(fcw + 2 * DFF + colg + 4), d0 = *(const f32x4*)(fcb + colg), d1 = *(const f32x4*)(fcb + colg + 4);
#pragma unroll
          for (int e = 0; e < 4; ++e) { w0[e] = a0[e]; w0[4 + e] = a1[e]; w1[e] = b0[e]; w1[4 + e] = b1[e]; w2[e] = c0[e]; w2[4 + e] = c1[e]; bb[e] = d0[e]; bb[4 + e] = d1[e]; } }
        LAS float* X = (LAS float*)xl;
#pragma unroll
        for (int ai = 0; ai < 2; ++ai) { const float r3 = __builtin_amdgcn_rsqf(SSQ[row0 + ai * 128 + 48] * (1.0f / DM) + EPS);
            if (fr >= 14) { LAS float* p = X + ((ai * 2 + wr) * 2 + (fr - 14)) * 128 + coll; *(LAS f32x4*)p = acc[ai][0][3][0] * r3; *(LAS f32x4*)(p + 4) = acc[ai][0][3][1] * r3; } }
        LDS_WAIT(); __builtin_amdgcn_s_barrier(); asm volatile("" ::: "memory");
#pragma unroll
        for (int ai = 0; ai < 2; ++ai) {
            float L0[8], L1[8];
            if (ai == 0 && wr == 0) {
#pragma unroll
                for (int e = 0; e < 8; ++e) { L0[e] = 0.f; L1[e] = 0.f; } }
            else { const int pb = wr == 1 ? ai * 2 : 1; const LAS float* p = X + (pb * 2) * 128 + coll;
                const f32x4 x0 = *(const LAS f32x4*)p, x1 = *(const LAS f32x4*)(p + 4), y0 = *(const LAS f32x4*)(p + 128), y1 = *(const LAS f32x4*)(p + 132);
#pragma unroll
                for (int e = 0; e < 4; ++e) { L0[e] = x0[e]; L0[4 + e] = x1[e]; L1[e] = y0[e]; L1[4 + e] = y1[e]; } }
            float q1[8], q2[8];
#pragma unroll
            for (int e = 0; e < 8; ++e) { q1[e] = L1[e]; q2[e] = fr == 0 ? L0[e] : L1[e]; }
#pragma unroll
            for (int m = 0; m < 4; ++m) { const int row = row0 + ai * 128 + m * 16;
                const float rr = __builtin_amdgcn_rsqf(SSQ[row] * (1.0f / DM) + EPS);
                float g[8], a[8];
#pragma unroll
                for (int e = 0; e < 4; ++e) { g[e] = acc[ai][0][m][0][e] * rr; g[4 + e] = acc[ai][0][m][1][e] * rr; }
#pragma unroll
                for (int e = 0; e < 8; ++e) { const float r1 = dpp_ror1(g[e]), r2 = dpp_ror2(g[e]);
                    const float p1 = fr >= 1 ? r1 : q1[e], p2 = fr >= 2 ? r2 : q2[e];
                    const float y = bb[e] + w0[e] * p2 + w1[e] * p1 + w2[e] * g[e];
                    const float vv = (e < 4 ? acc[ai][1][m][0][e] : acc[ai][1][m][1][e - 4]) * rr;
                    a[e] = gelu_tanh(y) * vv; q1[e] = r1; q2[e] = r2; }
                const bool deferred = (ai == 0 && m == 0) && wr == 0 && fr < 2;
                if (!dry) {
                    if (!deferred) { u32x4 w; w.x = pkh(a[0], a[1]); w.y = pkh(a[2], a[3]); w.z = pkh(a[4], a[5]); w.w = pkh(a[6], a[7]); *(u32x4*)(ACT + (size_t)row * DFF + colg) = w; }
                    else { float* pg = SG + (size_t)(u.pm * 2 + fr) * DFF + colg; float* pv = SV + (size_t)(u.pm * 2 + fr) * DFF + colg;
                        *(f32x4*)pg = (f32x4){g[0], g[1], g[2], g[3]}; *(f32x4*)(pg + 4) = (f32x4){g[4], g[5], g[6], g[7]};
                        *(f32x4*)pv = acc[ai][1][m][0] * rr; *(f32x4*)(pv + 4) = acc[ai][1][m][1] * rr; }
                    if ((ai == 1 && m == 3) && wr == 1 && fr >= 14) { float* pl = SL + (size_t)(u.pm * 2 + fr - 14) * DFF + colg;
                        *(f32x4*)pl = (f32x4){g[0], g[1], g[2], g[3]}; *(f32x4*)(pl + 4) = (f32x4){g[4], g[5], g[6], g[7]}; } }
                __builtin_amdgcn_sched_barrier(0); }
        }
    }
};
__device__ __forceinline__ void act_fix_tile(const float* SG, const float* SV, const float* SL, const float* fcw, const float* fcb, h16* ACT, int pm, int tid, int dry) {
    constexpr int NCG = DFF / 8; const bool bs = (pm & 31) == 0;
    for (int it = tid; it < 2 * NCG; it += NTHR) { const int cg = it % NCG, rr = it / NCG, c0 = cg * 8;
        float y[8];
#pragma unroll
        for (int h = 0; h < 2; ++h) { const int c = c0 + 4 * h;
            const f32x4 g = *(const f32x4*)(SG + (size_t)(pm * 2 + rr) * DFF + c), v = *(const f32x4*)(SV + (size_t)(pm * 2 + rr) * DFF + c);
            f32x4 g1, g2; const f32x4 z = {0.f, 0.f, 0.f, 0.f};
            if (rr == 0) { g1 = bs ? z : *(const f32x4*)(SL + (size_t)((pm - 1) * 2 + 1) * DFF + c); g2 = bs ? z : *(const f32x4*)(SL + (size_t)((pm - 1) * 2) * DFF + c); }
            else { g1 = *(const f32x4*)(SG + (size_t)(pm * 2) * DFF + c); g2 = bs ? z : *(const f32x4*)(SL + (size_t)((pm - 1) * 2 + 1) * DFF + c); }
            const f32x4 a0 = *(const f32x4*)(fcw + c), a1 = *(const f32x4*)(fcw + DFF + c), a2 = *(const f32x4*)(fcw + 2 * DFF + c), b = *(const f32x4*)(fcb + c);
#pragma unroll
            for (int e = 0; e < 4; ++e) y[4 * h + e] = gelu_tanh(b[e] + a0[e] * g2[e] + a1[e] * g1[e] + a2[e] * g[e]) * v[e]; }
        u32x4 w; w.x = pkh(y[0], y[1]); w.y = pkh(y[2], y[3]); w.z = pkh(y[4], y[5]); w.w = pkh(y[6], y[7]);
        if (!dry) *(u32x4*)(ACT + (size_t)(pm * 256 + rr) * DFF + c0) = w; }
}

struct EpiGateSig {
    static constexpr bool PERM = true;
    const float* SSQ; h16* GS; int dry;
    __device__ __forceinline__ void operator()(AccRef acc, const pg8::Unit& u, int wr, int wc, int fr, int fq) const {
        const int row0 = u.pm * 256 + wr * 64 + fr; const unsigned fo = frag_off(u.pm, u.pn, wr * 4 + wc, fq * 16 + fr);
#pragma unroll
        for (int ai = 0; ai < 2; ++ai)
#pragma unroll
            for (int m = 0; m < 4; ++m) { const int row = row0 + ai * 128 + m * 16; const float r = __builtin_amdgcn_rsqf(SSQ[row] * (1.0f / DM) + EPS);
#pragma unroll
                for (int bj = 0; bj < 2; ++bj) { const f32x4 v0 = acc[ai][bj][m][0] * r, v1 = acc[ai][bj][m][1] * r;
                    u32x4 w; w.x = pkh(sigmoid_f(v0[0]), sigmoid_f(v0[1])); w.y = pkh(sigmoid_f(v0[2]), sigmoid_f(v0[3])); w.z = pkh(sigmoid_f(v1[0]), sigmoid_f(v1[1])); w.w = pkh(sigmoid_f(v1[2]), sigmoid_f(v1[3]));
                    if (!dry) *(u32x4*)((char*)GS + fo + FRAG_SUB(ai, m, bj)) = w; }
                __builtin_amdgcn_sched_barrier(0); }
    }
};
struct EpiPleOut {
    static constexpr bool PERM = true;
    const h16* GS; const h16* X2; float* C; int dry;
    __device__ __forceinline__ void operator()(AccRef acc, const pg8::Unit& u, int wr, int wc, int fr, int fq) const {
        const int row0 = u.pm * 256 + wr * 64 + fr, col0 = u.pn * 256 + wc * 32 + 8 * fq;
        const unsigned e0 = (unsigned)row0 * DM + (unsigned)col0, fo = frag_off(u.pm, u.pn, wr * 4 + wc, fq * 16 + fr);
#pragma unroll
        for (int ai = 0; ai < 2; ++ai)
#pragma unroll
            for (int m = 0; m < 4; ++m) { const unsigned eo = e0 + (unsigned)((ai * 128 + m * 16) * DM);
#pragma unroll
                for (int bj = 0; bj < 2; ++bj) { const unsigned o2 = eo + bj * 128;
                    const h8 gs = *(const h8*)((const char*)GS + fo + FRAG_SUB(ai, m, bj)), xb = *(const h8*)((const char*)X2 + (size_t)o2 * 2u); const f32x4 a0 = acc[ai][bj][m][0], a1 = acc[ai][bj][m][1];
                    f32x4 o0, o1;
#pragma unroll
                    for (int j = 0; j < 4; ++j) { o0[j] = (float)xb[j] + (float)gs[j] * a0[j]; o1[j] = (float)xb[4 + j] + (float)gs[4 + j] * a1[j]; }
                    if (!dry) { *(f32x4*)((char*)C + (size_t)o2 * 4u) = o0; *(f32x4*)((char*)C + (size_t)o2 * 4u + 16) = o1; } }
                asm volatile("" ::: "memory"); }
    }
};


#define XB_TMO      128
#define XB_XCNT(j)  (256  + 64 * (j))
#define XB_XSUB(j)  (1280 + 64 * (j))
#define XB_XGEN(j)  (2304 + 64 * (j))
#define XB_TOP      3328
#define XB_TOPGEN   3392
#define XCD_BAR_WORDS 3456
#define XB_SPIN_CAP (1u << 20)

__device__ __forceinline__ unsigned xb_ld(unsigned* p)              { return __hip_atomic_load(p, __ATOMIC_RELAXED, __HIP_MEMORY_SCOPE_AGENT); }
__device__ __forceinline__ unsigned xb_add(unsigned* p, unsigned v) { return __hip_atomic_fetch_add(p, v, __ATOMIC_RELAXED, __HIP_MEMORY_SCOPE_AGENT); }
__device__ __forceinline__ unsigned xb_xcc_id() { return (unsigned)__builtin_amdgcn_s_getreg((3 << 11) | 20) & 0xFu; }
#define XB_SPIN(cond, bar) do { unsigned _sp = 0; while (cond) { __builtin_amdgcn_s_sleep(1); \
    if ((++_sp & 255u) == 0u) { if (xb_ld(&(bar)[XB_TMO])) break; if (_sp > XB_SPIN_CAP) { atomicAdd(&(bar)[XB_TMO], 1u); break; } } } } while (0)

struct XcdBarrier { unsigned* bar; unsigned x; volatile LAS unsigned* st; };

__device__ __forceinline__ XcdBarrier xcd_barrier_post(unsigned* bar, volatile LAS unsigned* st) {
    XcdBarrier b; b.bar = bar; b.x = xb_xcc_id(); b.st = st;
    if (threadIdx.x == 0) (void)xb_add(&bar[XB_XCNT(b.x)], 1u);
    return b;
}
__device__ __forceinline__ void xcd_barrier_complete(unsigned* bar, unsigned x, unsigned& nloc, unsigned& nx) {
    const unsigned G = gridDim.x * gridDim.y * gridDim.z;
    unsigned sum, cnt, mine, sp = 0u;
    for (;;) {
        sum = 0u; cnt = 0u; mine = 0u;
#pragma unroll
        for (unsigned j = 0; j < 16; ++j) { const unsigned c = xb_ld(&bar[XB_XCNT(j)]); sum += c; cnt += (c > 0u) ? 1u : 0u; mine = (j == x) ? c : mine; }
        if (sum == G) break;
        __builtin_amdgcn_s_sleep(1);
        if ((++sp & 255u) == 0u) { if (xb_ld(&bar[XB_TMO])) break; if (sp > XB_SPIN_CAP) { atomicAdd(&bar[XB_TMO], 1u); break; } }
    }
    nloc = mine > 0u ? mine : 1u; nx = cnt > 0u ? cnt : 1u;
}
__device__ __forceinline__ void xcd_barrier(const XcdBarrier& b) {
    asm volatile("s_waitcnt vmcnt(0)" ::: "memory");
    __syncthreads();
    if (threadIdx.x == 0) {
        unsigned* bar = b.bar;
        __builtin_amdgcn_s_waitcnt(0);
        unsigned nloc = b.st[0], nx = b.st[1];
        if (nloc == 0u) { xcd_barrier_complete(bar, b.x, nloc, nx); b.st[0] = nloc; b.st[1] = nx; }
        const unsigned old = xb_add(&bar[XB_XSUB(b.x)], 1u);
        const unsigned gen = old / nloc;
        if (old + 1u == (gen + 1u) * nloc) {
            __builtin_amdgcn_fence(__ATOMIC_RELEASE, "agent");
            asm volatile("s_waitcnt vmcnt(0)" ::: "memory");
            const unsigned og = xb_add(&bar[XB_TOP], 1u);
            const unsigned tg = og / nx;
            if (og + 1u == (tg + 1u) * nx) xb_add(&bar[XB_TOPGEN], 1u);
            else XB_SPIN(xb_ld(&bar[XB_TOPGEN]) == tg, bar);
            __builtin_amdgcn_fence(__ATOMIC_ACQUIRE, "agent");
            xb_add(&bar[XB_XGEN(b.x)], 1u);
            asm volatile("s_waitcnt vmcnt(0)" ::: "memory");
        } else {
            XB_SPIN(xb_ld(&bar[XB_XGEN(b.x)]) == gen, bar);
            __builtin_amdgcn_fence(__ATOMIC_ACQUIRE, "agent");
            asm volatile("s_waitcnt vmcnt(0)" ::: "memory");
        }
    }
    __syncthreads();
}

constexpr size_t MiB = 1u << 20;
constexpr size_t WS_CTL = 0, CTL_ZERO_BYTES = 1 * MiB;
constexpr size_t WS_SA = 1 * MiB, WS_SH = 2 * MiB;
constexpr size_t WS_WI = 3 * MiB;
constexpr size_t WS_KI = 4 * MiB;
constexpr size_t WS_W = 8 * MiB;
constexpr size_t W_IN = WS_W, W_LRU = W_IN + (size_t)NIN_PAD * DM * 2, W_ATT = W_LRU + 2 * MiB, W_OUT = W_ATT + 2 * MiB, W_PG = W_OUT + 2 * MiB,
                 W_UP = W_PG + 2 * MiB, W_DOWN = W_UP + 12 * MiB, W_PP = W_DOWN + 6 * MiB, W_GATE = W_PP + MiB / 2, W_END = W_GATE + MiB / 2;
static_assert(W_END <= 48 * MiB, "weights region");
constexpr size_t WS_A0 = 48 * MiB;
constexpr size_t WS_IDX = 48 * MiB, WS_NV = 64 * MiB;
constexpr size_t WS_K8 = 72 * MiB, WS_V8 = 80 * MiB;
constexpr size_t WS_T1 = 48 * MiB;
constexpr size_t WS_X1H = 48 * MiB;
constexpr size_t WS_PH = 112 * MiB;
constexpr size_t WS_LX = 128 * MiB;
constexpr size_t WS_GG = 192 * MiB;
constexpr size_t WS_Q = 256 * MiB;
constexpr size_t WS_K = 320 * MiB, WS_V = 336 * MiB;
constexpr size_t WS_QI = 352 * MiB;
constexpr size_t WS_SGA = 384 * MiB, WS_SGB = 448 * MiB;
constexpr size_t WS_UPG = 128 * MiB, WS_UPV = 320 * MiB;
constexpr size_t WS_X2H = 128 * MiB;
constexpr size_t WS_GS = 320 * MiB;
constexpr size_t WS_END = 512 * MiB;
constexpr int CW_BAR = 1024;
constexpr int CW_Q2 = 8192, CW_Q3 = 8192 + 256;
constexpr size_t CTL_SSQ1 = 256 * 1024, CTL_SSQ2 = 512 * 1024;
static_assert((CW_BAR + XCD_BAR_WORDS) * 4 <= 32768 && CTL_SSQ2 + MTOK * 4 <= CTL_ZERO_BYTES, "ctl map");

constexpr int LDS_BYTES = 159744;
constexpr int MISC_OFF = LDS_BYTES - 256;

struct Params {
    const float* in[25]; float* out; unsigned char* ws; int ph_lo, ph_hi, k_ple, pad;
};

__device__ __forceinline__ float wave_sum(float v) {
#pragma unroll
    for (int o = 1; o < 64; o <<= 1) v += __shfl_xor(v, o);
    return v;
}
template <int MAP> __device__ __forceinline__ int rowmap(int n) {
    if (MAP == 1) return n < 4168 ? n : n + 184;
    if (MAP == 2) return n < DFF ? ((n >> 7) * 256 + (n & 127)) : (((n - DFF) >> 7) * 256 + 128 + ((n - DFF) & 127));
    return n;
}
template <int MAP> __device__ __forceinline__ void p0_transpose_item(const float* W, int K, int N, h16* WT, const float* gain, LAS float* scr, int item, int lane) {
    const int nblk = (N + 31) / 32, kb = item / nblk, nb = item % nblk, k0 = 64 * kb, n0 = 32 * nb;
    const int nn = n0 + (lane & 31);
#pragma unroll 8
    for (int i = 0; i < 32; ++i) { const int kk = 2 * i + (lane >> 5); float v = 0.f; if (nn < N) v = W[(size_t)(k0 + kk) * N + nn]; if (gain) v *= gain[k0 + kk]; scr[kk * 33 + (lane & 31)] = v; }
    LDS_WAIT(); asm volatile("" ::: "memory");
    const int c = lane & 7;
#pragma unroll
    for (int j = 0; j < 4; ++j) { const int n = (lane >> 3) + 8 * j; const LAS float* s = scr + (8 * c) * 33 + n;
        u32x4 o; o.x = pkh(s[0 * 33], s[1 * 33]); o.y = pkh(s[2 * 33], s[3 * 33]); o.z = pkh(s[4 * 33], s[5 * 33]); o.w = pkh(s[6 * 33], s[7 * 33]);
        if (n0 + n < N) *(u32x4*)(WT + (size_t)rowmap<MAP>(n0 + n) * K + k0 + 8 * c) = o; }
    LDS_WAIT(); asm volatile("" ::: "memory");
}

struct Ctx {
    unsigned char* ws; float* out; int dry;
    const float *conv_w, *conv_b, *ba, *bx, *lam, *qn, *kn, *relb, *fcw, *fcb;
};
__device__ __forceinline__ unsigned ordered_u32(float v) { const unsigned u = __builtin_bit_cast(unsigned, v); return u ^ ((unsigned)((int)u >> 31) | 0x80000000u); }

constexpr int UA_STR = 272;
constexpr int LRU_UA = 0, LRU_HL = 128 * UA_STR, LRU_PP = 2 * 128 * UA_STR;
__device__ __forceinline__ void lru1_item(const Ctx& C, LAS unsigned char* lds, int item) {
    int tid = threadIdx.x; asm volatile("" : "+v"(tid));
    const int lane = tid & 63, wv = tid >> 6;
    const int b = item >> 7, n = (item >> 4) & 7, jg = item & 15;
    const h16* LX = (const h16*)(C.ws + WS_LX);
    const int cg = tid & 15, rg = tid >> 4, ch0 = n * 128 + cg * 8, tl = rg * 4;
    float cb[8], cw[4][8];
    { const f32x4 t0 = *(const f32x4*)(C.conv_b + ch0), t1 = *(const f32x4*)(C.conv_b + ch0 + 4); for (int e = 0; e < 4; ++e) { cb[e] = t0[e]; cb[4 + e] = t1[e]; } }
#pragma unroll
    for (int jj = 0; jj < 4; ++jj) { const f32x4 w0 = *(const f32x4*)(C.conv_w + jj * DM + ch0), w1 = *(const f32x4*)(C.conv_w + jj * DM + ch0 + 4); for (int e = 0; e < 4; ++e) { cw[jj][e] = w0[e]; cw[jj][4 + e] = w1[e]; } }
    const int q = lane & 15, c = lane >> 4, oc = wv * 16 + q, ch = n * 128 + oc;
    const h16* WG = (const h16*)(C.ws + W_GATE) + (size_t)n * 256 * 128;
    h8 Ba[4], Bx[4];
#pragma unroll
    for (int ks = 0; ks < 4; ++ks) { Ba[ks] = *(const h8*)(WG + (size_t)oc * 128 + 32 * ks + 8 * c); Bx[ks] = *(const h8*)(WG + (size_t)(128 + oc) * 128 + 32 * ks + 8 * c); }
    const float bav = C.ba[ch], bxv = C.bx[ch], m8sp = -8.0f * 1.4426950408889634f * log1pf(expf(-C.lam[ch]));
#pragma unroll 1
    for (int j4 = 0; j4 < 4; ++j4) {
    const int j = jg * 4 + j4;
    const size_t mrow0 = (size_t)b * SEQ + (size_t)j * 128;
    {
        const int tseq = j * 128 + tl;
        h8 xr[7];
#pragma unroll
        for (int i = 0; i < 7; ++i) { const int tt = tseq - 3 + i; if (tt >= 0) xr[i] = *(const h8*)(LX + ((size_t)b * SEQ + tt) * DM + ch0); else { for (int e = 0; e < 8; ++e) xr[i][e] = (h16)0.f; } }
        float y[4][8];
#pragma unroll
        for (int r = 0; r < 4; ++r)
#pragma unroll
            for (int e = 0; e < 8; ++e) y[r][e] = cb[e];
#pragma unroll
        for (int jj = 0; jj < 4; ++jj)
#pragma unroll
            for (int r = 0; r < 4; ++r)
#pragma unroll
                for (int e = 0; e < 8; ++e) y[r][e] += cw[jj][e] * (float)xr[r + jj][e];
#pragma unroll
        for (int r = 0; r < 4; ++r) { u32x4 w; w.x = pkh(y[r][0], y[r][1]); w.y = pkh(y[r][2], y[r][3]); w.z = pkh(y[r][4], y[r][5]); w.w = pkh(y[r][6], y[r][7]);
            *(LAS u32x4*)(lds + LRU_UA + (tl + r) * UA_STR + cg * 16) = w; }
    }
    __syncthreads();
    {
        float cH = 0.f, cP = 1.f;
        for (int tt = 0; tt < 8; ++tt) {
            f32x4 aa = {0.f, 0.f, 0.f, 0.f}, ax = {0.f, 0.f, 0.f, 0.f};
#pragma unroll
            for (int ks = 0; ks < 4; ++ks) { const h8 A = *(const LAS h8*)(lds + LRU_UA + (16 * tt + q) * UA_STR + (32 * ks + 8 * c) * 2);
                aa = __builtin_amdgcn_mfma_f32_16x16x32_f16(A, Ba[ks], aa, 0, 0, 0); ax = __builtin_amdgcn_mfma_f32_16x16x32_f16(A, Bx[ks], ax, 0, 0, 0); }
            float hl[4], pl[4]; float h = 0.f, p = 1.f;
#pragma unroll
            for (int i = 0; i < 4; ++i) { const int t = 16 * tt + 4 * c + i;
                const float uav = (float)*(const LAS h16*)(lds + LRU_UA + t * UA_STR + oc * 2);
                const float ra = sigmoid_f(aa[i] + bav), ix = sigmoid_f(ax[i] + bxv);
                const float a = __builtin_amdgcn_exp2f(m8sp * ra);
                const float mult = __builtin_amdgcn_sqrtf(fmaxf(1.0f - a * a, 0.f));
                const float u = mult * ix * uav;
                h = a * h + u; p *= a; hl[i] = h; pl[i] = p; }
            float Ak[4], Hk[4];
#pragma unroll
            for (int k = 0; k < 4; ++k) { Ak[k] = __shfl(p, q + 16 * k); Hk[k] = __shfl(h, q + 16 * k); }
            float PA = 1.f, PH = 0.f;
#pragma unroll
            for (int k = 0; k < 3; ++k) if (k < c) { PH = PH * Ak[k] + Hk[k]; PA *= Ak[k]; }
            const float hin = cH * PA + PH, pin = cP * PA;
#pragma unroll
            for (int i = 0; i < 4; ++i) { const int t = 16 * tt + 4 * c + i;
                *(LAS h16*)(lds + LRU_HL + t * UA_STR + oc * 2) = (h16)(hl[i] + pl[i] * hin);
                *(LAS h16*)(lds + LRU_PP + t * UA_STR + oc * 2) = (h16)(pin * pl[i]); }
            const float AT = Ak[0] * Ak[1] * Ak[2] * Ak[3], HT = ((Hk[0] * Ak[1] + Hk[1]) * Ak[2] + Hk[2]) * Ak[3] + Hk[3];
            cH = cH * AT + HT; cP = cP * AT;
        }
        if (c == 0 && !C.dry) { const size_t so = ((size_t)b * 64 + j) * DM + ch; ((float*)(C.ws + WS_SA))[so] = cP; ((float*)(C.ws + WS_SH))[so] = cH; }
    }
    __syncthreads();
    {
        h16* HLOC = (h16*)C.out; h16* PPRD = (h16*)C.out + (size_t)MTOK * DM;
#pragma unroll
        for (int r = 0; r < 4; ++r) { const int t = rg * 4 + r; const size_t go = (mrow0 + t) * DM + n * 128 + cg * 8;
            const u32x4 w0 = *(const LAS u32x4*)(lds + LRU_HL + t * UA_STR + cg * 16), w1 = *(const LAS u32x4*)(lds + LRU_PP + t * UA_STR + cg * 16);
            if (!C.dry) { *(u32x4*)(HLOC + go) = w0; *(u32x4*)(PPRD + go) = w1; } }
    }
    __syncthreads();
    }
}

__device__ __forceinline__ void lru2_item(const Ctx& C, LAS unsigned char* lds, int item) {
    int tid = threadIdx.x; asm volatile("" : "+v"(tid));
    const int b = item >> 7, n = (item >> 4) & 7, jg = item & 15, j0 = jg * 4;
    LAS float* carry = (LAS float*)lds;
    if (tid < 128) { const int ch = n * 128 + tid; const float* SA = (const float*)(C.ws + WS_SA) + (size_t)b * 64 * DM + ch; const float* SH = (const float*)(C.ws + WS_SH) + (size_t)b * 64 * DM + ch;
        float cr = 0.f; int jj = 0;
        for (; jj + 8 <= j0; jj += 8) { float a8[8], h8v[8];
#pragma unroll
            for (int k = 0; k < 8; ++k) { a8[k] = SA[(size_t)(jj + k) * DM]; h8v[k] = SH[(size_t)(jj + k) * DM]; }
#pragma unroll
            for (int k = 0; k < 8; ++k) cr = a8[k] * cr + h8v[k]; }
        for (; jj < j0; ++jj) cr = SA[(size_t)jj * DM] * cr + SH[(size_t)jj * DM];
        float a4[4], h4[4];
#pragma unroll
        for (int k = 0; k < 4; ++k) { a4[k] = SA[(size_t)(j0 + k) * DM]; h4[k] = SH[(size_t)(j0 + k) * DM]; }
#pragma unroll
        for (int k = 0; k < 4; ++k) { carry[k * 128 + tid] = cr; cr = a4[k] * cr + h4[k]; } }
    __syncthreads();
    const int cg = tid & 15, rg = tid >> 4; const h16* HLOC = (const h16*)C.out; const h16* PPRD = (const h16*)C.out + (size_t)MTOK * DM;
    const h16* GG = (const h16*)(C.ws + WS_GG); h16* YA = (h16*)(C.ws + WS_LX);
#pragma unroll 1
    for (int k = 0; k < 4; ++k) {
        float cr[8];
#pragma unroll
        for (int e = 0; e < 8; ++e) cr[e] = carry[k * 128 + cg * 8 + e];
#pragma unroll
        for (int r = 0; r < 4; ++r) { const size_t go = ((size_t)b * SEQ + (j0 + k) * 128 + rg * 4 + r) * DM + n * 128 + cg * 8;
            const h8 hl = *(const h8*)(HLOC + go), pp = *(const h8*)(PPRD + go), gg = *(const h8*)(GG + go);
            float y[8];
#pragma unroll
            for (int e = 0; e < 8; ++e) y[e] = ((float)hl[e] + (float)pp[e] * cr[e]) * (float)gg[e];
            u32x4 w; w.x = pkh(y[0], y[1]); w.y = pkh(y[2], y[3]); w.z = pkh(y[4], y[5]); w.w = pkh(y[6], y[7]);
            if (!C.dry) *(u32x4*)(YA + go) = w; } }
}

__device__ __forceinline__ unsigned pk4_fp8_k(float a, float b, float c, float d) { int w = 0; w = __builtin_amdgcn_cvt_pk_fp8_f32(a, b, w, false); w = __builtin_amdgcn_cvt_pk_fp8_f32(c, d, w, true); return (unsigned)w; }
__device__ __forceinline__ void knorm_unit(const Ctx& C, int unit) {
    int tid = threadIdx.x; asm volatile("" : "+v"(tid));
    const int lane = tid & 63, wv = tid >> 6;
    const h16* K = (const h16*)(C.ws + WS_K); const h16* V = (const h16*)(C.ws + WS_V);
    unsigned* K8 = (unsigned*)(C.ws + WS_K8); unsigned* V8 = (unsigned*)(C.ws + WS_V8);
    const int col = lane * 4, d0 = col & 127;
    const f32x4 g = *(const f32x4*)(C.kn + d0);
    for (int r = 0; r < 16; ++r) { const size_t row = (size_t)unit * 128 + wv * 16 + r;
        const h4 v = *(const h4*)(K + row * 256 + col), vv = *(const h4*)(V + row * 256 + col);
        float ss = 0.f, f[4];
#pragma unroll
        for (int e = 0; e < 4; ++e) { f[e] = (float)v[e]; ss += f[e] * f[e]; }
#pragma unroll
        for (int o = 1; o < 32; o <<= 1) ss += __shfl_xor(ss, o);
        const float rs = __builtin_amdgcn_rsqf(ss * (1.0f / 128.0f) + EPS);
        const unsigned wk = pk4_fp8_k(f[0] * rs * g[0], f[1] * rs * g[1], f[2] * rs * g[2], f[3] * rs * g[3]);
        const unsigned wvv = pk4_fp8_k((float)vv[0], (float)vv[1], (float)vv[2], (float)vv[3]);
        if (!C.dry) { K8[row * 64 + lane] = wk; V8[row * 64 + lane] = wvv; } }
}

#ifdef IX_PROBE
#define IX_PROBE_FINAL (C.dry && (IX_PROBE & 2))
#define IX_PROBE_NOFILT (C.dry && (IX_PROBE & 1))
#else
#define IX_PROBE_FINAL 0
#define IX_PROBE_NOFILT 0
#endif
constexpr int IX_SK = 256;
constexpr int IX_CAP = 1024;
constexpr int IX_ORD = 0;
constexpr int IX_KEY = IX_ORD + 16 * IX_CAP * 4;
constexpr int IX_HIST = IX_KEY + 16 * IX_CAP * 2;
constexpr int IX_CTR = IX_HIST + 8 * 512;
constexpr int IX_END = IX_CTR + 128;
static_assert(IX_END <= MISC_OFF, "indexer LDS");
constexpr int IX_NE = IX_CAP / 64;

struct IxBuf { LAS unsigned* ord; LAS unsigned short* key; };
#define IX_DPPMAX(v, ctl, rm) { const unsigned t_ = (unsigned)__builtin_amdgcn_update_dpp((int)(v), (int)(v), ctl, rm, 0xf, false); v = t_ > v ? t_ : v; }
__device__ __forceinline__ unsigned ix_rowmax(unsigned v) { IX_DPPMAX(v, 0xB1, 0xf) IX_DPPMAX(v, 0x4E, 0xf) IX_DPPMAX(v, 0x141, 0xf) IX_DPPMAX(v, 0x140, 0xf) return v; }
__device__ __forceinline__ unsigned ix_wavemax(unsigned v) { v = ix_rowmax(v); IX_DPPMAX(v, 0x142, 0xa) IX_DPPMAX(v, 0x143, 0xc) return (unsigned)__builtin_amdgcn_readlane((int)v, 63); }
__device__ __forceinline__ void ix_load_ord(const IxBuf& B, int cnt, int lane, unsigned (&o)[IX_NE]) {
#pragma unroll
    for (int k = 0; k < IX_NE; ++k) { const int idx = k * 64 + lane; o[k] = idx < cnt ? B.ord[idx] : 0u; }
}
__device__ __forceinline__ int ix_count_ge(const unsigned (&o)[IX_NE], unsigned x) {
    int c = 0;
#pragma unroll
    for (int k = 0; k < IX_NE; ++k) c += (int)__builtin_popcountll(__ballot(o[k] >= x));
    return c;
}
__device__ __forceinline__ unsigned ix_max(const unsigned (&o)[IX_NE]) {
    unsigned m = 0u;
#pragma unroll
    for (int k = 0; k < IX_NE; ++k) m = o[k] > m ? o[k] : m;
    return ix_wavemax(m);
}
__device__ __forceinline__ unsigned ix_tie_thr(const unsigned (&o)[IX_NE], const unsigned short (&kk)[IX_NE], unsigned x, int need) {
    unsigned lo = 0u, hi = 0x10000u;
    while (hi - lo > 1u) { const unsigned mid = (lo + hi) >> 1; int c = 0;
#pragma unroll
        for (int k = 0; k < IX_NE; ++k) c += (int)__builtin_popcountll(__ballot(o[k] == x && (unsigned)kk[k] >= mid));
        if (c >= need) lo = mid; else hi = mid; }
    return lo;
}
__device__ __forceinline__ int ix_rewrite(const IxBuf& B, const unsigned (&o)[IX_NE], const unsigned short (&kk)[IX_NE], int lane, unsigned x, unsigned th) {
    int base = 0;
#pragma unroll
    for (int k = 0; k < IX_NE; ++k) { const bool keep = o[k] > x || (o[k] == x && (unsigned)kk[k] >= th);
        const u64 m = __ballot(keep); const int pos = base + (int)__builtin_amdgcn_mbcnt_hi((unsigned)(m >> 32), __builtin_amdgcn_mbcnt_lo((unsigned)m, 0u));
        if (keep) { B.ord[pos] = o[k]; B.key[pos] = kk[k]; }
        base += (int)__builtin_popcountll(m); }
    LDS_WAIT();
    return base;
}
__device__ __forceinline__ unsigned ix_sample_pivot(unsigned s0, int rank) {
    int r = 0;
#define IX_ROT(n) { const unsigned t_ = (unsigned)__builtin_amdgcn_update_dpp(0, (int)s0, 0x120 + n, 0xf, 0xf, false); r += t_ > s0 ? 1 : 0; }
    IX_ROT(1) IX_ROT(2) IX_ROT(3) IX_ROT(4) IX_ROT(5) IX_ROT(6) IX_ROT(7) IX_ROT(8) IX_ROT(9) IX_ROT(10) IX_ROT(11) IX_ROT(12) IX_ROT(13) IX_ROT(14) IX_ROT(15)
#undef IX_ROT
    unsigned v = r >= rank ? s0 : 0u;
    v = ix_rowmax(v);
    return ((unsigned)__builtin_amdgcn_readlane((int)v, 0) >> 2) + ((unsigned)__builtin_amdgcn_readlane((int)v, 16) >> 2) + ((unsigned)__builtin_amdgcn_readlane((int)v, 32) >> 2) + ((unsigned)__builtin_amdgcn_readlane((int)v, 48) >> 2);
}
__device__ __forceinline__ unsigned ix_find_window(const unsigned (&o)[IX_NE], unsigned lo, unsigned hi, int cnt, int cmin, int cmax, bool& tie) {
    tie = false;
    int rank = (16 * ((cmin + cmax) / 2)) / cnt; rank = rank > 14 ? 14 : rank;
    unsigned x = ix_sample_pivot(o[0], rank);
    if (x <= lo || x >= hi) x = lo + ((hi - lo) >> 1);
    for (;;) { const int c = ix_count_ge(o, x);
        if (c > cmax) lo = x; else if (c < cmin) hi = x; else return x - 1u;
        if (hi - lo <= 1u) { tie = true; return lo; }
        x = lo + ((hi - lo) >> 1); }
}
__device__ __forceinline__ unsigned ix_compact(const IxBuf& B, int lane, int& cnt, unsigned T) {
    unsigned o[IX_NE]; ix_load_ord(B, cnt, lane, o);
    unsigned short kk[IX_NE];
#pragma unroll
    for (int k = 0; k < IX_NE; ++k) kk[k] = B.key[k * 64 + lane];
    LDS_WAIT();
    bool tie; unsigned th = 0x10000u;
    const unsigned x = ix_find_window(o, T, ix_max(o) + 1u, cnt, 256, 512, tie);
    if (tie) th = ix_tie_thr(o, kk, x, 512 - ix_count_ge(o, x + 1u));
    cnt = ix_rewrite(B, o, kk, lane, x, th); return x + 1u;
}
__device__ __forceinline__ unsigned ix_compact_to(const IxBuf& B, int lane, int& cnt, unsigned T) {
    unsigned o[IX_NE]; ix_load_ord(B, cnt, lane, o);
    unsigned short kk[IX_NE];
#pragma unroll
    for (int k = 0; k < IX_NE; ++k) kk[k] = B.key[k * 64 + lane];
    LDS_WAIT();
    bool tie; unsigned th = 0x10000u;
    const unsigned x = ix_find_window(o, T, ix_max(o) + 1u, cnt, 256, 320, tie);
    if (tie) th = ix_tie_thr(o, kk, x, 320 - ix_count_ge(o, x + 1u));
    cnt = ix_rewrite(B, o, kk, lane, x, th); return x + 1u;
}
__device__ __forceinline__ void ix_final(const IxBuf& B, LAS unsigned short* outl, int lane, int cnt, unsigned T, unsigned short* idx_row, int* nv_ptr, int dry) {
    if (cnt > 320) { cnt = cnt < IX_CAP ? cnt : IX_CAP; T = ix_compact_to(B, lane, cnt, T); }
    unsigned o[5]; unsigned short kk[5];
#pragma unroll
    for (int k = 0; k < 5; ++k) { const int idx = k * 64 + lane; o[k] = idx < cnt ? B.ord[idx] : 0u; kk[k] = B.key[idx]; }
    LDS_WAIT();
    unsigned x = 0u, th = 0u;
    if (cnt > 256) { unsigned mxv = 0u;
#pragma unroll
        for (int k = 0; k < 5; ++k) mxv = o[k] > mxv ? o[k] : mxv;
        mxv = ix_wavemax(mxv);
        unsigned lo = T, hi = mxv + 1u;
        for (;;) { if (hi - lo <= 1u) { x = lo; int ca = 0, need;
#pragma unroll
                for (int k = 0; k < 5; ++k) ca += (int)__builtin_popcountll(__ballot(o[k] >= lo + 1u));
                need = 256 - ca; unsigned tl = 0u, thh = 0x10000u;
                while (thh - tl > 1u) { const unsigned mid = (tl + thh) >> 1; int c = 0;
#pragma unroll
                    for (int k = 0; k < 5; ++k) c += (int)__builtin_popcountll(__ballot(o[k] == x && (unsigned)kk[k] >= mid));
                    if (c >= need) tl = mid; else thh = mid; }
                th = tl; break; }
            const unsigned mid = lo + ((hi - lo) >> 1); int c = 0;
#pragma unroll
            for (int k = 0; k < 5; ++k) c += (int)__builtin_popcountll(__ballot(o[k] >= mid));
            if (c == 256) { x = mid - 1u; th = 0x10000u; break; }
            if (c > 256) lo = mid; else hi = mid; } }
    int base = 0;
#pragma unroll
    for (int k = 0; k < 5; ++k) { const bool valid = k * 64 + lane < cnt; const bool sel = valid && (o[k] > x || (o[k] == x && (unsigned)kk[k] >= th));
        const u64 m = __ballot(sel); const int pos = base + (int)__builtin_amdgcn_mbcnt_hi((unsigned)(m >> 32), __builtin_amdgcn_mbcnt_lo((unsigned)m, 0u));
        if (sel && pos < 256) outl[pos] = (unsigned short)(0xFFFFu - (unsigned)kk[k]);
        base += (int)__builtin_popcountll(m); }
    LDS_WAIT();
    const int nsel = base < 256 ? base : 256;
    const u32x2 ow = *(const LAS u32x2*)(outl + lane * 4);
    if (!dry) { *(u32x2*)(idx_row + lane * 4) = ow; if (lane == 0) *nv_ptr = nsel; }
    LDS_WAIT();
}
__device__ __forceinline__ float ix_unordered(unsigned T) { const unsigned u = (T & 0x80000000u) ? (T ^ 0x80000000u) : ~T; return __builtin_bit_cast(float, u); }

__device__ __forceinline__ void indexer_unit(const Ctx& C, LAS unsigned char* lds, int unit) {
    int tid = threadIdx.x; asm volatile("" : "+v"(tid));
    const int lane = tid & 63, wv = __builtin_amdgcn_readfirstlane(tid >> 6);
    const int b = unit & 3, qt = 511 - (unit >> 2), t0 = qt * 16;
    const int q = lane & 15, c = lane >> 4;
    const size_t m0 = (size_t)b * SEQ + t0;
    const h16* QI = (const h16*)(C.ws + WS_QI); const h16* KI = (const h16*)(C.ws + WS_KI) + (size_t)b * SEQ * 64; const float* WI = (const float*)(C.ws + WS_WI);
    LAS unsigned* cntl = (LAS unsigned*)(lds + IX_CTR); volatile LAS float* taul = (volatile LAS float*)(lds + IX_CTR + 64);
    if (tid < 16) { cntl[tid] = 0u; taul[tid] = -3.402823466e38f; }
    h8 qf[8][2];
#pragma unroll
    for (int h = 0; h < 8; ++h)
#pragma unroll
        for (int ks = 0; ks < 2; ++ks) qf[h][ks] = *(const h8*)(QI + ((((m0 >> 4) * 8 + h) * 2 + ks) * 64 + lane) * 8);
    float wvv[8]; { const f32x4 w0 = *(const f32x4*)(WI + (m0 + q) * 8), w1 = *(const f32x4*)(WI + (m0 + q) * 8 + 4); for (int e = 0; e < 4; ++e) { wvv[e] = w0[e]; wvv[4 + e] = w1[e]; } }
#pragma unroll
    for (int h = 0; h < 8; ++h) wvv[h] *= 0.5f;
    h8 qs[2];
#pragma unroll
    for (int ks = 0; ks < 2; ++ks)
#pragma unroll
        for (int j = 0; j < 8; ++j) { float a = 0.f;
#pragma unroll
            for (int h = 0; h < 8; ++h) a += wvv[h] * (float)qf[h][ks][j];
            qs[ks][j] = (h16)a; }
    const int nkeys = t0 + 16, nslab = (nkeys + IX_SK - 1) / IX_SK;
    LAS unsigned* ordq = (LAS unsigned*)(lds + IX_ORD) + (size_t)q * IX_CAP; LAS unsigned short* keyq = (LAS unsigned short*)(lds + IX_KEY) + (size_t)q * IX_CAP;
    IxBuf BA, BB;
    BA.ord = (LAS unsigned*)(lds + IX_ORD) + (size_t)(2 * wv) * IX_CAP; BA.key = (LAS unsigned short*)(lds + IX_KEY) + (size_t)(2 * wv) * IX_CAP;
    BB.ord = BA.ord + IX_CAP; BB.key = BA.key + IX_CAP;
    LAS unsigned short* outl = (LAS unsigned short*)(lds + IX_HIST) + wv * 256;
    unsigned TA = 0x00800000u, TB = 0x00800000u; float tq = -3.402823466e38f;
    __syncthreads();
#define IX_LOADK(dst, s_) do { const int sc_ = (s_) < nslab - 1 ? (s_) : nslab - 1; _Pragma("unroll") for (int jt_ = 0; jt_ < 2; ++jt_) { int key0_ = sc_ * IX_SK + 32 * wv + 16 * jt_; key0_ = key0_ < nkeys ? key0_ : nkeys - 16; \
        const h16* p_ = KI + ((size_t)(key0_ >> 4) * 128 + lane) * 8;        \
        asm volatile("global_load_dwordx4 %0, %2, off\n\tglobal_load_dwordx4 %1, %2, off offset:1024" : "=&v"(dst[jt_][0]), "=&v"(dst[jt_][1]) : "v"(p_) : "memory"); } } while (0)
#define IX_WAITK(KF) asm volatile("s_waitcnt vmcnt(4)" : "+v"(KF[0][0]), "+v"(KF[0][1]), "+v"(KF[1][0]), "+v"(KF[1][1]) :: "memory")
#define IX_MM2(KF, A_, B_, Q0, Q1) do { A_ = __builtin_amdgcn_mfma_f32_16x16x32_f16(KF[0][0], Q0, (f32x4){0.f, 0.f, 0.f, 0.f}, 0, 0, 0); B_ = __builtin_amdgcn_mfma_f32_16x16x32_f16(KF[1][0], Q0, (f32x4){0.f, 0.f, 0.f, 0.f}, 0, 0, 0); \
        A_ = __builtin_amdgcn_mfma_f32_16x16x32_f16(KF[0][1], Q1, A_, 0, 0, 0); B_ = __builtin_amdgcn_mfma_f32_16x16x32_f16(KF[1][1], Q1, B_, 0, 0, 0); } while (0)
#define IX_SCORE2(KF, sca, scb) do { \
        f32x4 ta_[2], tb_[2]; \
        IX_MM2(KF, sca, scb, qs[0], qs[1]); IX_MM2(KF, ta_[0], tb_[0], qf[0][0], qf[0][1]); \
        _Pragma("unroll") for (int h = 0; h < 8; ++h) {        \
            __builtin_amdgcn_sched_barrier(0); \
            if (h < 7) IX_MM2(KF, ta_[(h + 1) & 1], tb_[(h + 1) & 1], qf[h + 1][0], qf[h + 1][1]); \
            __builtin_amdgcn_sched_barrier(0); \
            _Pragma("unroll") for (int i = 0; i < 4; ++i) { sca[i] = __builtin_fmaf(wvv[h], __builtin_fabsf(ta_[h & 1][i]), sca[i]); asm("" : "+v"(sca[i])); }   \
            _Pragma("unroll") for (int i = 0; i < 4; ++i) { scb[i] = __builtin_fmaf(wvv[h], __builtin_fabsf(tb_[h & 1][i]), scb[i]); asm("" : "+v"(scb[i])); } } \
        __builtin_amdgcn_sched_barrier(0); } while (0)
#define IX_SCORE(KF, sc, jt, key0) do { \
        sc = __builtin_amdgcn_mfma_f32_16x16x32_f16(KF[jt][0], qs[0], (f32x4){0.f, 0.f, 0.f, 0.f}, 0, 0, 0); sc = __builtin_amdgcn_mfma_f32_16x16x32_f16(KF[jt][1], qs[1], sc, 0, 0, 0); \
        _Pragma("unroll") for (int h = 0; h < 8; ++h) { f32x4 a = {0.f, 0.f, 0.f, 0.f}; \
            a = __builtin_amdgcn_mfma_f32_16x16x32_f16(KF[jt][0], qf[h][0], a, 0, 0, 0); a = __builtin_amdgcn_mfma_f32_16x16x32_f16(KF[jt][1], qf[h][1], a, 0, 0, 0); \
            _Pragma("unroll") for (int i = 0; i < 4; ++i) { sc[i] = __builtin_fmaf(wvv[h], __builtin_fabsf(a[i]), sc[i]); asm("" : "+v"(sc[i])); } } } while (0)
#define IX_MASK(sc, key0) do { if ((key0) + 15 > t0) {        \
            _Pragma("unroll") for (int i = 0; i < 4; ++i) if ((key0) + 4 * c + i > t0 + q) sc[i] = -INFINITY; } } while (0)
#define IX_ASK(sc, ps, pos) do { _Pragma("unroll") for (int i = 0; i < 4; ++i) { ps[i] = sc[i] >= tq; pos[i] = 0u; if (ps[i]) pos[i] = __hip_atomic_fetch_add(cntl + q, 1u, __ATOMIC_RELAXED, __HIP_MEMORY_SCOPE_WORKGROUP); } } while (0)
#define IX_PUT(sc, ps, pos, key0) do { _Pragma("unroll") for (int i = 0; i < 4; ++i) if (ps[i]) { ordq[pos[i]] = ordered_u32(sc[i] + 0.0f); keyq[pos[i]] = (unsigned short)(0xFFFFu - (unsigned)((key0) + 4 * c + i)); } } while (0)
#define IX_STEP(sv, KF) do { const int s_ = (sv); if (s_ < nslab) { \
        IX_WAITK(KF); \
        const int key0a = s_ * IX_SK + (2 * wv) * 16, key0b = key0a + 16; \
        const bool hb = key0b < nkeys;                                 \
        if (key0a < nkeys) { \
            f32x4 sca, scb; bool psa[4], psb[4]; unsigned posa[4], posb[4]; \
            if (hb) { IX_SCORE2(KF, sca, scb); IX_MASK(sca, key0a); IX_MASK(scb, key0b); \
                if (!IX_PROBE_NOFILT) { IX_ASK(sca, psa, posa); IX_ASK(scb, psb, posb); IX_PUT(sca, psa, posa, key0a); IX_PUT(scb, psb, posb, key0b); } } \
            else { IX_SCORE(KF, sca, 0, key0a); IX_MASK(sca, key0a); if (!IX_PROBE_NOFILT) { IX_ASK(sca, psa, posa); IX_PUT(sca, psa, posa, key0a); } } \
        } \
        IX_LOADK(KF, s_ + 2);                                         \
        LDS_WAIT(); \
        __syncthreads(); \
        const unsigned mycnt = cntl[q];                               \
        if (__ballot(mycnt > (unsigned)(IX_CAP - IX_SK)) != 0ull) {       \
            int ca = (int)cntl[2 * wv], cb = (int)cntl[2 * wv + 1]; ca = ca < IX_CAP ? ca : IX_CAP; cb = cb < IX_CAP ? cb : IX_CAP; \
            if (ca > 512) { TA = ix_compact(BA, lane, ca, TA); if (lane == 0) { cntl[2 * wv] = (unsigned)ca; taul[2 * wv] = ix_unordered(TA); } } \
            if (cb > 512) { TB = ix_compact(BB, lane, cb, TB); if (lane == 0) { cntl[2 * wv + 1] = (unsigned)cb; taul[2 * wv + 1] = ix_unordered(TB); } } \
            LDS_WAIT(); \
            __syncthreads(); \
            tq = taul[q]; } \
        } } while (0)
    h8 ka[2][2], kb[2][2];
    asm volatile("s_waitcnt vmcnt(0)" ::: "memory");
    IX_LOADK(ka, 0); IX_LOADK(kb, 1);
    for (int s = 0; s < nslab; s += 2) { IX_STEP(s, ka); IX_STEP(s + 1, kb); }
    asm volatile("s_waitcnt vmcnt(0)" : "+v"(ka[0][0]), "+v"(ka[0][1]), "+v"(ka[1][0]), "+v"(ka[1][1]), "+v"(kb[0][0]), "+v"(kb[0][1]), "+v"(kb[1][0]), "+v"(kb[1][1]) :: "memory");
#undef IX_STEP
#undef IX_SCORE
#undef IX_SCORE2
#undef IX_MM2
#undef IX_MASK
#undef IX_ASK
#undef IX_PUT
#undef IX_LOADK
#undef IX_WAITK
    LDS_WAIT();
    if (IX_PROBE_FINAL) return;
    unsigned short* IDX = (unsigned short*)(C.ws + WS_IDX); int* NV = (int*)(C.ws + WS_NV);
    int ca = (int)cntl[2 * wv], cb = (int)cntl[2 * wv + 1]; ca = ca < IX_CAP ? ca : IX_CAP; cb = cb < IX_CAP ? cb : IX_CAP;
    ix_final(BA, outl, lane, ca, TA, IDX + (m0 + 2 * wv) * 256, NV + m0 + 2 * wv, C.dry);
    ix_final(BB, outl, lane, cb, TB, IDX + (m0 + 2 * wv + 1) * 256, NV + m0 + 2 * wv + 1, C.dry);
}


constexpr int AT_CH = 4096;
constexpr int AT_NR = 4;
constexpr int AT_WAVE = AT_NR * AT_CH + 1024;
constexpr int AT_TAB = 8 * AT_WAVE;
constexpr int AT_QN = AT_TAB + 129 * 8 * 4;
constexpr int AT_END = AT_QN + 512;
static_assert(AT_END + 1024 <= MISC_OFF && (AT_WAVE % 16) == 0 && (AT_QN % 16) == 0, "attention LDS");
constexpr int AT_QPW = 8;
__device__ __forceinline__ int at_f(int row) { return 2 * ((row >> 1) & 3) | ((row >> 3) & 1); }

__device__ __forceinline__ void attn_build_tab(const Ctx& C, LAS unsigned char* lds) {
    LAS float* tab = (LAS float*)(lds + AT_TAB);
    for (int e = threadIdx.x; e < 129 * 8; e += NTHR) { const int d = e >> 3, h = e & 7; int bk;
        if (d < 16) bk = d; else { bk = 16 + (int)(logf((float)d / 16.0f) / 2.0794415416798357f * 16.0f); if (bk > 31) bk = 31; }
        tab[e] = C.relb[bk * 8 + h]; }
    if (threadIdx.x < 128) ((LAS float*)(lds + AT_QN))[threadIdx.x] = C.qn[threadIdx.x];
}
__device__ __forceinline__ void at_issue(const unsigned char* base, const LAS unsigned short* idl, int pos0, LAS unsigned char* buf, int lane) {
#pragma unroll
    for (int k2 = 0; k2 < 4; ++k2) { const int row = (lane >> 3) + 8 * k2, slot = lane & 7; const int idx = idl[pos0 + row];
        __builtin_amdgcn_global_load_lds((const unsigned*)(base + (size_t)idx * 256 + ((slot ^ at_f(row)) << 4)), (LAS unsigned*)(buf + k2 * 1024), 16, 0, 0); }
}
__device__ __forceinline__ unsigned pk4_fp8(float a, float b, float c, float d) { int w = 0; w = __builtin_amdgcn_cvt_pk_fp8_f32(a, b, w, false); w = __builtin_amdgcn_cvt_pk_fp8_f32(c, d, w, true); return (unsigned)w; }
__device__ __forceinline__ long mk64(unsigned lo, unsigned hi) { return (long)(((u64)hi << 32) | (u64)lo); }
#define AT_WAITN(n) asm volatile("s_waitcnt vmcnt(" #n ")" ::: "memory")

__device__ __forceinline__ void attn_item(const Ctx& C, LAS unsigned char* lds, int item) {
    int tid = threadIdx.x; asm volatile("" : "+v"(tid));
    const int lane = tid & 63, wv = __builtin_amdgcn_readfirstlane(tid >> 6);
    const int g = lane & 15, c = lane >> 4, gq = g & 3;
    const int qsel = item / (SEQ / (8 * AT_QPW)), b = qsel >> 1, n = qsel & 1, tbase = (item % (SEQ / (8 * AT_QPW))) * (8 * AT_QPW) + wv;
    LAS unsigned char* ring = lds + wv * AT_WAVE;
    LAS unsigned short* idlb = (LAS unsigned short*)(ring + AT_NR * AT_CH);
    const LAS float* tab = (const LAS float*)(lds + AT_TAB);
    const LAS float* qnl = (const LAS float*)(lds + AT_QN);
    const unsigned char* Kb = (const unsigned char*)(C.ws + WS_K8) + (size_t)b * SEQ * 256 + n * 128; const unsigned char* Vb = (const unsigned char*)(C.ws + WS_V8) + (size_t)b * SEQ * 256 + n * 128;
    const unsigned short* IDXb = (const unsigned short*)(C.ws + WS_IDX) + (size_t)b * SEQ * 256; const int* NVb = (const int*)(C.ws + WS_NV) + (size_t)b * SEQ;
    h16* Qb = (h16*)(C.ws + WS_Q) + (size_t)b * SEQ * DM + n * 512;
    const int fg = at_f(g), q4 = g >> 2, p4 = g & 3, rowA = 4 * c + q4, fr = at_f(rowA);
    u32x2 a_idx; int a_nv; h8 a_q[4];
#define AT_STAGE_A(tq) do { const size_t m_ = (size_t)(tq); a_idx = *(const u32x2*)(IDXb + m_ * 256 + lane * 4); a_nv = NVb[m_]; \
        _Pragma("unroll") for (int ks = 0; ks < 4; ++ks) a_q[ks] = *(const h8*)(Qb + m_ * DM + gq * 128 + 32 * c + 8 * ks); } while (0)
#define AT_STAGE_B(idl_, qf_, nv_) do { nv_ = a_nv; { const int p0 = lane * 4; unsigned s0 = a_idx.x & 0xFFFFu, s1 = a_idx.x >> 16, s2 = a_idx.y & 0xFFFFu, s3 = a_idx.y >> 16; \
          if (p0 + 0 >= nv_) s0 = 0; if (p0 + 1 >= nv_) s1 = 0; if (p0 + 2 >= nv_) s2 = 0; if (p0 + 3 >= nv_) s3 = 0; \
          u32x2 o_; o_.x = s0 | (s1 << 16); o_.y = s2 | (s3 << 16); *(LAS u32x2*)((idl_) + lane * 4) = o_; } \
        float ss_ = 0.f; _Pragma("unroll") for (int ks = 0; ks < 4; ++ks) _Pragma("unroll") for (int e = 0; e < 8; ++e) { const float x_ = (float)a_q[ks][e]; ss_ += x_ * x_; } \
        ss_ += __shfl_xor(ss_, 16); ss_ += __shfl_xor(ss_, 32); \
        const float rs_ = g < 4 ? __builtin_amdgcn_rsqf(ss_ * (1.0f / 128.0f) + EPS) : 0.f; \
        _Pragma("unroll") for (int ks = 0; ks < 4; ++ks) { const f32x4 g0 = *(const LAS f32x4*)(qnl + 32 * c + 8 * ks), g1 = *(const LAS f32x4*)(qnl + 32 * c + 8 * ks + 4); \
            qf_[ks] = mk64(pk4_fp8((float)a_q[ks][0] * rs_ * g0[0], (float)a_q[ks][1] * rs_ * g0[1], (float)a_q[ks][2] * rs_ * g0[2], (float)a_q[ks][3] * rs_ * g0[3]), \
                           pk4_fp8((float)a_q[ks][4] * rs_ * g1[0], (float)a_q[ks][5] * rs_ * g1[1], (float)a_q[ks][6] * rs_ * g1[2], (float)a_q[ks][7] * rs_ * g1[3])); } \
        LDS_WAIT(); } while (0)
    long qf[4]; int nv;
    AT_STAGE_A(tbase);
    AT_STAGE_B(idlb, qf, nv);
    AT_WAITN(0);
#pragma unroll
    for (int i = 0; i < AT_NR; ++i) at_issue(Kb, idlb, 32 * i, ring + i * AT_CH, lane);
#pragma unroll 1
    for (int k = 0; k < AT_QPW; ++k) {
        const int t = tbase + 8 * k, tn = k + 1 < AT_QPW ? t + 8 : t;
        const LAS unsigned short* idl = idlb + (k & 1) * 256; LAS unsigned short* idln = idlb + ((k + 1) & 1) * 256;
        float S[16][4];
#pragma unroll
        for (int kc = 0; kc < 8; ++kc) {
            LAS unsigned char* buf = ring + (kc & 3) * AT_CH;
            if (kc <= 4) AT_WAITN(12); else AT_WAITN(18);
#pragma unroll
            for (int j = 0; j < 2; ++j) { f32x4 a = {0.f, 0.f, 0.f, 0.f};
                const u32x4 A0 = *(const LAS u32x4*)(buf + (16 * j + g) * 128 + (((2 * c) ^ fg) << 4)), A1 = *(const LAS u32x4*)(buf + (16 * j + g) * 128 + (((2 * c + 1) ^ fg) << 4));
                a = __builtin_amdgcn_mfma_f32_16x16x32_fp8_fp8(mk64(A0.x, A0.y), qf[0], a, 0, 0, 0); a = __builtin_amdgcn_mfma_f32_16x16x32_fp8_fp8(mk64(A0.z, A0.w), qf[1], a, 0, 0, 0);
                a = __builtin_amdgcn_mfma_f32_16x16x32_fp8_fp8(mk64(A1.x, A1.y), qf[2], a, 0, 0, 0); a = __builtin_amdgcn_mfma_f32_16x16x32_fp8_fp8(mk64(A1.z, A1.w), qf[3], a, 0, 0, 0);
#pragma unroll
                for (int i = 0; i < 4; ++i) S[2 * kc + j][i] = a[i]; }
            LDS_WAIT();
            if (kc < 4) at_issue(Kb, idl, 32 * (kc + 4), buf, lane); else at_issue(Vb, idl, 32 * (kc - 4), buf, lane);
            if (kc == 4) AT_STAGE_A(tn);
        }
        const int rq = g >> 2;
        float V[4][4];
#pragma unroll
        for (int kk = 0; kk < 4; ++kk)
#pragma unroll
            for (int i = 0; i < 4; ++i) { int v = __builtin_bit_cast(int, S[kk][i]);
                v = __builtin_amdgcn_update_dpp(v, __builtin_bit_cast(int, S[4 + kk][i]), 0x114, 0xf, 0x2, false);
                v = __builtin_amdgcn_update_dpp(v, __builtin_bit_cast(int, S[8 + kk][i]), 0x118, 0xf, 0x4, false);
                v = __builtin_amdgcn_update_dpp(v, __builtin_bit_cast(int, S[12 + kk][i]), 0x11c, 0xf, 0x8, false);
                V[kk][i] = __builtin_bit_cast(float, v); }
        float mx = -INFINITY; const int nvc = nv - 4 * c - 64 * rq;
#pragma unroll
        for (int kk = 0; kk < 4; ++kk) { const u32x2 iw = *(const LAS u32x2*)(idl + 64 * rq + 16 * kk + 4 * c);
            const int ki[4] = {(int)(iw.x & 0xFFFFu), (int)(iw.x >> 16), (int)(iw.y & 0xFFFFu), (int)(iw.y >> 16)};
#pragma unroll
            for (int i = 0; i < 4; ++i) { int dist = t - ki[i]; dist = dist < 0 ? 0 : (dist > 128 ? 128 : dist);
                const float sv = V[kk][i] * 0.08838834764831845f + tab[dist * 8 + 4 * n + gq];
                const float s = (16 * kk + i) < nvc ? sv : -INFINITY; V[kk][i] = s; mx = fmaxf(mx, s); } }
        mx = fmaxf(mx, __builtin_bit_cast(float, __builtin_amdgcn_update_dpp(0, __builtin_bit_cast(int, mx), 0x124, 0xf, 0xf, false)));
        mx = fmaxf(mx, __builtin_bit_cast(float, __builtin_amdgcn_update_dpp(0, __builtin_bit_cast(int, mx), 0x128, 0xf, 0xf, false)));
        mx = fmaxf(mx, __shfl_xor(mx, 16)); mx = fmaxf(mx, __shfl_xor(mx, 32));
        float sum = 0.f; unsigned Pq[4];
#pragma unroll
        for (int kk = 0; kk < 4; ++kk) { float p[4];
#pragma unroll
            for (int i = 0; i < 4; ++i) { p[i] = __builtin_amdgcn_exp2f((V[kk][i] - mx) * 1.4426950408889634f); sum += p[i]; }
            Pq[kk] = pk4_fp8(p[0] * 256.0f, p[1] * 256.0f, p[2] * 256.0f, p[3] * 256.0f); }
        sum += __builtin_bit_cast(float, __builtin_amdgcn_update_dpp(0, __builtin_bit_cast(int, sum), 0x124, 0xf, 0xf, false));
        sum += __builtin_bit_cast(float, __builtin_amdgcn_update_dpp(0, __builtin_bit_cast(int, sum), 0x128, 0xf, 0xf, false));
        sum += __shfl_xor(sum, 16); sum += __shfl_xor(sum, 32);
        unsigned P8[16];
#pragma unroll
        for (int kk = 0; kk < 4; ++kk) { P8[kk] = Pq[kk];
            P8[4 + kk] = (unsigned)__builtin_amdgcn_update_dpp(0, (int)Pq[kk], 0x104, 0xf, 0xf, true);
            P8[8 + kk] = (unsigned)__builtin_amdgcn_update_dpp(0, (int)Pq[kk], 0x108, 0xf, 0xf, true);
            P8[12 + kk] = (unsigned)__builtin_amdgcn_update_dpp(0, (int)Pq[kk], 0x10c, 0xf, 0xf, true); }
        long qfn[4]; int nvn;
        AT_STAGE_B(idln, qfn, nvn);
        f32x4 oe[4], oo[4];
#pragma unroll
        for (int dt = 0; dt < 4; ++dt) { oe[dt] = (f32x4){0.f, 0.f, 0.f, 0.f}; oo[dt] = (f32x4){0.f, 0.f, 0.f, 0.f}; }
#pragma unroll
        for (int vc = 0; vc < 8; ++vc) {
            LAS unsigned char* buf = ring + (vc & 3) * AT_CH;
            if (vc == 0) AT_WAITN(18); else AT_WAITN(12);
            const long pf = mk64(P8[2 * vc], P8[2 * vc + 1]);
            u32x2 t0[4], t1[4];
            const unsigned ba = (unsigned)(size_t)buf;
#pragma unroll
            for (int dt = 0; dt < 4; ++dt) { const unsigned ad = ba + (unsigned)(rowA * 128 + (((2 * dt + (p4 >> 1)) ^ fr) << 4) + 8 * (p4 & 1));
                asm volatile("ds_read_b64_tr_b16 %0, %1" : "=&v"(t0[dt]) : "v"(ad) : "memory");
                asm volatile("ds_read_b64_tr_b16 %0, %1 offset:2048" : "=&v"(t1[dt]) : "v"(ad) : "memory"); }
            asm volatile("s_waitcnt lgkmcnt(0)" : "+v"(t0[0]), "+v"(t0[1]), "+v"(t0[2]), "+v"(t0[3]), "+v"(t1[0]), "+v"(t1[1]), "+v"(t1[2]), "+v"(t1[3]) :: "memory");
#pragma unroll
            for (int dt = 0; dt < 4; ++dt) {
                const long be = mk64(__builtin_amdgcn_perm(t0[dt].y, t0[dt].x, 0x06040200u), __builtin_amdgcn_perm(t1[dt].y, t1[dt].x, 0x06040200u));
                const long bo = mk64(__builtin_amdgcn_perm(t0[dt].y, t0[dt].x, 0x07050301u), __builtin_amdgcn_perm(t1[dt].y, t1[dt].x, 0x07050301u));
                oe[dt] = __builtin_amdgcn_mfma_f32_16x16x32_fp8_fp8(pf, be, oe[dt], 0, 0, 0); oo[dt] = __builtin_amdgcn_mfma_f32_16x16x32_fp8_fp8(pf, bo, oo[dt], 0, 0, 0); }
            if (vc < 4) at_issue(Vb, idl, 32 * (vc + 4), buf, lane); else at_issue(Kb, idln, 32 * (vc - 4), buf, lane);
        }
        float inv[4];
#pragma unroll
        for (int i = 0; i < 4; ++i) inv[i] = 1.0f / (256.0f * __shfl(sum, i));
        h16* Qo = Qb + (size_t)t * DM;
        LAS unsigned char* st = (LAS unsigned char*)(idlb + (k & 1) * 256);
#pragma unroll
        for (int hp = 0; hp < 2; ++hp) {
            if (c == 0) {
#pragma unroll
                for (int dt = 0; dt < 4; ++dt)
#pragma unroll
                    for (int i2 = 0; i2 < 2; ++i2) *(LAS unsigned*)(st + (i2 * 128 + 32 * dt + 2 * g) * 2) = pkh(oe[dt][2 * hp + i2] * inv[2 * hp + i2], oo[dt][2 * hp + i2] * inv[2 * hp + i2]);
            }
            LDS_WAIT();
            if (lane < 32) { const u32x4 ow = *(const LAS u32x4*)(st + lane * 16); if (!C.dry) *(u32x4*)(Qo + hp * 256 + lane * 8) = ow; }
            LDS_WAIT();
        }
#pragma unroll
        for (int ks = 0; ks < 4; ++ks) qf[ks] = qfn[ks];
        nv = nvn;
    }
    AT_WAITN(0);
#undef AT_STAGE_A
#undef AT_STAGE_B
}

__device__ __forceinline__ void act_phase(const Ctx& C, int gtid, int gthreads) {
    const h16* G = (const h16*)(C.ws + WS_UPG); h16* V = (h16*)(C.ws + WS_UPV);
    constexpr int NCG = DFF / 8, NITEM = (MTOK / 16) * NCG;
    for (int it = gtid; it < NITEM; it += gthreads) {
        const int cg = it % NCG, rb = it / NCG, c0 = cg * 8, r0 = rb * 16;
        float w[3][8], bb[8];
#pragma unroll
        for (int j = 0; j < 3; ++j) { const f32x4 a = *(const f32x4*)(C.fcw + j * DFF + c0), b2 = *(const f32x4*)(C.fcw + j * DFF + c0 + 4); for (int e = 0; e < 4; ++e) { w[j][e] = a[e]; w[j][4 + e] = b2[e]; } }
        { const f32x4 a = *(const f32x4*)(C.fcb + c0), b2 = *(const f32x4*)(C.fcb + c0 + 4); for (int e = 0; e < 4; ++e) { bb[e] = a[e]; bb[4 + e] = b2[e]; } }
        h8 gm2, gm1;
        const int tseq = r0 & (SEQ - 1);
        if (tseq >= 2) { gm2 = *(const h8*)(G + (size_t)(r0 - 2) * DFF + c0); gm1 = *(const h8*)(G + (size_t)(r0 - 1) * DFF + c0); }
        else { for (int e = 0; e < 8; ++e) { gm2[e] = (h16)0.f; gm1[e] = (h16)0.f; } }
#pragma unroll 4
        for (int r = 0; r < 16; ++r) { const size_t off = (size_t)(r0 + r) * DFF + c0;
            const h8 g0 = *(const h8*)(G + off), vv = *(const h8*)(V + off);
            float y[8];
#pragma unroll
            for (int e = 0; e < 8; ++e) { const float gf = bb[e] + w[0][e] * (float)gm2[e] + w[1][e] * (float)gm1[e] + w[2][e] * (float)g0[e]; y[e] = gelu_tanh(gf) * (float)vv[e]; }
            u32x4 o; o.x = pkh(y[0], y[1]); o.y = pkh(y[2], y[3]); o.z = pkh(y[4], y[5]); o.w = pkh(y[6], y[7]);
            if (!C.dry) *(u32x4*)(V + off) = o; gm2 = gm1; gm1 = g0; }
    }
}

__device__ __forceinline__ void p0_prologue(const Params& P, LAS unsigned char* lds) {
    const int tid = threadIdx.x, lane = tid & 63, wv = tid >> 6;
    LAS float* scr = (LAS float*)(lds + wv * 16384);
    const int gw = blockIdx.x * NWAVES + wv, NGW = gridDim.x * NWAVES;
    unsigned char* ws = P.ws;
    const float* w_in = P.in[3];
    constexpr int I_IN = 16 * 195;
    for (int it = gw; it < I_IN + 16 * 8; it += NGW) {
        if (it < I_IN) { p0_transpose_item<1>(w_in, DM, NIN, (h16*)(ws + W_IN), nullptr, scr, it, lane); continue; }
        const int r = it - I_IN, blk = r / 16, rr = r % 16, which = rr / 8, it2 = rr % 8;
        p0_transpose_item<0>((which ? P.in[8] : P.in[6]) + (size_t)blk * 128 * 128, 128, 128, (h16*)(ws + W_GATE) + (size_t)blk * 256 * 128 + (size_t)which * 128 * 128, nullptr, scr, it2, lane); }
    { u32x4* z = (u32x4*)((h16*)(ws + W_IN) + (size_t)4168 * DM); const int nz = 184 * DM * 2 / 16;
      for (int i = blockIdx.x * NTHR + tid; i < nz; i += gridDim.x * NTHR) z[i] = (u32x4){0u, 0u, 0u, 0u}; }
    { const float* x = P.in[0]; const float* gn = P.in[2]; h16* A0 = (h16*)(ws + WS_A0);
      f32x4 gv[4];
#pragma unroll
      for (int j = 0; j < 4; ++j) gv[j] = *(const f32x4*)(gn + 4 * lane + 256 * j);
      for (int m = gw; m < MTOK; m += NGW) { const f32x4* xr = (const f32x4*)(x + (size_t)m * DM) + lane; f32x4 v[4]; float s = 0.f;
#pragma unroll
          for (int j = 0; j < 4; ++j) { v[j] = xr[64 * j]; s += (v[j].x * v[j].x + v[j].y * v[j].y) + (v[j].z * v[j].z + v[j].w * v[j].w); }
          const float rs = __builtin_amdgcn_rsqf(wave_sum(s) * (1.0f / DM) + EPS);
          u32x2* o8 = (u32x2*)(A0 + (size_t)m * DM) + lane;
#pragma unroll
          for (int j = 0; j < 4; ++j) { u32x2 w; w.x = pkh(v[j].x * rs * gv[j].x, v[j].y * rs * gv[j].y); w.y = pkh(v[j].z * rs * gv[j].z, v[j].w * rs * gv[j].w); o8[64 * j] = w; } } }
}
constexpr int PD_SQ = 16 * 32, PD_UP = 16 * 192, PD_DN = 48 * 32, PD_PP = 4 * 32, PD_NTR = 4 * PD_SQ + PD_UP + PD_DN + PD_PP, PD_NT = PD_NTR / 32, PD_NP = MTOK * PLE / 4 / 8192;
static_assert(PD_NTR % 32 == 0, "deferred transposes");
__device__ __forceinline__ void p0_deferred_item(const Params& P, LAS unsigned char* lds, int item) {
    int tid = threadIdx.x; asm volatile("" : "+v"(tid));
    const int lane = tid & 63, wv = tid >> 6;
    unsigned char* ws = P.ws;
    if (item >= PD_NT) { const f32x4* p4 = (const f32x4*)P.in[1] + (size_t)(item - PD_NT) * 8192; u32x2* o = (u32x2*)(ws + WS_PH) + (size_t)(item - PD_NT) * 8192;
#pragma unroll 4
        for (int i = tid; i < 8192; i += NTHR) { const f32x4 v = p4[i]; u32x2 w; w.x = pkh(v.x, v.y); w.y = pkh(v.z, v.w); o[i] = w; }
        return; }
    LAS float* scr = (LAS float*)(lds + wv * 16384);
    const float *w_lru = P.in[14], *w_att = P.in[15], *w_out = P.in[16], *w_up = P.in[18], *w_down = P.in[21], *w_pg = P.in[23], *w_pp = P.in[24];
    for (int k = 0; k < 4; ++k) {
        int r = item * 32 + wv * 4 + k;
        if (r < PD_SQ) { p0_transpose_item<0>(w_lru, DM, DM, (h16*)(ws + W_LRU), nullptr, scr, r, lane); continue; } r -= PD_SQ;
        if (r < PD_SQ) { p0_transpose_item<0>(w_att, DM, DM, (h16*)(ws + W_ATT), nullptr, scr, r, lane); continue; } r -= PD_SQ;
        if (r < PD_SQ) { p0_transpose_item<0>(w_out, DM, DM, (h16*)(ws + W_OUT), nullptr, scr, r, lane); continue; } r -= PD_SQ;
        if (r < PD_SQ) { p0_transpose_item<0>(w_pg, DM, DM, (h16*)(ws + W_PG), P.in[22], scr, r, lane); continue; } r -= PD_SQ;
        if (r < PD_UP) { p0_transpose_item<2>(w_up, DM, 2 * DFF, (h16*)(ws + W_UP), P.in[17], scr, r, lane); continue; } r -= PD_UP;
        if (r < PD_DN) { p0_transpose_item<0>(w_down, DFF, DM, (h16*)(ws + W_DOWN), nullptr, scr, r, lane); continue; } r -= PD_DN;
        p0_transpose_item<0>(w_pp, PLE, DM, (h16*)(ws + W_PP), nullptr, scr, r, lane);
    }
}

__device__ __forceinline__ int next_unit(unsigned* head, volatile LAS unsigned* slot) {
    __syncthreads();
    if (threadIdx.x == 0) *slot = __hip_atomic_fetch_add(head, 1u, __ATOMIC_RELAXED, __HIP_MEMORY_SCOPE_AGENT);
    __syncthreads();
    return (int)*slot;
}

constexpr int NPHASE = 10;
__global__ void __launch_bounds__(NTHR, 2) fwd(Params P) {
    extern __shared__ __attribute__((aligned(16))) unsigned char lds_raw[];
    LAS unsigned char* lds = (LAS unsigned char*)lds_raw;
    volatile LAS unsigned* MISC = (volatile LAS unsigned*)(lds + MISC_OFF);
    const int tid = threadIdx.x;
    if (tid < 64) MISC[tid] = 0u;
    __syncthreads();
    unsigned char* ws = P.ws;
    unsigned* ctl = (unsigned*)(ws + WS_CTL);
    const int lo = P.ph_lo, hi = P.ph_hi;
    XcdBarrier bar; bar.bar = ctl + CW_BAR; bar.x = 0; bar.st = MISC;
    if (hi - lo > 1) bar = xcd_barrier_post(ctl + CW_BAR, MISC);
    const int dry = P.pad;
    Ctx C; C.ws = ws; C.out = P.out; C.dry = dry; C.conv_w = P.in[4]; C.conv_b = P.in[5]; C.ba = P.in[7]; C.bx = P.in[9]; C.lam = P.in[10]; C.qn = P.in[11]; C.kn = P.in[12]; C.relb = P.in[13]; C.fcw = P.in[19]; C.fcb = P.in[20];
    float* SSQ1 = (float*)(ws + CTL_SSQ1); float* SSQ2 = (float*)(ws + CTL_SSQ2);
#ifdef ONLY_PHASE
#define IN(k) ((k) == ONLY_PHASE)
#else
#define IN(k) (lo <= (k) && (k) < hi)
#endif
#define SEAM(k) do { if (IN(k) && IN((k) + 1)) xcd_barrier(bar); } while (0)

    if (IN(0)) { p0_prologue(P, lds); } SEAM(0);

    if (IN(1)) {
        pg8::Gemm g{(const h16*)(ws + WS_A0), (const h16*)(ws + W_IN), MTOK, NIN_PAD, DM}; pg8::StaticOrder S; S.init(MTOK, NIN_PAD, gridDim.x, blockIdx.x);
        EpiIn E{(h16*)(ws + WS_LX), (h16*)(ws + WS_GG), (h16*)(ws + WS_Q), (h16*)(ws + WS_K), (h16*)(ws + WS_V), (h16*)(ws + WS_QI), (h16*)(ws + WS_KI), (h16*)(ws + WS_SGA), (h16*)(ws + WS_SGB), (float*)(ws + WS_WI), dry};
        pg8::gemm_phase<EpiIn>(lds, g, S, E);
    } SEAM(1);

    if (IN(2)) {
        constexpr int N_IX = NB * (SEQ / 16), N_L1 = NB * 64 * 8 / 4, N_KN = MTOK / 128 / 4, N_PD = PD_NT + PD_NP, N_ALL = N_IX + N_L1 + N_KN + N_PD;
        unsigned* head = ctl + CW_Q2 + 128 * dry;
        int u = next_unit(head, MISC + 4);
        for (int it = 0; u < N_ALL; ++it) {
            unsigned nxt = 0u;
            if (tid == 0) nxt = __hip_atomic_fetch_add(head, 1u, __ATOMIC_RELAXED, __HIP_MEMORY_SCOPE_AGENT);
#ifdef PROBE_P2_KIND
            if (!(dry && (u < N_IX ? 0 : (u < N_IX + N_L1 ? 1 : (u < N_IX + N_L1 + N_KN ? 2 : 3))) != PROBE_P2_KIND))
#endif
            {
            if (u < N_IX) indexer_unit(C, lds, u);
            else if (u < N_IX + N_L1) lru1_item(C, lds, u - N_IX);
            else if (u < N_IX + N_L1 + N_KN) { for (int k = 0; k < 4; ++k) knorm_unit(C, (u - N_IX - N_L1) * 4 + k); }
            else p0_deferred_item(P, lds, u - N_IX - N_L1 - N_KN);
            }
            if (tid == 0) MISC[6 + (it & 1)] = nxt;
            __syncthreads();
            u = (int)MISC[6 + (it & 1)];
        }
    } SEAM(2);

    if (IN(3)) {
        constexpr int N_AQ = SEQ / (8 * AT_QPW), N_L2 = NB * 64 * 8 / 4;
        attn_build_tab(C, lds);
        unsigned* qh = ctl + CW_Q3 + 2048 * dry;
        if (tid == 0) MISC[5] = 0u;
        for (;;) {
            __syncthreads();
            if (tid == 0) { const unsigned x = xb_xcc_id() & 7u; unsigned k = MISC[5]; int u = -1;
                for (; k < 8u; ++k) { const unsigned q = (x + k) & 7u; const unsigned v = __hip_atomic_fetch_add(qh + 64 * q, 1u, __ATOMIC_RELAXED, __HIP_MEMORY_SCOPE_AGENT); if (v < (unsigned)N_AQ) { u = (int)(q * N_AQ + v); break; } }
                MISC[5] = k;
                if (u < 0) { const unsigned v = __hip_atomic_fetch_add(qh + 64 * 8, 1u, __ATOMIC_RELAXED, __HIP_MEMORY_SCOPE_AGENT); u = v < (unsigned)N_L2 ? (int)(8 * N_AQ + v) : -1; }
                MISC[4] = (unsigned)u; }
            __syncthreads();
            const int u = (int)MISC[4];
            if (u < 0) break;
            if (u < 8 * N_AQ) attn_item(C, lds, u);
            else lru2_item(C, lds + AT_END, u - 8 * N_AQ);
        }
    } SEAM(3);

    if (IN(4)) {
        pg8::StaticOrder S; S.init(MTOK, DM, gridDim.x, blockIdx.x);
        { pg8::Gemm g{(const h16*)(ws + WS_LX), (const h16*)(ws + W_LRU), MTOK, DM, DM}; EpiMerge<0> E{(const h16*)(ws + WS_SGA), (h16*)(ws + WS_T1), nullptr, dry}; pg8::gemm_phase<EpiMerge<0>>(lds, g, S, E); }
        { pg8::Gemm g{(const h16*)(ws + WS_Q), (const h16*)(ws + W_ATT), MTOK, DM, DM}; EpiMerge<1> E{(const h16*)(ws + WS_SGB), (h16*)(ws + WS_T1), (h16*)(ws + WS_GG), dry}; pg8::gemm_phase<EpiMerge<1>>(lds, g, S, E); }
    } SEAM(4);

    if (IN(5)) {
        pg8::Gemm g{(const h16*)(ws + WS_GG), (const h16*)(ws + W_OUT), MTOK, DM, DM}; pg8::StaticOrder S; S.init(MTOK, DM, gridDim.x, blockIdx.x);
        EpiResid<true> E{P.in[0], nullptr, (h16*)(ws + WS_X1H), SSQ1, dry}; pg8::gemm_phase<EpiResid<true>>(lds, g, S, E);
    } SEAM(5);

    if (IN(6)) {
        pg8::Gemm g{(const h16*)(ws + WS_X1H), (const h16*)(ws + W_UP), MTOK, 2 * DFF, DM}; pg8::StaticOrder S; S.init(MTOK, 2 * DFF, gridDim.x, blockIdx.x);
        EpiUpAct E{SSQ1, (h16*)(ws + WS_UPV), (float*)(ws + WS_UPG), (float*)(ws + WS_UPG + 4 * MiB), (float*)(ws + WS_UPG + 8 * MiB), C.fcw, C.fcb, lds + pg8::STAGE_BYTES, dry}; pg8::gemm_phase<EpiUpAct>(lds, g, S, E);
    } SEAM(6);


    if (IN(8)) {
        pg8::Gemm g{(const h16*)(ws + WS_UPV), (const h16*)(ws + W_DOWN), MTOK, DM, DFF}; pg8::StaticOrder S; S.init(MTOK, DM, gridDim.x, blockIdx.x);
        {
#pragma unroll
          for (int i = 0; i < 2; ++i) { pg8::Unit uu; if (S.next(i, uu)) act_fix_tile((const float*)(ws + WS_UPG), (const float*)(ws + WS_UPG + 4 * MiB), (const float*)(ws + WS_UPG + 8 * MiB), C.fcw, C.fcb, (h16*)(ws + WS_UPV), uu.pm, tid, dry); }
          static_assert((MTOK / 256) * (DM / 256) == 2 * 256, "two units per workgroup on a 256-workgroup grid");
          VM_WAIT(); __syncthreads(); }
        EpiResid<false> E{nullptr, (const h16*)(ws + WS_X1H), (h16*)(ws + WS_X2H), SSQ2, dry}; pg8::gemm_phase<EpiResid<false>>(lds, g, S, E);
    } SEAM(8);

    if (IN(9)) {
        pg8::StaticOrder S; S.init(MTOK, DM, gridDim.x, blockIdx.x);
        { pg8::Gemm g{(const h16*)(ws + WS_X2H), (const h16*)(ws + W_PG), MTOK, DM, DM}; EpiGateSig E{SSQ2, (h16*)(ws + WS_GS), dry}; pg8::gemm_phase<EpiGateSig>(lds, g, S, E); }
        { pg8::Gemm g{(const h16*)(ws + WS_PH), (const h16*)(ws + W_PP), MTOK, DM, P.k_ple}; EpiPleOut E{(const h16*)(ws + WS_GS), (const h16*)(ws + WS_X2H), P.out, dry}; pg8::gemm_phase<EpiPleOut>(lds, g, S, E); }
    }
#undef IN
#undef SEAM
}

#ifndef N_LAUNCHES
#define N_LAUNCHES 1
#endif
extern "C" void kernel_launch(void* const* d_in, const int* in_sizes, int n_in, void* d_out, int out_size, void* d_ws, size_t ws_size, hipStream_t stream) {
    static int grid = 0;
    if (grid == 0) {
        if (n_in != 25 || out_size != MTOK * DM || ws_size < WS_END) { fprintf(stderr, "kernel_launch: unexpected shapes (n_in %d out %d ws %zu)\n", n_in, out_size, ws_size); grid = -1; return; }
        int dev = 0, cus = 0, per_cu = 0;
        hipGetDevice(&dev); hipDeviceGetAttribute(&cus, hipDeviceAttributeMultiprocessorCount, dev);
        if (hipFuncSetAttribute((const void*)fwd, hipFuncAttributeMaxDynamicSharedMemorySize, LDS_BYTES) != hipSuccess) { fprintf(stderr, "kernel_launch: hipFuncSetAttribute failed\n"); grid = -1; return; }
        if (hipOccupancyMaxActiveBlocksPerMultiprocessor(&per_cu, (const void*)fwd, NTHR, LDS_BYTES) != hipSuccess || per_cu < 1) { fprintf(stderr, "kernel_launch: occupancy query says %d\n", per_cu); }
        (void)hipGetLastError();
        grid = cus > 0 ? cus : 256;
    }
    if (grid < 0) return;
    hipMemsetAsync((char*)d_ws + WS_CTL, 0, CTL_ZERO_BYTES, stream);
    Params p{};
    for (int i = 0; i < 25; ++i) p.in[i] = (const float*)d_in[i];
    p.out = (float*)d_out; p.ws = (unsigned char*)d_ws; p.k_ple = PLE; p.pad = 0;
    if (N_LAUNCHES == 1) { p.ph_lo = 0; p.ph_hi = NPHASE; hipLaunchKernelGGL(fwd, dim3(grid), dim3(NTHR), LDS_BYTES, stream, p); }
    else for (int ph = 0; ph < NPHASE; ++ph) { p.ph_lo = ph; p.ph_hi = ph + 1;
#ifdef PROBE_MASK
        if ((PROBE_MASK >> ph) & 1) { p.pad = 1; hipLaunchKernelGGL(fwd, dim3(grid), dim3(NTHR), LDS_BYTES, stream, p); p.pad = 0; }
#endif
        hipLaunchKernelGGL(fwd, dim3(grid), dim3(NTHR), LDS_BYTES, stream, p); }
}
```

```cpp
#include <hip/hip_runtime.h>
#include <cstdio>
#include <cstdint>

#define GAS __attribute__((address_space(1)))
#define LAS __attribute__((address_space(3)))
typedef _Float16 h16;
typedef _Float16 h8 __attribute__((ext_vector_type(8)));
typedef _Float16 h4 __attribute__((ext_vector_type(4)));
typedef _Float16 h2 __attribute__((ext_vector_type(2)));
typedef __fp16 fh4 __attribute__((__vector_size__(4 * sizeof(__fp16))));
typedef float f32x4 __attribute__((ext_vector_type(4)));
typedef float f32x2 __attribute__((ext_vector_type(2)));
typedef unsigned u32x4 __attribute__((ext_vector_type(4)));
typedef unsigned u32x2 __attribute__((ext_vector_type(2)));
typedef unsigned long long u64;

__device__ __forceinline__ unsigned pkh(float a, float b) { h2 r; r.x = (h16)a; r.y = (h16)b; return __builtin_bit_cast(unsigned, r); }
__device__ __forceinline__ float sigmoid_f(float x) { return __builtin_amdgcn_rcpf(1.0f + __builtin_amdgcn_exp2f(-1.4426950408889634f * x)); }
__device__ __forceinline__ float gelu_tanh(float x) { const float u = 1.5957691216057308f * (x + 0.044715f * x * x * x); return x * sigmoid_f(u); }
#define LDS_WAIT() asm volatile("s_waitcnt lgkmcnt(0)" ::: "memory")
#define VM_WAIT() asm volatile("s_waitcnt vmcnt(0)" ::: "memory")

namespace pg8 {
constexpr int BM = 256, BK = 64, HALF = 128, HTB = HALF * BK * 2, STAGE_BYTES = 8 * HTB, NXCD = 8, WGM = 8;
__host__ __device__ __forceinline__ int lds_byte(int r, int c) { const int st = (r >> 4) * 2 + (c >> 5), rr = r & 15, cc = c & 31, ob = rr * 64 + cc * 2; return st * 1024 + (ob ^ (((ob >> 9) & 1) << 5)); }
__host__ __device__ __forceinline__ void stage_rc(int b, int& R, int& C) { const int st = b / 1024, sb = b % 1024, swz = sb ^ (((sb >> 9) & 1) << 5); R = (st >> 1) * 16 + swz / 64; C = (st & 1) * 32 + (swz % 64) / 2; }
__host__ __device__ __forceinline__ int perm32(int rho) { const int n = rho >> 4, i = rho & 15; return 8 * (i >> 2) + 4 * n + (i & 3); }

struct Unit { int pm, pn; };
struct Gemm { const h16* A; const h16* Bt; int M, N, K; };

struct StaticOrder {
    int nM, nN, nwg, G, c;
    __host__ __device__ void init(int M, int N, int G_, int c_) { nM = M / BM; nN = N / BM; nwg = nM * nN; G = G_; c = c_; }
    __host__ __device__ __forceinline__ bool next(int i, Unit& u) const {
        const long L = (long)i * G + c; if (L >= nwg) return false;
        int wgid = (int)L; { const int q = nwg / NXCD, r = nwg % NXCD, xcd = wgid % NXCD, off = wgid / NXCD; wgid = (xcd < r ? xcd * (q + 1) : r * (q + 1) + (xcd - r) * q) + off; }
        const int nig = WGM * nN, gid = wgid / nig, fm = gid * WGM, gsz = (nM - fm) < WGM ? (nM - fm) : WGM;
        u.pm = fm + ((wgid % nig) % gsz); u.pn = (wgid % nig) / gsz; return true;
    }
};

template <class Epi, bool ALIGN_EPI = true, bool SP2 = true>
__device__ __forceinline__ void gemm_phase(LAS unsigned char* lds, const Gemm g, const StaticOrder& S, const Epi& E) {
    const int tid = threadIdx.x, wid = __builtin_amdgcn_readfirstlane(tid >> 6), lane = tid & 63, wr = wid >> 2, wc = wid & 3, fr = lane & 15, fq = lane >> 4;
    const int K = g.K, nt = K / BK;
    unsigned voffA[2], voffB[2];
#pragma unroll
    for (int i = 0; i < 2; ++i) { int R, C; stage_rc(tid * 16 + i * 8192, R, C); const int Rb = Epi::PERM ? ((R & ~31) + perm32(R & 31)) : R;
        voffA[i] = (unsigned)(R * K + C) * 2u; voffB[i] = (unsigned)(Rb * K + C) * 2u; }
    const size_t kstep = (size_t)(BK * 2);
    const size_t hstep = (size_t)HALF * K * 2;
    const size_t tstep = 2 * hstep;
    const unsigned ldsw = (unsigned)wid * 1024u;
    const int aoff = lds_byte(wr * 64 + fr, fq * 8), boff = lds_byte(wc * 32 + fr, fq * 8);
#define PG8_SA(b, h) (((b) * 2 + (h)) * HTB)
#define PG8_SB(b, h) ((4 + (b) * 2 + (h)) * HTB)
#define PG8_STAGE(bufoff, gbase, voff) do { _Pragma("unroll") for (int _i = 0; _i < 2; ++_i) \
        __builtin_amdgcn_global_load_lds((const unsigned*)((const char*)(gbase) + (voff)[_i]), (LAS unsigned*)(lds + (bufoff) + ldsw + _i * 8192), 16, 0, 0); } while (0)
#define PG8_LDA(dst, b, h) do { _Pragma("unroll") for (int m = 0; m < 4; ++m) _Pragma("unroll") for (int k = 0; k < 2; ++k) dst[m][k] = *(const LAS h8*)(lds + PG8_SA(b, h) + aoff + m * 2048 + k * 1024); } while (0)
#define PG8_LDB(dst, b, h) do { _Pragma("unroll") for (int n = 0; n < 2; ++n) _Pragma("unroll") for (int k = 0; k < 2; ++k) dst[n][k] = *(const LAS h8*)(lds + PG8_SB(b, h) + boff + n * 2048 + k * 1024); } while (0)
#define PG8_MMA(ai, bj, At, Bt) do { __builtin_amdgcn_s_setprio(1); _Pragma("unroll") for (int m = 0; m < 4; ++m) _Pragma("unroll") for (int n = 0; n < 2; ++n) _Pragma("unroll") for (int k = 0; k < 2; ++k) \
        acc[ai][bj][m][n] = __builtin_amdgcn_mfma_f32_16x16x32_f16(Bt[n][k], At[m][k], acc[ai][bj][m][n], 0, 0, 0); __builtin_amdgcn_s_setprio(0); } while (0)
#define PG8_WAIT_V(n) asm volatile("s_waitcnt vmcnt(" #n ")" ::: "memory")
#define PG8_WAIT_L(n) asm volatile("s_waitcnt lgkmcnt(" #n ")" ::: "memory")
#define PG8_BAR __builtin_amdgcn_s_barrier()
#define PG8_SCHED __builtin_amdgcn_sched_barrier(0)
    Unit cur, nxt; int ui = 0;
    if (!S.next(0, cur)) return;
    f32x4 acc[2][2][4][2];
#pragma unroll
    for (int a = 0; a < 2; ++a)
#pragma unroll
        for (int b = 0; b < 2; ++b)
#pragma unroll
            for (int m = 0; m < 4; ++m)
#pragma unroll
                for (int n = 0; n < 2; ++n) acc[a][b][m][n] = (f32x4){0.f, 0.f, 0.f, 0.f};
    h8 At[4][2], B0[2][2], B1[2][2];
    const char* cA = (const char*)g.A + (size_t)cur.pm * tstep; const char* cB = (const char*)g.Bt + (size_t)cur.pn * tstep;
    if constexpr (SP2) {
        PG8_STAGE(PG8_SB(0, 0), cB, voffB); PG8_STAGE(PG8_SB(0, 1), cB + hstep, voffB); PG8_STAGE(PG8_SA(0, 0), cA, voffA); PG8_STAGE(PG8_SA(0, 1), cA + hstep, voffA);
        if (wr == 1) PG8_BAR;
        PG8_WAIT_V(2); PG8_BAR;
        PG8_STAGE(PG8_SB(1, 0), cB + kstep, voffB); PG8_STAGE(PG8_SA(1, 0), cA + kstep, voffA); PG8_STAGE(PG8_SB(1, 1), cB + hstep + kstep, voffB);
        PG8_WAIT_V(6); PG8_BAR;
    } else {
        PG8_STAGE(PG8_SB(0, 0), cB, voffB); PG8_STAGE(PG8_SA(0, 0), cA, voffA); PG8_STAGE(PG8_SB(0, 1), cB + hstep, voffB); PG8_STAGE(PG8_SA(0, 1), cA + hstep, voffA);
        if (wr == 1) PG8_BAR;
        PG8_WAIT_V(4); PG8_BAR;
        PG8_STAGE(PG8_SB(1, 0), cB + kstep, voffB); PG8_STAGE(PG8_SA(1, 0), cA + kstep, voffA); PG8_STAGE(PG8_SB(1, 1), cB + hstep + kstep, voffB);
        PG8_WAIT_V(6); PG8_BAR;
    }
    for (;;) {
        const bool has_next = S.next(ui + 1, nxt);
        const char* nA = has_next ? (const char*)g.A + (size_t)nxt.pm * tstep : cA; const char* nB = has_next ? (const char*)g.Bt + (size_t)nxt.pn * tstep : cB;
        for (int t = 0; t < nt; t += 2) {
            const bool last = (t == nt - 2);
            const char* a1 = cA + (size_t)(t + 1) * kstep;
            const char* a2 = last ? nA : cA + (size_t)(t + 2) * kstep; const char* b2 = last ? nB : cB + (size_t)(t + 2) * kstep;
            const char* a3 = a2 + kstep; const char* b3 = b2 + kstep;
            if constexpr (SP2) {
            PG8_LDB(B0, 0, 0); PG8_LDB(B1, 0, 1); PG8_SCHED; PG8_LDA(At, 0, 0); PG8_STAGE(PG8_SA(1, 1), a1 + hstep, voffA);
            PG8_WAIT_V(8); PG8_WAIT_L(0); PG8_BAR; PG8_MMA(0, 0, At, B0); PG8_MMA(0, 1, At, B1); PG8_BAR; PG8_SCHED;
            PG8_LDA(At, 0, 1); PG8_STAGE(PG8_SB(0, 0), b2, voffB); PG8_STAGE(PG8_SB(0, 1), b2 + hstep, voffB); PG8_STAGE(PG8_SA(0, 0), a2, voffA);
            PG8_WAIT_V(8); PG8_WAIT_L(0); PG8_BAR; PG8_MMA(1, 0, At, B0); PG8_MMA(1, 1, At, B1); PG8_BAR; PG8_SCHED;
            PG8_LDB(B0, 1, 0); PG8_LDB(B1, 1, 1); PG8_SCHED; PG8_LDA(At, 1, 0); PG8_STAGE(PG8_SA(0, 1), a2 + hstep, voffA);
            PG8_WAIT_V(8); PG8_WAIT_L(0); PG8_BAR; PG8_MMA(0, 0, At, B0); PG8_MMA(0, 1, At, B1); PG8_BAR; PG8_SCHED;
            PG8_LDA(At, 1, 1); PG8_STAGE(PG8_SB(1, 0), b3, voffB); PG8_STAGE(PG8_SB(1, 1), b3 + hstep, voffB); PG8_STAGE(PG8_SA(1, 0), a3, voffA);
            PG8_WAIT_V(8); PG8_WAIT_L(0); PG8_BAR; PG8_MMA(1, 0, At, B0); PG8_MMA(1, 1, At, B1); PG8_BAR; PG8_SCHED;
            } else {
            PG8_LDB(B0, 0, 0); PG8_SCHED; PG8_LDA(At, 0, 0); PG8_STAGE(PG8_SA(1, 1), a1 + hstep, voffA);
            PG8_WAIT_L(8); PG8_BAR; PG8_WAIT_L(0); PG8_MMA(0, 0, At, B0); PG8_BAR; PG8_SCHED;
            PG8_LDB(B1, 0, 1); PG8_STAGE(PG8_SB(0, 0), b2, voffB);
            PG8_BAR; PG8_WAIT_L(0); PG8_MMA(0, 1, At, B1); PG8_BAR;
            PG8_LDA(At, 0, 1); PG8_STAGE(PG8_SA(0, 0), a2, voffA);
            PG8_BAR; PG8_WAIT_L(0); PG8_MMA(1, 0, At, B0); PG8_BAR; PG8_SCHED;
            PG8_STAGE(PG8_SB(0, 1), b2 + hstep, voffB);
            PG8_WAIT_V(6); PG8_BAR; PG8_MMA(1, 1, At, B1); PG8_BAR;
            PG8_LDB(B0, 1, 0); PG8_SCHED; PG8_LDA(At, 1, 0); PG8_STAGE(PG8_SA(0, 1), a2 + hstep, voffA);
            PG8_WAIT_L(8); PG8_BAR; PG8_WAIT_L(0); PG8_MMA(0, 0, At, B0); PG8_BAR; PG8_SCHED;
            PG8_LDB(B1, 1, 1); PG8_STAGE(PG8_SB(1, 0), b3, voffB);
            PG8_BAR; PG8_WAIT_L(0); PG8_MMA(0, 1, At, B1); PG8_BAR;
            PG8_LDA(At, 1, 1); PG8_STAGE(PG8_SA(1, 0), a3, voffA);
            PG8_BAR; PG8_WAIT_L(0); PG8_MMA(1, 0, At, B0); PG8_BAR; PG8_SCHED;
            PG8_STAGE(PG8_SB(1, 1), b3 + hstep, voffB);
            PG8_WAIT_V(6); PG8_BAR; PG8_MMA(1, 1, At, B1); PG8_BAR;
            }
        }
        if constexpr (ALIGN_EPI) { if (wr == 0) PG8_BAR; }
        E(acc, cur, wr, wc, fr, fq);
        if (!has_next) break;
#pragma unroll
        for (int a = 0; a < 2; ++a)
#pragma unroll
            for (int b = 0; b < 2; ++b)
#pragma unroll
                for (int m = 0; m < 4; ++m)
#pragma unroll
                    for (int n = 0; n < 2; ++n) acc[a][b][m][n] = (f32x4){0.f, 0.f, 0.f, 0.f};
        cur = nxt; cA = nA; cB = nB; ++ui;
        if constexpr (ALIGN_EPI) { if (wr == 1) PG8_BAR; }
    }
    PG8_WAIT_V(0);
    if constexpr (!ALIGN_EPI) { if (wr == 0) PG8_BAR; }
    PG8_BAR;
#undef PG8_SA
#undef PG8_SB
#undef PG8_STAGE
#undef PG8_LDA
#undef PG8_LDB
#undef PG8_MMA
#undef PG8_WAIT_V
#undef PG8_WAIT_L
#undef PG8_BAR
#undef PG8_SCHED
}
}

constexpr int NB = 4, SEQ = 8192, MTOK = NB * SEQ, DM = 1024, DFF = 3072, PLE = 256;
constexpr int NIN = 6216, NIN_PAD = 6400;
constexpr float EPS = 1e-6f;
constexpr int NWAVES = 8, NTHR = 512;

typedef const f32x4 (&AccRef)[2][2][4][2];

template <int ACT> __device__ __forceinline__ float act_f(float v) {
    if (ACT == 1) return gelu_tanh(v);
    if (ACT == 2) return sigmoid_f(v);
    if (ACT == 3) return v * 0.125f;
    return v;
}
template <int ACT> __device__ __forceinline__ void store_tile_h(AccRef acc, h16* base, int ldc, int row0, int col0, int dry) {
    const unsigned bo0 = ((unsigned)row0 * (unsigned)ldc + (unsigned)col0) * 2u;
#pragma unroll
    for (int ai = 0; ai < 2; ++ai)
#pragma unroll
        for (int m = 0; m < 4; ++m) { const unsigned bo = bo0 + (unsigned)((ai * 128 + m * 16) * ldc * 2);
#pragma unroll
            for (int bj = 0; bj < 2; ++bj) { const f32x4 v0 = acc[ai][bj][m][0], v1 = acc[ai][bj][m][1];
                u32x4 w; w.x = pkh(act_f<ACT>(v0[0]), act_f<ACT>(v0[1])); w.y = pkh(act_f<ACT>(v0[2]), act_f<ACT>(v0[3]));
                w.z = pkh(act_f<ACT>(v1[0]), act_f<ACT>(v1[1])); w.w = pkh(act_f<ACT>(v1[2]), act_f<ACT>(v1[3]));
                if (!dry) *(u32x4*)((char*)base + bo + bj * 256) = w; }
            if (ACT == 1 || ACT == 2) __builtin_amdgcn_sched_barrier(0); }
}

__device__ __forceinline__ unsigned frag_off(int pm, int pn, int wid, int lane) { return ((unsigned)((pm * 4 + pn) * 8 + wid) * 1024u + (unsigned)lane) * 16u; }
#define FRAG_SUB(ai, m, bj) ((unsigned)((((ai) * 4 + (m)) * 2 + (bj)) * 1024))
template <int ACT> __device__ __forceinline__ void store_tile_frag(AccRef acc, h16* base, unsigned fo, int dry) {
#pragma unroll
    for (int ai = 0; ai < 2; ++ai)
#pragma unroll
        for (int m = 0; m < 4; ++m) {
#pragma unroll
            for (int bj = 0; bj < 2; ++bj) { const f32x4 v0 = acc[ai][bj][m][0], v1 = acc[ai][bj][m][1];
                u32x4 w; w.x = pkh(act_f<ACT>(v0[0]), act_f<ACT>(v0[1])); w.y = pkh(act_f<ACT>(v0[2]), act_f<ACT>(v0[3]));
                w.z = pkh(act_f<ACT>(v1[0]), act_f<ACT>(v1[1])); w.w = pkh(act_f<ACT>(v1[2]), act_f<ACT>(v1[3]));
                if (!dry) *(u32x4*)((char*)base + fo + FRAG_SUB(ai, m, bj)) = w; }
            if (ACT == 1 || ACT == 2) __builtin_amdgcn_sched_barrier(0); }
}

struct EpiIn {
    static constexpr bool PERM = true;
    h16 *LX, *GG, *Q, *K, *V, *QI, *KI, *SGA, *SGB; float* WI; int dry;
    __device__ __forceinline__ void operator()(AccRef acc, const pg8::Unit& u, int wr, int wc, int fr, int fq) const {
        const int pn = u.pn, row0 = u.pm * 256 + wr * 64 + fr, cw = wc * 32 + 8 * fq;
        if (pn < 4 || (pn >= 8 && pn < 14)) {
            h16* base = pn < 4 ? LX : (pn < 12 ? Q : (pn == 12 ? K : V)); const int ldc = pn < 12 ? DM : 256; const int ct = pn < 4 ? pn * 256 : (pn < 12 ? (pn - 8) * 256 : 0);
            if (pn < 12) store_tile_h<0>(acc, base, DM, row0, ct + cw, dry); else store_tile_h<0>(acc, base, 256, row0, cw, dry);
            (void)ldc;
        }
        else if (pn < 8) store_tile_h<1>(acc, GG, DM, row0, (pn - 4) * 256 + cw, dry);
        else if (pn < 16) {
#pragma unroll
            for (int ai = 0; ai < 2; ++ai)
#pragma unroll
                for (int m = 0; m < 4; ++m) { const unsigned t16 = (unsigned)(u.pm * 16 + wr * 4 + ai * 8 + m);
#pragma unroll
                    for (int bj = 0; bj < 2; ++bj) { const f32x4 v0 = acc[ai][bj][m][0] * 0.125f, v1 = acc[ai][bj][m][1] * 0.125f;
                        const unsigned hh = (unsigned)((pn - 14) * 4 + bj * 2 + (wc >> 1)), slot = ((t16 * 8u + hh) * 2u + (unsigned)(wc & 1)) * 64u + (unsigned)(fq * 16 + fr);
                        u32x4 w; w.x = pkh(v0[0], v0[1]); w.y = pkh(v0[2], v0[3]); w.z = pkh(v1[0], v1[1]); w.w = pkh(v1[2], v1[3]);
                        if (!dry) *(u32x4*)((char*)QI + slot * 16u) = w; } }
        }
        else if (pn == 16) {
            if (wc < 2) {
#pragma unroll
                for (int ai = 0; ai < 2; ++ai)
#pragma unroll
                    for (int m = 0; m < 4; ++m) { const f32x4 v0 = acc[ai][0][m][0], v1 = acc[ai][0][m][1];
                        u32x4 w; w.x = pkh(v0[0], v0[1]); w.y = pkh(v0[2], v0[3]); w.z = pkh(v1[0], v1[1]); w.w = pkh(v1[2], v1[3]);
                        if (!dry) *(u32x4*)((char*)KI + ((unsigned)((u.pm * 16 + wr * 4 + ai * 8 + m) * 2 + wc) * 64u + (unsigned)(fq * 16 + fr)) * 16u) = w; }
            } else if (wc == 2 && fq == 0) {
#pragma unroll
                for (int ai = 0; ai < 2; ++ai)
#pragma unroll
                    for (int m = 0; m < 4; ++m) { float* p = WI + (size_t)(row0 + ai * 128 + m * 16) * 8;
                        if (!dry) { *(f32x4*)p = acc[ai][0][m][0] * 0.35355339059327373f; *(f32x4*)(p + 4) = acc[ai][0][m][1] * 0.35355339059327373f; } }
            }
        }
        else { h16* base = pn < 21 ? SGA : SGB; const int pl = pn < 21 ? pn - 17 : pn - 21; store_tile_frag<2>(acc, base, frag_off(u.pm, pl, wr * 4 + wc, fq * 16 + fr), dry); }
    }
};

template <int SECOND> struct EpiMerge {
    static constexpr bool PERM = true;
    const h16* SG; h16* T1; h16* OUT; int dry;
    __device__ __forceinline__ void operator()(AccRef acc, const pg8::Unit& u, int wr, int wc, int fr, int fq) const {
        const int row0 = u.pm * 256 + wr * 64 + fr, col0 = u.pn * 256 + wc * 32 + 8 * fq;
        const unsigned fo = frag_off(u.pm, u.pn, wr * 4 + wc, fq * 16 + fr);
#pragma unroll
        for (int ai = 0; ai < 2; ++ai)
#pragma unroll
            for (int m = 0; m < 4; ++m) { const size_t off = (size_t)(row0 + ai * 128 + m * 16) * DM + col0;
#pragma unroll
                for (int bj = 0; bj < 2; ++bj) { const f32x4 v0 = acc[ai][bj][m][0], v1 = acc[ai][bj][m][1];
                    const h8 sg = *(const h8*)((const char*)SG + fo + FRAG_SUB(ai, m, bj));
                    float r[8];
#pragma unroll
                    for (int j = 0; j < 4; ++j) { r[j] = (float)sg[j] * v0[j]; r[4 + j] = (float)sg[4 + j] * v1[j]; }
                    if (SECOND) { const h8 t1 = *(const h8*)((const char*)T1 + fo + FRAG_SUB(ai, m, bj));
#pragma unroll
                        for (int j = 0; j < 8; ++j) r[j] += (float)t1[j]; }
                    u32x4 w; w.x = pkh(r[0], r[1]); w.y = pkh(r[2], r[3]); w.z = pkh(r[4], r[5]); w.w = pkh(r[6], r[7]);
                    if (!dry) { if (SECOND) *(u32x4*)(OUT + off + bj * 128) = w; else *(u32x4*)((char*)T1 + fo + FRAG_SUB(ai, m, bj)) = w; } }
                asm volatile("" ::: "memory"); }
    }
};

template <bool BASE_F32> struct EpiResid {
    static constexpr bool PERM = true;
    const float* BF; const h16* BH; h16* XOUT; float* SSQ; int dry;
    __device__ __forceinline__ void operator()(AccRef acc, const pg8::Unit& u, int wr, int wc, int fr, int fq) const {
        const int row0 = u.pm * 256 + wr * 64 + fr, col0 = u.pn * 256 + wc * 32 + 8 * fq;
#pragma unroll
        for (int ai = 0; ai < 2; ++ai)
#pragma unroll
            for (int m = 0; m < 4; ++m) { const int row = row0 + ai * 128 + m * 16; const size_t off = (size_t)row * DM + col0; float ss = 0.f;
#pragma unroll
                for (int bj = 0; bj < 2; ++bj) { const f32x4 v0 = acc[ai][bj][m][0], v1 = acc[ai][bj][m][1];
                    float r[8];
                    if (BASE_F32) { const f32x4 b0 = *(const f32x4*)(BF + off + bj * 128), b1 = *(const f32x4*)(BF + off + bj * 128 + 4);
#pragma unroll
                        for (int j = 0; j < 4; ++j) { r[j] = b0[j] + v0[j]; r[4 + j] = b1[j] + v1[j]; } }
                    else { const h8 b = *(const h8*)(BH + off + bj * 128);
#pragma unroll
                        for (int j = 0; j < 4; ++j) { r[j] = (float)b[j] + v0[j]; r[4 + j] = (float)b[4 + j] + v1[j]; } }
#pragma unroll
                    for (int j = 0; j < 8; ++j) ss += r[j] * r[j];
                    u32x4 w; w.x = pkh(r[0], r[1]); w.y = pkh(r[2], r[3]); w.z = pkh(r[4], r[5]); w.w = pkh(r[6], r[7]);
                    if (!dry) *(u32x4*)(XOUT + off + bj * 128) = w; }
                ss += __shfl_xor(ss, 16); ss += __shfl_xor(ss, 32);
                if (fq == 0 && !dry) unsafeAtomicAdd(SSQ + row, ss);
                asm volatile("" ::: "memory"); }
    }
};

struct EpiUp {
    static constexpr bool PERM = true;
    const float* SSQ; h16* UPG; h16* UPV; int dry;
    __device__ __forceinline__ void operator()(AccRef acc, const pg8::Unit& u, int wr, int wc, int fr, int fq) const {
        const int row0 = u.pm * 256 + wr * 64 + fr, col0 = u.pn * 128 + wc * 32 + 8 * fq;
#pragma unroll
        for (int ai = 0; ai < 2; ++ai)
#pragma unroll
            for (int m = 0; m < 4; ++m) { const int row = row0 + ai * 128 + m * 16; const size_t off = (size_t)row * DFF + col0;
                const float r = __builtin_amdgcn_rsqf(SSQ[row] * (1.0f / DM) + EPS);
#pragma unroll
                for (int bj = 0; bj < 2; ++bj) { const f32x4 v0 = acc[ai][bj][m][0] * r, v1 = acc[ai][bj][m][1] * r;
                    u32x4 w; w.x = pkh(v0[0], v0[1]); w.y = pkh(v0[2], v0[3]); w.z = pkh(v1[0], v1[1]); w.w = pkh(v1[2], v1[3]);
                    if (!dry) *(u32x4*)((bj ? UPV : UPG) + off) = w; } }
    }
};

__device__ __forceinline__ float dpp_ror1(float v) { return __builtin_bit_cast(float, __builtin_amdgcn_update_dpp(0, __builtin_bit_cast(int, v), 0x121, 0xf, 0xf, false)); }
__device__ __forceinline__ float dpp_ror2(float v) { return __builtin_bit_cast(float, __builtin_amdgcn_update_dpp(0, __builtin_bit_cast(int, v), 0x122, 0xf, 0xf, false)); }
struct EpiUpAct {
    static constexpr bool PERM = true;
    const float* SSQ; h16* ACT; float* SG; float* SV; float* SL; const float* fcw; const float* fcb; LAS unsigned char* xl; int dry;
    __device__ __forceinline__ void operator()(AccRef acc, const pg8::Unit& u, int wr, int wc, int fr, int fq) const {
        const int row0 = u.pm * 256 + wr * 64 + fr, colg = u.pn * 128 + wc * 32 + 8 * fq, coll = wc * 32 + 8 * fq;
        float w0[8], w1[8], w2[8], bb[8];
        { const f32x4 a0 = *(const f32x4*)(fcw + colg), a1 = *(const f32x4*)(fcw + colg + 4), b0 = *(const f32x4*)(fcw + DFF + colg), b1 = *(const f32x4*)(fcw + DFF + colg + 4),
                      c0 = *(const f32x4*)(fcw + 2 * DFF + colg), c1 = *(const f32x4*)(fcw + 2 * DFF + colg + 4), d0 = *(const f32x4*)(fcb + colg), d1 = *(const f32x4*)(fcb + colg + 4);
#pragma unroll
          for (int e = 0; e < 4; ++e) { w0[e] = a0[e]; w0[4 + e] = a1[e]; w1[e] = b0[e]; w1[4 + e] = b1[e]; w2[e] = c0[e]; w2[4 + e] = c1[e]; bb[e] = d0[e]; bb[4 + e] = d1[e]; } }
        LAS float* X = (LAS float*)xl;
#pragma unroll
        for (int ai = 0; ai < 2; ++ai) { const float r3 = __builtin_amdgcn_rsqf(SSQ[row0 + ai * 128 + 48] * (1.0f / DM) + EPS);
            if (fr >= 14) { LAS float* p = X + ((ai * 2 + wr) * 2 + (fr - 14)) * 128 + coll; *(LAS f32x4*)p = acc[ai][0][3][0] * r3; *(LAS f32x4*)(p + 4) = acc[ai][0][3][1] * r3; } }
        LDS_WAIT(); __builtin_amdgcn_s_barrier(); asm volatile("" ::: "memory");
#pragma unroll
        for (int ai = 0; ai < 2; ++ai) {
            float L0[8], L1[8];
            if (ai == 0 && wr == 0) {
#pragma unroll
                for (int e = 0; e < 8; ++e) { L0[e] = 0.f; L1[e] = 0.f; } }
            else { const int pb = wr == 1 ? ai * 2 : 1; const LAS float* p = X + (pb * 2) * 128 + coll;
                const f32x4 x0 = *(const LAS f32x4*)p, x1 = *(const LAS f32x4*)(p + 4), y0 = *(const LAS f32x4*)(p + 128), y1 = *(const LAS f32x4*)(p + 132);
#pragma unroll
                for (int e = 0; e < 4; ++e) { L0[e] = x0[e]; L0[4 + e] = x1[e]; L1[e] = y0[e]; L1[4 + e] = y1[e]; } }
            float q1[8], q2[8];
#pragma unroll
            for (int e = 0; e < 8; ++e) { q1[e] = L1[e]; q2[e] = fr == 0 ? L0[e] : L1[e]; }
#pragma unroll
            for (int m = 0; m < 4; ++m) { const int row = row0 + ai * 128 + m * 16;
                const float rr = __builtin_amdgcn_rsqf(SSQ[row] * (1.0f / DM) + EPS);
                float g[8], a[8];
#pragma unroll
                for (int e = 0; e < 4; ++e) { g[e] = acc[ai][0][m][0][e] * rr; g[4 + e] = acc[ai][0][m][1][e] * rr; }
#pragma unroll
                for (int e = 0; e < 8; ++e) { const float r1 = dpp_ror1(g[e]), r2 = dpp_ror2(g[e]);
                    const float p1 = fr >= 1 ? r1 : q1[e], p2 = fr >= 2 ? r2 : q2[e];
                    const float y = bb[e] + w0[e] * p2 + w1[e] * p1 + w2[e] * g[e];
                    const float vv = (e < 4 ? acc[ai][1][m][0][e] : acc[ai][1][m][1][e - 4]) * rr;
                    a[e] = gelu_tanh(y) * vv; q1[e] = r1; q2[e] = r2; }
                const bool deferred = (ai == 0 && m == 0) && wr == 0 && fr < 2;
                if (!dry) {
                    if (!deferred) { u32x4 w; w.x = pkh(a[0], a[1]); w.y = pkh(a[2], a[3]); w.z = pkh(a[4], a[5]); w.w = pkh(a[6], a[7]); *(u32x4*)(ACT + (size_t)row * DFF + colg) = w; }
                    else { float* pg = SG + (size_t)(u.pm * 2 + fr) * DFF + colg; float* pv = SV + (size_t)(u.pm * 2 + fr) * DFF + colg;
                        *(f32x4*)pg = (f32x4){g[0], g[1], g[2], g[3]}; *(f32x4*)(pg + 4) = (f32x4){g[4], g[5], g[6], g[7]};
                        *(f32x4*)pv = acc[ai][1][m][0] * rr; *(f32x4*)(pv + 4) = acc[ai][1][m][1] * rr; }
                    if ((ai == 1 && m == 3) && wr == 1 && fr >= 14) { float* pl = SL + (size_t)(u.pm * 2 + fr - 14) * DFF + colg;
                        *(f32x4*)pl = (f32x4){g[0], g[1], g[2], g[3]}; *(f32x4*)(pl + 4) = (f32x4){g[4], g[5], g[6], g[7]}; } }
                __builtin_amdgcn_sched_barrier(0); }
        }
    }
};
__device__ __forceinline__ void act_fix_tile(const float* SG, const float* SV, const float* SL, const float* fcw, const float* fcb, h16* ACT, int pm, int tid, int dry) {
    constexpr int NCG = DFF / 8; const bool bs = (pm & 31) == 0;
    for (int it = tid; it < 2 * NCG; it += NTHR) { const int cg = it % NCG, rr = it / NCG, c0 = cg * 8;
        float y[8];
#pragma unroll
        for (int h = 0; h < 2; ++h) { const int c = c0 + 4 * h;
            const f32x4 g = *(const f32x4*)(SG + (size_t)(pm * 2 + rr) * DFF + c), v = *(const f32x4*)(SV + (size_t)(pm * 2 + rr) * DFF + c);
            f32x4 g1, g2; const f32x4 z = {0.f, 0.f, 0.f, 0.f};
            if (rr == 0) { g1 = bs ? z : *(const f32x4*)(SL + (size_t)((pm - 1) * 2 + 1) * DFF + c); g2 = bs ? z : *(const f32x4*)(SL + (size_t)((pm - 1) * 2) * DFF + c); }
            else { g1 = *(const f32x4*)(SG + (size_t)(pm * 2) * DFF + c); g2 = bs ? z : *(const f32x4*)(SL + (size_t)((pm - 1) * 2 + 1) * DFF + c); }
            const f32x4 a0 = *(const f32x4*)(fcw + c), a1 = *(const f32x4*)(fcw + DFF + c), a2 = *(const f32x4*)(fcw + 2 * DFF + c), b = *(const f32x4*)(fcb + c);
#pragma unroll
            for (int e = 0; e < 4; ++e) y[4 * h + e] = gelu_tanh(b[e] + a0[e] * g2[e] + a1[e] * g1[e] + a2[e] * g[e]) * v[e]; }
        u32x4 w; w.x = pkh(y[0], y[1]); w.y = pkh(y[2], y[3]); w.z = pkh(y[4], y[5]); w.w = pkh(y[6], y[7]);
        if (!dry) *(u32x4*)(ACT + (size_t)(pm * 256 + rr) * DFF + c0) = w; }
}

struct EpiGateSig {
    static constexpr bool PERM = true;
    const float* SSQ; h16* GS; int dry;
    __device__ __forceinline__ void operator()(AccRef acc, const pg8::Unit& u, int wr, int wc, int fr, int fq) const {
        const int row0 = u.pm * 256 + wr * 64 + fr; const unsigned fo = frag_off(u.pm, u.pn, wr * 4 + wc, fq * 16 + fr);
#pragma unroll
        for (int ai = 0; ai < 2; ++ai)
#pragma unroll
            for (int m = 0; m < 4; ++m) { const int row = row0 + ai * 128 + m * 16; const float r = __builtin_amdgcn_rsqf(SSQ[row] * (1.0f / DM) + EPS);
#pragma unroll
                for (int bj = 0; bj < 2; ++bj) { const f32x4 v0 = acc[ai][bj][m][0] * r, v1 = acc[ai][bj][m][1] * r;
                    u32x4 w; w.x = pkh(sigmoid_f(v0[0]), sigmoid_f(v0[1])); w.y = pkh(sigmoid_f(v0[2]), sigmoid_f(v0[3])); w.z = pkh(sigmoid_f(v1[0]), sigmoid_f(v1[1])); w.w = pkh(sigmoid_f(v1[2]), sigmoid_f(v1[3]));
                    if (!dry) *(u32x4*)((char*)GS + fo + FRAG_SUB(ai, m, bj)) = w; }
                __builtin_amdgcn_sched_barrier(0); }
    }
};
struct EpiPleOut {
    static constexpr bool PERM = true;
    const h16* GS; const h16* X2; float* C; int dry;
    __device__ __forceinline__ void operator()(AccRef acc, const pg8::Unit& u, int wr, int wc, int fr, int fq) const {
        const int row0 = u.pm * 256 + wr * 64 + fr, col0 = u.pn * 256 + wc * 32 + 8 * fq;
        const unsigned e0 = (unsigned)row0 * DM + (unsigned)col0, fo = frag_off(u.pm, u.pn, wr * 4 + wc, fq * 16 + fr);
#pragma unroll
        for (int ai = 0; ai < 2; ++ai)
#pragma unroll
            for (int m = 0; m < 4; ++m) { const unsigned eo = e0 + (unsigned)((ai * 128 + m * 16) * DM);
#pragma unroll
                for (int bj = 0; bj < 2; ++bj) { const unsigned o2 = eo + bj * 128;
                    const h8 gs = *(const h8*)((const char*)GS + fo + FRAG_SUB(ai, m, bj)), xb = *(const h8*)((const char*)X2 + (size_t)o2 * 2u); const f32x4 a0 = acc[ai][bj][m][0], a1 = acc[ai][bj][m][1];
                    f32x4 o0, o1;
#pragma unroll
                    for (int j = 0; j < 4; ++j) { o0[j] = (float)xb[j] + (float)gs[j] * a0[j]; o1[j] = (float)xb[4 + j] + (float)gs[4 + j] * a1[j]; }
                    if (!dry) { *(f32x4*)((char*)C + (size_t)o2 * 4u) = o0; *(f32x4*)((char*)C + (size_t)o2 * 4u + 16) = o1; } }
                asm volatile("" ::: "memory"); }
    }
};


#define XB_TMO      128
#define XB_XCNT(j)  (256  + 64 * (j))
#define XB_XSUB(j)  (1280 + 64 * (j))
#define XB_XGEN(j)  (2304 + 64 * (j))
#define XB_TOP      3328
#define XB_TOPGEN   3392
#define XCD_BAR_WORDS 3456
#define XB_SPIN_CAP (1u << 20)

__device__ __forceinline__ unsigned xb_ld(unsigned* p)              { return __hip_atomic_load(p, __ATOMIC_RELAXED, __HIP_MEMORY_SCOPE_AGENT); }
__device__ __forceinline__ unsigned xb_add(unsigned* p, unsigned v) { return __hip_atomic_fetch_add(p, v, __ATOMIC_RELAXED, __HIP_MEMORY_SCOPE_AGENT); }
__device__ __forceinline__ unsigned xb_xcc_id() { return (unsigned)__builtin_amdgcn_s_getreg((3 << 11) | 20) & 0xFu; }
#define XB_SPIN(cond, bar) do { unsigned _sp = 0; while (cond) { __builtin_amdgcn_s_sleep(1); \
    if ((++_sp & 255u) == 0u) { if (xb_ld(&(bar)[XB_TMO])) break; if (_sp > XB_SPIN_CAP) { atomicAdd(&(bar)[XB_TMO], 1u); break; } } } } while (0)

struct XcdBarrier { unsigned* bar; unsigned x; volatile LAS unsigned* st; };

__device__ __forceinline__ XcdBarrier xcd_barrier_post(unsigned* bar, volatile LAS unsigned* st) {
    XcdBarrier b; b.bar = bar; b.x = xb_xcc_id(); b.st = st;
    if (threadIdx.x == 0) (void)xb_add(&bar[XB_XCNT(b.x)], 1u);
    return b;
}
__device__ __forceinline__ void xcd_barrier_complete(unsigned* bar, unsigned x, unsigned& nloc, unsigned& nx) {
    const unsigned G = gridDim.x * gridDim.y * gridDim.z;
    unsigned sum, cnt, mine, sp = 0u;
    for (;;) {
        sum = 0u; cnt = 0u; mine = 0u;
#pragma unroll
        for (unsigned j = 0; j < 16; ++j) { const unsigned c = xb_ld(&bar[XB_XCNT(j)]); sum += c; cnt += (c > 0u) ? 1u : 0u; mine = (j == x) ? c : mine; }
        if (sum == G) break;
        __builtin_amdgcn_s_sleep(1);
        if ((++sp & 255u) == 0u) { if (xb_ld(&bar[XB_TMO])) break; if (sp > XB_SPIN_CAP) { atomicAdd(&bar[XB_TMO], 1u); break; } }
    }
    nloc = mine > 0u ? mine : 1u; nx = cnt > 0u ? cnt : 1u;
}
__device__ __forceinline__ void xcd_barrier(const XcdBarrier& b) {
    asm volatile("s_waitcnt vmcnt(0)" ::: "memory");
    __syncthreads();
    if (threadIdx.x == 0) {
        unsigned* bar = b.bar;
        __builtin_amdgcn_s_waitcnt(0);
        unsigned nloc = b.st[0], nx = b.st[1];
        if (nloc == 0u) { xcd_barrier_complete(bar, b.x, nloc, nx); b.st[0] = nloc; b.st[1] = nx; }
        const unsigned old = xb_add(&bar[XB_XSUB(b.x)], 1u);
        const unsigned gen = old / nloc;
        if (old + 1u == (gen + 1u) * nloc) {
            __builtin_amdgcn_fence(__ATOMIC_RELEASE, "agent");
            asm volatile("s_waitcnt vmcnt(0)" ::: "memory");
            const unsigned og = xb_add(&bar[XB_TOP], 1u);
            const unsigned tg = og / nx;
            if (og + 1u == (tg + 1u) * nx) xb_add(&bar[XB_TOPGEN], 1u);
            else XB_SPIN(xb_ld(&bar[XB_TOPGEN]) == tg, bar);
            __builtin_amdgcn_fence(__ATOMIC_ACQUIRE, "agent");
            xb_add(&bar[XB_XGEN(b.x)], 1u);
            asm volatile("s_waitcnt vmcnt(0)" ::: "memory");
        } else {
            XB_SPIN(xb_ld(&bar[XB_XGEN(b.x)]) == gen, bar);
            __builtin_amdgcn_fence(__ATOMIC_ACQUIRE, "agent");
            asm volatile("s_waitcnt vmcnt(0)" ::: "memory");
        }
    }
    __syncthreads();
}

constexpr size_t MiB = 1u << 20;
constexpr size_t WS_CTL = 0, CTL_ZERO_BYTES = 1 * MiB;
constexpr size_t WS_SA = 1 * MiB, WS_SH = 2 * MiB;
constexpr size_t WS_WI = 3 * MiB;
constexpr size_t WS_KI = 4 * MiB;
constexpr size_t WS_W = 8 * MiB;
constexpr size_t W_IN = WS_W, W_LRU = W_IN + (size_t)NIN_PAD * DM * 2, W_ATT = W_LRU + 2 * MiB, W_OUT = W_ATT + 2 * MiB, W_PG = W_OUT + 2 * MiB,
                 W_UP = W_PG + 2 * MiB, W_DOWN = W_UP + 12 * MiB, W_PP = W_DOWN + 6 * MiB, W_GATE = W_PP + MiB / 2, W_END = W_GATE + MiB / 2;
static_assert(W_END <= 48 * MiB, "weights region");
constexpr size_t WS_A0 = 48 * MiB;
constexpr size_t WS_IDX = 48 * MiB, WS_NV = 64 * MiB;
constexpr size_t WS_K8 = 72 * MiB, WS_V8 = 80 * MiB;
constexpr size_t WS_T1 = 48 * MiB;
constexpr size_t WS_X1H = 48 * MiB;
constexpr size_t WS_PH = 112 * MiB;
constexpr size_t WS_LX = 128 * MiB;
constexpr size_t WS_GG = 192 * MiB;
constexpr size_t WS_Q = 256 * MiB;
constexpr size_t WS_K = 320 * MiB, WS_V = 336 * MiB;
constexpr size_t WS_QI = 352 * MiB;
constexpr size_t WS_SGA = 384 * MiB, WS_SGB = 448 * MiB;
constexpr size_t WS_UPG = 128 * MiB, WS_UPV = 320 * MiB;
constexpr size_t WS_X2H = 128 * MiB;
constexpr size_t WS_GS = 320 * MiB;
constexpr size_t WS_END = 512 * MiB;
constexpr int CW_BAR = 1024;
constexpr int CW_Q2 = 8192, CW_Q3 = 8192 + 256;
constexpr size_t CTL_SSQ1 = 256 * 1024, CTL_SSQ2 = 512 * 1024;
static_assert((CW_BAR + XCD_BAR_WORDS) * 4 <= 32768 && CTL_SSQ2 + MTOK * 4 <= CTL_ZERO_BYTES, "ctl map");

constexpr int LDS_BYTES = 159744;
constexpr int MISC_OFF = LDS_BYTES - 256;

struct Params {
    const float* in[25]; float* out; unsigned char* ws; int ph_lo, ph_hi, k_ple, pad;
};

__device__ __forceinline__ float wave_sum(float v) {
#pragma unroll
    for (int o = 1; o < 64; o <<= 1) v += __shfl_xor(v, o);
    return v;
}
template <int MAP> __device__ __forceinline__ int rowmap(int n) {
    if (MAP == 1) return n < 4168 ? n : n + 184;
    if (MAP == 2) return n < DFF ? ((n >> 7) * 256 + (n & 127)) : (((n - DFF) >> 7) * 256 + 128 + ((n - DFF) & 127));
    return n;
}
template <int MAP> __device__ __forceinline__ void p0_transpose_item(const float* W, int K, int N, h16* WT, const float* gain, LAS float* scr, int item, int lane) {
    const int nblk = (N + 31) / 32, kb = item / nblk, nb = item % nblk, k0 = 64 * kb, n0 = 32 * nb;
    const int nn = n0 + (lane & 31);
#pragma unroll 8
    for (int i = 0; i < 32; ++i) { const int kk = 2 * i + (lane >> 5); float v = 0.f; if (nn < N) v = W[(size_t)(k0 + kk) * N + nn]; if (gain) v *= gain[k0 + kk]; scr[kk * 33 + (lane & 31)] = v; }
    LDS_WAIT(); asm volatile("" ::: "memory");
    const int c = lane & 7;
#pragma unroll
    for (int j = 0; j < 4; ++j) { const int n = (lane >> 3) + 8 * j; const LAS float* s = scr + (8 * c) * 33 + n;
        u32x4 o; o.x = pkh(s[0 * 33], s[1 * 33]); o.y = pkh(s[2 * 33], s[3 * 33]); o.z = pkh(s[4 * 33], s[5 * 33]); o.w = pkh(s[6 * 33], s[7 * 33]);
        if (n0 + n < N) *(u32x4*)(WT + (size_t)rowmap<MAP>(n0 + n) * K + k0 + 8 * c) = o; }
    LDS_WAIT(); asm volatile("" ::: "memory");
}

struct Ctx {
    unsigned char* ws; float* out; int dry;
    const float *conv_w, *conv_b, *ba, *bx, *lam, *qn, *kn, *relb, *fcw, *fcb;
};
__device__ __forceinline__ unsigned ordered_u32(float v) { const unsigned u = __builtin_bit_cast(unsigned, v); return u ^ ((unsigned)((int)u >> 31) | 0x80000000u); }

constexpr int UA_STR = 272;
constexpr int LRU_UA = 0, LRU_HL = 128 * UA_STR, LRU_PP = 2 * 128 * UA_STR;
__device__ __forceinline__ void lru1_item(const Ctx& C, LAS unsigned char* lds, int item) {
    int tid = threadIdx.x; asm volatile("" : "+v"(tid));
    const int lane = tid & 63, wv = tid >> 6;
    const int b = item >> 7, n = (item >> 4) & 7, jg = item & 15;
    const h16* LX = (const h16*)(C.ws + WS_LX);
    const int cg = tid & 15, rg = tid >> 4, ch0 = n * 128 + cg * 8, tl = rg * 4;
    float cb[8], cw[4][8];
    { const f32x4 t0 = *(const f32x4*)(C.conv_b + ch0), t1 = *(const f32x4*)(C.conv_b + ch0 + 4); for (int e = 0; e < 4; ++e) { cb[e] = t0[e]; cb[4 + e] = t1[e]; } }
#pragma unroll
    for (int jj = 0; jj < 4; ++jj) { const f32x4 w0 = *(const f32x4*)(C.conv_w + jj * DM + ch0), w1 = *(const f32x4*)(C.conv_w + jj * DM + ch0 + 4); for (int e = 0; e < 4; ++e) { cw[jj][e] = w0[e]; cw[jj][4 + e] = w1[e]; } }
    const int q = lane & 15, c = lane >> 4, oc = wv * 16 + q, ch = n * 128 + oc;
    const h16* WG = (const h16*)(C.ws + W_GATE) + (size_t)n * 256 * 128;
    h8 Ba[4], Bx[4];
#pragma unroll
    for (int ks = 0; ks < 4; ++ks) { Ba[ks] = *(const h8*)(WG + (size_t)oc * 128 + 32 * ks + 8 * c); Bx[ks] = *(const h8*)(WG + (size_t)(128 + oc) * 128 + 32 * ks + 8 * c); }
    const float bav = C.ba[ch], bxv = C.bx[ch], m8sp = -8.0f * 1.4426950408889634f * log1pf(expf(-C.lam[ch]));
#pragma unroll 1
    for (int j4 = 0; j4 < 4; ++j4) {
    const int j = jg * 4 + j4;
    const size_t mrow0 = (size_t)b * SEQ + (size_t)j * 128;
    {
        const int tseq = j * 128 + tl;
        h8 xr[7];
#pragma unroll
        for (int i = 0; i < 7; ++i) { const int tt = tseq - 3 + i; if (tt >= 0) xr[i] = *(const h8*)(LX + ((size_t)b * SEQ + tt) * DM + ch0); else { for (int e = 0; e < 8; ++e) xr[i][e] = (h16)0.f; } }
        float y[4][8];
#pragma unroll
        for (int r = 0; r < 4; ++r)
#pragma unroll
            for (int e = 0; e < 8; ++e) y[r][e] = cb[e];
#pragma unroll
        for (int jj = 0; jj < 4; ++jj)
#pragma unroll
            for (int r = 0; r < 4; ++r)
#pragma unroll
                for (int e = 0; e < 8; ++e) y[r][e] += cw[jj][e] * (float)xr[r + jj][e];
#pragma unroll
        for (int r = 0; r < 4; ++r) { u32x4 w; w.x = pkh(y[r][0], y[r][1]); w.y = pkh(y[r][2], y[r][3]); w.z = pkh(y[r][4], y[r][5]); w.w = pkh(y[r][6], y[r][7]);
            *(LAS u32x4*)(lds + LRU_UA + (tl + r) * UA_STR + cg * 16) = w; }
    }
    __syncthreads();
    {
        float cH = 0.f, cP = 1.f;
        for (int tt = 0; tt < 8; ++tt) {
            f32x4 aa = {0.f, 0.f, 0.f, 0.f}, ax = {0.f, 0.f, 0.f, 0.f};
#pragma unroll
            for (int ks = 0; ks < 4; ++ks) { const h8 A = *(const LAS h8*)(lds + LRU_UA + (16 * tt + q) * UA_STR + (32 * ks + 8 * c) * 2);
                aa = __builtin_amdgcn_mfma_f32_16x16x32_f16(A, Ba[ks], aa, 0, 0, 0); ax = __builtin_amdgcn_mfma_f32_16x16x32_f16(A, Bx[ks], ax, 0, 0, 0); }
            float hl[4], pl[4]; float h = 0.f, p = 1.f;
#pragma unroll
            for (int i = 0; i < 4; ++i) { const int t = 16 * tt + 4 * c + i;
                const float uav = (float)*(const LAS h16*)(lds + LRU_UA + t * UA_STR + oc * 2);
                const float ra = sigmoid_f(aa[i] + bav), ix = sigmoid_f(ax[i] + bxv);
                const float a = __builtin_amdgcn_exp2f(m8sp * ra);
                const float mult = __builtin_amdgcn_sqrtf(fmaxf(1.0f - a * a, 0.f));
                const float u = mult * ix * uav;
                h = a * h + u; p *= a; hl[i] = h; pl[i] = p; }
            float Ak[4], Hk[4];
#pragma unroll
            for (int k = 0; k < 4; ++k) { Ak[k] = __shfl(p, q + 16 * k); Hk[k] = __shfl(h, q + 16 * k); }
            float PA = 1.f, PH = 0.f;
#pragma unroll
            for (int k = 0; k < 3; ++k) if (k < c) { PH = PH * Ak[k] + Hk[k]; PA *= Ak[k]; }
            const float hin = cH * PA + PH, pin = cP * PA;
#pragma unroll
            for (int i = 0; i < 4; ++i) { const int t = 16 * tt + 4 * c + i;
                *(LAS h16*)(lds + LRU_HL + t * UA_STR + oc * 2) = (h16)(hl[i] + pl[i] * hin);
                *(LAS h16*)(lds + LRU_PP + t * UA_STR + oc * 2) = (h16)(pin * pl[i]); }
            const float AT = Ak[0] * Ak[1] * Ak[2] * Ak[3], HT = ((Hk[0] * Ak[1] + Hk[1]) * Ak[2] + Hk[2]) * Ak[3] + Hk[3];
            cH = cH * AT + HT; cP = cP * AT;
        }
        if (c == 0 && !C.dry) { const size_t so = ((size_t)b * 64 + j) * DM + ch; ((float*)(C.ws + WS_SA))[so] = cP; ((float*)(C.ws + WS_SH))[so] = cH; }
    }
    __syncthreads();
    {
        h16* HLOC = (h16*)C.out; h16* PPRD = (h16*)C.out + (size_t)MTOK * DM;
#pragma unroll
        for (int r = 0; r < 4; ++r) { const int t = rg * 4 + r; const size_t go = (mrow0 + t) * DM + n * 128 + cg * 8;
            const u32x4 w0 = *(const LAS u32x4*)(lds + LRU_HL + t * UA_STR + cg * 16), w1 = *(const LAS u32x4*)(lds + LRU_PP + t * UA_STR + cg * 16);
            if (!C.dry) { *(u32x4*)(HLOC + go) = w0; *(u32x4*)(PPRD + go) = w1; } }
    }
    __syncthreads();
    }
}

__device__ __forceinline__ void lru2_item(const Ctx& C, LAS unsigned char* lds, int item) {
    int tid = threadIdx.x; asm volatile("" : "+v"(tid));
    const int b = item >> 7, n = (item >> 4) & 7, jg = item & 15, j0 = jg * 4;
    LAS float* carry = (LAS float*)lds;
    if (tid < 128) { const int ch = n * 128 + tid; const float* SA = (const float*)(C.ws + WS_SA) + (size_t)b * 64 * DM + ch; const float* SH = (const float*)(C.ws + WS_SH) + (size_t)b * 64 * DM + ch;
        float cr = 0.f; int jj = 0;
        for (; jj + 8 <= j0; jj += 8) { float a8[8], h8v[8];
#pragma unroll
            for (int k = 0; k < 8; ++k) { a8[k] = SA[(size_t)(jj + k) * DM]; h8v[k] = SH[(size_t)(jj + k) * DM]; }
#pragma unroll
            for (int k = 0; k < 8; ++k) cr = a8[k] * cr + h8v[k]; }
        for (; jj < j0; ++jj) cr = SA[(size_t)jj * DM] * cr + SH[(size_t)jj * DM];
        float a4[4], h4[4];
#pragma unroll
        for (int k = 0; k < 4; ++k) { a4[k] = SA[(size_t)(j0 + k) * DM]; h4[k] = SH[(size_t)(j0 + k) * DM]; }
#pragma unroll
        for (int k = 0; k < 4; ++k) { carry[k * 128 + tid] = cr; cr = a4[k] * cr + h4[k]; } }
    __syncthreads();
    const int cg = tid & 15, rg = tid >> 4; const h16* HLOC = (const h16*)C.out; const h16* PPRD = (const h16*)C.out + (size_t)MTOK * DM;
    const h16* GG = (const h16*)(C.ws + WS_GG); h16* YA = (h16*)(C.ws + WS_LX);
#pragma unroll 1
    for (int k = 0; k < 4; ++k) {
        float cr[8];
#pragma unroll
        for (int e = 0; e < 8; ++e) cr[e] = carry[k * 128 + cg * 8 + e];
#pragma unroll
        for (int r = 0; r < 4; ++r) { const size_t go = ((size_t)b * SEQ + (j0 + k) * 128 + rg * 4 + r) * DM + n * 128 + cg * 8;
            const h8 hl = *(const h8*)(HLOC + go), pp = *(const h8*)(PPRD + go), gg = *(const h8*)(GG + go);
            float y[8];
#pragma unroll
            for (int e = 0; e < 8; ++e) y[e] = ((float)hl[e] + (float)pp[e] * cr[e]) * (float)gg[e];
            u32x4 w; w.x = pkh(y[0], y[1]); w.y = pkh(y[2], y[3]); w.z = pkh(y[4], y[5]); w.w = pkh(y[6], y[7]);
            if (!C.dry) *(u32x4*)(YA + go) = w; } }
}

__device__ __forceinline__ unsigned pk4_fp8_k(float a, float b, float c, float d) { int w = 0; w = __builtin_amdgcn_cvt_pk_fp8_f32(a, b, w, false); w = __builtin_amdgcn_cvt_pk_fp8_f32(c, d, w, true); return (unsigned)w; }
__device__ __forceinline__ void knorm_unit(const Ctx& C, int unit) {
    int tid = threadIdx.x; asm volatile("" : "+v"(tid));
    const int lane = tid & 63, wv = tid >> 6;
    const h16* K = (const h16*)(C.ws + WS_K); const h16* V = (const h16*)(C.ws + WS_V);
    unsigned* K8 = (unsigned*)(C.ws + WS_K8); unsigned* V8 = (unsigned*)(C.ws + WS_V8);
    const int col = lane * 4, d0 = col & 127;
    const f32x4 g = *(const f32x4*)(C.kn + d0);
    for (int r = 0; r < 16; ++r) { const size_t row = (size_t)unit * 128 + wv * 16 + r;
        const h4 v = *(const h4*)(K + row * 256 + col), vv = *(const h4*)(V + row * 256 + col);
        float ss = 0.f, f[4];
#pragma unroll
        for (int e = 0; e < 4; ++e) { f[e] = (float)v[e]; ss += f[e] * f[e]; }
#pragma unroll
        for (int o = 1; o < 32; o <<= 1) ss += __shfl_xor(ss, o);
        const float rs = __builtin_amdgcn_rsqf(ss * (1.0f / 128.0f) + EPS);
        const unsigned wk = pk4_fp8_k(f[0] * rs * g[0], f[1] * rs * g[1], f[2] * rs * g[2], f[3] * rs * g[3]);
        const unsigned wvv = pk4_fp8_k((float)vv[0], (float)vv[1], (float)vv[2], (float)vv[3]);
        if (!C.dry) { K8[row * 64 + lane] = wk; V8[row * 64 + lane] = wvv; } }
}

#ifdef IX_PROBE
#define IX_PROBE_FINAL (C.dry && (IX_PROBE & 2))
#define IX_PROBE_NOFILT (C.dry && (IX_PROBE & 1))
#else
#define IX_PROBE_FINAL 0
#define IX_PROBE_NOFILT 0
#endif
constexpr int IX_SK = 256;
constexpr int IX_CAP = 1024;
constexpr int IX_ORD = 0;
constexpr int IX_KEY = IX_ORD + 16 * IX_CAP * 4;
constexpr int IX_HIST = IX_KEY + 16 * IX_CAP * 2;
constexpr int IX_CTR = IX_HIST + 8 * 512;
constexpr int IX_END = IX_CTR + 128;
static_assert(IX_END <= MISC_OFF, "indexer LDS");
constexpr int IX_NE = IX_CAP / 64;

struct IxBuf { LAS unsigned* ord; LAS unsigned short* key; };
#define IX_DPPMAX(v, ctl, rm) { const unsigned t_ = (unsigned)__builtin_amdgcn_update_dpp((int)(v), (int)(v), ctl, rm, 0xf, false); v = t_ > v ? t_ : v; }
__device__ __forceinline__ unsigned ix_rowmax(unsigned v) { IX_DPPMAX(v, 0xB1, 0xf) IX_DPPMAX(v, 0x4E, 0xf) IX_DPPMAX(v, 0x141, 0xf) IX_DPPMAX(v, 0x140, 0xf) return v; }
__device__ __forceinline__ unsigned ix_wavemax(unsigned v) { v = ix_rowmax(v); IX_DPPMAX(v, 0x142, 0xa) IX_DPPMAX(v, 0x143, 0xc) return (unsigned)__builtin_amdgcn_readlane((int)v, 63); }
__device__ __forceinline__ void ix_load_ord(const IxBuf& B, int cnt, int lane, unsigned (&o)[IX_NE]) {
#pragma unroll
    for (int k = 0; k < IX_NE; ++k) { const int idx = k * 64 + lane; o[k] = idx < cnt ? B.ord[idx] : 0u; }
}
__device__ __forceinline__ int ix_count_ge(const unsigned (&o)[IX_NE], unsigned x) {
    int c = 0;
#pragma unroll
    for (int k = 0; k < IX_NE; ++k) c += (int)__builtin_popcountll(__ballot(o[k] >= x));
    return c;
}
__device__ __forceinline__ unsigned ix_max(const unsigned (&o)[IX_NE]) {
    unsigned m = 0u;
#pragma unroll
    for (int k = 0; k < IX_NE; ++k) m = o[k] > m ? o[k] : m;
    return ix_wavemax(m);
}
__device__ __forceinline__ unsigned ix_tie_thr(const unsigned (&o)[IX_NE], const unsigned short (&kk)[IX_NE], unsigned x, int need) {
    unsigned lo = 0u, hi = 0x10000u;
    while (hi - lo > 1u) { const unsigned mid = (lo + hi) >> 1; int c = 0;
#pragma unroll
        for (int k = 0; k < IX_NE; ++k) c += (int)__builtin_popcountll(__ballot(o[k] == x && (unsigned)kk[k] >= mid));
        if (c >= need) lo = mid; else hi = mid; }
    return lo;
}
__device__ __forceinline__ int ix_rewrite(const IxBuf& B, const unsigned (&o)[IX_NE], const unsigned short (&kk)[IX_NE], int lane, unsigned x, unsigned th) {
    int base = 0;
#pragma unroll
    for (int k = 0; k < IX_NE; ++k) { const bool keep = o[k] > x || (o[k] == x && (unsigned)kk[k] >= th);
        const u64 m = __ballot(keep); const int pos = base + (int)__builtin_amdgcn_mbcnt_hi((unsigned)(m >> 32), __builtin_amdgcn_mbcnt_lo((unsigned)m, 0u));
        if (keep) { B.ord[pos] = o[k]; B.key[pos] = kk[k]; }
        base += (int)__builtin_popcountll(m); }
    LDS_WAIT();
    return base;
}
__device__ __forceinline__ unsigned ix_sample_pivot(unsigned s0, int rank) {
    int r = 0;
#define IX_ROT(n) { const unsigned t_ = (unsigned)__builtin_amdgcn_update_dpp(0, (int)s0, 0x120 + n, 0xf, 0xf, false); r += t_ > s0 ? 1 : 0; }
    IX_ROT(1) IX_ROT(2) IX_ROT(3) IX_ROT(4) IX_ROT(5) IX_ROT(6) IX_ROT(7) IX_ROT(8) IX_ROT(9) IX_ROT(10) IX_ROT(11) IX_ROT(12) IX_ROT(13) IX_ROT(14) IX_ROT(15)
#undef IX_ROT
    unsigned v = r >= rank ? s0 : 0u;
    v = ix_rowmax(v);
    return ((unsigned)__builtin_amdgcn_readlane((int)v, 0) >> 2) + ((unsigned)__builtin_amdgcn_readlane((int)v, 16) >> 2) + ((unsigned)__builtin_amdgcn_readlane((int)v, 32) >> 2) + ((unsigned)__builtin_amdgcn_readlane((int)v, 48) >> 2);
}
__device__ __forceinline__ unsigned ix_find_window(const unsigned (&o)[IX_NE], unsigned lo, unsigned hi, int cnt, int cmin, int cmax, bool& tie) {
    tie = false;
    int rank = (16 * ((cmin + cmax) / 2)) / cnt; rank = rank > 14 ? 14 : rank;
    unsigned x = ix_sample_pivot(o[0], rank);
    if (x <= lo || x >= hi) x = lo + ((hi - lo) >> 1);
    for (;;) { const int c = ix_count_ge(o, x);
        if (c > cmax) lo = x; else if (c < cmin) hi = x; else return x - 1u;
        if (hi - lo <= 1u) { tie = true; return lo; }
        x = lo + ((hi - lo) >> 1); }
}
__device__ __forceinline__ unsigned ix_compact(const IxBuf& B, int lane, int& cnt, unsigned T) {
    unsigned o[IX_NE]; ix_load_ord(B, cnt, lane, o);
    unsigned short kk[IX_NE];
#pragma unroll
    for (int k = 0; k < IX_NE; ++k) kk[k] = B.key[k * 64 + lane];
    LDS_WAIT();
    bool tie; unsigned th = 0x10000u;
    const unsigned x = ix_find_window(o, T, ix_max(o) + 1u, cnt, 256, 512, tie);
    if (tie) th = ix_tie_thr(o, kk, x, 512 - ix_count_ge(o, x + 1u));
    cnt = ix_rewrite(B, o, kk, lane, x, th); return x + 1u;
}
__device__ __forceinline__ unsigned ix_compact_to(const IxBuf& B, int lane, int& cnt, unsigned T) {
    unsigned o[IX_NE]; ix_load_ord(B, cnt, lane, o);
    unsigned short kk[IX_NE];
#pragma unroll
    for (int k = 0; k < IX_NE; ++k) kk[k] = B.key[k * 64 + lane];
    LDS_WAIT();
    bool tie; unsigned th = 0x10000u;
    const unsigned x = ix_find_window(o, T, ix_max(o) + 1u, cnt, 256, 320, tie);
    if (tie) th = ix_tie_thr(o, kk, x, 320 - ix_count_ge(o, x + 1u));
    cnt = ix_rewrite(B, o, kk, lane, x, th); return x + 1u;
}
__device__ __forceinline__ void ix_final(const IxBuf& B, LAS unsigned short* outl, int lane, int cnt, unsigned T, unsigned short* idx_row, int* nv_ptr, int dry) {
    if (cnt > 320) { cnt = cnt < IX_CAP ? cnt : IX_CAP; T = ix_compact_to(B, lane, cnt, T); }
    unsigned o[5]; unsigned short kk[5];
#pragma unroll
    for (int k = 0; k < 5; ++k) { const int idx = k * 64 + lane; o[k] = idx < cnt ? B.ord[idx] : 0u; kk[k] = B.key[idx]; }
    LDS_WAIT();
    unsigned x = 0u, th = 0u;
    if (cnt > 256) { unsigned mxv = 0u;
#pragma unroll
        for (int k = 0; k < 5; ++k) mxv = o[k] > mxv ? o[k] : mxv;
        mxv = ix_wavemax(mxv);
        unsigned lo = T, hi = mxv + 1u;
        for (;;) { if (hi - lo <= 1u) { x = lo; int ca = 0, need;
#pragma unroll
                for (int k = 0; k < 5; ++k) ca += (int)__builtin_popcountll(__ballot(o[k] >= lo + 1u));
                need = 256 - ca; unsigned tl = 0u, thh = 0x10000u;
                while (thh - tl > 1u) { const unsigned mid = (tl + thh) >> 1; int c = 0;
#pragma unroll
                    for (int k = 0; k < 5; ++k) c += (int)__builtin_popcountll(__ballot(o[k] == x && (unsigned)kk[k] >= mid));
                    if (c >= need) tl = mid; else thh = mid; }
                th = tl; break; }
            const unsigned mid = lo + ((hi - lo) >> 1); int c = 0;
#pragma unroll
            for (int k = 0; k < 5; ++k) c += (int)__builtin_popcountll(__ballot(o[k] >= mid));
            if (c == 256) { x = mid - 1u; th = 0x10000u; break; }
            if (c > 256) lo = mid; else hi = mid; } }
    int base = 0;
#pragma unroll
    for (int k = 0; k < 5; ++k) { const bool valid = k * 64 + lane < cnt; const bool sel = valid && (o[k] > x || (o[k] == x && (unsigned)kk[k] >= th));
        const u64 m = __ballot(sel); const int pos = base + (int)__builtin_amdgcn_mbcnt_hi((unsigned)(m >> 32), __builtin_amdgcn_mbcnt_lo((unsigned)m, 0u));
        if (sel && pos < 256) outl[pos] = (unsigned short)(0xFFFFu - (unsigned)kk[k]);
        base += (int)__builtin_popcountll(m); }
    LDS_WAIT();
    const int nsel = base < 256 ? base : 256;
    const u32x2 ow = *(const LAS u32x2*)(outl + lane * 4);
    if (!dry) { *(u32x2*)(idx_row + lane * 4) = ow; if (lane == 0) *nv_ptr = nsel; }
    LDS_WAIT();
}
__device__ __forceinline__ float ix_unordered(unsigned T) { const unsigned u = (T & 0x80000000u) ? (T ^ 0x80000000u) : ~T; return __builtin_bit_cast(float, u); }

__device__ __forceinline__ void indexer_unit(const Ctx& C, LAS unsigned char* lds, int unit) {
    int tid = threadIdx.x; asm volatile("" : "+v"(tid));
    const int lane = tid & 63, wv = __builtin_amdgcn_readfirstlane(tid >> 6);
    const int b = unit & 3, qt = 511 - (unit >> 2), t0 = qt * 16;
    const int q = lane & 15, c = lane >> 4;
    const size_t m0 = (size_t)b * SEQ + t0;
    const h16* QI = (const h16*)(C.ws + WS_QI); const h16* KI = (const h16*)(C.ws + WS_KI) + (size_t)b * SEQ * 64; const float* WI = (const float*)(C.ws + WS_WI);
    LAS unsigned* cntl = (LAS unsigned*)(lds + IX_CTR); volatile LAS float* taul = (volatile LAS float*)(lds + IX_CTR + 64);
    if (tid < 16) { cntl[tid] = 0u; taul[tid] = -3.402823466e38f; }
    h8 qf[8][2];
#pragma unroll
    for (int h = 0; h < 8; ++h)
#pragma unroll
        for (int ks = 0; ks < 2; ++ks) qf[h][ks] = *(const h8*)(QI + ((((m0 >> 4) * 8 + h) * 2 + ks) * 64 + lane) * 8);
    float wvv[8]; { const f32x4 w0 = *(const f32x4*)(WI + (m0 + q) * 8), w1 = *(const f32x4*)(WI + (m0 + q) * 8 + 4); for (int e = 0; e < 4; ++e) { wvv[e] = w0[e]; wvv[4 + e] = w1[e]; } }
#pragma unroll
    for (int h = 0; h < 8; ++h) wvv[h] *= 0.5f;
    h8 qs[2];
#pragma unroll
    for (int ks = 0; ks < 2; ++ks)
#pragma unroll
        for (int j = 0; j < 8; ++j) { float a = 0.f;
#pragma unroll
            for (int h = 0; h < 8; ++h) a += wvv[h] * (float)qf[h][ks][j];
            qs[ks][j] = (h16)a; }
    const int nkeys = t0 + 16, nslab = (nkeys + IX_SK - 1) / IX_SK;
    LAS unsigned* ordq = (LAS unsigned*)(lds + IX_ORD) + (size_t)q * IX_CAP; LAS unsigned short* keyq = (LAS unsigned short*)(lds + IX_KEY) + (size_t)q * IX_CAP;
    IxBuf BA, BB;
    BA.ord = (LAS unsigned*)(lds + IX_ORD) + (size_t)(2 * wv) * IX_CAP; BA.key = (LAS unsigned short*)(lds + IX_KEY) + (size_t)(2 * wv) * IX_CAP;
    BB.ord = BA.ord + IX_CAP; BB.key = BA.key + IX_CAP;
    LAS unsigned short* outl = (LAS unsigned short*)(lds + IX_HIST) + wv * 256;
    unsigned TA = 0x00800000u, TB = 0x00800000u; float tq = -3.402823466e38f;
    __syncthreads();
#define IX_LOADK(dst, s_) do { const int sc_ = (s_) < nslab - 1 ? (s_) : nslab - 1; _Pragma("unroll") for (int jt_ = 0; jt_ < 2; ++jt_) { int key0_ = sc_ * IX_SK + 32 * wv + 16 * jt_; key0_ = key0_ < nkeys ? key0_ : nkeys - 16; \
        const h16* p_ = KI + ((size_t)(key0_ >> 4) * 128 + lane) * 8;        \
        asm volatile("global_load_dwordx4 %0, %2, off\n\tglobal_load_dwordx4 %1, %2, off offset:1024" : "=&v"(dst[jt_][0]), "=&v"(dst[jt_][1]) : "v"(p_) : "memory"); } } while (0)
#define IX_WAITK(KF) asm volatile("s_waitcnt vmcnt(4)" : "+v"(KF[0][0]), "+v"(KF[0][1]), "+v"(KF[1][0]), "+v"(KF[1][1]) :: "memory")
#define IX_MM2(KF, A_, B_, Q0, Q1) do { A_ = __builtin_amdgcn_mfma_f32_16x16x32_f16(KF[0][0], Q0, (f32x4){0.f, 0.f, 0.f, 0.f}, 0, 0, 0); B_ = __builtin_amdgcn_mfma_f32_16x16x32_f16(KF[1][0], Q0, (f32x4){0.f, 0.f, 0.f, 0.f}, 0, 0, 0); \
        A_ = __builtin_amdgcn_mfma_f32_16x16x32_f16(KF[0][1], Q1, A_, 0, 0, 0); B_ = __builtin_amdgcn_mfma_f32_16x16x32_f16(KF[1][1], Q1, B_, 0, 0, 0); } while (0)
#define IX_SCORE2(KF, sca, scb) do { \
        f32x4 ta_[2], tb_[2]; \
        IX_MM2(KF, sca, scb, qs[0], qs[1]); IX_MM2(KF, ta_[0], tb_[0], qf[0][0], qf[0][1]); \
        _Pragma("unroll") for (int h = 0; h < 8; ++h) {        \
            __builtin_amdgcn_sched_barrier(0); \
            if (h < 7) IX_MM2(KF, ta_[(h + 1) & 1], tb_[(h + 1) & 1], qf[h + 1][0], qf[h + 1][1]); \
            __builtin_amdgcn_sched_barrier(0); \
            _Pragma("unroll") for (int i = 0; i < 4; ++i) { sca[i] = __builtin_fmaf(wvv[h], __builtin_fabsf(ta_[h & 1][i]), sca[i]); asm("" : "+v"(sca[i])); }   \
            _Pragma("unroll") for (int i = 0; i < 4; ++i) { scb[i] = __builtin_fmaf(wvv[h], __builtin_fabsf(tb_[h & 1][i]), scb[i]); asm("" : "+v"(scb[i])); } } \
        __builtin_amdgcn_sched_barrier(0); } while (0)
#define IX_SCORE(KF, sc, jt, key0) do { \
        sc = __builtin_amdgcn_mfma_f32_16x16x32_f16(KF[jt][0], qs[0], (f32x4){0.f, 0.f, 0.f, 0.f}, 0, 0, 0); sc = __builtin_amdgcn_mfma_f32_16x16x32_f16(KF[jt][1], qs[1], sc, 0, 0, 0); \
        _Pragma("unroll") for (int h = 0; h < 8; ++h) { f32x4 a = {0.f, 0.f, 0.f, 0.f}; \
            a = __builtin_amdgcn_mfma_f32_16x16x32_f16(KF[jt][0], qf[h][0], a, 0, 0, 0); a = __builtin_amdgcn_mfma_f32_16x16x32_f16(KF[jt][1], qf[h][1], a, 0, 0, 0); \
            _Pragma("unroll") for (int i = 0; i < 4; ++i) { sc[i] = __builtin_fmaf(wvv[h], __builtin_fabsf(a[i]), sc[i]); asm("" : "+v"(sc[i])); } } } while (0)
#define IX_MASK(sc, key0) do { if ((key0) + 15 > t0) {        \
            _Pragma("unroll") for (int i = 0; i < 4; ++i) if ((key0) + 4 * c + i > t0 + q) sc[i] = -INFINITY; } } while (0)
#define IX_ASK(sc, ps, pos) do { _Pragma("unroll") for (int i = 0; i < 4; ++i) { ps[i] = sc[i] >= tq; pos[i] = 0u; if (ps[i]) pos[i] = __hip_atomic_fetch_add(cntl + q, 1u, __ATOMIC_RELAXED, __HIP_MEMORY_SCOPE_WORKGROUP); } } while (0)
#define IX_PUT(sc, ps, pos, key0) do { _Pragma("unroll") for (int i = 0; i < 4; ++i) if (ps[i]) { ordq[pos[i]] = ordered_u32(sc[i] + 0.0f); keyq[pos[i]] = (unsigned short)(0xFFFFu - (unsigned)((key0) + 4 * c + i)); } } while (0)
#define IX_STEP(sv, KF) do { const int s_ = (sv); if (s_ < nslab) { \
        IX_WAITK(KF); \
        const int key0a = s_ * IX_SK + (2 * wv) * 16, key0b = key0a + 16; \
        const bool hb = key0b < nkeys;                                 \
        if (key0a < nkeys) { \
            f32x4 sca, scb; bool psa[4], psb[4]; unsigned posa[4], posb[4]; \
            if (hb) { IX_SCORE2(KF, sca, scb); IX_MASK(sca, key0a); IX_MASK(scb, key0b); \
                if (!IX_PROBE_NOFILT) { IX_ASK(sca, psa, posa); IX_ASK(scb, psb, posb); IX_PUT(sca, psa, posa, key0a); IX_PUT(scb, psb, posb, key0b); } } \
            else { IX_SCORE(KF, sca, 0, key0a); IX_MASK(sca, key0a); if (!IX_PROBE_NOFILT) { IX_ASK(sca, psa, posa); IX_PUT(sca, psa, posa, key0a); } } \
        } \
        IX_LOADK(KF, s_ + 2);                                         \
        LDS_WAIT(); \
        __syncthreads(); \
        const unsigned mycnt = cntl[q];                               \
        if (__ballot(mycnt > (unsigned)(IX_CAP - IX_SK)) != 0ull) {       \
            int ca = (int)cntl[2 * wv], cb = (int)cntl[2 * wv + 1]; ca = ca < IX_CAP ? ca : IX_CAP; cb = cb < IX_CAP ? cb : IX_CAP; \
            if (ca > 512) { TA = ix_compact(BA, lane, ca, TA); if (lane == 0) { cntl[2 * wv] = (unsigned)ca; taul[2 * wv] = ix_unordered(TA); } } \
            if (cb > 512) { TB = ix_compact(BB, lane, cb, TB); if (lane == 0) { cntl[2 * wv + 1] = (unsigned)cb; taul[2 * wv + 1] = ix_unordered(TB); } } \
            LDS_WAIT(); \
            __syncthreads(); \
            tq = taul[q]; } \
        } } while (0)
    h8 ka[2][2], kb[2][2];
    asm volatile("s_waitcnt vmcnt(0)" ::: "memory");
    IX_LOADK(ka, 0); IX_LOADK(kb, 1);
    for (int s = 0; s < nslab; s += 2) { IX_STEP(s, ka); IX_STEP(s + 1, kb); }
    asm volatile("s_waitcnt vmcnt(0)" : "+v"(ka[0][0]), "+v"(ka[0][1]), "+v"(ka[1][0]), "+v"(ka[1][1]), "+v"(kb[0][0]), "+v"(kb[0][1]), "+v"(kb[1][0]), "+v"(kb[1][1]) :: "memory");
#undef IX_STEP
#undef IX_SCORE
#undef IX_SCORE2
#undef IX_MM2
#undef IX_MASK
#undef IX_ASK
#undef IX_PUT
#undef IX_LOADK
#undef IX_WAITK
    LDS_WAIT();
    if (IX_PROBE_FINAL) return;
    unsigned short* IDX = (unsigned short*)(C.ws + WS_IDX); int* NV = (int*)(C.ws + WS_NV);
    int ca = (int)cntl[2 * wv], cb = (int)cntl[2 * wv + 1]; ca = ca < IX_CAP ? ca : IX_CAP; cb = cb < IX_CAP ? cb : IX_CAP;
    ix_final(BA, outl, lane, ca, TA, IDX + (m0 + 2 * wv) * 256, NV + m0 + 2 * wv, C.dry);
    ix_final(BB, outl, lane, cb, TB, IDX + (m0 + 2 * wv + 1) * 256, NV + m0 + 2 * wv + 1, C.dry);
}


constexpr int AT_CH = 4096;
constexpr int AT_NR = 4;
constexpr int AT_WAVE = AT_NR * AT_CH + 1024;
constexpr int AT_TAB = 8 * AT_WAVE;
constexpr int AT_QN = AT_TAB + 129 * 8 * 4;
constexpr int AT_END = AT_QN + 512;
static_assert(AT_END + 1024 <= MISC_OFF && (AT_WAVE % 16) == 0 && (AT_QN % 16) == 0, "attention LDS");
constexpr int AT_QPW = 8;
__device__ __forceinline__ int at_f(int row) { return 2 * ((row >> 1) & 3) | ((row >> 3) & 1); }

__device__ __forceinline__ void attn_build_tab(const Ctx& C, LAS unsigned char* lds) {
    LAS float* tab = (LAS float*)(lds + AT_TAB);
    for (int e = threadIdx.x; e < 129 * 8; e += NTHR) { const int d = e >> 3, h = e & 7; int bk;
        if (d < 16) bk = d; else { bk = 16 + (int)(logf((float)d / 16.0f) / 2.0794415416798357f * 16.0f); if (bk > 31) bk = 31; }
        tab[e] = C.relb[bk * 8 + h]; }
    if (threadIdx.x < 128) ((LAS float*)(lds + AT_QN))[threadIdx.x] = C.qn[threadIdx.x];
}
__device__ __forceinline__ void at_issue(const unsigned char* base, const LAS unsigned short* idl, int pos0, LAS unsigned char* buf, int lane) {
#pragma unroll
    for (int k2 = 0; k2 < 4; ++k2) { const int row = (lane >> 3) + 8 * k2, slot = lane & 7; const int idx = idl[pos0 + row];
        __builtin_amdgcn_global_load_lds((const unsigned*)(base + (size_t)idx * 256 + ((slot ^ at_f(row)) << 4)), (LAS unsigned*)(buf + k2 * 1024), 16, 0, 0); }
}
__device__ __forceinline__ unsigned pk4_fp8(float a, float b, float c, float d) { int w = 0; w = __builtin_amdgcn_cvt_pk_fp8_f32(a, b, w, false); w = __builtin_amdgcn_cvt_pk_fp8_f32(c, d, w, true); return (unsigned)w; }
__device__ __forceinline__ long mk64(unsigned lo, unsigned hi) { return (long)(((u64)hi << 32) | (u64)lo); }
#define AT_WAITN(n) asm volatile("s_waitcnt vmcnt(" #n ")" ::: "memory")

__device__ __forceinline__ void attn_item(const Ctx& C, LAS unsigned char* lds, int item) {
    int tid = threadIdx.x; asm volatile("" : "+v"(tid));
    const int lane = tid & 63, wv = __builtin_amdgcn_readfirstlane(tid >> 6);
    const int g = lane & 15, c = lane >> 4, gq = g & 3;
    const int qsel = item / (SEQ / (8 * AT_QPW)), b = qsel >> 1, n = qsel & 1, tbase = (item % (SEQ / (8 * AT_QPW))) * (8 * AT_QPW) + wv;
    LAS unsigned char* ring = lds + wv * AT_WAVE;
    LAS unsigned short* idlb = (LAS unsigned short*)(ring + AT_NR * AT_CH);
    const LAS float* tab = (const LAS float*)(lds + AT_TAB);
    const LAS float* qnl = (const LAS float*)(lds + AT_QN);
    const unsigned char* Kb = (const unsigned char*)(C.ws + WS_K8) + (size_t)b * SEQ * 256 + n * 128; const unsigned char* Vb = (const unsigned char*)(C.ws + WS_V8) + (size_t)b * SEQ * 256 + n * 128;
    const unsigned short* IDXb = (const unsigned short*)(C.ws + WS_IDX) + (size_t)b * SEQ * 256; const int* NVb = (const int*)(C.ws + WS_NV) + (size_t)b * SEQ;
    h16* Qb = (h16*)(C.ws + WS_Q) + (size_t)b * SEQ * DM + n * 512;
    const int fg = at_f(g), q4 = g >> 2, p4 = g & 3, rowA = 4 * c + q4, fr = at_f(rowA);
    u32x2 a_idx; int a_nv; h8 a_q[4];
#define AT_STAGE_A(tq) do { const size_t m_ = (size_t)(tq); a_idx = *(const u32x2*)(IDXb + m_ * 256 + lane * 4); a_nv = NVb[m_]; \
        _Pragma("unroll") for (int ks = 0; ks < 4; ++ks) a_q[ks] = *(const h8*)(Qb + m_ * DM + gq * 128 + 32 * c + 8 * ks); } while (0)
#define AT_STAGE_B(idl_, qf_, nv_) do { nv_ = a_nv; { const int p0 = lane * 4; unsigned s0 = a_idx.x & 0xFFFFu, s1 = a_idx.x >> 16, s2 = a_idx.y & 0xFFFFu, s3 = a_idx.y >> 16; \
          if (p0 + 0 >= nv_) s0 = 0; if (p0 + 1 >= nv_) s1 = 0; if (p0 + 2 >= nv_) s2 = 0; if (p0 + 3 >= nv_) s3 = 0; \
          u32x2 o_; o_.x = s0 | (s1 << 16); o_.y = s2 | (s3 << 16); *(LAS u32x2*)((idl_) + lane * 4) = o_; } \
        float ss_ = 0.f; _Pragma("unroll") for (int ks = 0; ks < 4; ++ks) _Pragma("unroll") for (int e = 0; e < 8; ++e) { const float x_ = (float)a_q[ks][e]; ss_ += x_ * x_; } \
        ss_ += __shfl_xor(ss_, 16); ss_ += __shfl_xor(ss_, 32); \
        const float rs_ = g < 4 ? __builtin_amdgcn_rsqf(ss_ * (1.0f / 128.0f) + EPS) : 0.f; \
        _Pragma("unroll") for (int ks = 0; ks < 4; ++ks) { const f32x4 g0 = *(const LAS f32x4*)(qnl + 32 * c + 8 * ks), g1 = *(const LAS f32x4*)(qnl + 32 * c + 8 * ks + 4); \
            qf_[ks] = mk64(pk4_fp8((float)a_q[ks][0] * rs_ * g0[0], (float)a_q[ks][1] * rs_ * g0[1], (float)a_q[ks][2] * rs_ * g0[2], (float)a_q[ks][3] * rs_ * g0[3]), \
                           pk4_fp8((float)a_q[ks][4] * rs_ * g1[0], (float)a_q[ks][5] * rs_ * g1[1], (float)a_q[ks][6] * rs_ * g1[2], (float)a_q[ks][7] * rs_ * g1[3])); } \
        LDS_WAIT(); } while (0)
    long qf[4]; int nv;
    AT_STAGE_A(tbase);
    AT_STAGE_B(idlb, qf, nv);
    AT_WAITN(0);
#pragma unroll
    for (int i = 0; i < AT_NR; ++i) at_issue(Kb, idlb, 32 * i, ring + i * AT_CH, lane);
#pragma unroll 1
    for (int k = 0; k < AT_QPW; ++k) {
        const int t = tbase + 8 * k, tn = k + 1 < AT_QPW ? t + 8 : t;
        const LAS unsigned short* idl = idlb + (k & 1) * 256; LAS unsigned short* idln = idlb + ((k + 1) & 1) * 256;
        float S[16][4];
#pragma unroll
        for (int kc = 0; kc < 8; ++kc) {
            LAS unsigned char* buf = ring + (kc & 3) * AT_CH;
            if (kc <= 4) AT_WAITN(12); else AT_WAITN(18);
#pragma unroll
            for (int j = 0; j < 2; ++j) { f32x4 a = {0.f, 0.f, 0.f, 0.f};
                const u32x4 A0 = *(const LAS u32x4*)(buf + (16 * j + g) * 128 + (((2 * c) ^ fg) << 4)), A1 = *(const LAS u32x4*)(buf + (16 * j + g) * 128 + (((2 * c + 1) ^ fg) << 4));
                a = __builtin_amdgcn_mfma_f32_16x16x32_fp8_fp8(mk64(A0.x, A0.y), qf[0], a, 0, 0, 0); a = __builtin_amdgcn_mfma_f32_16x16x32_fp8_fp8(mk64(A0.z, A0.w), qf[1], a, 0, 0, 0);
                a = __builtin_amdgcn_mfma_f32_16x16x32_fp8_fp8(mk64(A1.x, A1.y), qf[2], a, 0, 0, 0); a = __builtin_amdgcn_mfma_f32_16x16x32_fp8_fp8(mk64(A1.z, A1.w), qf[3], a, 0, 0, 0);
#pragma unroll
                for (int i = 0; i < 4; ++i) S[2 * kc + j][i] = a[i]; }
            LDS_WAIT();
            if (kc < 4) at_issue(Kb, idl, 32 * (kc + 4), buf, lane); else at_issue(Vb, idl, 32 * (kc - 4), buf, lane);
            if (kc == 4) AT_STAGE_A(tn);
        }
        const int rq = g >> 2;
        float V[4][4];
#pragma unroll
        for (int kk = 0; kk < 4; ++kk)
#pragma unroll
            for (int i = 0; i < 4; ++i) { int v = __builtin_bit_cast(int, S[kk][i]);
                v = __builtin_amdgcn_update_dpp(v, __builtin_bit_cast(int, S[4 + kk][i]), 0x114, 0xf, 0x2, false);
                v = __builtin_amdgcn_update_dpp(v, __builtin_bit_cast(int, S[8 + kk][i]), 0x118, 0xf, 0x4, false);
                v = __builtin_amdgcn_update_dpp(v, __builtin_bit_cast(int, S[12 + kk][i]), 0x11c, 0xf, 0x8, false);
                V[kk][i] = __builtin_bit_cast(float, v); }
        float mx = -INFINITY; const int nvc = nv - 4 * c - 64 * rq;
#pragma unroll
        for (int kk = 0; kk < 4; ++kk) { const u32x2 iw = *(const LAS u32x2*)(idl + 64 * rq + 16 * kk + 4 * c);
            const int ki[4] = {(int)(iw.x & 0xFFFFu), (int)(iw.x >> 16), (int)(iw.y & 0xFFFFu), (int)(iw.y >> 16)};
#pragma unroll
            for (int i = 0; i < 4; ++i) { int dist = t - ki[i]; dist = dist < 0 ? 0 : (dist > 128 ? 128 : dist);
                const float sv = V[kk][i] * 0.08838834764831845f + tab[dist * 8 + 4 * n + gq];
                const float s = (16 * kk + i) < nvc ? sv : -INFINITY; V[kk][i] = s; mx = fmaxf(mx, s); } }
        mx = fmaxf(mx, __builtin_bit_cast(float, __builtin_amdgcn_update_dpp(0, __builtin_bit_cast(int, mx), 0x124, 0xf, 0xf, false)));
        mx = fmaxf(mx, __builtin_bit_cast(float, __builtin_amdgcn_update_dpp(0, __builtin_bit_cast(int, mx), 0x128, 0xf, 0xf, false)));
        mx = fmaxf(mx, __shfl_xor(mx, 16)); mx = fmaxf(mx, __shfl_xor(mx, 32));
        float sum = 0.f; unsigned Pq[4];
#pragma unroll
        for (int kk = 0; kk < 4; ++kk) { float p[4];
#pragma unroll
            for (int i = 0; i < 4; ++i) { p[i] = __builtin_amdgcn_exp2f((V[kk][i] - mx) * 1.4426950408889634f); sum += p[i]; }
            Pq[kk] = pk4_fp8(p[0] * 256.0f, p[1] * 256.0f, p[2] * 256.0f, p[3] * 256.0f); }
        sum += __builtin_bit_cast(float, __builtin_amdgcn_update_dpp(0, __builtin_bit_cast(int, sum), 0x124, 0xf, 0xf, false));
        sum += __builtin_bit_cast(float, __builtin_amdgcn_update_dpp(0, __builtin_bit_cast(int, sum), 0x128, 0xf, 0xf, false));
        sum += __shfl_xor(sum, 16); sum += __shfl_xor(sum, 32);
        unsigned P8[16];
#pragma unroll
        for (int kk = 0; kk < 4; ++kk) { P8[kk] = Pq[kk];
            P8[4 + kk] = (unsigned)__builtin_amdgcn_update_dpp(0, (int)Pq[kk], 0x104, 0xf, 0xf, true);
            P8[8 + kk] = (unsigned)__builtin_amdgcn_update_dpp(0, (int)Pq[kk], 0x108, 0xf, 0xf, true);
            P8[12 + kk] = (unsigned)__builtin_amdgcn_update_dpp(0, (int)Pq[kk], 0x10c, 0xf, 0xf, true); }
        long qfn[4]; int nvn;
        AT_STAGE_B(idln, qfn, nvn);
        f32x4 oe[4], oo[4];
#pragma unroll
        for (int dt = 0; dt < 4; ++dt) { oe[dt] = (f32x4){0.f, 0.f, 0.f, 0.f}; oo[dt] = (f32x4){0.f, 0.f, 0.f, 0.f}; }
#pragma unroll
        for (int vc = 0; vc < 8; ++vc) {
            LAS unsigned char* buf = ring + (vc & 3) * AT_CH;
            if (vc == 0) AT_WAITN(18); else AT_WAITN(12);
            const long pf = mk64(P8[2 * vc], P8[2 * vc + 1]);
            u32x2 t0[4], t1[4];
            const unsigned ba = (unsigned)(size_t)buf;
#pragma unroll
            for (int dt = 0; dt < 4; ++dt) { const unsigned ad = ba + (unsigned)(rowA * 128 + (((2 * dt + (p4 >> 1)) ^ fr) << 4) + 8 * (p4 & 1));
                asm volatile("ds_read_b64_tr_b16 %0, %1" : "=&v"(t0[dt]) : "v"(ad) : "memory");
                asm volatile("ds_read_b64_tr_b16 %0, %1 offset:2048" : "=&v"(t1[dt]) : "v"(ad) : "memory"); }
            asm volatile("s_waitcnt lgkmcnt(0)" : "+v"(t0[0]), "+v"(t0[1]), "+v"(t0[2]), "+v"(t0[3]), "+v"(t1[0]), "+v"(t1[1]), "+v"(t1[2]), "+v"(t1[3]) :: "memory");
#pragma unroll
            for (int dt = 0; dt < 4; ++dt) {
                const long be = mk64(__builtin_amdgcn_perm(t0[dt].y, t0[dt].x, 0x06040200u), __builtin_amdgcn_perm(t1[dt].y, t1[dt].x, 0x06040200u));
                const long bo = mk64(__builtin_amdgcn_perm(t0[dt].y, t0[dt].x, 0x07050301u), __builtin_amdgcn_perm(t1[dt].y, t1[dt].x, 0x07050301u));
                oe[dt] = __builtin_amdgcn_mfma_f32_16x16x32_fp8_fp8(pf, be, oe[dt], 0, 0, 0); oo[dt] = __builtin_amdgcn_mfma_f32_16x16x32_fp8_fp8(pf, bo, oo[dt], 0, 0, 0); }
            if (vc < 4) at_issue(Vb, idl, 32 * (vc + 4), buf, lane); else at_issue(Kb, idln, 32 * (vc - 4), buf, lane);
        }
        float inv[4];
#pragma unroll
        for (int i = 0; i < 4; ++i) inv[i] = 1.0f / (256.0f * __shfl(sum, i));
        h16* Qo = Qb + (size_t)t * DM;
        LAS unsigned char* st = (LAS unsigned char*)(idlb + (k & 1) * 256);
#pragma unroll
        for (int hp = 0; hp < 2; ++hp) {
            if (c == 0) {
#pragma unroll
                for (int dt = 0; dt < 4; ++dt)
#pragma unroll
                    for (int i2 = 0; i2 < 2; ++i2) *(LAS unsigned*)(st + (i2 * 128 + 32 * dt + 2 * g) * 2) = pkh(oe[dt][2 * hp + i2] * inv[2 * hp + i2], oo[dt][2 * hp + i2] * inv[2 * hp + i2]);
            }
            LDS_WAIT();
            if (lane < 32) { const u32x4 ow = *(const LAS u32x4*)(st + lane * 16); if (!C.dry) *(u32x4*)(Qo + hp * 256 + lane * 8) = ow; }
            LDS_WAIT();
        }
#pragma unroll
        for (int ks = 0; ks < 4; ++ks) qf[ks] = qfn[ks];
        nv = nvn;
    }
    AT_WAITN(0);
#undef AT_STAGE_A
#undef AT_STAGE_B
}

__device__ __forceinline__ void act_phase(const Ctx& C, int gtid, int gthreads) {
    const h16* G = (const h16*)(C.ws + WS_UPG); h16* V = (h16*)(C.ws + WS_UPV);
    constexpr int NCG = DFF / 8, NITEM = (MTOK / 16) * NCG;
    for (int it = gtid; it < NITEM; it += gthreads) {
        const int cg = it % NCG, rb = it / NCG, c0 = cg * 8, r0 = rb * 16;
        float w[3][8], bb[8];
#pragma unroll
        for (int j = 0; j < 3; ++j) { const f32x4 a = *(const f32x4*)(C.fcw + j * DFF + c0), b2 = *(const f32x4*)(C.fcw + j * DFF + c0 + 4); for (int e = 0; e < 4; ++e) { w[j][e] = a[e]; w[j][4 + e] = b2[e]; } }
        { const f32x4 a = *(const f32x4*)(C.fcb + c0), b2 = *(const f32x4*)(C.fcb + c0 + 4); for (int e = 0; e < 4; ++e) { bb[e] = a[e]; bb[4 + e] = b2[e]; } }
        h8 gm2, gm1;
        const int tseq = r0 & (SEQ - 1);
        if (tseq >= 2) { gm2 = *(const h8*)(G + (size_t)(r0 - 2) * DFF + c0); gm1 = *(const h8*)(G + (size_t)(r0 - 1) * DFF + c0); }
        else { for (int e = 0; e < 8; ++e) { gm2[e] = (h16)0.f; gm1[e] = (h16)0.f; } }
#pragma unroll 4
        for (int r = 0; r < 16; ++r) { const size_t off = (size_t)(r0 + r) * DFF + c0;
            const h8 g0 = *(const h8*)(G + off), vv = *(const h8*)(V + off);
            float y[8];
#pragma unroll
            for (int e = 0; e < 8; ++e) { const float gf = bb[e] + w[0][e] * (float)gm2[e] + w[1][e] * (float)gm1[e] + w[2][e] * (float)g0[e]; y[e] = gelu_tanh(gf) * (float)vv[e]; }
            u32x4 o; o.x = pkh(y[0], y[1]); o.y = pkh(y[2], y[3]); o.z = pkh(y[4], y[5]); o.w = pkh(y[6], y[7]);
            if (!C.dry) *(u32x4*)(V + off) = o; gm2 = gm1; gm1 = g0; }
    }
}

__device__ __forceinline__ void p0_prologue(const Params& P, LAS unsigned char* lds) {
    const int tid = threadIdx.x, lane = tid & 63, wv = tid >> 6;
    LAS float* scr = (LAS float*)(lds + wv * 16384);
    const int gw = blockIdx.x * NWAVES + wv, NGW = gridDim.x * NWAVES;
    unsigned char* ws = P.ws;
    const float* w_in = P.in[3];
    constexpr int I_IN = 16 * 195;
    for (int it = gw; it < I_IN + 16 * 8; it += NGW) {
        if (it < I_IN) { p0_transpose_item<1>(w_in, DM, NIN, (h16*)(ws + W_IN), nullptr, scr, it, lane); continue; }
        const int r = it - I_IN, blk = r / 16, rr = r % 16, which = rr / 8, it2 = rr % 8;
        p0_transpose_item<0>((which ? P.in[8] : P.in[6]) + (size_t)blk * 128 * 128, 128, 128, (h16*)(ws + W_GATE) + (size_t)blk * 256 * 128 + (size_t)which * 128 * 128, nullptr, scr, it2, lane); }
    { u32x4* z = (u32x4*)((h16*)(ws + W_IN) + (size_t)4168 * DM); const int nz = 184 * DM * 2 / 16;
      for (int i = blockIdx.x * NTHR + tid; i < nz; i += gridDim.x * NTHR) z[i] = (u32x4){0u, 0u, 0u, 0u}; }
    { const float* x = P.in[0]; const float* gn = P.in[2]; h16* A0 = (h16*)(ws + WS_A0);
      f32x4 gv[4];
#pragma unroll
      for (int j = 0; j < 4; ++j) gv[j] = *(const f32x4*)(gn + 4 * lane + 256 * j);
      for (int m = gw; m < MTOK; m += NGW) { const f32x4* xr = (const f32x4*)(x + (size_t)m * DM) + lane; f32x4 v[4]; float s = 0.f;
#pragma unroll
          for (int j = 0; j < 4; ++j) { v[j] = xr[64 * j]; s += (v[j].x * v[j].x + v[j].y * v[j].y) + (v[j].z * v[j].z + v[j].w * v[j].w); }
          const float rs = __builtin_amdgcn_rsqf(wave_sum(s) * (1.0f / DM) + EPS);
          u32x2* o8 = (u32x2*)(A0 + (size_t)m * DM) + lane;
#pragma unroll
          for (int j = 0; j < 4; ++j) { u32x2 w; w.x = pkh(v[j].x * rs * gv[j].x, v[j].y * rs * gv[j].y); w.y = pkh(v[j].z * rs * gv[j].z, v[j].w * rs * gv[j].w); o8[64 * j] = w; } } }
}
constexpr int PD_SQ = 16 * 32, PD_UP = 16 * 192, PD_DN = 48 * 32, PD_PP = 4 * 32, PD_NTR = 4 * PD_SQ + PD_UP + PD_DN + PD_PP, PD_NT = PD_NTR / 32, PD_NP = MTOK * PLE / 4 / 8192;
static_assert(PD_NTR % 32 == 0, "deferred transposes");
__device__ __forceinline__ void p0_deferred_item(const Params& P, LAS unsigned char* lds, int item) {
    int tid = threadIdx.x; asm volatile("" : "+v"(tid));
    const int lane = tid & 63, wv = tid >> 6;
    unsigned char* ws = P.ws;
    if (item >= PD_NT) { const f32x4* p4 = (const f32x4*)P.in[1] + (size_t)(item - PD_NT) * 8192; u32x2* o = (u32x2*)(ws + WS_PH) + (size_t)(item - PD_NT) * 8192;
#pragma unroll 4
        for (int i = tid; i < 8192; i += NTHR) { const f32x4 v = p4[i]; u32x2 w; w.x = pkh(v.x, v.y); w.y = pkh(v.z, v.w); o[i] = w; }
        return; }
    LAS float* scr = (LAS float*)(lds + wv * 16384);
    const float *w_lru = P.in[14], *w_att = P.in[15], *w_out = P.in[16], *w_up = P.in[18], *w_down = P.in[21], *w_pg = P.in[23], *w_pp = P.in[24];
    for (int k = 0; k < 4; ++k) {
        int r = item * 32 + wv * 4 + k;
        if (r < PD_SQ) { p0_transpose_item<0>(w_lru, DM, DM, (h16*)(ws + W_LRU), nullptr, scr, r, lane); continue; } r -= PD_SQ;
        if (r < PD_SQ) { p0_transpose_item<0>(w_att, DM, DM, (h16*)(ws + W_ATT), nullptr, scr, r, lane); continue; } r -= PD_SQ;
        if (r < PD_SQ) { p0_transpose_item<0>(w_out, DM, DM, (h16*)(ws + W_OUT), nullptr, scr, r, lane); continue; } r -= PD_SQ;
        if (r < PD_SQ) { p0_transpose_item<0>(w_pg, DM, DM, (h16*)(ws + W_PG), P.in[22], scr, r, lane); continue; } r -= PD_SQ;
        if (r < PD_UP) { p0_transpose_item<2>(w_up, DM, 2 * DFF, (h16*)(ws + W_UP), P.in[17], scr, r, lane); continue; } r -= PD_UP;
        if (r < PD_DN) { p0_transpose_item<0>(w_down, DFF, DM, (h16*)(ws + W_DOWN), nullptr, scr, r, lane); continue; } r -= PD_DN;
        p0_transpose_item<0>(w_pp, PLE, DM, (h16*)(ws + W_PP), nullptr, scr, r, lane);
    }
}

__device__ __forceinline__ int next_unit(unsigned* head, volatile LAS unsigned* slot) {
    __syncthreads();
    if (threadIdx.x == 0) *slot = __hip_atomic_fetch_add(head, 1u, __ATOMIC_RELAXED, __HIP_MEMORY_SCOPE_AGENT);
    __syncthreads();
    return (int)*slot;
}

constexpr int NPHASE = 10;
__global__ void __launch_bounds__(NTHR, 2) fwd(Params P) {
    extern __shared__ __attribute__((aligned(16))) unsigned char lds_raw[];
    LAS unsigned char* lds = (LAS unsigned char*)lds_raw;
    volatile LAS unsigned* MISC = (volatile LAS unsigned*)(lds + MISC_OFF);
    const int tid = threadIdx.x;
    if (tid < 64) MISC[tid] = 0u;
    __syncthreads();
    unsigned char* ws = P.ws;
    unsigned* ctl = (unsigned*)(ws + WS_CTL);
    const int lo = P.ph_lo, hi = P.ph_hi;
    XcdBarrier bar; bar.bar = ctl + CW_BAR; bar.x = 0; bar.st = MISC;
    if (hi - lo > 1) bar = xcd_barrier_post(ctl + CW_BAR, MISC);
    const int dry = P.pad;
    Ctx C; C.ws = ws; C.out = P.out; C.dry = dry; C.conv_w = P.in[4]; C.conv_b = P.in[5]; C.ba = P.in[7]; C.bx = P.in[9]; C.lam = P.in[10]; C.qn = P.in[11]; C.kn = P.in[12]; C.relb = P.in[13]; C.fcw = P.in[19]; C.fcb = P.in[20];
    float* SSQ1 = (float*)(ws + CTL_SSQ1); float* SSQ2 = (float*)(ws + CTL_SSQ2);
#ifdef ONLY_PHASE
#define IN(k) ((k) == ONLY_PHASE)
#else
#define IN(k) (lo <= (k) && (k) < hi)
#endif
#define SEAM(k) do { if (IN(k) && IN((k) + 1)) xcd_barrier(bar); } while (0)

    if (IN(0)) { p0_prologue(P, lds); } SEAM(0);

    if (IN(1)) {
        pg8::Gemm g{(const h16*)(ws + WS_A0), (const h16*)(ws + W_IN), MTOK, NIN_PAD, DM}; pg8::StaticOrder S; S.init(MTOK, NIN_PAD, gridDim.x, blockIdx.x);
        EpiIn E{(h16*)(ws + WS_LX), (h16*)(ws + WS_GG), (h16*)(ws + WS_Q), (h16*)(ws + WS_K), (h16*)(ws + WS_V), (h16*)(ws + WS_QI), (h16*)(ws + WS_KI), (h16*)(ws + WS_SGA), (h16*)(ws + WS_SGB), (float*)(ws + WS_WI), dry};
        pg8::gemm_phase<EpiIn>(lds, g, S, E);
    } SEAM(1);

    if (IN(2)) {
        constexpr int N_IX = NB * (SEQ / 16), N_L1 = NB * 64 * 8 / 4, N_KN = MTOK / 128 / 4, N_PD = PD_NT + PD_NP, N_SM = N_KN + N_PD, N_BIG = N_L1 + N_IX, N_ALL = N_BIG + N_SM;
        static_assert(N_BIG >= 4 * N_SM, "interleave");
        unsigned* head = ctl + CW_Q2 + 128 * dry;
        int u = next_unit(head, MISC + 4);
        for (int it = 0; u < N_ALL; ++it) {
            unsigned nxt = 0u;
            if (tid == 0) nxt = __hip_atomic_fetch_add(head, 1u, __ATOMIC_RELAXED, __HIP_MEMORY_SCOPE_AGENT);
            int kind, idx;
            { int big = -1, sm = -1;
              if (u < 5 * N_SM) { if (u % 5 == 4) sm = u / 5; else big = 4 * (u / 5) + u % 5; } else big = u - N_SM;
              if (big >= 0) { if (big < N_L1) { kind = 1; idx = big; } else { kind = 0; idx = big - N_L1; } }
              else { if (sm < N_KN) { kind = 2; idx = sm; } else { kind = 3; idx = sm - N_KN; } } }
#ifdef PROBE_P2_KIND
            if (!(dry && kind != PROBE_P2_KIND))
#endif
            {
            if (kind == 0) indexer_unit(C, lds, idx);
            else if (kind == 1) lru1_item(C, lds, idx);
            else if (kind == 2) { for (int k = 0; k < 4; ++k) knorm_unit(C, idx * 4 + k); }
            else p0_deferred_item(P, lds, idx);
            }
            if (tid == 0) MISC[6 + (it & 1)] = nxt;
            __syncthreads();
            u = (int)MISC[6 + (it & 1)];
        }
    } SEAM(2);

    if (IN(3)) {
        constexpr int N_AQ = SEQ / (8 * AT_QPW), N_L2 = NB * 64 * 8 / 4;
        attn_build_tab(C, lds);
        unsigned* qh = ctl + CW_Q3 + 2048 * dry;
        if (tid == 0) MISC[5] = 0u;
        for (;;) {
            __syncthreads();
            if (tid == 0) { const unsigned x = xb_xcc_id() & 7u; unsigned k = MISC[5]; int u = -1;
                for (; k < 8u; ++k) { const unsigned q = (x + k) & 7u; const unsigned v = __hip_atomic_fetch_add(qh + 64 * q, 1u, __ATOMIC_RELAXED, __HIP_MEMORY_SCOPE_AGENT); if (v < (unsigned)N_AQ) { u = (int)(q * N_AQ + v); break; } }
                MISC[5] = k;
                if (u < 0) { const unsigned v = __hip_atomic_fetch_add(qh + 64 * 8, 1u, __ATOMIC_RELAXED, __HIP_MEMORY_SCOPE_AGENT); u = v < (unsigned)N_L2 ? (int)(8 * N_AQ + v) : -1; }
                MISC[4] = (unsigned)u; }
            __syncthreads();
            const int u = (int)MISC[4];
            if (u < 0) break;
            if (u < 8 * N_AQ) attn_item(C, lds, u);
            else lru2_item(C, lds + AT_END, u - 8 * N_AQ);
        }
    } SEAM(3);

    if (IN(4)) {
        pg8::StaticOrder S; S.init(MTOK, DM, gridDim.x, blockIdx.x);
        { pg8::Gemm g{(const h16*)(ws + WS_LX), (const h16*)(ws + W_LRU), MTOK, DM, DM}; EpiMerge<0> E{(const h16*)(ws + WS_SGA), (h16*)(ws + WS_T1), nullptr, dry}; pg8::gemm_phase<EpiMerge<0>>(lds, g, S, E); }
        { pg8::Gemm g{(const h16*)(ws + WS_Q), (const h16*)(ws + W_ATT), MTOK, DM, DM}; EpiMerge<1> E{(const h16*)(ws + WS_SGB), (h16*)(ws + WS_T1), (h16*)(ws + WS_GG), dry}; pg8::gemm_phase<EpiMerge<1>>(lds, g, S, E); }
    } SEAM(4);

    if (IN(5)) {
        pg8::Gemm g{(const h16*)(ws + WS_GG), (const h16*)(ws + W_OUT), MTOK, DM, DM}; pg8::StaticOrder S; S.init(MTOK, DM, gridDim.x, blockIdx.x);
        EpiResid<true> E{P.in[0], nullptr, (h16*)(ws + WS_X1H), SSQ1, dry}; pg8::gemm_phase<EpiResid<true>>(lds, g, S, E);
    } SEAM(5);

    if (IN(6)) {
        pg8::Gemm g{(const h16*)(ws + WS_X1H), (const h16*)(ws + W_UP), MTOK, 2 * DFF, DM}; pg8::StaticOrder S; S.init(MTOK, 2 * DFF, gridDim.x, blockIdx.x);
        EpiUpAct E{SSQ1, (h16*)(ws + WS_UPV), (float*)(ws + WS_UPG), (float*)(ws + WS_UPG + 4 * MiB), (float*)(ws + WS_UPG + 8 * MiB), C.fcw, C.fcb, lds + pg8::STAGE_BYTES, dry}; pg8::gemm_phase<EpiUpAct>(lds, g, S, E);
    } SEAM(6);


    if (IN(8)) {
        pg8::Gemm g{(const h16*)(ws + WS_UPV), (const h16*)(ws + W_DOWN), MTOK, DM, DFF}; pg8::StaticOrder S; S.init(MTOK, DM, gridDim.x, blockIdx.x);
        {
#pragma unroll
          for (int i = 0; i < 2; ++i) { pg8::Unit uu; if (S.next(i, uu)) act_fix_tile((const float*)(ws + WS_UPG), (const float*)(ws + WS_UPG + 4 * MiB), (const float*)(ws + WS_UPG + 8 * MiB), C.fcw, C.fcb, (h16*)(ws + WS_UPV), uu.pm, tid, dry); }
          static_assert((MTOK / 256) * (DM / 256) == 2 * 256, "two units per workgroup on a 256-workgroup grid");
          VM_WAIT(); __syncthreads(); }
        EpiResid<false> E{nullptr, (const h16*)(ws + WS_X1H), (h16*)(ws + WS_X2H), SSQ2, dry}; pg8::gemm_phase<EpiResid<false>>(lds, g, S, E);
    } SEAM(8);

    if (IN(9)) {
        pg8::StaticOrder S; S.init(MTOK, DM, gridDim.x, blockIdx.x);
        { pg8::Gemm g{(const h16*)(ws + WS_X2H), (const h16*)(ws + W_PG), MTOK, DM, DM}; EpiGateSig E{SSQ2, (h16*)(ws + WS_GS), dry}; pg8::gemm_phase<EpiGateSig>(lds, g, S, E); }
        { pg8::Gemm g{(const h16*)(ws + WS_PH), (const h16*)(ws + W_PP), MTOK, DM, P.k_ple}; EpiPleOut E{(const h16*)(ws + WS_GS), (const h16*)(ws + WS_X2H), P.out, dry}; pg8::gemm_phase<EpiPleOut>(lds, g, S, E); }
    }
#undef IN
#undef SEAM
}

#ifndef N_LAUNCHES
#define N_LAUNCHES 1
#endif
extern "C" void kernel_launch(void* const* d_in, const int* in_sizes, int n_in, void* d_out, int out_size, void* d_ws, size_t ws_size, hipStream_t stream) {
    static int grid = 0;
    if (grid == 0) {
        if (n_in != 25 || out_size != MTOK * DM || ws_size < WS_END) { fprintf(stderr, "kernel_launch: unexpected shapes (n_in %d out %d ws %zu)\n", n_in, out_size, ws_size); grid = -1; return; }
        int dev = 0, cus = 0, per_cu = 0;
        hipGetDevice(&dev); hipDeviceGetAttribute(&cus, hipDeviceAttributeMultiprocessorCount, dev);
        if (hipFuncSetAttribute((const void*)fwd, hipFuncAttributeMaxDynamicSharedMemorySize, LDS_BYTES) != hipSuccess) { fprintf(stderr, "kernel_launch: hipFuncSetAttribute failed\n"); grid = -1; return; }
        if (hipOccupancyMaxActiveBlocksPerMultiprocessor(&per_cu, (const void*)fwd, NTHR, LDS_BYTES) != hipSuccess || per_cu < 1) { fprintf(stderr, "kernel_launch: occupancy query says %d\n", per_cu); }
        (void)hipGetLastError();
        grid = cus > 0 ? cus : 256;
    }
    if (grid < 0) return;
    hipMemsetAsync((char*)d_ws + WS_CTL, 0, CTL_ZERO_BYTES, stream);
    Params p{};
    for (int i = 0; i < 25; ++i) p.in[i] = (const float*)d_in[i];
    p.out = (float*)d_out; p.ws = (unsigned char*)d_ws; p.k_ple = PLE; p.pad = 0;
    if (N_LAUNCHES == 1) { p.ph_lo = 0; p.ph_hi = NPHASE; hipLaunchKernelGGL(fwd, dim3(grid), dim3(NTHR), LDS_BYTES, stream, p); }
    else for (int ph = 0; ph < NPHASE; ++ph) { p.ph_lo = ph; p.ph_hi = ph + 1;
#ifdef PROBE_MASK
        if ((PROBE_MASK >> ph) & 1) { p.pad = 1; hipLaunchKernelGGL(fwd, dim3(grid), dim3(NTHR), LDS_BYTES, stream, p); p.pad = 0; }
#endif
        hipLaunchKernelGGL(fwd, dim3(grid), dim3(NTHR), LDS_BYTES, stream, p); }
}
```

```cpp
#include <hip/hip_runtime.h>
#include <cstdio>
#include <cstdint>

#define GAS __attribute__((address_space(1)))
#define LAS __attribute__((address_space(3)))
typedef _Float16 h16;
typedef _Float16 h8 __attribute__((ext_vector_type(8)));
typedef _Float16 h4 __attribute__((ext_vector_type(4)));
typedef _Float16 h2 __attribute__((ext_vector_type(2)));
typedef __fp16 fh4 __attribute__((__vector_size__(4 * sizeof(__fp16))));
typedef float f32x4 __attribute__((ext_vector_type(4)));
typedef float f32x2 __attribute__((ext_vector_type(2)));
typedef unsigned u32x4 __attribute__((ext_vector_type(4)));
typedef unsigned u32x2 __attribute__((ext_vector_type(2)));
typedef unsigned long long u64;

__device__ __forceinline__ unsigned pkh(float a, float b) { h2 r; r.x = (h16)a; r.y = (h16)b; return __builtin_bit_cast(unsigned, r); }
__device__ __forceinline__ float sigmoid_f(float x) { return __builtin_amdgcn_rcpf(1.0f + __builtin_amdgcn_exp2f(-1.4426950408889634f * x)); }
__device__ __forceinline__ float gelu_tanh(float x) { const float u = 1.5957691216057308f * (x + 0.044715f * x * x * x); return x * sigmoid_f(u); }
#define LDS_WAIT() asm volatile("s_waitcnt lgkmcnt(0)" ::: "memory")
#define VM_WAIT() asm volatile("s_waitcnt vmcnt(0)" ::: "memory")

namespace pg8 {
constexpr int BM = 256, BK = 64, HALF = 128, HTB = HALF * BK * 2, STAGE_BYTES = 8 * HTB, NXCD = 8, WGM = 8;
__host__ __device__ __forceinline__ int lds_byte(int r, int c) { const int st = (r >> 4) * 2 + (c >> 5), rr = r & 15, cc = c & 31, ob = rr * 64 + cc * 2; return st * 1024 + (ob ^ (((ob >> 9) & 1) << 5)); }
__host__ __device__ __forceinline__ void stage_rc(int b, int& R, int& C) { const int st = b / 1024, sb = b % 1024, swz = sb ^ (((sb >> 9) & 1) << 5); R = (st >> 1) * 16 + swz / 64; C = (st & 1) * 32 + (swz % 64) / 2; }
__host__ __device__ __forceinline__ int perm32(int rho) { const int n = rho >> 4, i = rho & 15; return 8 * (i >> 2) + 4 * n + (i & 3); }

struct Unit { int pm, pn; };
struct Gemm { const h16* A; const h16* Bt; int M, N, K; };

struct StaticOrder {
    int nM, nN, nwg, G, c;
    __host__ __device__ void init(int M, int N, int G_, int c_) { nM = M / BM; nN = N / BM; nwg = nM * nN; G = G_; c = c_; }
    __host__ __device__ __forceinline__ bool next(int i, Unit& u) const {
        const long L = (long)i * G + c; if (L >= nwg) return false;
        int wgid = (int)L; { const int q = nwg / NXCD, r = nwg % NXCD, xcd = wgid % NXCD, off = wgid / NXCD; wgid = (xcd < r ? xcd * (q + 1) : r * (q + 1) + (xcd - r) * q) + off; }
        const int nig = WGM * nN, gid = wgid / nig, fm = gid * WGM, gsz = (nM - fm) < WGM ? (nM - fm) : WGM;
        u.pm = fm + ((wgid % nig) % gsz); u.pn = (wgid % nig) / gsz; return true;
    }
};

template <class Epi, bool ALIGN_EPI = true, bool SP2 = true>
__device__ __forceinline__ void gemm_phase(LAS unsigned char* lds, const Gemm g, const StaticOrder& S, const Epi& E) {
    const int tid = threadIdx.x, wid = __builtin_amdgcn_readfirstlane(tid >> 6), lane = tid & 63, wr = wid >> 2, wc = wid & 3, fr = lane & 15, fq = lane >> 4;
    const int K = g.K, nt = K / BK;
    unsigned voffA[2], voffB[2];
#pragma unroll
    for (int i = 0; i < 2; ++i) { int R, C; stage_rc(tid * 16 + i * 8192, R, C); const int Rb = Epi::PERM ? ((R & ~31) + perm32(R & 31)) : R;
        voffA[i] = (unsigned)(R * K + C) * 2u; voffB[i] = (unsigned)(Rb * K + C) * 2u; }
    const size_t kstep = (size_t)(BK * 2);
    const size_t hstep = (size_t)HALF * K * 2;
    const size_t tstep = 2 * hstep;
    const unsigned ldsw = (unsigned)wid * 1024u;
    const int aoff = lds_byte(wr * 64 + fr, fq * 8), boff = lds_byte(wc * 32 + fr, fq * 8);
#define PG8_SA(b, h) (((b) * 2 + (h)) * HTB)
#define PG8_SB(b, h) ((4 + (b) * 2 + (h)) * HTB)
#define PG8_STAGE(bufoff, gbase, voff) do { _Pragma("unroll") for (int _i = 0; _i < 2; ++_i) \
        __builtin_amdgcn_global_load_lds((const unsigned*)((const char*)(gbase) + (voff)[_i]), (LAS unsigned*)(lds + (bufoff) + ldsw + _i * 8192), 16, 0, 0); } while (0)
#define PG8_LDA(dst, b, h) do { _Pragma("unroll") for (int m = 0; m < 4; ++m) _Pragma("unroll") for (int k = 0; k < 2; ++k) dst[m][k] = *(const LAS h8*)(lds + PG8_SA(b, h) + aoff + m * 2048 + k * 1024); } while (0)
#define PG8_LDB(dst, b, h) do { _Pragma("unroll") for (int n = 0; n < 2; ++n) _Pragma("unroll") for (int k = 0; k < 2; ++k) dst[n][k] = *(const LAS h8*)(lds + PG8_SB(b, h) + boff + n * 2048 + k * 1024); } while (0)
#define PG8_MMA(ai, bj, At, Bt) do { __builtin_amdgcn_s_setprio(1); _Pragma("unroll") for (int m = 0; m < 4; ++m) _Pragma("unroll") for (int n = 0; n < 2; ++n) _Pragma("unroll") for (int k = 0; k < 2; ++k) \
        acc[ai][bj][m][n] = __builtin_amdgcn_mfma_f32_16x16x32_f16(Bt[n][k], At[m][k], acc[ai][bj][m][n], 0, 0, 0); __builtin_amdgcn_s_setprio(0); } while (0)
#define PG8_WAIT_V(n) asm volatile("s_waitcnt vmcnt(" #n ")" ::: "memory")
#define PG8_WAIT_L(n) asm volatile("s_waitcnt lgkmcnt(" #n ")" ::: "memory")
#define PG8_BAR __builtin_amdgcn_s_barrier()
#define PG8_SCHED __builtin_amdgcn_sched_barrier(0)
    Unit cur, nxt; int ui = 0;
    if (!S.next(0, cur)) return;
    f32x4 acc[2][2][4][2];
#pragma unroll
    for (int a = 0; a < 2; ++a)
#pragma unroll
        for (int b = 0; b < 2; ++b)
#pragma unroll
            for (int m = 0; m < 4; ++m)
#pragma unroll
                for (int n = 0; n < 2; ++n) acc[a][b][m][n] = (f32x4){0.f, 0.f, 0.f, 0.f};
    h8 At[4][2], B0[2][2], B1[2][2];
    const char* cA = (const char*)g.A + (size_t)cur.pm * tstep; const char* cB = (const char*)g.Bt + (size_t)cur.pn * tstep;
    if constexpr (SP2) {
        PG8_STAGE(PG8_SB(0, 0), cB, voffB); PG8_STAGE(PG8_SB(0, 1), cB + hstep, voffB); PG8_STAGE(PG8_SA(0, 0), cA, voffA); PG8_STAGE(PG8_SA(0, 1), cA + hstep, voffA);
        if (wr == 1) PG8_BAR;
        PG8_WAIT_V(2); PG8_BAR;
        PG8_STAGE(PG8_SB(1, 0), cB + kstep, voffB); PG8_STAGE(PG8_SA(1, 0), cA + kstep, voffA); PG8_STAGE(PG8_SB(1, 1), cB + hstep + kstep, voffB);
        PG8_WAIT_V(6); PG8_BAR;
    } else {
        PG8_STAGE(PG8_SB(0, 0), cB, voffB); PG8_STAGE(PG8_SA(0, 0), cA, voffA); PG8_STAGE(PG8_SB(0, 1), cB + hstep, voffB); PG8_STAGE(PG8_SA(0, 1), cA + hstep, voffA);
        if (wr == 1) PG8_BAR;
        PG8_WAIT_V(4); PG8_BAR;
        PG8_STAGE(PG8_SB(1, 0), cB + kstep, voffB); PG8_STAGE(PG8_SA(1, 0), cA + kstep, voffA); PG8_STAGE(PG8_SB(1, 1), cB + hstep + kstep, voffB);
        PG8_WAIT_V(6); PG8_BAR;
    }
    for (;;) {
        const bool has_next = S.next(ui + 1, nxt);
        const char* nA = has_next ? (const char*)g.A + (size_t)nxt.pm * tstep : cA; const char* nB = has_next ? (const char*)g.Bt + (size_t)nxt.pn * tstep : cB;
        for (int t = 0; t < nt; t += 2) {
            const bool last = (t == nt - 2);
            const char* a1 = cA + (size_t)(t + 1) * kstep;
            const char* a2 = last ? nA : cA + (size_t)(t + 2) * kstep; const char* b2 = last ? nB : cB + (size_t)(t + 2) * kstep;
            const char* a3 = a2 + kstep; const char* b3 = b2 + kstep;
            if constexpr (SP2) {
            PG8_LDB(B0, 0, 0); PG8_LDB(B1, 0, 1); PG8_SCHED; PG8_LDA(At, 0, 0); PG8_STAGE(PG8_SA(1, 1), a1 + hstep, voffA);
            PG8_WAIT_V(8); PG8_WAIT_L(0); PG8_BAR; PG8_MMA(0, 0, At, B0); PG8_MMA(0, 1, At, B1); PG8_BAR; PG8_SCHED;
            PG8_LDA(At, 0, 1); PG8_STAGE(PG8_SB(0, 0), b2, voffB); PG8_STAGE(PG8_SB(0, 1), b2 + hstep, voffB); PG8_STAGE(PG8_SA(0, 0), a2, voffA);
            PG8_WAIT_V(8); PG8_WAIT_L(0); PG8_BAR; PG8_MMA(1, 0, At, B0); PG8_MMA(1, 1, At, B1); PG8_BAR; PG8_SCHED;
            PG8_LDB(B0, 1, 0); PG8_LDB(B1, 1, 1); PG8_SCHED; PG8_LDA(At, 1, 0); PG8_STAGE(PG8_SA(0, 1), a2 + hstep, voffA);
            PG8_WAIT_V(8); PG8_WAIT_L(0); PG8_BAR; PG8_MMA(0, 0, At, B0); PG8_MMA(0, 1, At, B1); PG8_BAR; PG8_SCHED;
            PG8_LDA(At, 1, 1); PG8_STAGE(PG8_SB(1, 0), b3, voffB); PG8_STAGE(PG8_SB(1, 1), b3 + hstep, voffB); PG8_STAGE(PG8_SA(1, 0), a3, voffA);
            PG8_WAIT_V(8); PG8_WAIT_L(0); PG8_BAR; PG8_MMA(1, 0, At, B0); PG8_MMA(1, 1, At, B1); PG8_BAR; PG8_SCHED;
            } else {
            PG8_LDB(B0, 0, 0); PG8_SCHED; PG8_LDA(At, 0, 0); PG8_STAGE(PG8_SA(1, 1), a1 + hstep, voffA);
            PG8_WAIT_L(8); PG8_BAR; PG8_WAIT_L(0); PG8_MMA(0, 0, At, B0); PG8_BAR; PG8_SCHED;
            PG8_LDB(B1, 0, 1); PG8_STAGE(PG8_SB(0, 0), b2, voffB);
            PG8_BAR; PG8_WAIT_L(0); PG8_MMA(0, 1, At, B1); PG8_BAR;
            PG8_LDA(At, 0, 1); PG8_STAGE(PG8_SA(0, 0), a2, voffA);
            PG8_BAR; PG8_WAIT_L(0); PG8_MMA(1, 0, At, B0); PG8_BAR; PG8_SCHED;
            PG8_STAGE(PG8_SB(0, 1), b2 + hstep, voffB);
            PG8_WAIT_V(6); PG8_BAR; PG8_MMA(1, 1, At, B1); PG8_BAR;
            PG8_LDB(B0, 1, 0); PG8_SCHED; PG8_LDA(At, 1, 0); PG8_STAGE(PG8_SA(0, 1), a2 + hstep, voffA);
            PG8_WAIT_L(8); PG8_BAR; PG8_WAIT_L(0); PG8_MMA(0, 0, At, B0); PG8_BAR; PG8_SCHED;
            PG8_LDB(B1, 1, 1); PG8_STAGE(PG8_SB(1, 0), b3, voffB);
            PG8_BAR; PG8_WAIT_L(0); PG8_MMA(0, 1, At, B1); PG8_BAR;
            PG8_LDA(At, 1, 1); PG8_STAGE(PG8_SA(1, 0), a3, voffA);
            PG8_BAR; PG8_WAIT_L(0); PG8_MMA(1, 0, At, B0); PG8_BAR; PG8_SCHED;
            PG8_STAGE(PG8_SB(1, 1), b3 + hstep, voffB);
            PG8_WAIT_V(6); PG8_BAR; PG8_MMA(1, 1, At, B1); PG8_BAR;
            }
        }
        if constexpr (ALIGN_EPI) { if (wr == 0) PG8_BAR; }
        E(acc, cur, wr, wc, fr, fq);
        if (!has_next) break;
#pragma unroll
        for (int a = 0; a < 2; ++a)
#pragma unroll
            for (int b = 0; b < 2; ++b)
#pragma unroll
                for (int m = 0; m < 4; ++m)
#pragma unroll
                    for (int n = 0; n < 2; ++n) acc[a][b][m][n] = (f32x4){0.f, 0.f, 0.f, 0.f};
        cur = nxt; cA = nA; cB = nB; ++ui;
        if constexpr (ALIGN_EPI) { if (wr == 1) PG8_BAR; }
    }
    PG8_WAIT_V(0);
    if constexpr (!ALIGN_EPI) { if (wr == 0) PG8_BAR; }
    PG8_BAR;
#undef PG8_SA
#undef PG8_SB
#undef PG8_STAGE
#undef PG8_LDA
#undef PG8_LDB
#undef PG8_MMA
#undef PG8_WAIT_V
#undef PG8_WAIT_L
#undef PG8_BAR
#undef PG8_SCHED
}
}

constexpr int NB = 4, SEQ = 8192, MTOK = NB * SEQ, DM = 1024, DFF = 3072, PLE = 256;
constexpr int NIN = 6216, NIN_PAD = 6400;
constexpr float EPS = 1e-6f;
constexpr int NWAVES = 8, NTHR = 512;

typedef const f32x4 (&AccRef)[2][2][4][2];

template <int ACT> __device__ __forceinline__ float act_f(float v) {
    if (ACT == 1) return gelu_tanh(v);
    if (ACT == 2) return sigmoid_f(v);
    if (ACT == 3) return v * 0.125f;
    return v;
}
template <int ACT> __device__ __forceinline__ void store_tile_h(AccRef acc, h16* base, int ldc, int row0, int col0, int dry) {
    const unsigned bo0 = ((unsigned)row0 * (unsigned)ldc + (unsigned)col0) * 2u;
#pragma unroll
    for (int ai = 0; ai < 2; ++ai)
#pragma unroll
        for (int m = 0; m < 4; ++m) { const unsigned bo = bo0 + (unsigned)((ai * 128 + m * 16) * ldc * 2);
#pragma unroll
            for (int bj = 0; bj < 2; ++bj) { const f32x4 v0 = acc[ai][bj][m][0], v1 = acc[ai][bj][m][1];
                u32x4 w; w.x = pkh(act_f<ACT>(v0[0]), act_f<ACT>(v0[1])); w.y = pkh(act_f<ACT>(v0[2]), act_f<ACT>(v0[3]));
                w.z = pkh(act_f<ACT>(v1[0]), act_f<ACT>(v1[1])); w.w = pkh(act_f<ACT>(v1[2]), act_f<ACT>(v1[3]));
                if (!dry) *(u32x4*)((char*)base + bo + bj * 256) = w; }
            if (ACT == 1 || ACT == 2) __builtin_amdgcn_sched_barrier(0); }
}

__device__ __forceinline__ unsigned frag_off(int pm, int pn, int wid, int lane) { return ((unsigned)((pm * 4 + pn) * 8 + wid) * 1024u + (unsigned)lane) * 16u; }
#define FRAG_SUB(ai, m, bj) ((unsigned)((((ai) * 4 + (m)) * 2 + (bj)) * 1024))
template <int ACT> __device__ __forceinline__ void store_tile_frag(AccRef acc, h16* base, unsigned fo, int dry) {
#pragma unroll
    for (int ai = 0; ai < 2; ++ai)
#pragma unroll
        for (int m = 0; m < 4; ++m) {
#pragma unroll
            for (int bj = 0; bj < 2; ++bj) { const f32x4 v0 = acc[ai][bj][m][0], v1 = acc[ai][bj][m][1];
                u32x4 w; w.x = pkh(act_f<ACT>(v0[0]), act_f<ACT>(v0[1])); w.y = pkh(act_f<ACT>(v0[2]), act_f<ACT>(v0[3]));
                w.z = pkh(act_f<ACT>(v1[0]), act_f<ACT>(v1[1])); w.w = pkh(act_f<ACT>(v1[2]), act_f<ACT>(v1[3]));
                if (!dry) *(u32x4*)((char*)base + fo + FRAG_SUB(ai, m, bj)) = w; }
            if (ACT == 1 || ACT == 2) __builtin_amdgcn_sched_barrier(0); }
}

struct EpiIn {
    static constexpr bool PERM = true;
    h16 *LX, *GG, *Q, *K, *V, *QI, *KI, *SGA, *SGB; float* WI; int dry;
    __device__ __forceinline__ void operator()(AccRef acc, const pg8::Unit& u, int wr, int wc, int fr, int fq) const {
        const int pn = u.pn, row0 = u.pm * 256 + wr * 64 + fr, cw = wc * 32 + 8 * fq;
        if (pn < 4 || (pn >= 8 && pn < 14)) {
            h16* base = pn < 4 ? LX : (pn < 12 ? Q : (pn == 12 ? K : V)); const int ldc = pn < 12 ? DM : 256; const int ct = pn < 4 ? pn * 256 : (pn < 12 ? (pn - 8) * 256 : 0);
            if (pn < 12) store_tile_h<0>(acc, base, DM, row0, ct + cw, dry); else store_tile_h<0>(acc, base, 256, row0, cw, dry);
            (void)ldc;
        }
        else if (pn < 8) store_tile_h<1>(acc, GG, DM, row0, (pn - 4) * 256 + cw, dry);
        else if (pn < 16) {
#pragma unroll
            for (int ai = 0; ai < 2; ++ai)
#pragma unroll
                for (int m = 0; m < 4; ++m) { const unsigned t16 = (unsigned)(u.pm * 16 + wr * 4 + ai * 8 + m);
#pragma unroll
                    for (int bj = 0; bj < 2; ++bj) { const f32x4 v0 = acc[ai][bj][m][0] * 0.125f, v1 = acc[ai][bj][m][1] * 0.125f;
                        const unsigned hh = (unsigned)((pn - 14) * 4 + bj * 2 + (wc >> 1)), slot = ((t16 * 8u + hh) * 2u + (unsigned)(wc & 1)) * 64u + (unsigned)(fq * 16 + fr);
                        u32x4 w; w.x = pkh(v0[0], v0[1]); w.y = pkh(v0[2], v0[3]); w.z = pkh(v1[0], v1[1]); w.w = pkh(v1[2], v1[3]);
                        if (!dry) *(u32x4*)((char*)QI + slot * 16u) = w; } }
        }
        else if (pn == 16) {
            if (wc < 2) {
#pragma unroll
                for (int ai = 0; ai < 2; ++ai)
#pragma unroll
                    for (int m = 0; m < 4; ++m) { const f32x4 v0 = acc[ai][0][m][0], v1 = acc[ai][0][m][1];
                        u32x4 w; w.x = pkh(v0[0], v0[1]); w.y = pkh(v0[2], v0[3]); w.z = pkh(v1[0], v1[1]); w.w = pkh(v1[2], v1[3]);
                        if (!dry) *(u32x4*)((char*)KI + ((unsigned)((u.pm * 16 + wr * 4 + ai * 8 + m) * 2 + wc) * 64u + (unsigned)(fq * 16 + fr)) * 16u) = w; }
            } else if (wc == 2 && fq == 0) {
#pragma unroll
                for (int ai = 0; ai < 2; ++ai)
#pragma unroll
                    for (int m = 0; m < 4; ++m) { float* p = WI + (size_t)(row0 + ai * 128 + m * 16) * 8;
                        if (!dry) { *(f32x4*)p = acc[ai][0][m][0] * 0.35355339059327373f; *(f32x4*)(p + 4) = acc[ai][0][m][1] * 0.35355339059327373f; } }
            }
        }
        else { h16* base = pn < 21 ? SGA : SGB; const int pl = pn < 21 ? pn - 17 : pn - 21; store_tile_frag<2>(acc, base, frag_off(u.pm, pl, wr * 4 + wc, fq * 16 + fr), dry); }
    }
};

template <int SECOND> struct EpiMerge {
    static constexpr bool PERM = true;
    const h16* SG; h16* T1; h16* OUT; int dry;
    __device__ __forceinline__ void operator()(AccRef acc, const pg8::Unit& u, int wr, int wc, int fr, int fq) const {
        const int row0 = u.pm * 256 + wr * 64 + fr, col0 = u.pn * 256 + wc * 32 + 8 * fq;
        const unsigned fo = frag_off(u.pm, u.pn, wr * 4 + wc, fq * 16 + fr);
#pragma unroll
        for (int ai = 0; ai < 2; ++ai) {
            h8 sg[4][2], t1[4][2];
#pragma unroll
            for (int m = 0; m < 4; ++m)
#pragma unroll
                for (int bj = 0; bj < 2; ++bj) { sg[m][bj] = *(const h8*)((const char*)SG + fo + FRAG_SUB(ai, m, bj)); if (SECOND) t1[m][bj] = *(const h8*)((const char*)T1 + fo + FRAG_SUB(ai, m, bj)); }
            __builtin_amdgcn_sched_barrier(0);
#pragma unroll
            for (int m = 0; m < 4; ++m) { const size_t off = (size_t)(row0 + ai * 128 + m * 16) * DM + col0;
#pragma unroll
                for (int bj = 0; bj < 2; ++bj) { const f32x4 v0 = acc[ai][bj][m][0], v1 = acc[ai][bj][m][1];
                    float r[8];
#pragma unroll
                    for (int j = 0; j < 4; ++j) { r[j] = (float)sg[m][bj][j] * v0[j]; r[4 + j] = (float)sg[m][bj][4 + j] * v1[j]; }
                    if (SECOND) {
#pragma unroll
                        for (int j = 0; j < 8; ++j) r[j] += (float)t1[m][bj][j]; }
                    u32x4 w; w.x = pkh(r[0], r[1]); w.y = pkh(r[2], r[3]); w.z = pkh(r[4], r[5]); w.w = pkh(r[6], r[7]);
                    if (!dry) { if (SECOND) *(u32x4*)(OUT + off + bj * 128) = w; else *(u32x4*)((char*)T1 + fo + FRAG_SUB(ai, m, bj)) = w; } } }
            __builtin_amdgcn_sched_barrier(0); }
    }
};

template <bool BASE_F32> struct EpiResid {
    static constexpr bool PERM = true;
    const float* BF; const h16* BH; h16* XOUT; float* SSQ; int dry;
    __device__ __forceinline__ void operator()(AccRef acc, const pg8::Unit& u, int wr, int wc, int fr, int fq) const {
        const int row0 = u.pm * 256 + wr * 64 + fr, col0 = u.pn * 256 + wc * 32 + 8 * fq;
#pragma unroll
        for (int ai = 0; ai < 2; ++ai) {
            f32x4 bf[4][2][2]; h8 bh[4][2];
#pragma unroll
            for (int m = 0; m < 4; ++m) { const size_t off = (size_t)(row0 + ai * 128 + m * 16) * DM + col0;
#pragma unroll
                for (int bj = 0; bj < 2; ++bj) { if (BASE_F32) { bf[m][bj][0] = *(const f32x4*)(BF + off + bj * 128); bf[m][bj][1] = *(const f32x4*)(BF + off + bj * 128 + 4); } else bh[m][bj] = *(const h8*)(BH + off + bj * 128); } }
            __builtin_amdgcn_sched_barrier(0);
#pragma unroll
            for (int m = 0; m < 4; ++m) { const int row = row0 + ai * 128 + m * 16; const size_t off = (size_t)row * DM + col0; float ss = 0.f;
#pragma unroll
                for (int bj = 0; bj < 2; ++bj) { const f32x4 v0 = acc[ai][bj][m][0], v1 = acc[ai][bj][m][1];
                    float r[8];
                    if (BASE_F32) {
#pragma unroll
                        for (int j = 0; j < 4; ++j) { r[j] = bf[m][bj][0][j] + v0[j]; r[4 + j] = bf[m][bj][1][j] + v1[j]; } }
                    else {
#pragma unroll
                        for (int j = 0; j < 4; ++j) { r[j] = (float)bh[m][bj][j] + v0[j]; r[4 + j] = (float)bh[m][bj][4 + j] + v1[j]; } }
#pragma unroll
                    for (int j = 0; j < 8; ++j) ss += r[j] * r[j];
                    u32x4 w; w.x = pkh(r[0], r[1]); w.y = pkh(r[2], r[3]); w.z = pkh(r[4], r[5]); w.w = pkh(r[6], r[7]);
                    if (!dry) *(u32x4*)(XOUT + off + bj * 128) = w; }
                ss += __shfl_xor(ss, 16); ss += __shfl_xor(ss, 32);
                if (fq == 0 && !dry) unsafeAtomicAdd(SSQ + row, ss); }
            __builtin_amdgcn_sched_barrier(0); }
    }
};

struct EpiUp {
    static constexpr bool PERM = true;
    const float* SSQ; h16* UPG; h16* UPV; int dry;
    __device__ __forceinline__ void operator()(AccRef acc, const pg8::Unit& u, int wr, int wc, int fr, int fq) const {
        const int row0 = u.pm * 256 + wr * 64 + fr, col0 = u.pn * 128 + wc * 32 + 8 * fq;
#pragma unroll
        for (int ai = 0; ai < 2; ++ai)
#pragma unroll
            for (int m = 0; m < 4; ++m) { const int row = row0 + ai * 128 + m * 16; const size_t off = (size_t)row * DFF + col0;
                const float r = __builtin_amdgcn_rsqf(SSQ[row] * (1.0f / DM) + EPS);
#pragma unroll
                for (int bj = 0; bj < 2; ++bj) { const f32x4 v0 = acc[ai][bj][m][0] * r, v1 = acc[ai][bj][m][1] * r;
                    u32x4 w; w.x = pkh(v0[0], v0[1]); w.y = pkh(v0[2], v0[3]); w.z = pkh(v1[0], v1[1]); w.w = pkh(v1[2], v1[3]);
                    if (!dry) *(u32x4*)((bj ? UPV : UPG) + off) = w; } }
    }
};

__device__ __forceinline__ float dpp_ror1(float v) { return __builtin_bit_cast(float, __builtin_amdgcn_update_dpp(0, __builtin_bit_cast(int, v), 0x121, 0xf, 0xf, false)); }
__device__ __forceinline__ float dpp_ror2(float v) { return __builtin_bit_cast(float, __builtin_amdgcn_update_dpp(0, __builtin_bit_cast(int, v), 0x122, 0xf, 0xf, false)); }
struct EpiUpAct {
    static constexpr bool PERM = true;
    const float* SSQ; h16* ACT; float* SG; float* SV; float* SL; const float* fcw; const float* fcb; LAS unsigned char* xl; int dry;
    __device__ __forceinline__ void operator()(AccRef acc, const pg8::Unit& u, int wr, int wc, int fr, int fq) const {
        const int row0 = u.pm * 256 + wr * 64 + fr, colg = u.pn * 128 + wc * 32 + 8 * fq, coll = wc * 32 + 8 * fq;
        float w0[8], w1[8], w2[8], bb[8];
        { const f32x4 a0 = *(const f32x4*)(fcw + colg), a1 = *(const f32x4*)(fcw + colg + 4), b0 = *(const f32x4*)(fcw + DFF + colg), b1 = *(const f32x4*)(fcw + DFF + colg + 4),
                      c0 = *(const f32x4*)(fcw + 2 * DFF + colg), c1 = *(const f32x4*)(fcw + 2 * DFF + colg + 4), d0 = *(const f32x4*)(fcb + colg), d1 = *(const f32x4*)(fcb + colg + 4);
#pragma unroll
          for (int e = 0; e < 4; ++e) { w0[e] = a0[e]; w0[4 + e] = a1[e]; w1[e] = b0[e]; w1[4 + e] = b1[e]; w2[e] = c0[e]; w2[4 + e] = c1[e]; bb[e] = d0[e]; bb[4 + e] = d1[e]; } }
        float rsv[2][4];
#pragma unroll
        for (int ai = 0; ai < 2; ++ai)
#pragma unroll
            for (int m = 0; m < 4; ++m) rsv[ai][m] = SSQ[row0 + ai * 128 + m * 16];
#pragma unroll
        for (int ai = 0; ai < 2; ++ai)
#pragma unroll
            for (int m = 0; m < 4; ++m) rsv[ai][m] = __builtin_amdgcn_rsqf(rsv[ai][m] * (1.0f / DM) + EPS);
        LAS float* X = (LAS float*)xl;
#pragma unroll
        for (int ai = 0; ai < 2; ++ai) { const float r3 = rsv[ai][3];
            if (fr >= 14) { LAS float* p = X + ((ai * 2 + wr) * 2 + (fr - 14)) * 128 + coll; *(LAS f32x4*)p = acc[ai][0][3][0] * r3; *(LAS f32x4*)(p + 4) = acc[ai][0][3][1] * r3; } }
        LDS_WAIT(); __builtin_amdgcn_s_barrier(); asm volatile("" ::: "memory");
#pragma unroll
        for (int ai = 0; ai < 2; ++ai) {
            float L0[8], L1[8];
            if (ai == 0 && wr == 0) {
#pragma unroll
                for (int e = 0; e < 8; ++e) { L0[e] = 0.f; L1[e] = 0.f; } }
            else { const int pb = wr == 1 ? ai * 2 : 1; const LAS float* p = X + (pb * 2) * 128 + coll;
                const f32x4 x0 = *(const LAS f32x4*)p, x1 = *(const LAS f32x4*)(p + 4), y0 = *(const LAS f32x4*)(p + 128), y1 = *(const LAS f32x4*)(p + 132);
#pragma unroll
                for (int e = 0; e < 4; ++e) { L0[e] = x0[e]; L0[4 + e] = x1[e]; L1[e] = y0[e]; L1[4 + e] = y1[e]; } }
            float q1[8], q2[8];
#pragma unroll
            for (int e = 0; e < 8; ++e) { q1[e] = L1[e]; q2[e] = fr == 0 ? L0[e] : L1[e]; }
#pragma unroll
            for (int m = 0; m < 4; ++m) { const int row = row0 + ai * 128 + m * 16;
                const float rr = rsv[ai][m];
                float g[8], a[8];
#pragma unroll
                for (int e = 0; e < 4; ++e) { g[e] = acc[ai][0][m][0][e] * rr; g[4 + e] = acc[ai][0][m][1][e] * rr; }
#pragma unroll
                for (int e = 0; e < 8; ++e) { const float r1 = dpp_ror1(g[e]), r2 = dpp_ror2(g[e]);
                    const float p1 = fr >= 1 ? r1 : q1[e], p2 = fr >= 2 ? r2 : q2[e];
                    const float y = bb[e] + w0[e] * p2 + w1[e] * p1 + w2[e] * g[e];
                    const float vv = (e < 4 ? acc[ai][1][m][0][e] : acc[ai][1][m][1][e - 4]) * rr;
                    a[e] = gelu_tanh(y) * vv; q1[e] = r1; q2[e] = r2; }
                const bool deferred = (ai == 0 && m == 0) && wr == 0 && fr < 2;
                if (!dry) {
                    if (!deferred) { u32x4 w; w.x = pkh(a[0], a[1]); w.y = pkh(a[2], a[3]); w.z = pkh(a[4], a[5]); w.w = pkh(a[6], a[7]); *(u32x4*)(ACT + (size_t)row * DFF + colg) = w; }
                    else { float* pg = SG + (size_t)(u.pm * 2 + fr) * DFF + colg; float* pv = SV + (size_t)(u.pm * 2 + fr) * DFF + colg;
                        *(f32x4*)pg = (f32x4){g[0], g[1], g[2], g[3]}; *(f32x4*)(pg + 4) = (f32x4){g[4], g[5], g[6], g[7]};
                        *(f32x4*)pv = acc[ai][1][m][0] * rr; *(f32x4*)(pv + 4) = acc[ai][1][m][1] * rr; }
                    if ((ai == 1 && m == 3) && wr == 1 && fr >= 14) { float* pl = SL + (size_t)(u.pm * 2 + fr - 14) * DFF + colg;
                        *(f32x4*)pl = (f32x4){g[0], g[1], g[2], g[3]}; *(f32x4*)(pl + 4) = (f32x4){g[4], g[5], g[6], g[7]}; } }
                __builtin_amdgcn_sched_barrier(0); }
        }
    }
};
__device__ __forceinline__ void act_fix_tile(const float* SG, const float* SV, const float* SL, const float* fcw, const float* fcb, h16* ACT, int pm, int tid, int dry) {
    constexpr int NCG = DFF / 8; const bool bs = (pm & 31) == 0;
    for (int it = tid; it < 2 * NCG; it += NTHR) { const int cg = it % NCG, rr = it / NCG, c0 = cg * 8;
        float y[8];
#pragma unroll
        for (int h = 0; h < 2; ++h) { const int c = c0 + 4 * h;
            const f32x4 g = *(const f32x4*)(SG + (size_t)(pm * 2 + rr) * DFF + c), v = *(const f32x4*)(SV + (size_t)(pm * 2 + rr) * DFF + c);
            f32x4 g1, g2; const f32x4 z = {0.f, 0.f, 0.f, 0.f};
            if (rr == 0) { g1 = bs ? z : *(const f32x4*)(SL + (size_t)((pm - 1) * 2 + 1) * DFF + c); g2 = bs ? z : *(const f32x4*)(SL + (size_t)((pm - 1) * 2) * DFF + c); }
            else { g1 = *(const f32x4*)(SG + (size_t)(pm * 2) * DFF + c); g2 = bs ? z : *(const f32x4*)(SL + (size_t)((pm - 1) * 2 + 1) * DFF + c); }
            const f32x4 a0 = *(const f32x4*)(fcw + c), a1 = *(const f32x4*)(fcw + DFF + c), a2 = *(const f32x4*)(fcw + 2 * DFF + c), b = *(const f32x4*)(fcb + c);
#pragma unroll
            for (int e = 0; e < 4; ++e) y[4 * h + e] = gelu_tanh(b[e] + a0[e] * g2[e] + a1[e] * g1[e] + a2[e] * g[e]) * v[e]; }
        u32x4 w; w.x = pkh(y[0], y[1]); w.y = pkh(y[2], y[3]); w.z = pkh(y[4], y[5]); w.w = pkh(y[6], y[7]);
        if (!dry) *(u32x4*)(ACT + (size_t)(pm * 256 + rr) * DFF + c0) = w; }
}

struct EpiGateSig {
    static constexpr bool PERM = true;
    const float* SSQ; h16* GS; int dry;
    __device__ __forceinline__ void operator()(AccRef acc, const pg8::Unit& u, int wr, int wc, int fr, int fq) const {
        const int row0 = u.pm * 256 + wr * 64 + fr; const unsigned fo = frag_off(u.pm, u.pn, wr * 4 + wc, fq * 16 + fr);
        float rsv[2][4];
#pragma unroll
        for (int ai = 0; ai < 2; ++ai)
#pragma unroll
            for (int m = 0; m < 4; ++m) rsv[ai][m] = SSQ[row0 + ai * 128 + m * 16];
        __builtin_amdgcn_sched_barrier(0);
#pragma unroll
        for (int ai = 0; ai < 2; ++ai)
#pragma unroll
            for (int m = 0; m < 4; ++m) { const float r = __builtin_amdgcn_rsqf(rsv[ai][m] * (1.0f / DM) + EPS);
#pragma unroll
                for (int bj = 0; bj < 2; ++bj) { const f32x4 v0 = acc[ai][bj][m][0] * r, v1 = acc[ai][bj][m][1] * r;
                    u32x4 w; w.x = pkh(sigmoid_f(v0[0]), sigmoid_f(v0[1])); w.y = pkh(sigmoid_f(v0[2]), sigmoid_f(v0[3])); w.z = pkh(sigmoid_f(v1[0]), sigmoid_f(v1[1])); w.w = pkh(sigmoid_f(v1[2]), sigmoid_f(v1[3]));
                    if (!dry) *(u32x4*)((char*)GS + fo + FRAG_SUB(ai, m, bj)) = w; }
                __builtin_amdgcn_sched_barrier(0); }
    }
};
struct EpiPleOut {
    static constexpr bool PERM = true;
    const h16* GS; const h16* X2; float* C; int dry;
    __device__ __forceinline__ void operator()(AccRef acc, const pg8::Unit& u, int wr, int wc, int fr, int fq) const {
        const int row0 = u.pm * 256 + wr * 64 + fr, col0 = u.pn * 256 + wc * 32 + 8 * fq;
        const unsigned e0 = (unsigned)row0 * DM + (unsigned)col0, fo = frag_off(u.pm, u.pn, wr * 4 + wc, fq * 16 + fr);
#pragma unroll
        for (int ai = 0; ai < 2; ++ai) {
            h8 gsv[4][2], xbv[4][2];
#pragma unroll
            for (int m = 0; m < 4; ++m)
#pragma unroll
                for (int bj = 0; bj < 2; ++bj) { const unsigned o2 = e0 + (unsigned)((ai * 128 + m * 16) * DM) + bj * 128;
                    gsv[m][bj] = *(const h8*)((const char*)GS + fo + FRAG_SUB(ai, m, bj)); xbv[m][bj] = *(const h8*)((const char*)X2 + (size_t)o2 * 2u); }
            __builtin_amdgcn_sched_barrier(0);
#pragma unroll
            for (int m = 0; m < 4; ++m) { const unsigned eo = e0 + (unsigned)((ai * 128 + m * 16) * DM);
#pragma unroll
                for (int bj = 0; bj < 2; ++bj) { const unsigned o2 = eo + bj * 128; const f32x4 a0 = acc[ai][bj][m][0], a1 = acc[ai][bj][m][1];
                    f32x4 o0, o1;
#pragma unroll
                    for (int j = 0; j < 4; ++j) { o0[j] = (float)xbv[m][bj][j] + (float)gsv[m][bj][j] * a0[j]; o1[j] = (float)xbv[m][bj][4 + j] + (float)gsv[m][bj][4 + j] * a1[j]; }
                    if (!dry) { *(f32x4*)((char*)C + (size_t)o2 * 4u) = o0; *(f32x4*)((char*)C + (size_t)o2 * 4u + 16) = o1; } } }
            __builtin_amdgcn_sched_barrier(0); }
    }
};


#define XB_TMO      128
#define XB_XCNT(j)  (256  + 64 * (j))
#define XB_XSUB(j)  (1280 + 64 * (j))
#define XB_XGEN(j)  (2304 + 64 * (j))
#define XB_TOP      3328
#define XB_TOPGEN   3392
#define XCD_BAR_WORDS 3456
#define XB_SPIN_CAP (1u << 20)

__device__ __forceinline__ unsigned xb_ld(unsigned* p)              { return __hip_atomic_load(p, __ATOMIC_RELAXED, __HIP_MEMORY_SCOPE_AGENT); }
__device__ __forceinline__ unsigned xb_add(unsigned* p, unsigned v) { return __hip_atomic_fetch_add(p, v, __ATOMIC_RELAXED, __HIP_MEMORY_SCOPE_AGENT); }
__device__ __forceinline__ unsigned xb_xcc_id() { return (unsigned)__builtin_amdgcn_s_getreg((3 << 11) | 20) & 0xFu; }
#define XB_SPIN(cond, bar) do { unsigned _sp = 0; while (cond) { __builtin_amdgcn_s_sleep(1); \
    if ((++_sp & 255u) == 0u) { if (xb_ld(&(bar)[XB_TMO])) break; if (_sp > XB_SPIN_CAP) { atomicAdd(&(bar)[XB_TMO], 1u); break; } } } } while (0)

struct XcdBarrier { unsigned* bar; unsigned x; volatile LAS unsigned* st; };

__device__ __forceinline__ XcdBarrier xcd_barrier_post(unsigned* bar, volatile LAS unsigned* st) {
    XcdBarrier b; b.bar = bar; b.x = xb_xcc_id(); b.st = st;
    if (threadIdx.x == 0) (void)xb_add(&bar[XB_XCNT(b.x)], 1u);
    return b;
}
__device__ __forceinline__ void xcd_barrier_complete(unsigned* bar, unsigned x, unsigned& nloc, unsigned& nx) {
    const unsigned G = gridDim.x * gridDim.y * gridDim.z;
    unsigned sum, cnt, mine, sp = 0u;
    for (;;) {
        sum = 0u; cnt = 0u; mine = 0u;
#pragma unroll
        for (unsigned j = 0; j < 16; ++j) { const unsigned c = xb_ld(&bar[XB_XCNT(j)]); sum += c; cnt += (c > 0u) ? 1u : 0u; mine = (j == x) ? c : mine; }
        if (sum == G) break;
        __builtin_amdgcn_s_sleep(1);
        if ((++sp & 255u) == 0u) { if (xb_ld(&bar[XB_TMO])) break; if (sp > XB_SPIN_CAP) { atomicAdd(&bar[XB_TMO], 1u); break; } }
    }
    nloc = mine > 0u ? mine : 1u; nx = cnt > 0u ? cnt : 1u;
}
__device__ __forceinline__ void xcd_barrier(const XcdBarrier& b) {
    asm volatile("s_waitcnt vmcnt(0)" ::: "memory");
    __syncthreads();
    if (threadIdx.x == 0) {
        unsigned* bar = b.bar;
        __builtin_amdgcn_s_waitcnt(0);
        unsigned nloc = b.st[0], nx = b.st[1];
        if (nloc == 0u) { xcd_barrier_complete(bar, b.x, nloc, nx); b.st[0] = nloc; b.st[1] = nx; }
        const unsigned old = xb_add(&bar[XB_XSUB(b.x)], 1u);
        const unsigned gen = old / nloc;
        if (old + 1u == (gen + 1u) * nloc) {
            __builtin_amdgcn_fence(__ATOMIC_RELEASE, "agent");
            asm volatile("s_waitcnt vmcnt(0)" ::: "memory");
            const unsigned og = xb_add(&bar[XB_TOP], 1u);
            const unsigned tg = og / nx;
            if (og + 1u == (tg + 1u) * nx) xb_add(&bar[XB_TOPGEN], 1u);
            else XB_SPIN(xb_ld(&bar[XB_TOPGEN]) == tg, bar);
            __builtin_amdgcn_fence(__ATOMIC_ACQUIRE, "agent");
            xb_add(&bar[XB_XGEN(b.x)], 1u);
            asm volatile("s_waitcnt vmcnt(0)" ::: "memory");
        } else {
            XB_SPIN(xb_ld(&bar[XB_XGEN(b.x)]) == gen, bar);
            __builtin_amdgcn_fence(__ATOMIC_ACQUIRE, "agent");
            asm volatile("s_waitcnt vmcnt(0)" ::: "memory");
        }
    }
    __syncthreads();
}

constexpr size_t MiB = 1u << 20;
constexpr size_t WS_CTL = 0, CTL_ZERO_BYTES = 1 * MiB;
constexpr size_t WS_SA = 1 * MiB, WS_SH = 2 * MiB;
constexpr size_t WS_WI = 3 * MiB;
constexpr size_t WS_KI = 4 * MiB;
constexpr size_t WS_W = 8 * MiB;
constexpr size_t W_IN = WS_W, W_LRU = W_IN + (size_t)NIN_PAD * DM * 2, W_ATT = W_LRU + 2 * MiB, W_OUT = W_ATT + 2 * MiB, W_PG = W_OUT + 2 * MiB,
                 W_UP = W_PG + 2 * MiB, W_DOWN = W_UP + 12 * MiB, W_PP = W_DOWN + 6 * MiB, W_GATE = W_PP + MiB / 2, W_END = W_GATE + MiB / 2;
static_assert(W_END <= 48 * MiB, "weights region");
constexpr size_t WS_A0 = 48 * MiB;
constexpr size_t WS_IDX = 48 * MiB, WS_NV = 64 * MiB;
constexpr size_t WS_K8 = 72 * MiB, WS_V8 = 80 * MiB;
constexpr size_t WS_T1 = 48 * MiB;
constexpr size_t WS_X1H = 48 * MiB;
constexpr size_t WS_PH = 112 * MiB;
constexpr size_t WS_LX = 128 * MiB;
constexpr size_t WS_GG = 192 * MiB;
constexpr size_t WS_Q = 256 * MiB;
constexpr size_t WS_K = 320 * MiB, WS_V = 336 * MiB;
constexpr size_t WS_QI = 352 * MiB;
constexpr size_t WS_SGA = 384 * MiB, WS_SGB = 448 * MiB;
constexpr size_t WS_UPG = 128 * MiB, WS_UPV = 320 * MiB;
constexpr size_t WS_X2H = 128 * MiB;
constexpr size_t WS_GS = 320 * MiB;
constexpr size_t WS_END = 512 * MiB;
constexpr int CW_BAR = 1024;
constexpr int CW_Q2 = 8192, CW_Q3 = 8192 + 256;
constexpr size_t CTL_SSQ1 = 256 * 1024, CTL_SSQ2 = 512 * 1024;
static_assert((CW_BAR + XCD_BAR_WORDS) * 4 <= 32768 && CTL_SSQ2 + MTOK * 4 <= CTL_ZERO_BYTES, "ctl map");

constexpr int LDS_BYTES = 159744;
constexpr int MISC_OFF = LDS_BYTES - 256;

struct Params {
    const float* in[25]; float* out; unsigned char* ws; int ph_lo, ph_hi, k_ple, pad;
};

__device__ __forceinline__ float wave_sum(float v) {
#pragma unroll
    for (int o = 1; o < 64; o <<= 1) v += __shfl_xor(v, o);
    return v;
}
template <int MAP> __device__ __forceinline__ int rowmap(int n) {
    if (MAP == 1) return n < 4168 ? n : n + 184;
    if (MAP == 2) return n < DFF ? ((n >> 7) * 256 + (n & 127)) : (((n - DFF) >> 7) * 256 + 128 + ((n - DFF) & 127));
    return n;
}
template <int MAP> __device__ __forceinline__ void p0_transpose_item(const float* W, int K, int N, h16* WT, const float* gain, LAS float* scr, int item, int lane) {
    const int nblk = (N + 31) / 32, kb = item / nblk, nb = item % nblk, k0 = 64 * kb, n0 = 32 * nb;
    const int nn = n0 + (lane & 31);
#pragma unroll 8
    for (int i = 0; i < 32; ++i) { const int kk = 2 * i + (lane >> 5); float v = 0.f; if (nn < N) v = W[(size_t)(k0 + kk) * N + nn]; if (gain) v *= gain[k0 + kk]; scr[kk * 33 + (lane & 31)] = v; }
    LDS_WAIT(); asm volatile("" ::: "memory");
    const int c = lane & 7;
#pragma unroll
    for (int j = 0; j < 4; ++j) { const int n = (lane >> 3) + 8 * j; const LAS float* s = scr + (8 * c) * 33 + n;
        u32x4 o; o.x = pkh(s[0 * 33], s[1 * 33]); o.y = pkh(s[2 * 33], s[3 * 33]); o.z = pkh(s[4 * 33], s[5 * 33]); o.w = pkh(s[6 * 33], s[7 * 33]);
        if (n0 + n < N) *(u32x4*)(WT + (size_t)rowmap<MAP>(n0 + n) * K + k0 + 8 * c) = o; }
    LDS_WAIT(); asm volatile("" ::: "memory");
}

struct Ctx {
    unsigned char* ws; float* out; int dry;
    const float *conv_w, *conv_b, *ba, *bx, *lam, *qn, *kn, *relb, *fcw, *fcb;
};
__device__ __forceinline__ unsigned ordered_u32(float v) { const unsigned u = __builtin_bit_cast(unsigned, v); return u ^ ((unsigned)((int)u >> 31) | 0x80000000u); }

constexpr int UA_STR = 272;
constexpr int LRU_UA = 0, LRU_HL = 128 * UA_STR, LRU_PP = 2 * 128 * UA_STR;
__device__ __forceinline__ void lru1_item(const Ctx& C, LAS unsigned char* lds, int item) {
    int tid = threadIdx.x; asm volatile("" : "+v"(tid));
    const int lane = tid & 63, wv = tid >> 6;
    const int b = item >> 7, n = (item >> 4) & 7, jg = item & 15;
    const h16* LX = (const h16*)(C.ws + WS_LX);
    const int cg = tid & 15, rg = tid >> 4, ch0 = n * 128 + cg * 8, tl = rg * 4;
    float cb[8], cw[4][8];
    { const f32x4 t0 = *(const f32x4*)(C.conv_b + ch0), t1 = *(const f32x4*)(C.conv_b + ch0 + 4); for (int e = 0; e < 4; ++e) { cb[e] = t0[e]; cb[4 + e] = t1[e]; } }
#pragma unroll
    for (int jj = 0; jj < 4; ++jj) { const f32x4 w0 = *(const f32x4*)(C.conv_w + jj * DM + ch0), w1 = *(const f32x4*)(C.conv_w + jj * DM + ch0 + 4); for (int e = 0; e < 4; ++e) { cw[jj][e] = w0[e]; cw[jj][4 + e] = w1[e]; } }
    const int q = lane & 15, c = lane >> 4, oc = wv * 16 + q, ch = n * 128 + oc;
    const h16* WG = (const h16*)(C.ws + W_GATE) + (size_t)n * 256 * 128;
    h8 Ba[4], Bx[4];
#pragma unroll
    for (int ks = 0; ks < 4; ++ks) { Ba[ks] = *(const h8*)(WG + (size_t)oc * 128 + 32 * ks + 8 * c); Bx[ks] = *(const h8*)(WG + (size_t)(128 + oc) * 128 + 32 * ks + 8 * c); }
    const float bav = C.ba[ch], bxv = C.bx[ch], m8sp = -8.0f * 1.4426950408889634f * log1pf(expf(-C.lam[ch]));
#pragma unroll 1
    for (int j4 = 0; j4 < 4; ++j4) {
    const int j = jg * 4 + j4;
    const size_t mrow0 = (size_t)b * SEQ + (size_t)j * 128;
    {
        const int tseq = j * 128 + tl;
        h8 xr[7];
#pragma unroll
        for (int i = 0; i < 7; ++i) { const int tt = tseq - 3 + i; if (tt >= 0) xr[i] = *(const h8*)(LX + ((size_t)b * SEQ + tt) * DM + ch0); else { for (int e = 0; e < 8; ++e) xr[i][e] = (h16)0.f; } }
        float y[4][8];
#pragma unroll
        for (int r = 0; r < 4; ++r)
#pragma unroll
            for (int e = 0; e < 8; ++e) y[r][e] = cb[e];
#pragma unroll
        for (int jj = 0; jj < 4; ++jj)
#pragma unroll
            for (int r = 0; r < 4; ++r)
#pragma unroll
                for (int e = 0; e < 8; ++e) y[r][e] += cw[jj][e] * (float)xr[r + jj][e];
#pragma unroll
        for (int r = 0; r < 4; ++r) { u32x4 w; w.x = pkh(y[r][0], y[r][1]); w.y = pkh(y[r][2], y[r][3]); w.z = pkh(y[r][4], y[r][5]); w.w = pkh(y[r][6], y[r][7]);
            *(LAS u32x4*)(lds + LRU_UA + (tl + r) * UA_STR + cg * 16) = w; }
    }
    __syncthreads();
    {
        float cH = 0.f, cP = 1.f;
        for (int tt = 0; tt < 8; ++tt) {
            f32x4 aa = {0.f, 0.f, 0.f, 0.f}, ax = {0.f, 0.f, 0.f, 0.f};
#pragma unroll
            for (int ks = 0; ks < 4; ++ks) { const h8 A = *(const LAS h8*)(lds + LRU_UA + (16 * tt + q) * UA_STR + (32 * ks + 8 * c) * 2);
                aa = __builtin_amdgcn_mfma_f32_16x16x32_f16(A, Ba[ks], aa, 0, 0, 0); ax = __builtin_amdgcn_mfma_f32_16x16x32_f16(A, Bx[ks], ax, 0, 0, 0); }
            float hl[4], pl[4]; float h = 0.f, p = 1.f;
#pragma unroll
            for (int i = 0; i < 4; ++i) { const int t = 16 * tt + 4 * c + i;
                const float uav = (float)*(const LAS h16*)(lds + LRU_UA + t * UA_STR + oc * 2);
                const float ra = sigmoid_f(aa[i] + bav), ix = sigmoid_f(ax[i] + bxv);
                const float a = __builtin_amdgcn_exp2f(m8sp * ra);
                const float mult = __builtin_amdgcn_sqrtf(fmaxf(1.0f - a * a, 0.f));
                const float u = mult * ix * uav;
                h = a * h + u; p *= a; hl[i] = h; pl[i] = p; }
            float Ak[4], Hk[4];
#pragma unroll
            for (int k = 0; k < 4; ++k) { Ak[k] = __shfl(p, q + 16 * k); Hk[k] = __shfl(h, q + 16 * k); }
            float PA = 1.f, PH = 0.f;
#pragma unroll
            for (int k = 0; k < 3; ++k) if (k < c) { PH = PH * Ak[k] + Hk[k]; PA *= Ak[k]; }
            const float hin = cH * PA + PH, pin = cP * PA;
#pragma unroll
            for (int i = 0; i < 4; ++i) { const int t = 16 * tt + 4 * c + i;
                *(LAS h16*)(lds + LRU_HL + t * UA_STR + oc * 2) = (h16)(hl[i] + pl[i] * hin);
                *(LAS h16*)(lds + LRU_PP + t * UA_STR + oc * 2) = (h16)(pin * pl[i]); }
            const float AT = Ak[0] * Ak[1] * Ak[2] * Ak[3], HT = ((Hk[0] * Ak[1] + Hk[1]) * Ak[2] + Hk[2]) * Ak[3] + Hk[3];
            cH = cH * AT + HT; cP = cP * AT;
        }
        if (c == 0 && !C.dry) { const size_t so = ((size_t)b * 64 + j) * DM + ch; ((float*)(C.ws + WS_SA))[so] = cP; ((float*)(C.ws + WS_SH))[so] = cH; }
    }
    __syncthreads();
    {
        h16* HLOC = (h16*)C.out; h16* PPRD = (h16*)C.out + (size_t)MTOK * DM;
#pragma unroll
        for (int r = 0; r < 4; ++r) { const int t = rg * 4 + r; const size_t go = (mrow0 + t) * DM + n * 128 + cg * 8;
            const u32x4 w0 = *(const LAS u32x4*)(lds + LRU_HL + t * UA_STR + cg * 16), w1 = *(const LAS u32x4*)(lds + LRU_PP + t * UA_STR + cg * 16);
            if (!C.dry) { *(u32x4*)(HLOC + go) = w0; *(u32x4*)(PPRD + go) = w1; } }
    }
    __syncthreads();
    }
}

__device__ __forceinline__ void lru2_item(const Ctx& C, LAS unsigned char* lds, int item) {
    int tid = threadIdx.x; asm volatile("" : "+v"(tid));
    const int b = item >> 7, n = (item >> 4) & 7, jg = item & 15, j0 = jg * 4;
    LAS float* carry = (LAS float*)lds;
    if (tid < 128) { const int ch = n * 128 + tid; const float* SA = (const float*)(C.ws + WS_SA) + (size_t)b * 64 * DM + ch; const float* SH = (const float*)(C.ws + WS_SH) + (size_t)b * 64 * DM + ch;
        float cr = 0.f; int jj = 0;
        for (; jj + 8 <= j0; jj += 8) { float a8[8], h8v[8];
#pragma unroll
            for (int k = 0; k < 8; ++k) { a8[k] = SA[(size_t)(jj + k) * DM]; h8v[k] = SH[(size_t)(jj + k) * DM]; }
#pragma unroll
            for (int k = 0; k < 8; ++k) cr = a8[k] * cr + h8v[k]; }
        for (; jj < j0; ++jj) cr = SA[(size_t)jj * DM] * cr + SH[(size_t)jj * DM];
        float a4[4], h4[4];
#pragma unroll
        for (int k = 0; k < 4; ++k) { a4[k] = SA[(size_t)(j0 + k) * DM]; h4[k] = SH[(size_t)(j0 + k) * DM]; }
#pragma unroll
        for (int k = 0; k < 4; ++k) { carry[k * 128 + tid] = cr; cr = a4[k] * cr + h4[k]; } }
    __syncthreads();
    const int cg = tid & 15, rg = tid >> 4; const h16* HLOC = (const h16*)C.out; const h16* PPRD = (const h16*)C.out + (size_t)MTOK * DM;
    const h16* GG = (const h16*)(C.ws + WS_GG); h16* YA = (h16*)(C.ws + WS_LX);
#pragma unroll 1
    for (int k = 0; k < 4; ++k) {
        float cr[8];
#pragma unroll
        for (int e = 0; e < 8; ++e) cr[e] = carry[k * 128 + cg * 8 + e];
#pragma unroll
        for (int r = 0; r < 4; ++r) { const size_t go = ((size_t)b * SEQ + (j0 + k) * 128 + rg * 4 + r) * DM + n * 128 + cg * 8;
            const h8 hl = *(const h8*)(HLOC + go), pp = *(const h8*)(PPRD + go), gg = *(const h8*)(GG + go);
            float y[8];
#pragma unroll
            for (int e = 0; e < 8; ++e) y[e] = ((float)hl[e] + (float)pp[e] * cr[e]) * (float)gg[e];
            u32x4 w; w.x = pkh(y[0], y[1]); w.y = pkh(y[2], y[3]); w.z = pkh(y[4], y[5]); w.w = pkh(y[6], y[7]);
            if (!C.dry) *(u32x4*)(YA + go) = w; } }
}

__device__ __forceinline__ unsigned pk4_fp8_k(float a, float b, float c, float d) { int w = 0; w = __builtin_amdgcn_cvt_pk_fp8_f32(a, b, w, false); w = __builtin_amdgcn_cvt_pk_fp8_f32(c, d, w, true); return (unsigned)w; }
__device__ __forceinline__ void knorm_unit(const Ctx& C, int unit) {
    int tid = threadIdx.x; asm volatile("" : "+v"(tid));
    const int lane = tid & 63, wv = tid >> 6;
    const h16* K = (const h16*)(C.ws + WS_K); const h16* V = (const h16*)(C.ws + WS_V);
    unsigned* K8 = (unsigned*)(C.ws + WS_K8); unsigned* V8 = (unsigned*)(C.ws + WS_V8);
    const int col = lane * 4, d0 = col & 127;
    const f32x4 g = *(const f32x4*)(C.kn + d0);
    for (int r = 0; r < 16; ++r) { const size_t row = (size_t)unit * 128 + wv * 16 + r;
        const h4 v = *(const h4*)(K + row * 256 + col), vv = *(const h4*)(V + row * 256 + col);
        float ss = 0.f, f[4];
#pragma unroll
        for (int e = 0; e < 4; ++e) { f[e] = (float)v[e]; ss += f[e] * f[e]; }
#pragma unroll
        for (int o = 1; o < 32; o <<= 1) ss += __shfl_xor(ss, o);
        const float rs = __builtin_amdgcn_rsqf(ss * (1.0f / 128.0f) + EPS);
        const unsigned wk = pk4_fp8_k(f[0] * rs * g[0], f[1] * rs * g[1], f[2] * rs * g[2], f[3] * rs * g[3]);
        const unsigned wvv = pk4_fp8_k((float)vv[0], (float)vv[1], (float)vv[2], (float)vv[3]);
        if (!C.dry) { K8[row * 64 + lane] = wk; V8[row * 64 + lane] = wvv; } }
}

#ifdef IX_PROBE
#define IX_PROBE_FINAL (C.dry && (IX_PROBE & 2))
#define IX_PROBE_NOFILT (C.dry && (IX_PROBE & 1))
#else
#define IX_PROBE_FINAL 0
#define IX_PROBE_NOFILT 0
#endif
constexpr int IX_SK = 256;
constexpr int IX_CAP = 1024;
constexpr int IX_ORD = 0;
constexpr int IX_KEY = IX_ORD + 16 * IX_CAP * 4;
constexpr int IX_HIST = IX_KEY + 16 * IX_CAP * 2;
constexpr int IX_CTR = IX_HIST + 8 * 512;
constexpr int IX_END = IX_CTR + 128;
static_assert(IX_END <= MISC_OFF, "indexer LDS");
constexpr int IX_NE = IX_CAP / 64;

struct IxBuf { LAS unsigned* ord; LAS unsigned short* key; };
#define IX_DPPMAX(v, ctl, rm) { const unsigned t_ = (unsigned)__builtin_amdgcn_update_dpp((int)(v), (int)(v), ctl, rm, 0xf, false); v = t_ > v ? t_ : v; }
__device__ __forceinline__ unsigned ix_rowmax(unsigned v) { IX_DPPMAX(v, 0xB1, 0xf) IX_DPPMAX(v, 0x4E, 0xf) IX_DPPMAX(v, 0x141, 0xf) IX_DPPMAX(v, 0x140, 0xf) return v; }
__device__ __forceinline__ unsigned ix_wavemax(unsigned v) { v = ix_rowmax(v); IX_DPPMAX(v, 0x142, 0xa) IX_DPPMAX(v, 0x143, 0xc) return (unsigned)__builtin_amdgcn_readlane((int)v, 63); }
__device__ __forceinline__ void ix_load_ord(const IxBuf& B, int cnt, int lane, unsigned (&o)[IX_NE]) {
#pragma unroll
    for (int k = 0; k < IX_NE; ++k) { const int idx = k * 64 + lane; o[k] = idx < cnt ? B.ord[idx] : 0u; }
}
__device__ __forceinline__ int ix_count_ge(const unsigned (&o)[IX_NE], unsigned x) {
    int c = 0;
#pragma unroll
    for (int k = 0; k < IX_NE; ++k) c += (int)__builtin_popcountll(__ballot(o[k] >= x));
    return c;
}
__device__ __forceinline__ unsigned ix_max(const unsigned (&o)[IX_NE]) {
    unsigned m = 0u;
#pragma unroll
    for (int k = 0; k < IX_NE; ++k) m = o[k] > m ? o[k] : m;
    return ix_wavemax(m);
}
__device__ __forceinline__ unsigned ix_tie_thr(const unsigned (&o)[IX_NE], const unsigned short (&kk)[IX_NE], unsigned x, int need) {
    unsigned lo = 0u, hi = 0x10000u;
    while (hi - lo > 1u) { const unsigned mid = (lo + hi) >> 1; int c = 0;
#pragma unroll
        for (int k = 0; k < IX_NE; ++k) c += (int)__builtin_popcountll(__ballot(o[k] == x && (unsigned)kk[k] >= mid));
        if (c >= need) lo = mid; else hi = mid; }
    return lo;
}
__device__ __forceinline__ int ix_rewrite(const IxBuf& B, const unsigned (&o)[IX_NE], const unsigned short (&kk)[IX_NE], int lane, unsigned x, unsigned th) {
    int base = 0;
#pragma unroll
    for (int k = 0; k < IX_NE; ++k) { const bool keep = o[k] > x || (o[k] == x && (unsigned)kk[k] >= th);
        const u64 m = __ballot(keep); const int pos = base + (int)__builtin_amdgcn_mbcnt_hi((unsigned)(m >> 32), __builtin_amdgcn_mbcnt_lo((unsigned)m, 0u));
        if (keep) { B.ord[pos] = o[k]; B.key[pos] = kk[k]; }
        base += (int)__builtin_popcountll(m); }
    LDS_WAIT();
    return base;
}
__device__ __forceinline__ unsigned ix_sample_pivot(unsigned s0, int rank) {
    int r = 0;
#define IX_ROT(n) { const unsigned t_ = (unsigned)__builtin_amdgcn_update_dpp(0, (int)s0, 0x120 + n, 0xf, 0xf, false); r += t_ > s0 ? 1 : 0; }
    IX_ROT(1) IX_ROT(2) IX_ROT(3) IX_ROT(4) IX_ROT(5) IX_ROT(6) IX_ROT(7) IX_ROT(8) IX_ROT(9) IX_ROT(10) IX_ROT(11) IX_ROT(12) IX_ROT(13) IX_ROT(14) IX_ROT(15)
#undef IX_ROT
    unsigned v = r >= rank ? s0 : 0u;
    v = ix_rowmax(v);
    return ((unsigned)__builtin_amdgcn_readlane((int)v, 0) >> 2) + ((unsigned)__builtin_amdgcn_readlane((int)v, 16) >> 2) + ((unsigned)__builtin_amdgcn_readlane((int)v, 32) >> 2) + ((unsigned)__builtin_amdgcn_readlane((int)v, 48) >> 2);
}
__device__ __forceinline__ unsigned ix_find_window(const unsigned (&o)[IX_NE], unsigned lo, unsigned hi, int cnt, int cmin, int cmax, bool& tie) {
    tie = false;
    int rank = (16 * ((cmin + cmax) / 2)) / cnt; rank = rank > 14 ? 14 : rank;
    unsigned x = ix_sample_pivot(o[0], rank);
    if (x <= lo || x >= hi) x = lo + ((hi - lo) >> 1);
    for (;;) { const int c = ix_count_ge(o, x);
        if (c > cmax) lo = x; else if (c < cmin) hi = x; else return x - 1u;
        if (hi - lo <= 1u) { tie = true; return lo; }
        x = lo + ((hi - lo) >> 1); }
}
__device__ __forceinline__ unsigned ix_compact(const IxBuf& B, int lane, int& cnt, unsigned T) {
    unsigned o[IX_NE]; ix_load_ord(B, cnt, lane, o);
    unsigned short kk[IX_NE];
#pragma unroll
    for (int k = 0; k < IX_NE; ++k) kk[k] = B.key[k * 64 + lane];
    LDS_WAIT();
    bool tie; unsigned th = 0x10000u;
    const unsigned x = ix_find_window(o, T, ix_max(o) + 1u, cnt, 256, 512, tie);
    if (tie) th = ix_tie_thr(o, kk, x, 512 - ix_count_ge(o, x + 1u));
    cnt = ix_rewrite(B, o, kk, lane, x, th); return x + 1u;
}
__device__ __forceinline__ unsigned ix_compact_to(const IxBuf& B, int lane, int& cnt, unsigned T) {
    unsigned o[IX_NE]; ix_load_ord(B, cnt, lane, o);
    unsigned short kk[IX_NE];
#pragma unroll
    for (int k = 0; k < IX_NE; ++k) kk[k] = B.key[k * 64 + lane];
    LDS_WAIT();
    bool tie; unsigned th = 0x10000u;
    const unsigned x = ix_find_window(o, T, ix_max(o) + 1u, cnt, 256, 320, tie);
    if (tie) th = ix_tie_thr(o, kk, x, 320 - ix_count_ge(o, x + 1u));
    cnt = ix_rewrite(B, o, kk, lane, x, th); return x + 1u;
}
__device__ __forceinline__ void ix_final(const IxBuf& B, LAS unsigned short* outl, int lane, int cnt, unsigned T, unsigned short* idx_row, int* nv_ptr, int dry) {
    if (cnt > 320) { cnt = cnt < IX_CAP ? cnt : IX_CAP; T = ix_compact_to(B, lane, cnt, T); }
    unsigned o[5]; unsigned short kk[5];
#pragma unroll
    for (int k = 0; k < 5; ++k) { const int idx = k * 64 + lane; o[k] = idx < cnt ? B.ord[idx] : 0u; kk[k] = B.key[idx]; }
    LDS_WAIT();
    unsigned x = 0u, th = 0u;
    if (cnt > 256) { unsigned mxv = 0u;
#pragma unroll
        for (int k = 0; k < 5; ++k) mxv = o[k] > mxv ? o[k] : mxv;
        mxv = ix_wavemax(mxv);
        unsigned lo = T, hi = mxv + 1u;
        for (;;) { if (hi - lo <= 1u) { x = lo; int ca = 0, need;
#pragma unroll
                for (int k = 0; k < 5; ++k) ca += (int)__builtin_popcountll(__ballot(o[k] >= lo + 1u));
                need = 256 - ca; unsigned tl = 0u, thh = 0x10000u;
                while (thh - tl > 1u) { const unsigned mid = (tl + thh) >> 1; int c = 0;
#pragma unroll
                    for (int k = 0; k < 5; ++k) c += (int)__builtin_popcountll(__ballot(o[k] == x && (unsigned)kk[k] >= mid));
                    if (c >= need) tl = mid; else thh = mid; }
                th = tl; break; }
            const unsigned mid = lo + ((hi - lo) >> 1); int c = 0;
#pragma unroll
            for (int k = 0; k < 5; ++k) c += (int)__builtin_popcountll(__ballot(o[k] >= mid));
            if (c == 256) { x = mid - 1u; th = 0x10000u; break; }
            if (c > 256) lo = mid; else hi = mid; } }
    int base = 0;
#pragma unroll
    for (int k = 0; k < 5; ++k) { const bool valid = k * 64 + lane < cnt; const bool sel = valid && (o[k] > x || (o[k] == x && (unsigned)kk[k] >= th));
        const u64 m = __ballot(sel); const int pos = base + (int)__builtin_amdgcn_mbcnt_hi((unsigned)(m >> 32), __builtin_amdgcn_mbcnt_lo((unsigned)m, 0u));
        if (sel && pos < 256) outl[pos] = (unsigned short)(0xFFFFu - (unsigned)kk[k]);
        base += (int)__builtin_popcountll(m); }
    LDS_WAIT();
    const int nsel = base < 256 ? base : 256;
    const u32x2 ow = *(const LAS u32x2*)(outl + lane * 4);
    if (!dry) { *(u32x2*)(idx_row + lane * 4) = ow; if (lane == 0) *nv_ptr = nsel; }
    LDS_WAIT();
}
__device__ __forceinline__ float ix_unordered(unsigned T) { const unsigned u = (T & 0x80000000u) ? (T ^ 0x80000000u) : ~T; return __builtin_bit_cast(float, u); }

__device__ __forceinline__ void indexer_unit(const Ctx& C, LAS unsigned char* lds, int unit) {
    int tid = threadIdx.x; asm volatile("" : "+v"(tid));
    const int lane = tid & 63, wv = __builtin_amdgcn_readfirstlane(tid >> 6);
    const int b = unit & 3, qt = 511 - (unit >> 2), t0 = qt * 16;
    const int q = lane & 15, c = lane >> 4;
    const size_t m0 = (size_t)b * SEQ + t0;
    const h16* QI = (const h16*)(C.ws + WS_QI); const h16* KI = (const h16*)(C.ws + WS_KI) + (size_t)b * SEQ * 64; const float* WI = (const float*)(C.ws + WS_WI);
    LAS unsigned* cntl = (LAS unsigned*)(lds + IX_CTR); volatile LAS float* taul = (volatile LAS float*)(lds + IX_CTR + 64);
    if (tid < 16) { cntl[tid] = 0u; taul[tid] = -3.402823466e38f; }
    h8 qf[8][2];
#pragma unroll
    for (int h = 0; h < 8; ++h)
#pragma unroll
        for (int ks = 0; ks < 2; ++ks) qf[h][ks] = *(const h8*)(QI + ((((m0 >> 4) * 8 + h) * 2 + ks) * 64 + lane) * 8);
    float wvv[8]; { const f32x4 w0 = *(const f32x4*)(WI + (m0 + q) * 8), w1 = *(const f32x4*)(WI + (m0 + q) * 8 + 4); for (int e = 0; e < 4; ++e) { wvv[e] = w0[e]; wvv[4 + e] = w1[e]; } }
#pragma unroll
    for (int h = 0; h < 8; ++h) wvv[h] *= 0.5f;
    h8 qs[2];
#pragma unroll
    for (int ks = 0; ks < 2; ++ks)
#pragma unroll
        for (int j = 0; j < 8; ++j) { float a = 0.f;
#pragma unroll
            for (int h = 0; h < 8; ++h) a += wvv[h] * (float)qf[h][ks][j];
            qs[ks][j] = (h16)a; }
    const int nkeys = t0 + 16, nslab = (nkeys + IX_SK - 1) / IX_SK;
    LAS unsigned* ordq = (LAS unsigned*)(lds + IX_ORD) + (size_t)q * IX_CAP; LAS unsigned short* keyq = (LAS unsigned short*)(lds + IX_KEY) + (size_t)q * IX_CAP;
    IxBuf BA, BB;
    BA.ord = (LAS unsigned*)(lds + IX_ORD) + (size_t)(2 * wv) * IX_CAP; BA.key = (LAS unsigned short*)(lds + IX_KEY) + (size_t)(2 * wv) * IX_CAP;
    BB.ord = BA.ord + IX_CAP; BB.key = BA.key + IX_CAP;
    LAS unsigned short* outl = (LAS unsigned short*)(lds + IX_HIST) + wv * 256;
    unsigned TA = 0x00800000u, TB = 0x00800000u; float tq = -3.402823466e38f;
    __syncthreads();
#define IX_LOADK(dst, s_) do { const int sc_ = (s_) < nslab - 1 ? (s_) : nslab - 1; _Pragma("unroll") for (int jt_ = 0; jt_ < 2; ++jt_) { int key0_ = sc_ * IX_SK + 32 * wv + 16 * jt_; key0_ = key0_ < nkeys ? key0_ : nkeys - 16; \
        const h16* p_ = KI + ((size_t)(key0_ >> 4) * 128 + lane) * 8;        \
        asm volatile("global_load_dwordx4 %0, %2, off\n\tglobal_load_dwordx4 %1, %2, off offset:1024" : "=&v"(dst[jt_][0]), "=&v"(dst[jt_][1]) : "v"(p_) : "memory"); } } while (0)
#define IX_WAITK(KF) asm volatile("s_waitcnt vmcnt(4)" : "+v"(KF[0][0]), "+v"(KF[0][1]), "+v"(KF[1][0]), "+v"(KF[1][1]) :: "memory")
#define IX_MM2(KF, A_, B_, Q0, Q1) do { A_ = __builtin_amdgcn_mfma_f32_16x16x32_f16(KF[0][0], Q0, (f32x4){0.f, 0.f, 0.f, 0.f}, 0, 0, 0); B_ = __builtin_amdgcn_mfma_f32_16x16x32_f16(KF[1][0], Q0, (f32x4){0.f, 0.f, 0.f, 0.f}, 0, 0, 0); \
        A_ = __builtin_amdgcn_mfma_f32_16x16x32_f16(KF[0][1], Q1, A_, 0, 0, 0); B_ = __builtin_amdgcn_mfma_f32_16x16x32_f16(KF[1][1], Q1, B_, 0, 0, 0); } while (0)
#define IX_SCORE2(KF, sca, scb) do { \
        f32x4 ta_[2], tb_[2]; \
        IX_MM2(KF, sca, scb, qs[0], qs[1]); IX_MM2(KF, ta_[0], tb_[0], qf[0][0], qf[0][1]); \
        _Pragma("unroll") for (int h = 0; h < 8; ++h) {        \
            __builtin_amdgcn_sched_barrier(0); \
            if (h < 7) IX_MM2(KF, ta_[(h + 1) & 1], tb_[(h + 1) & 1], qf[h + 1][0], qf[h + 1][1]); \
            __builtin_amdgcn_sched_barrier(0); \
            _Pragma("unroll") for (int i = 0; i < 4; ++i) { sca[i] = __builtin_fmaf(wvv[h], __builtin_fabsf(ta_[h & 1][i]), sca[i]); asm("" : "+v"(sca[i])); }   \
            _Pragma("unroll") for (int i = 0; i < 4; ++i) { scb[i] = __builtin_fmaf(wvv[h], __builtin_fabsf(tb_[h & 1][i]), scb[i]); asm("" : "+v"(scb[i])); } } \
        __builtin_amdgcn_sched_barrier(0); } while (0)
#define IX_SCORE(KF, sc, jt, key0) do { \
        sc = __builtin_amdgcn_mfma_f32_16x16x32_f16(KF[jt][0], qs[0], (f32x4){0.f, 0.f, 0.f, 0.f}, 0, 0, 0); sc = __builtin_amdgcn_mfma_f32_16x16x32_f16(KF[jt][1], qs[1], sc, 0, 0, 0); \
        _Pragma("unroll") for (int h = 0; h < 8; ++h) { f32x4 a = {0.f, 0.f, 0.f, 0.f}; \
            a = __builtin_amdgcn_mfma_f32_16x16x32_f16(KF[jt][0], qf[h][0], a, 0, 0, 0); a = __builtin_amdgcn_mfma_f32_16x16x32_f16(KF[jt][1], qf[h][1], a, 0, 0, 0); \
            _Pragma("unroll") for (int i = 0; i < 4; ++i) { sc[i] = __builtin_fmaf(wvv[h], __builtin_fabsf(a[i]), sc[i]); asm("" : "+v"(sc[i])); } } } while (0)
#define IX_MASK(sc, key0) do { if ((key0) + 15 > t0) {        \
            _Pragma("unroll") for (int i = 0; i < 4; ++i) if ((key0) + 4 * c + i > t0 + q) sc[i] = -INFINITY; } } while (0)
#define IX_ASK(sc, ps, pos) do { _Pragma("unroll") for (int i = 0; i < 4; ++i) { ps[i] = sc[i] >= tq; pos[i] = 0u; if (ps[i]) pos[i] = __hip_atomic_fetch_add(cntl + q, 1u, __ATOMIC_RELAXED, __HIP_MEMORY_SCOPE_WORKGROUP); } } while (0)
#define IX_PUT(sc, ps, pos, key0) do { _Pragma("unroll") for (int i = 0; i < 4; ++i) if (ps[i]) { ordq[pos[i]] = ordered_u32(sc[i] + 0.0f); keyq[pos[i]] = (unsigned short)(0xFFFFu - (unsigned)((key0) + 4 * c + i)); } } while (0)
#define IX_STEP(sv, KF) do { const int s_ = (sv); if (s_ < nslab) { \
        IX_WAITK(KF); \
        const int key0a = s_ * IX_SK + (2 * wv) * 16, key0b = key0a + 16; \
        const bool hb = key0b < nkeys;                                 \
        if (key0a < nkeys) { \
            f32x4 sca, scb; bool psa[4], psb[4]; unsigned posa[4], posb[4]; \
            if (hb) { IX_SCORE2(KF, sca, scb); IX_MASK(sca, key0a); IX_MASK(scb, key0b); \
                if (!IX_PROBE_NOFILT) { IX_ASK(sca, psa, posa); IX_ASK(scb, psb, posb); IX_PUT(sca, psa, posa, key0a); IX_PUT(scb, psb, posb, key0b); } } \
            else { IX_SCORE(KF, sca, 0, key0a); IX_MASK(sca, key0a); if (!IX_PROBE_NOFILT) { IX_ASK(sca, psa, posa); IX_PUT(sca, psa, posa, key0a); } } \
        } \
        IX_LOADK(KF, s_ + 2);                                         \
        LDS_WAIT(); \
        __syncthreads(); \
        const unsigned mycnt = cntl[q];                               \
        if (__ballot(mycnt > (unsigned)(IX_CAP - IX_SK)) != 0ull) {       \
            int ca = (int)cntl[2 * wv], cb = (int)cntl[2 * wv + 1]; ca = ca < IX_CAP ? ca : IX_CAP; cb = cb < IX_CAP ? cb : IX_CAP; \
            if (ca > 512) { TA = ix_compact(BA, lane, ca, TA); if (lane == 0) { cntl[2 * wv] = (unsigned)ca; taul[2 * wv] = ix_unordered(TA); } } \
            if (cb > 512) { TB = ix_compact(BB, lane, cb, TB); if (lane == 0) { cntl[2 * wv + 1] = (unsigned)cb; taul[2 * wv + 1] = ix_unordered(TB); } } \
            LDS_WAIT(); \
            __syncthreads(); \
            tq = taul[q]; } \
        } } while (0)
    h8 ka[2][2], kb[2][2];
    asm volatile("s_waitcnt vmcnt(0)" ::: "memory");
    IX_LOADK(ka, 0); IX_LOADK(kb, 1);
    for (int s = 0; s < nslab; s += 2) { IX_STEP(s, ka); IX_STEP(s + 1, kb); }
    asm volatile("s_waitcnt vmcnt(0)" : "+v"(ka[0][0]), "+v"(ka[0][1]), "+v"(ka[1][0]), "+v"(ka[1][1]), "+v"(kb[0][0]), "+v"(kb[0][1]), "+v"(kb[1][0]), "+v"(kb[1][1]) :: "memory");
#undef IX_STEP
#undef IX_SCORE
#undef IX_SCORE2
#undef IX_MM2
#undef IX_MASK
#undef IX_ASK
#undef IX_PUT
#undef IX_LOADK
#undef IX_WAITK
    LDS_WAIT();
    if (IX_PROBE_FINAL) return;
    unsigned short* IDX = (unsigned short*)(C.ws + WS_IDX); int* NV = (int*)(C.ws + WS_NV);
    int ca = (int)cntl[2 * wv], cb = (int)cntl[2 * wv + 1]; ca = ca < IX_CAP ? ca : IX_CAP; cb = cb < IX_CAP ? cb : IX_CAP;
    ix_final(BA, outl, lane, ca, TA, IDX + (m0 + 2 * wv) * 256, NV + m0 + 2 * wv, C.dry);
    ix_final(BB, outl, lane, cb, TB, IDX + (m0 + 2 * wv + 1) * 256, NV + m0 + 2 * wv + 1, C.dry);
}


constexpr int AT_CH = 4096;
constexpr int AT_NR = 4;
constexpr int AT_WAVE = AT_NR * AT_CH + 1024;
constexpr int AT_TAB = 8 * AT_WAVE;
constexpr int AT_QN = AT_TAB + 129 * 8 * 4;
constexpr int AT_END = AT_QN + 512;
static_assert(AT_END + 1024 <= MISC_OFF && (AT_WAVE % 16) == 0 && (AT_QN % 16) == 0, "attention LDS");
constexpr int AT_QPW = 8;
__device__ __forceinline__ int at_f(int row) { return 2 * ((row >> 1) & 3) | ((row >> 3) & 1); }

__device__ __forceinline__ void attn_build_tab(const Ctx& C, LAS unsigned char* lds) {
    LAS float* tab = (LAS float*)(lds + AT_TAB);
    for (int e = threadIdx.x; e < 129 * 8; e += NTHR) { const int d = e >> 3, h = e & 7; int bk;
        if (d < 16) bk = d; else { bk = 16 + (int)(logf((float)d / 16.0f) / 2.0794415416798357f * 16.0f); if (bk > 31) bk = 31; }
        tab[e] = C.relb[bk * 8 + h]; }
    if (threadIdx.x < 128) ((LAS float*)(lds + AT_QN))[threadIdx.x] = C.qn[threadIdx.x];
}
__device__ __forceinline__ void at_issue(const unsigned char* base, const LAS unsigned short* idl, int pos0, LAS unsigned char* buf, int lane) {
#pragma unroll
    for (int k2 = 0; k2 < 4; ++k2) { const int row = (lane >> 3) + 8 * k2, slot = lane & 7; const int idx = idl[pos0 + row];
        __builtin_amdgcn_global_load_lds((const unsigned*)(base + (size_t)idx * 256 + ((slot ^ at_f(row)) << 4)), (LAS unsigned*)(buf + k2 * 1024), 16, 0, 0); }
}
__device__ __forceinline__ unsigned pk4_fp8(float a, float b, float c, float d) { int w = 0; w = __builtin_amdgcn_cvt_pk_fp8_f32(a, b, w, false); w = __builtin_amdgcn_cvt_pk_fp8_f32(c, d, w, true); return (unsigned)w; }
__device__ __forceinline__ long mk64(unsigned lo, unsigned hi) { return (long)(((u64)hi << 32) | (u64)lo); }
#define AT_WAITN(n) asm volatile("s_waitcnt vmcnt(" #n ")" ::: "memory")

__device__ __forceinline__ void attn_item(const Ctx& C, LAS unsigned char* lds, int item) {
    int tid = threadIdx.x; asm volatile("" : "+v"(tid));
    const int lane = tid & 63, wv = __builtin_amdgcn_readfirstlane(tid >> 6);
    const int g = lane & 15, c = lane >> 4, gq = g & 3;
    const int qsel = item / (SEQ / (8 * AT_QPW)), b = qsel >> 1, n = qsel & 1, tbase = (item % (SEQ / (8 * AT_QPW))) * (8 * AT_QPW) + wv;
    LAS unsigned char* ring = lds + wv * AT_WAVE;
    LAS unsigned short* idlb = (LAS unsigned short*)(ring + AT_NR * AT_CH);
    const LAS float* tab = (const LAS float*)(lds + AT_TAB);
    const LAS float* qnl = (const LAS float*)(lds + AT_QN);
    const unsigned char* Kb = (const unsigned char*)(C.ws + WS_K8) + (size_t)b * SEQ * 256 + n * 128; const unsigned char* Vb = (const unsigned char*)(C.ws + WS_V8) + (size_t)b * SEQ * 256 + n * 128;
    const unsigned short* IDXb = (const unsigned short*)(C.ws + WS_IDX) + (size_t)b * SEQ * 256; const int* NVb = (const int*)(C.ws + WS_NV) + (size_t)b * SEQ;
    h16* Qb = (h16*)(C.ws + WS_Q) + (size_t)b * SEQ * DM + n * 512;
    const int fg = at_f(g), q4 = g >> 2, p4 = g & 3, rowA = 4 * c + q4, fr = at_f(rowA);
    u32x2 a_idx; int a_nv; h8 a_q[4];
#define AT_STAGE_A(tq) do { const size_t m_ = (size_t)(tq); a_idx = *(const u32x2*)(IDXb + m_ * 256 + lane * 4); a_nv = NVb[m_]; \
        _Pragma("unroll") for (int ks = 0; ks < 4; ++ks) a_q[ks] = *(const h8*)(Qb + m_ * DM + gq * 128 + 32 * c + 8 * ks); } while (0)
#define AT_STAGE_B(idl_, qf_, nv_) do { nv_ = a_nv; { const int p0 = lane * 4; unsigned s0 = a_idx.x & 0xFFFFu, s1 = a_idx.x >> 16, s2 = a_idx.y & 0xFFFFu, s3 = a_idx.y >> 16; \
          if (p0 + 0 >= nv_) s0 = 0; if (p0 + 1 >= nv_) s1 = 0; if (p0 + 2 >= nv_) s2 = 0; if (p0 + 3 >= nv_) s3 = 0; \
          u32x2 o_; o_.x = s0 | (s1 << 16); o_.y = s2 | (s3 << 16); *(LAS u32x2*)((idl_) + lane * 4) = o_; } \
        float ss_ = 0.f; _Pragma("unroll") for (int ks = 0; ks < 4; ++ks) _Pragma("unroll") for (int e = 0; e < 8; ++e) { const float x_ = (float)a_q[ks][e]; ss_ += x_ * x_; } \
        ss_ += __shfl_xor(ss_, 16); ss_ += __shfl_xor(ss_, 32); \
        const float rs_ = g < 4 ? __builtin_amdgcn_rsqf(ss_ * (1.0f / 128.0f) + EPS) : 0.f; \
        _Pragma("unroll") for (int ks = 0; ks < 4; ++ks) { const f32x4 g0 = *(const LAS f32x4*)(qnl + 32 * c + 8 * ks), g1 = *(const LAS f32x4*)(qnl + 32 * c + 8 * ks + 4); \
            qf_[ks] = mk64(pk4_fp8((float)a_q[ks][0] * rs_ * g0[0], (float)a_q[ks][1] * rs_ * g0[1], (float)a_q[ks][2] * rs_ * g0[2], (float)a_q[ks][3] * rs_ * g0[3]), \
                           pk4_fp8((float)a_q[ks][4] * rs_ * g1[0], (float)a_q[ks][5] * rs_ * g1[1], (float)a_q[ks][6] * rs_ * g1[2], (float)a_q[ks][7] * rs_ * g1[3])); } \
        LDS_WAIT(); } while (0)
    long qf[4]; int nv;
    AT_STAGE_A(tbase);
    AT_STAGE_B(idlb, qf, nv);
    AT_WAITN(0);
#pragma unroll
    for (int i = 0; i < AT_NR; ++i) at_issue(Kb, idlb, 32 * i, ring + i * AT_CH, lane);
#pragma unroll 1
    for (int k = 0; k < AT_QPW; ++k) {
        const int t = tbase + 8 * k, tn = k + 1 < AT_QPW ? t + 8 : t;
        const LAS unsigned short* idl = idlb + (k & 1) * 256; LAS unsigned short* idln = idlb + ((k + 1) & 1) * 256;
        float S[16][4];
#pragma unroll
        for (int kc = 0; kc < 8; ++kc) {
            LAS unsigned char* buf = ring + (kc & 3) * AT_CH;
            if (kc <= 4) AT_WAITN(12); else AT_WAITN(18);
#pragma unroll
            for (int j = 0; j < 2; ++j) { f32x4 a = {0.f, 0.f, 0.f, 0.f};
                const u32x4 A0 = *(const LAS u32x4*)(buf + (16 * j + g) * 128 + (((2 * c) ^ fg) << 4)), A1 = *(const LAS u32x4*)(buf + (16 * j + g) * 128 + (((2 * c + 1) ^ fg) << 4));
                a = __builtin_amdgcn_mfma_f32_16x16x32_fp8_fp8(mk64(A0.x, A0.y), qf[0], a, 0, 0, 0); a = __builtin_amdgcn_mfma_f32_16x16x32_fp8_fp8(mk64(A0.z, A0.w), qf[1], a, 0, 0, 0);
                a = __builtin_amdgcn_mfma_f32_16x16x32_fp8_fp8(mk64(A1.x, A1.y), qf[2], a, 0, 0, 0); a = __builtin_amdgcn_mfma_f32_16x16x32_fp8_fp8(mk64(A1.z, A1.w), qf[3], a, 0, 0, 0);
#pragma unroll
                for (int i = 0; i < 4; ++i) S[2 * kc + j][i] = a[i]; }
            LDS_WAIT();
            if (kc < 4) at_issue(Kb, idl, 32 * (kc + 4), buf, lane); else at_issue(Vb, idl, 32 * (kc - 4), buf, lane);
            if (kc == 4) AT_STAGE_A(tn);
        }
        const int rq = g >> 2;
        float V[4][4];
#pragma unroll
        for (int kk = 0; kk < 4; ++kk)
#pragma unroll
            for (int i = 0; i < 4; ++i) { int v = __builtin_bit_cast(int, S[kk][i]);
                v = __builtin_amdgcn_update_dpp(v, __builtin_bit_cast(int, S[4 + kk][i]), 0x114, 0xf, 0x2, false);
                v = __builtin_amdgcn_update_dpp(v, __builtin_bit_cast(int, S[8 + kk][i]), 0x118, 0xf, 0x4, false);
                v = __builtin_amdgcn_update_dpp(v, __builtin_bit_cast(int, S[12 + kk][i]), 0x11c, 0xf, 0x8, false);
                V[kk][i] = __builtin_bit_cast(float, v); }
        float mx = -INFINITY; const int nvc = nv - 4 * c - 64 * rq;
#pragma unroll
        for (int kk = 0; kk < 4; ++kk) { const u32x2 iw = *(const LAS u32x2*)(idl + 64 * rq + 16 * kk + 4 * c);
            const int ki[4] = {(int)(iw.x & 0xFFFFu), (int)(iw.x >> 16), (int)(iw.y & 0xFFFFu), (int)(iw.y >> 16)};
#pragma unroll
            for (int i = 0; i < 4; ++i) { int dist = t - ki[i]; dist = dist < 0 ? 0 : (dist > 128 ? 128 : dist);
                const float sv = V[kk][i] * 0.08838834764831845f + tab[dist * 8 + 4 * n + gq];
                const float s = (16 * kk + i) < nvc ? sv : -INFINITY; V[kk][i] = s; mx = fmaxf(mx, s); } }
        mx = fmaxf(mx, __builtin_bit_cast(float, __builtin_amdgcn_update_dpp(0, __builtin_bit_cast(int, mx), 0x124, 0xf, 0xf, false)));
        mx = fmaxf(mx, __builtin_bit_cast(float, __builtin_amdgcn_update_dpp(0, __builtin_bit_cast(int, mx), 0x128, 0xf, 0xf, false)));
        mx = fmaxf(mx, __shfl_xor(mx, 16)); mx = fmaxf(mx, __shfl_xor(mx, 32));
        float sum = 0.f; unsigned Pq[4];
#pragma unroll
        for (int kk = 0; kk < 4; ++kk) { float p[4];
#pragma unroll
            for (int i = 0; i < 4; ++i) { p[i] = __builtin_amdgcn_exp2f((V[kk][i] - mx) * 1.4426950408889634f); sum += p[i]; }
            Pq[kk] = pk4_fp8(p[0] * 256.0f, p[1] * 256.0f, p[2] * 256.0f, p[3] * 256.0f); }
        sum += __builtin_bit_cast(float, __builtin_amdgcn_update_dpp(0, __builtin_bit_cast(int, sum), 0x124, 0xf, 0xf, false));
        sum += __builtin_bit_cast(float, __builtin_amdgcn_update_dpp(0, __builtin_bit_cast(int, sum), 0x128, 0xf, 0xf, false));
        sum += __shfl_xor(sum, 16); sum += __shfl_xor(sum, 32);
        unsigned P8[16];
#pragma unroll
        for (int kk = 0; kk < 4; ++kk) { P8[kk] = Pq[kk];
            P8[4 + kk] = (unsigned)__builtin_amdgcn_update_dpp(0, (int)Pq[kk], 0x104, 0xf, 0xf, true);
            P8[8 + kk] = (unsigned)__builtin_amdgcn_update_dpp(0, (int)Pq[kk], 0x108, 0xf, 0xf, true);
            P8[12 + kk] = (unsigned)__builtin_amdgcn_update_dpp(0, (int)Pq[kk], 0x10c, 0xf, 0xf, true); }
        long qfn[4]; int nvn;
        AT_STAGE_B(idln, qfn, nvn);
        f32x4 oe[4], oo[4];
#pragma unroll
        for (int dt = 0; dt < 4; ++dt) { oe[dt] = (f32x4){0.f, 0.f, 0.f, 0.f}; oo[dt] = (f32x4){0.f, 0.f, 0.f, 0.f}; }
#pragma unroll
        for (int vc = 0; vc < 8; ++vc) {
            LAS unsigned char* buf = ring + (vc & 3) * AT_CH;
            if (vc == 0) AT_WAITN(18); else AT_WAITN(12);
            const long pf = mk64(P8[2 * vc], P8[2 * vc + 1]);
            u32x2 t0[4], t1[4];
            const unsigned ba = (unsigned)(size_t)buf;
#pragma unroll
            for (int dt = 0; dt < 4; ++dt) { const unsigned ad = ba + (unsigned)(rowA * 128 + (((2 * dt + (p4 >> 1)) ^ fr) << 4) + 8 * (p4 & 1));
                asm volatile("ds_read_b64_tr_b16 %0, %1" : "=&v"(t0[dt]) : "v"(ad) : "memory");
                asm volatile("ds_read_b64_tr_b16 %0, %1 offset:2048" : "=&v"(t1[dt]) : "v"(ad) : "memory"); }
            asm volatile("s_waitcnt lgkmcnt(0)" : "+v"(t0[0]), "+v"(t0[1]), "+v"(t0[2]), "+v"(t0[3]), "+v"(t1[0]), "+v"(t1[1]), "+v"(t1[2]), "+v"(t1[3]) :: "memory");
#pragma unroll
            for (int dt = 0; dt < 4; ++dt) {
                const long be = mk64(__builtin_amdgcn_perm(t0[dt].y, t0[dt].x, 0x06040200u), __builtin_amdgcn_perm(t1[dt].y, t1[dt].x, 0x06040200u));
                const long bo = mk64(__builtin_amdgcn_perm(t0[dt].y, t0[dt].x, 0x07050301u), __builtin_amdgcn_perm(t1[dt].y, t1[dt].x, 0x07050301u));
                oe[dt] = __builtin_amdgcn_mfma_f32_16x16x32_fp8_fp8(pf, be, oe[dt], 0, 0, 0); oo[dt] = __builtin_amdgcn_mfma_f32_16x16x32_fp8_fp8(pf, bo, oo[dt], 0, 0, 0); }
            if (vc < 4) at_issue(Vb, idl, 32 * (vc + 4), buf, lane); else at_issue(Kb, idln, 32 * (vc - 4), buf, lane);
        }
        float inv[4];
#pragma unroll
        for (int i = 0; i < 4; ++i) inv[i] = 1.0f / (256.0f * __shfl(sum, i));
        h16* Qo = Qb + (size_t)t * DM;
        LAS unsigned char* st = (LAS unsigned char*)(idlb + (k & 1) * 256);
#pragma unroll
        for (int hp = 0; hp < 2; ++hp) {
            if (c == 0) {
#pragma unroll
                for (int dt = 0; dt < 4; ++dt)
#pragma unroll
                    for (int i2 = 0; i2 < 2; ++i2) *(LAS unsigned*)(st + (i2 * 128 + 32 * dt + 2 * g) * 2) = pkh(oe[dt][2 * hp + i2] * inv[2 * hp + i2], oo[dt][2 * hp + i2] * inv[2 * hp + i2]);
            }
            LDS_WAIT();
            if (lane < 32) { const u32x4 ow = *(const LAS u32x4*)(st + lane * 16); if (!C.dry) *(u32x4*)(Qo + hp * 256 + lane * 8) = ow; }
            LDS_WAIT();
        }
#pragma unroll
        for (int ks = 0; ks < 4; ++ks) qf[ks] = qfn[ks];
        nv = nvn;
    }
    AT_WAITN(0);
#undef AT_STAGE_A
#undef AT_STAGE_B
}

__device__ __forceinline__ void act_phase(const Ctx& C, int gtid, int gthreads) {
    const h16* G = (const h16*)(C.ws + WS_UPG); h16* V = (h16*)(C.ws + WS_UPV);
    constexpr int NCG = DFF / 8, NITEM = (MTOK / 16) * NCG;
    for (int it = gtid; it < NITEM; it += gthreads) {
        const int cg = it % NCG, rb = it / NCG, c0 = cg * 8, r0 = rb * 16;
        float w[3][8], bb[8];
#pragma unroll
        for (int j = 0; j < 3; ++j) { const f32x4 a = *(const f32x4*)(C.fcw + j * DFF + c0), b2 = *(const f32x4*)(C.fcw + j * DFF + c0 + 4); for (int e = 0; e < 4; ++e) { w[j][e] = a[e]; w[j][4 + e] = b2[e]; } }
        { const f32x4 a = *(const f32x4*)(C.fcb + c0), b2 = *(const f32x4*)(C.fcb + c0 + 4); for (int e = 0; e < 4; ++e) { bb[e] = a[e]; bb[4 + e] = b2[e]; } }
        h8 gm2, gm1;
        const int tseq = r0 & (SEQ - 1);
        if (tseq >= 2) { gm2 = *(const h8*)(G + (size_t)(r0 - 2) * DFF + c0); gm1 = *(const h8*)(G + (size_t)(r0 - 1) * DFF + c0); }
        else { for (int e = 0; e < 8; ++e) { gm2[e] = (h16)0.f; gm1[e] = (h16)0.f; } }
#pragma unroll 4
        for (int r = 0; r < 16; ++r) { const size_t off = (size_t)(r0 + r) * DFF + c0;
            const h8 g0 = *(const h8*)(G + off), vv = *(const h8*)(V + off);
            float y[8];
#pragma unroll
            for (int e = 0; e < 8; ++e) { const float gf = bb[e] + w[0][e] * (float)gm2[e] + w[1][e] * (float)gm1[e] + w[2][e] * (float)g0[e]; y[e] = gelu_tanh(gf) * (float)vv[e]; }
            u32x4 o; o.x = pkh(y[0], y[1]); o.y = pkh(y[2], y[3]); o.z = pkh(y[4], y[5]); o.w = pkh(y[6], y[7]);
            if (!C.dry) *(u32x4*)(V + off) = o; gm2 = gm1; gm1 = g0; }
    }
}

__device__ __forceinline__ void p0_prologue(const Params& P, LAS unsigned char* lds) {
    const int tid = threadIdx.x, lane = tid & 63, wv = tid >> 6;
    LAS float* scr = (LAS float*)(lds + wv * 16384);
    const int gw = blockIdx.x * NWAVES + wv, NGW = gridDim.x * NWAVES;
    unsigned char* ws = P.ws;
    const float* w_in = P.in[3];
    constexpr int I_IN = 16 * 195;
    for (int it = gw; it < I_IN + 16 * 8; it += NGW) {
        if (it < I_IN) { p0_transpose_item<1>(w_in, DM, NIN, (h16*)(ws + W_IN), nullptr, scr, it, lane); continue; }
        const int r = it - I_IN, blk = r / 16, rr = r % 16, which = rr / 8, it2 = rr % 8;
        p0_transpose_item<0>((which ? P.in[8] : P.in[6]) + (size_t)blk * 128 * 128, 128, 128, (h16*)(ws + W_GATE) + (size_t)blk * 256 * 128 + (size_t)which * 128 * 128, nullptr, scr, it2, lane); }
    { u32x4* z = (u32x4*)((h16*)(ws + W_IN) + (size_t)4168 * DM); const int nz = 184 * DM * 2 / 16;
      for (int i = blockIdx.x * NTHR + tid; i < nz; i += gridDim.x * NTHR) z[i] = (u32x4){0u, 0u, 0u, 0u}; }
    { const float* x = P.in[0]; const float* gn = P.in[2]; h16* A0 = (h16*)(ws + WS_A0);
      f32x4 gv[4];
#pragma unroll
      for (int j = 0; j < 4; ++j) gv[j] = *(const f32x4*)(gn + 4 * lane + 256 * j);
      for (int m = gw; m < MTOK; m += NGW) { const f32x4* xr = (const f32x4*)(x + (size_t)m * DM) + lane; f32x4 v[4]; float s = 0.f;
#pragma unroll
          for (int j = 0; j < 4; ++j) { v[j] = xr[64 * j]; s += (v[j].x * v[j].x + v[j].y * v[j].y) + (v[j].z * v[j].z + v[j].w * v[j].w); }
          const float rs = __builtin_amdgcn_rsqf(wave_sum(s) * (1.0f / DM) + EPS);
          u32x2* o8 = (u32x2*)(A0 + (size_t)m * DM) + lane;
#pragma unroll
          for (int j = 0; j < 4; ++j) { u32x2 w; w.x = pkh(v[j].x * rs * gv[j].x, v[j].y * rs * gv[j].y); w.y = pkh(v[j].z * rs * gv[j].z, v[j].w * rs * gv[j].w); o8[64 * j] = w; } } }
}
constexpr int PD_SQ = 16 * 32, PD_UP = 16 * 192, PD_DN = 48 * 32, PD_PP = 4 * 32, PD_NTR = 4 * PD_SQ + PD_UP + PD_DN + PD_PP, PD_NT = PD_NTR / 32, PD_NP = MTOK * PLE / 4 / 8192;
static_assert(PD_NTR % 32 == 0, "deferred transposes");
__device__ __forceinline__ void p0_deferred_item(const Params& P, LAS unsigned char* lds, int item) {
    int tid = threadIdx.x; asm volatile("" : "+v"(tid));
    const int lane = tid & 63, wv = tid >> 6;
    unsigned char* ws = P.ws;
    if (item >= PD_NT) { const f32x4* p4 = (const f32x4*)P.in[1] + (size_t)(item - PD_NT) * 8192; u32x2* o = (u32x2*)(ws + WS_PH) + (size_t)(item - PD_NT) * 8192;
#pragma unroll 4
        for (int i = tid; i < 8192; i += NTHR) { const f32x4 v = p4[i]; u32x2 w; w.x = pkh(v.x, v.y); w.y = pkh(v.z, v.w); o[i] = w; }
        return; }
    LAS float* scr = (LAS float*)(lds + wv * 16384);
    const float *w_lru = P.in[14], *w_att = P.in[15], *w_out = P.in[16], *w_up = P.in[18], *w_down = P.in[21], *w_pg = P.in[23], *w_pp = P.in[24];
    for (int k = 0; k < 4; ++k) {
        int r = item * 32 + wv * 4 + k;
        if (r < PD_SQ) { p0_transpose_item<0>(w_lru, DM, DM, (h16*)(ws + W_LRU), nullptr, scr, r, lane); continue; } r -= PD_SQ;
        if (r < PD_SQ) { p0_transpose_item<0>(w_att, DM, DM, (h16*)(ws + W_ATT), nullptr, scr, r, lane); continue; } r -= PD_SQ;
        if (r < PD_SQ) { p0_transpose_item<0>(w_out, DM, DM, (h16*)(ws + W_OUT), nullptr, scr, r, lane); continue; } r -= PD_SQ;
        if (r < PD_SQ) { p0_transpose_item<0>(w_pg, DM, DM, (h16*)(ws + W_PG), P.in[22], scr, r, lane); continue; } r -= PD_SQ;
        if (r < PD_UP) { p0_transpose_item<2>(w_up, DM, 2 * DFF, (h16*)(ws + W_UP), P.in[17], scr, r, lane); continue; } r -= PD_UP;
        if (r < PD_DN) { p0_transpose_item<0>(w_down, DFF, DM, (h16*)(ws + W_DOWN), nullptr, scr, r, lane); continue; } r -= PD_DN;
        p0_transpose_item<0>(w_pp, PLE, DM, (h16*)(ws + W_PP), nullptr, scr, r, lane);
    }
}

__device__ __forceinline__ int next_unit(unsigned* head, volatile LAS unsigned* slot) {
    __syncthreads();
    if (threadIdx.x == 0) *slot = __hip_atomic_fetch_add(head, 1u, __ATOMIC_RELAXED, __HIP_MEMORY_SCOPE_AGENT);
    __syncthreads();
    return (int)*slot;
}

constexpr int NPHASE = 10;
__global__ void __launch_bounds__(NTHR, 2) fwd(Params P) {
    extern __shared__ __attribute__((aligned(16))) unsigned char lds_raw[];
    LAS unsigned char* lds = (LAS unsigned char*)lds_raw;
    volatile LAS unsigned* MISC = (volatile LAS unsigned*)(lds + MISC_OFF);
    const int tid = threadIdx.x;
    if (tid < 64) MISC[tid] = 0u;
    __syncthreads();
    unsigned char* ws = P.ws;
    unsigned* ctl = (unsigned*)(ws + WS_CTL);
    const int lo = P.ph_lo, hi = P.ph_hi;
    XcdBarrier bar; bar.bar = ctl + CW_BAR; bar.x = 0; bar.st = MISC;
    if (hi - lo > 1) bar = xcd_barrier_post(ctl + CW_BAR, MISC);
    const int dry = P.pad;
    Ctx C; C.ws = ws; C.out = P.out; C.dry = dry; C.conv_w = P.in[4]; C.conv_b = P.in[5]; C.ba = P.in[7]; C.bx = P.in[9]; C.lam = P.in[10]; C.qn = P.in[11]; C.kn = P.in[12]; C.relb = P.in[13]; C.fcw = P.in[19]; C.fcb = P.in[20];
    float* SSQ1 = (float*)(ws + CTL_SSQ1); float* SSQ2 = (float*)(ws + CTL_SSQ2);
#ifdef ONLY_PHASE
#define IN(k) ((k) == ONLY_PHASE)
#else
#define IN(k) (lo <= (k) && (k) < hi)
#endif
#define SEAM(k) do { if (IN(k) && IN((k) + 1)) xcd_barrier(bar); } while (0)

    if (IN(0)) { p0_prologue(P, lds); } SEAM(0);

    if (IN(1)) {
        pg8::Gemm g{(const h16*)(ws + WS_A0), (const h16*)(ws + W_IN), MTOK, NIN_PAD, DM}; pg8::StaticOrder S; S.init(MTOK, NIN_PAD, gridDim.x, blockIdx.x);
        EpiIn E{(h16*)(ws + WS_LX), (h16*)(ws + WS_GG), (h16*)(ws + WS_Q), (h16*)(ws + WS_K), (h16*)(ws + WS_V), (h16*)(ws + WS_QI), (h16*)(ws + WS_KI), (h16*)(ws + WS_SGA), (h16*)(ws + WS_SGB), (float*)(ws + WS_WI), dry};
        pg8::gemm_phase<EpiIn>(lds, g, S, E);
    } SEAM(1);

    if (IN(2)) {
        constexpr int N_IX = NB * (SEQ / 16), N_L1 = NB * 64 * 8 / 4, N_KN = MTOK / 128 / 4, N_PD = PD_NT + PD_NP, N_SM = N_KN + N_PD, N_BIG = N_L1 + N_IX, N_ALL = N_BIG + N_SM;
        static_assert(N_BIG >= 4 * N_SM, "interleave");
        unsigned* head = ctl + CW_Q2 + 128 * dry;
        int u = next_unit(head, MISC + 4);
        for (int it = 0; u < N_ALL; ++it) {
            unsigned nxt = 0u;
            if (tid == 0) nxt = __hip_atomic_fetch_add(head, 1u, __ATOMIC_RELAXED, __HIP_MEMORY_SCOPE_AGENT);
            int kind, idx;
            { int big = -1, sm = -1;
              if (u < 5 * N_SM) { if (u % 5 == 4) sm = u / 5; else big = 4 * (u / 5) + u % 5; } else big = u - N_SM;
              if (big >= 0) { if (big < N_L1) { kind = 1; idx = big; } else { kind = 0; idx = big - N_L1; } }
              else { if (sm < N_KN) { kind = 2; idx = sm; } else { kind = 3; idx = sm - N_KN; } } }
#ifdef PROBE_P2_KIND
            if (!(dry && kind != PROBE_P2_KIND))
#endif
            {
            if (kind == 0) indexer_unit(C, lds, idx);
            else if (kind == 1) lru1_item(C, lds, idx);
            else if (kind == 2) { for (int k = 0; k < 4; ++k) knorm_unit(C, idx * 4 + k); }
            else p0_deferred_item(P, lds, idx);
            }
            if (tid == 0) MISC[6 + (it & 1)] = nxt;
            __syncthreads();
            u = (int)MISC[6 + (it & 1)];
        }
    } SEAM(2);

    if (IN(3)) {
        constexpr int N_AQ = SEQ / (8 * AT_QPW), N_L2 = NB * 64 * 8 / 4;
        attn_build_tab(C, lds);
        unsigned* qh = ctl + CW_Q3 + 2048 * dry;
        if (tid == 0) MISC[5] = 0u;
        for (;;) {
            __syncthreads();
            if (tid == 0) { const unsigned x = xb_xcc_id() & 7u; unsigned k = MISC[5]; int u = -1;
                for (; k < 8u; ++k) { const unsigned q = (x + k) & 7u; const unsigned v = __hip_atomic_fetch_add(qh + 64 * q, 1u, __ATOMIC_RELAXED, __HIP_MEMORY_SCOPE_AGENT); if (v < (unsigned)N_AQ) { u = (int)(q * N_AQ + v); break; } }
                MISC[5] = k;
                if (u < 0) { const unsigned v = __hip_atomic_fetch_add(qh + 64 * 8, 1u, __ATOMIC_RELAXED, __HIP_MEMORY_SCOPE_AGENT); u = v < (unsigned)N_L2 ? (int)(8 * N_AQ + v) : -1; }
                MISC[4] = (unsigned)u; }
            __syncthreads();
            const int u = (int)MISC[4];
            if (u < 0) break;
            if (u < 8 * N_AQ) attn_item(C, lds, u);
            else lru2_item(C, lds + AT_END, u - 8 * N_AQ);
        }
    } SEAM(3);

    if (IN(4)) {
        pg8::StaticOrder S; S.init(MTOK, DM, gridDim.x, blockIdx.x);
        { pg8::Gemm g{(const h16*)(ws + WS_LX), (const h16*)(ws + W_LRU), MTOK, DM, DM}; EpiMerge<0> E{(const h16*)(ws + WS_SGA), (h16*)(ws + WS_T1), nullptr, dry}; pg8::gemm_phase<EpiMerge<0>>(lds, g, S, E); }
        { pg8::Gemm g{(const h16*)(ws + WS_Q), (const h16*)(ws + W_ATT), MTOK, DM, DM}; EpiMerge<1> E{(const h16*)(ws + WS_SGB), (h16*)(ws + WS_T1), (h16*)(ws + WS_GG), dry}; pg8::gemm_phase<EpiMerge<1>>(lds, g, S, E); }
    } SEAM(4);

    if (IN(5)) {
        pg8::Gemm g{(const h16*)(ws + WS_GG), (const h16*)(ws + W_OUT), MTOK, DM, DM}; pg8::StaticOrder S; S.init(MTOK, DM, gridDim.x, blockIdx.x);
        EpiResid<true> E{P.in[0], nullptr, (h16*)(ws + WS_X1H), SSQ1, dry}; pg8::gemm_phase<EpiResid<true>>(lds, g, S, E);
    } SEAM(5);

    if (IN(6)) {
        pg8::Gemm g{(const h16*)(ws + WS_X1H), (const h16*)(ws + W_UP), MTOK, 2 * DFF, DM}; pg8::StaticOrder S; S.init(MTOK, 2 * DFF, gridDim.x, blockIdx.x);
        EpiUpAct E{SSQ1, (h16*)(ws + WS_UPV), (float*)(ws + WS_UPG), (float*)(ws + WS_UPG + 4 * MiB), (float*)(ws + WS_UPG + 8 * MiB), C.fcw, C.fcb, lds + pg8::STAGE_BYTES, dry}; pg8::gemm_phase<EpiUpAct>(lds, g, S, E);
    } SEAM(6);


    if (IN(8)) {
        pg8::Gemm g{(const h16*)(ws + WS_UPV), (const h16*)(ws + W_DOWN), MTOK, DM, DFF}; pg8::StaticOrder S; S.init(MTOK, DM, gridDim.x, blockIdx.x);
        {
#pragma unroll
          for (int i = 0; i < 2; ++i) { pg8::Unit uu; if (S.next(i, uu)) act_fix_tile((const float*)(ws + WS_UPG), (const float*)(ws + WS_UPG + 4 * MiB), (const float*)(ws + WS_UPG + 8 * MiB), C.fcw, C.fcb, (h16*)(ws + WS_UPV), uu.pm, tid, dry); }
          static_assert((MTOK / 256) * (DM / 256) == 2 * 256, "two units per workgroup on a 256-workgroup grid");
          VM_WAIT(); __syncthreads(); }
        EpiResid<false> E{nullptr, (const h16*)(ws + WS_X1H), (h16*)(ws + WS_X2H), SSQ2, dry}; pg8::gemm_phase<EpiResid<false>>(lds, g, S, E);
    } SEAM(8);

    if (IN(9)) {
        pg8::StaticOrder S; S.init(MTOK, DM, gridDim.x, blockIdx.x);
        { pg8::Gemm g{(const h16*)(ws + WS_X2H), (const h16*)(ws + W_PG), MTOK, DM, DM}; EpiGateSig E{SSQ2, (h16*)(ws + WS_GS), dry}; pg8::gemm_phase<EpiGateSig>(lds, g, S, E); }
        { pg8::Gemm g{(const h16*)(ws + WS_PH), (const h16*)(ws + W_PP), MTOK, DM, P.k_ple}; EpiPleOut E{(const h16*)(ws + WS_GS), (const h16*)(ws + WS_X2H), P.out, dry}; pg8::gemm_phase<EpiPleOut>(lds, g, S, E); }
    }
#undef IN
#undef SEAM
}

#ifndef N_LAUNCHES
#define N_LAUNCHES 1
#endif
extern "C" void kernel_launch(void* const* d_in, const int* in_sizes, int n_in, void* d_out, int out_size, void* d_ws, size_t ws_size, hipStream_t stream) {
    static int grid = 0;
    if (grid == 0) {
        if (n_in != 25 || out_size != MTOK * DM || ws_size < WS_END) { fprintf(stderr, "kernel_launch: unexpected shapes (n_in %d out %d ws %zu)\n", n_in, out_size, ws_size); grid = -1; return; }
        int dev = 0, cus = 0, per_cu = 0;
        hipGetDevice(&dev); hipDeviceGetAttribute(&cus, hipDeviceAttributeMultiprocessorCount, dev);
        if (hipFuncSetAttribute((const void*)fwd, hipFuncAttributeMaxDynamicSharedMemorySize, LDS_BYTES) != hipSuccess) { fprintf(stderr, "kernel_launch: hipFuncSetAttribute failed\n"); grid = -1; return; }
        if (hipOccupancyMaxActiveBlocksPerMultiprocessor(&per_cu, (const void*)fwd, NTHR, LDS_BYTES) != hipSuccess || per_cu < 1) { fprintf(stderr, "kernel_launch: occupancy query says %d\n", per_cu); }
        (void)hipGetLastError();
        grid = cus > 0 ? cus : 256;
    }
    if (grid < 0) return;
    hipMemsetAsync((char*)d_ws + WS_CTL, 0, CTL_ZERO_BYTES, stream);
    Params p{};
    for (int i = 0; i < 25; ++i) p.in[i] = (const float*)d_in[i];
    p.out = (float*)d_out; p.ws = (unsigned char*)d_ws; p.k_ple = PLE; p.pad = 0;
    if (N_LAUNCHES == 1) { p.ph_lo = 0; p.ph_hi = NPHASE; hipLaunchKernelGGL(fwd, dim3(grid), dim3(NTHR), LDS_BYTES, stream, p); }
    else for (int ph = 0; ph < NPHASE; ++ph) { p.ph_lo = ph; p.ph_hi = ph + 1;
#ifdef PROBE_MASK
        if ((PROBE_MASK >> ph) & 1) { p.pad = 1; hipLaunchKernelGGL(fwd, dim3(grid), dim3(NTHR), LDS_BYTES, stream, p); p.pad = 0; }
#endif
        hipLaunchKernelGGL(fwd, dim3(grid), dim3(NTHR), LDS_BYTES, stream, p); }
}
```

```cpp
#include <hip/hip_runtime.h>
#include <cstdio>
#include <cstdint>

#define GAS __attribute__((address_space(1)))
#define LAS __attribute__((address_space(3)))
typedef _Float16 h16;
typedef _Float16 h8 __attribute__((ext_vector_type(8)));
typedef _Float16 h4 __attribute__((ext_vector_type(4)));
typedef _Float16 h2 __attribute__((ext_vector_type(2)));
typedef __fp16 fh4 __attribute__((__vector_size__(4 * sizeof(__fp16))));
typedef float f32x4 __attribute__((ext_vector_type(4)));
typedef float f32x2 __attribute__((ext_vector_type(2)));
typedef unsigned u32x4 __attribute__((ext_vector_type(4)));
typedef unsigned u32x2 __attribute__((ext_vector_type(2)));
typedef unsigned long long u64;

__device__ __forceinline__ unsigned pkh(float a, float b) { h2 r; r.x = (h16)a; r.y = (h16)b; return __builtin_bit_cast(unsigned, r); }
__device__ __forceinline__ float sigmoid_f(float x) { return __builtin_amdgcn_rcpf(1.0f + __builtin_amdgcn_exp2f(-1.4426950408889634f * x)); }
__device__ __forceinline__ float gelu_tanh(float x) { const float u = 1.5957691216057308f * (x + 0.044715f * x * x * x); return x * sigmoid_f(u); }
#define LDS_WAIT() asm volatile("s_waitcnt lgkmcnt(0)" ::: "memory")
#define VM_WAIT() asm volatile("s_waitcnt vmcnt(0)" ::: "memory")

namespace pg8 {
constexpr int BM = 256, BK = 64, HALF = 128, HTB = HALF * BK * 2, STAGE_BYTES = 8 * HTB, NXCD = 8, WGM = 8;
__host__ __device__ __forceinline__ int lds_byte(int r, int c) { const int st = (r >> 4) * 2 + (c >> 5), rr = r & 15, cc = c & 31, ob = rr * 64 + cc * 2; return st * 1024 + (ob ^ (((ob >> 9) & 1) << 5)); }
__host__ __device__ __forceinline__ void stage_rc(int b, int& R, int& C) { const int st = b / 1024, sb = b % 1024, swz = sb ^ (((sb >> 9) & 1) << 5); R = (st >> 1) * 16 + swz / 64; C = (st & 1) * 32 + (swz % 64) / 2; }
__host__ __device__ __forceinline__ int perm32(int rho) { const int n = rho >> 4, i = rho & 15; return 8 * (i >> 2) + 4 * n + (i & 3); }

struct Unit { int pm, pn; };
struct Gemm { const h16* A; const h16* Bt; int M, N, K; };

struct StaticOrder {
    int nM, nN, nwg, G, c;
    __host__ __device__ void init(int M, int N, int G_, int c_) { nM = M / BM; nN = N / BM; nwg = nM * nN; G = G_; c = c_; }
    __host__ __device__ __forceinline__ bool next(int i, Unit& u) const {
        const long L = (long)i * G + c; if (L >= nwg) return false;
        int wgid = (int)L; { const int q = nwg / NXCD, r = nwg % NXCD, xcd = wgid % NXCD, off = wgid / NXCD; wgid = (xcd < r ? xcd * (q + 1) : r * (q + 1) + (xcd - r) * q) + off; }
        const int nig = WGM * nN, gid = wgid / nig, fm = gid * WGM, gsz = (nM - fm) < WGM ? (nM - fm) : WGM;
        u.pm = fm + ((wgid % nig) % gsz); u.pn = (wgid % nig) / gsz; return true;
    }
};

template <class Epi, bool ALIGN_EPI = true, bool SP2 = true>
__device__ __forceinline__ void gemm_phase(LAS unsigned char* lds, const Gemm g, const StaticOrder& S, const Epi& E) {
    const int tid = threadIdx.x, wid = __builtin_amdgcn_readfirstlane(tid >> 6), lane = tid & 63, wr = wid >> 2, wc = wid & 3, fr = lane & 15, fq = lane >> 4;
    const int K = g.K, nt = K / BK;
    unsigned voffA[2], voffB[2];
#pragma unroll
    for (int i = 0; i < 2; ++i) { int R, C; stage_rc(tid * 16 + i * 8192, R, C); const int Rb = Epi::PERM ? ((R & ~31) + perm32(R & 31)) : R;
        voffA[i] = (unsigned)(R * K + C) * 2u; voffB[i] = (unsigned)(Rb * K + C) * 2u; }
    const size_t kstep = (size_t)(BK * 2);
    const size_t hstep = (size_t)HALF * K * 2;
    const size_t tstep = 2 * hstep;
    const unsigned ldsw = (unsigned)wid * 1024u;
    const int aoff = lds_byte(wr * 64 + fr, fq * 8), boff = lds_byte(wc * 32 + fr, fq * 8);
#define PG8_SA(b, h) (((b) * 2 + (h)) * HTB)
#define PG8_SB(b, h) ((4 + (b) * 2 + (h)) * HTB)
#define PG8_STAGE(bufoff, gbase, voff) do { _Pragma("unroll") for (int _i = 0; _i < 2; ++_i) \
        __builtin_amdgcn_global_load_lds((const unsigned*)((const char*)(gbase) + (voff)[_i]), (LAS unsigned*)(lds + (bufoff) + ldsw + _i * 8192), 16, 0, 0); } while (0)
#define PG8_LDA(dst, b, h) do { _Pragma("unroll") for (int m = 0; m < 4; ++m) _Pragma("unroll") for (int k = 0; k < 2; ++k) dst[m][k] = *(const LAS h8*)(lds + PG8_SA(b, h) + aoff + m * 2048 + k * 1024); } while (0)
#define PG8_LDB(dst, b, h) do { _Pragma("unroll") for (int n = 0; n < 2; ++n) _Pragma("unroll") for (int k = 0; k < 2; ++k) dst[n][k] = *(const LAS h8*)(lds + PG8_SB(b, h) + boff + n * 2048 + k * 1024); } while (0)
#define PG8_MMA(ai, bj, At, Bt) do { __builtin_amdgcn_s_setprio(1); _Pragma("unroll") for (int m = 0; m < 4; ++m) _Pragma("unroll") for (int n = 0; n < 2; ++n) _Pragma("unroll") for (int k = 0; k < 2; ++k) \
        acc[ai][bj][m][n] = __builtin_amdgcn_mfma_f32_16x16x32_f16(Bt[n][k], At[m][k], acc[ai][bj][m][n], 0, 0, 0); __builtin_amdgcn_s_setprio(0); } while (0)
#define PG8_WAIT_V(n) asm volatile("s_waitcnt vmcnt(" #n ")" ::: "memory")
#define PG8_WAIT_L(n) asm volatile("s_waitcnt lgkmcnt(" #n ")" ::: "memory")
#define PG8_BAR __builtin_amdgcn_s_barrier()
#define PG8_SCHED __builtin_amdgcn_sched_barrier(0)
    Unit cur, nxt; int ui = 0;
    if (!S.next(0, cur)) return;
    f32x4 acc[2][2][4][2];
#pragma unroll
    for (int a = 0; a < 2; ++a)
#pragma unroll
        for (int b = 0; b < 2; ++b)
#pragma unroll
            for (int m = 0; m < 4; ++m)
#pragma unroll
                for (int n = 0; n < 2; ++n) acc[a][b][m][n] = (f32x4){0.f, 0.f, 0.f, 0.f};
    h8 At[4][2], B0[2][2], B1[2][2];
    const char* cA = (const char*)g.A + (size_t)cur.pm * tstep; const char* cB = (const char*)g.Bt + (size_t)cur.pn * tstep;
    if constexpr (SP2) {
        PG8_STAGE(PG8_SB(0, 0), cB, voffB); PG8_STAGE(PG8_SB(0, 1), cB + hstep, voffB); PG8_STAGE(PG8_SA(0, 0), cA, voffA); PG8_STAGE(PG8_SA(0, 1), cA + hstep, voffA);
        if (wr == 1) PG8_BAR;
        PG8_WAIT_V(2); PG8_BAR;
        PG8_STAGE(PG8_SB(1, 0), cB + kstep, voffB); PG8_STAGE(PG8_SA(1, 0), cA + kstep, voffA); PG8_STAGE(PG8_SB(1, 1), cB + hstep + kstep, voffB);
        PG8_WAIT_V(6); PG8_BAR;
    } else {
        PG8_STAGE(PG8_SB(0, 0), cB, voffB); PG8_STAGE(PG8_SA(0, 0), cA, voffA); PG8_STAGE(PG8_SB(0, 1), cB + hstep, voffB); PG8_STAGE(PG8_SA(0, 1), cA + hstep, voffA);
        if (wr == 1) PG8_BAR;
        PG8_WAIT_V(4); PG8_BAR;
        PG8_STAGE(PG8_SB(1, 0), cB + kstep, voffB); PG8_STAGE(PG8_SA(1, 0), cA + kstep, voffA); PG8_STAGE(PG8_SB(1, 1), cB + hstep + kstep, voffB);
        PG8_WAIT_V(6); PG8_BAR;
    }
    for (;;) {
        const bool has_next = S.next(ui + 1, nxt);
        const char* nA = has_next ? (const char*)g.A + (size_t)nxt.pm * tstep : cA; const char* nB = has_next ? (const char*)g.Bt + (size_t)nxt.pn * tstep : cB;
        for (int t = 0; t < nt; t += 2) {
            const bool last = (t == nt - 2);
            const char* a1 = cA + (size_t)(t + 1) * kstep;
            const char* a2 = last ? nA : cA + (size_t)(t + 2) * kstep; const char* b2 = last ? nB : cB + (size_t)(t + 2) * kstep;
            const char* a3 = a2 + kstep; const char* b3 = b2 + kstep;
            if constexpr (SP2) {
            PG8_LDB(B0, 0, 0); PG8_LDB(B1, 0, 1); PG8_SCHED; PG8_LDA(At, 0, 0); PG8_STAGE(PG8_SA(1, 1), a1 + hstep, voffA);
            PG8_WAIT_V(8); PG8_WAIT_L(0); PG8_BAR; PG8_MMA(0, 0, At, B0); PG8_MMA(0, 1, At, B1); PG8_BAR; PG8_SCHED;
            PG8_LDA(At, 0, 1); PG8_STAGE(PG8_SB(0, 0), b2, voffB); PG8_STAGE(PG8_SB(0, 1), b2 + hstep, voffB); PG8_STAGE(PG8_SA(0, 0), a2, voffA);
            PG8_WAIT_V(8); PG8_WAIT_L(0); PG8_BAR; PG8_MMA(1, 0, At, B0); PG8_MMA(1, 1, At, B1); PG8_BAR; PG8_SCHED;
            PG8_LDB(B0, 1, 0); PG8_LDB(B1, 1, 1); PG8_SCHED; PG8_LDA(At, 1, 0); PG8_STAGE(PG8_SA(0, 1), a2 + hstep, voffA);
            PG8_WAIT_V(8); PG8_WAIT_L(0); PG8_BAR; PG8_MMA(0, 0, At, B0); PG8_MMA(0, 1, At, B1); PG8_BAR; PG8_SCHED;
            PG8_LDA(At, 1, 1); PG8_STAGE(PG8_SB(1, 0), b3, voffB); PG8_STAGE(PG8_SB(1, 1), b3 + hstep, voffB); PG8_STAGE(PG8_SA(1, 0), a3, voffA);
            PG8_WAIT_V(8); PG8_WAIT_L(0); PG8_BAR; PG8_MMA(1, 0, At, B0); PG8_MMA(1, 1, At, B1); PG8_BAR; PG8_SCHED;
            } else {
            PG8_LDB(B0, 0, 0); PG8_SCHED; PG8_LDA(At, 0, 0); PG8_STAGE(PG8_SA(1, 1), a1 + hstep, voffA);
            PG8_WAIT_L(8); PG8_BAR; PG8_WAIT_L(0); PG8_MMA(0, 0, At, B0); PG8_BAR; PG8_SCHED;
            PG8_LDB(B1, 0, 1); PG8_STAGE(PG8_SB(0, 0), b2, voffB);
            PG8_BAR; PG8_WAIT_L(0); PG8_MMA(0, 1, At, B1); PG8_BAR;
            PG8_LDA(At, 0, 1); PG8_STAGE(PG8_SA(0, 0), a2, voffA);
            PG8_BAR; PG8_WAIT_L(0); PG8_MMA(1, 0, At, B0); PG8_BAR; PG8_SCHED;
            PG8_STAGE(PG8_SB(0, 1), b2 + hstep, voffB);
            PG8_WAIT_V(6); PG8_BAR; PG8_MMA(1, 1, At, B1); PG8_BAR;
            PG8_LDB(B0, 1, 0); PG8_SCHED; PG8_LDA(At, 1, 0); PG8_STAGE(PG8_SA(0, 1), a2 + hstep, voffA);
            PG8_WAIT_L(8); PG8_BAR; PG8_WAIT_L(0); PG8_MMA(0, 0, At, B0); PG8_BAR; PG8_SCHED;
            PG8_LDB(B1, 1, 1); PG8_STAGE(PG8_SB(1, 0), b3, voffB);
            PG8_BAR; PG8_WAIT_L(0); PG8_MMA(0, 1, At, B1); PG8_BAR;
            PG8_LDA(At, 1, 1); PG8_STAGE(PG8_SA(1, 0), a3, voffA);
            PG8_BAR; PG8_WAIT_L(0); PG8_MMA(1, 0, At, B0); PG8_BAR; PG8_SCHED;
            PG8_STAGE(PG8_SB(1, 1), b3 + hstep, voffB);
            PG8_WAIT_V(6); PG8_BAR; PG8_MMA(1, 1, At, B1); PG8_BAR;
            }
        }
        if constexpr (ALIGN_EPI) { if (wr == 0) PG8_BAR; }
        E(acc, cur, wr, wc, fr, fq);
        if (!has_next) break;
#pragma unroll
        for (int a = 0; a < 2; ++a)
#pragma unroll
            for (int b = 0; b < 2; ++b)
#pragma unroll
                for (int m = 0; m < 4; ++m)
#pragma unroll
                    for (int n = 0; n < 2; ++n) acc[a][b][m][n] = (f32x4){0.f, 0.f, 0.f, 0.f};
        cur = nxt; cA = nA; cB = nB; ++ui;
        if constexpr (ALIGN_EPI) { if (wr == 1) PG8_BAR; }
    }
    PG8_WAIT_V(0);
    if constexpr (!ALIGN_EPI) { if (wr == 0) PG8_BAR; }
    PG8_BAR;
#undef PG8_SA
#undef PG8_SB
#undef PG8_STAGE
#undef PG8_LDA
#undef PG8_LDB
#undef PG8_MMA
#undef PG8_WAIT_V
#undef PG8_WAIT_L
#undef PG8_BAR
#undef PG8_SCHED
}
}

constexpr int NB = 4, SEQ = 8192, MTOK = NB * SEQ, DM = 1024, DFF = 3072, PLE = 256;
constexpr int NIN = 6216, NIN_PAD = 6400;
constexpr float EPS = 1e-6f;
constexpr int NWAVES = 8, NTHR = 512;

typedef const f32x4 (&AccRef)[2][2][4][2];

template <int ACT> __device__ __forceinline__ float act_f(float v) {
    if (ACT == 1) return gelu_tanh(v);
    if (ACT == 2) return sigmoid_f(v);
    if (ACT == 3) return v * 0.125f;
    return v;
}
template <int ACT> __device__ __forceinline__ void store_tile_h(AccRef acc, h16* base, int ldc, int row0, int col0, int dry) {
    const unsigned bo0 = ((unsigned)row0 * (unsigned)ldc + (unsigned)col0) * 2u;
#pragma unroll
    for (int ai = 0; ai < 2; ++ai)
#pragma unroll
        for (int m = 0; m < 4; ++m) { const unsigned bo = bo0 + (unsigned)((ai * 128 + m * 16) * ldc * 2);
#pragma unroll
            for (int bj = 0; bj < 2; ++bj) { const f32x4 v0 = acc[ai][bj][m][0], v1 = acc[ai][bj][m][1];
                u32x4 w; w.x = pkh(act_f<ACT>(v0[0]), act_f<ACT>(v0[1])); w.y = pkh(act_f<ACT>(v0[2]), act_f<ACT>(v0[3]));
                w.z = pkh(act_f<ACT>(v1[0]), act_f<ACT>(v1[1])); w.w = pkh(act_f<ACT>(v1[2]), act_f<ACT>(v1[3]));
                if (!dry) *(u32x4*)((char*)base + bo + bj * 256) = w; }
            if (ACT == 1 || ACT == 2) __builtin_amdgcn_sched_barrier(0); }
}

__device__ __forceinline__ unsigned frag_off(int pm, int pn, int wid, int lane) { return ((unsigned)((pm * 4 + pn) * 8 + wid) * 1024u + (unsigned)lane) * 16u; }
#define FRAG_SUB(ai, m, bj) ((unsigned)((((ai) * 4 + (m)) * 2 + (bj)) * 1024))
template <int ACT> __device__ __forceinline__ void store_tile_frag(AccRef acc, h16* base, unsigned fo, int dry) {
#pragma unroll
    for (int ai = 0; ai < 2; ++ai)
#pragma unroll
        for (int m = 0; m < 4; ++m) {
#pragma unroll
            for (int bj = 0; bj < 2; ++bj) { const f32x4 v0 = acc[ai][bj][m][0], v1 = acc[ai][bj][m][1];
                u32x4 w; w.x = pkh(act_f<ACT>(v0[0]), act_f<ACT>(v0[1])); w.y = pkh(act_f<ACT>(v0[2]), act_f<ACT>(v0[3]));
                w.z = pkh(act_f<ACT>(v1[0]), act_f<ACT>(v1[1])); w.w = pkh(act_f<ACT>(v1[2]), act_f<ACT>(v1[3]));
                if (!dry) *(u32x4*)((char*)base + fo + FRAG_SUB(ai, m, bj)) = w; }
            if (ACT == 1 || ACT == 2) __builtin_amdgcn_sched_barrier(0); }
}

struct EpiIn {
    static constexpr bool PERM = true;
    h16 *LX, *GG, *Q, *K, *V, *QI, *KI, *SGA, *SGB; float* WI; int dry;
    __device__ __forceinline__ void operator()(AccRef acc, const pg8::Unit& u, int wr, int wc, int fr, int fq) const {
        const int pn = u.pn, row0 = u.pm * 256 + wr * 64 + fr, cw = wc * 32 + 8 * fq;
        if (pn < 4 || (pn >= 8 && pn < 14)) {
            h16* base = pn < 4 ? LX : (pn < 12 ? Q : (pn == 12 ? K : V)); const int ldc = pn < 12 ? DM : 256; const int ct = pn < 4 ? pn * 256 : (pn < 12 ? (pn - 8) * 256 : 0);
            if (pn < 12) store_tile_h<0>(acc, base, DM, row0, ct + cw, dry); else store_tile_h<0>(acc, base, 256, row0, cw, dry);
            (void)ldc;
        }
        else if (pn < 8) store_tile_h<1>(acc, GG, DM, row0, (pn - 4) * 256 + cw, dry);
        else if (pn < 16) {
#pragma unroll
            for (int ai = 0; ai < 2; ++ai)
#pragma unroll
                for (int m = 0; m < 4; ++m) { const unsigned t16 = (unsigned)(u.pm * 16 + wr * 4 + ai * 8 + m);
#pragma unroll
                    for (int bj = 0; bj < 2; ++bj) { const f32x4 v0 = acc[ai][bj][m][0] * 0.125f, v1 = acc[ai][bj][m][1] * 0.125f;
                        const unsigned hh = (unsigned)((pn - 14) * 4 + bj * 2 + (wc >> 1)), slot = ((t16 * 8u + hh) * 2u + (unsigned)(wc & 1)) * 64u + (unsigned)(fq * 16 + fr);
                        u32x4 w; w.x = pkh(v0[0], v0[1]); w.y = pkh(v0[2], v0[3]); w.z = pkh(v1[0], v1[1]); w.w = pkh(v1[2], v1[3]);
                        if (!dry) *(u32x4*)((char*)QI + slot * 16u) = w; } }
        }
        else if (pn == 16) {
            if (wc < 2) {
#pragma unroll
                for (int ai = 0; ai < 2; ++ai)
#pragma unroll
                    for (int m = 0; m < 4; ++m) { const f32x4 v0 = acc[ai][0][m][0], v1 = acc[ai][0][m][1];
                        u32x4 w; w.x = pkh(v0[0], v0[1]); w.y = pkh(v0[2], v0[3]); w.z = pkh(v1[0], v1[1]); w.w = pkh(v1[2], v1[3]);
                        if (!dry) *(u32x4*)((char*)KI + ((unsigned)((u.pm * 16 + wr * 4 + ai * 8 + m) * 2 + wc) * 64u + (unsigned)(fq * 16 + fr)) * 16u) = w; }
            } else if (wc == 2 && fq == 0) {
#pragma unroll
                for (int ai = 0; ai < 2; ++ai)
#pragma unroll
                    for (int m = 0; m < 4; ++m) { float* p = WI + (size_t)(row0 + ai * 128 + m * 16) * 8;
                        if (!dry) { *(f32x4*)p = acc[ai][0][m][0] * 0.35355339059327373f; *(f32x4*)(p + 4) = acc[ai][0][m][1] * 0.35355339059327373f; } }
            }
        }
        else { h16* base = pn < 21 ? SGA : SGB; const int pl = pn < 21 ? pn - 17 : pn - 21; store_tile_frag<2>(acc, base, frag_off(u.pm, pl, wr * 4 + wc, fq * 16 + fr), dry); }
    }
};

template <int SECOND> struct EpiMerge {
    static constexpr bool PERM = true;
    const h16* SG; h16* T1; h16* OUT; int dry;
    __device__ __forceinline__ void operator()(AccRef acc, const pg8::Unit& u, int wr, int wc, int fr, int fq) const {
        const int row0 = u.pm * 256 + wr * 64 + fr, col0 = u.pn * 256 + wc * 32 + 8 * fq;
        const unsigned fo = frag_off(u.pm, u.pn, wr * 4 + wc, fq * 16 + fr);
#pragma unroll
        for (int ai = 0; ai < 2; ++ai) {
            h8 sg[4][2], t1[4][2];
#pragma unroll
            for (int m = 0; m < 4; ++m)
#pragma unroll
                for (int bj = 0; bj < 2; ++bj) { sg[m][bj] = *(const h8*)((const char*)SG + fo + FRAG_SUB(ai, m, bj)); if (SECOND) t1[m][bj] = *(const h8*)((const char*)T1 + fo + FRAG_SUB(ai, m, bj)); }
            __builtin_amdgcn_sched_barrier(0);
#pragma unroll
            for (int m = 0; m < 4; ++m) { const size_t off = (size_t)(row0 + ai * 128 + m * 16) * DM + col0;
#pragma unroll
                for (int bj = 0; bj < 2; ++bj) { const f32x4 v0 = acc[ai][bj][m][0], v1 = acc[ai][bj][m][1];
                    float r[8];
#pragma unroll
                    for (int j = 0; j < 4; ++j) { r[j] = (float)sg[m][bj][j] * v0[j]; r[4 + j] = (float)sg[m][bj][4 + j] * v1[j]; }
                    if (SECOND) {
#pragma unroll
                        for (int j = 0; j < 8; ++j) r[j] += (float)t1[m][bj][j]; }
                    u32x4 w; w.x = pkh(r[0], r[1]); w.y = pkh(r[2], r[3]); w.z = pkh(r[4], r[5]); w.w = pkh(r[6], r[7]);
                    if (!dry) { if (SECOND) *(u32x4*)(OUT + off + bj * 128) = w; else *(u32x4*)((char*)T1 + fo + FRAG_SUB(ai, m, bj)) = w; } } }
            __builtin_amdgcn_sched_barrier(0); }
    }
};

template <bool BASE_F32> struct EpiResid {
    static constexpr bool PERM = true;
    const float* BF; const h16* BH; h16* XOUT; float* SSQ; int dry;
    __device__ __forceinline__ void operator()(AccRef acc, const pg8::Unit& u, int wr, int wc, int fr, int fq) const {
        const int row0 = u.pm * 256 + wr * 64 + fr, col0 = u.pn * 256 + wc * 32 + 8 * fq;
#pragma unroll
        for (int ai = 0; ai < 2; ++ai) {
            f32x4 bf[4][2][2]; h8 bh[4][2];
#pragma unroll
            for (int m = 0; m < 4; ++m) { const size_t off = (size_t)(row0 + ai * 128 + m * 16) * DM + col0;
#pragma unroll
                for (int bj = 0; bj < 2; ++bj) { if (BASE_F32) { bf[m][bj][0] = *(const f32x4*)(BF + off + bj * 128); bf[m][bj][1] = *(const f32x4*)(BF + off + bj * 128 + 4); } else bh[m][bj] = *(const h8*)(BH + off + bj * 128); } }
            __builtin_amdgcn_sched_barrier(0);
#pragma unroll
            for (int m = 0; m < 4; ++m) { const int row = row0 + ai * 128 + m * 16; const size_t off = (size_t)row * DM + col0; float ss = 0.f;
#pragma unroll
                for (int bj = 0; bj < 2; ++bj) { const f32x4 v0 = acc[ai][bj][m][0], v1 = acc[ai][bj][m][1];
                    float r[8];
                    if (BASE_F32) {
#pragma unroll
                        for (int j = 0; j < 4; ++j) { r[j] = bf[m][bj][0][j] + v0[j]; r[4 + j] = bf[m][bj][1][j] + v1[j]; } }
                    else {
#pragma unroll
                        for (int j = 0; j < 4; ++j) { r[j] = (float)bh[m][bj][j] + v0[j]; r[4 + j] = (float)bh[m][bj][4 + j] + v1[j]; } }
#pragma unroll
                    for (int j = 0; j < 8; ++j) ss += r[j] * r[j];
                    u32x4 w; w.x = pkh(r[0], r[1]); w.y = pkh(r[2], r[3]); w.z = pkh(r[4], r[5]); w.w = pkh(r[6], r[7]);
                    if (!dry) *(u32x4*)(XOUT + off + bj * 128) = w; }
                ss += __shfl_xor(ss, 16); ss += __shfl_xor(ss, 32);
                if (fq == 0 && !dry) unsafeAtomicAdd(SSQ + row, ss); }
            __builtin_amdgcn_sched_barrier(0); }
    }
};

struct EpiUp {
    static constexpr bool PERM = true;
    const float* SSQ; h16* UPG; h16* UPV; int dry;
    __device__ __forceinline__ void operator()(AccRef acc, const pg8::Unit& u, int wr, int wc, int fr, int fq) const {
        const int row0 = u.pm * 256 + wr * 64 + fr, col0 = u.pn * 128 + wc * 32 + 8 * fq;
#pragma unroll
        for (int ai = 0; ai < 2; ++ai)
#pragma unroll
            for (int m = 0; m < 4; ++m) { const int row = row0 + ai * 128 + m * 16; const size_t off = (size_t)row * DFF + col0;
                const float r = __builtin_amdgcn_rsqf(SSQ[row] * (1.0f / DM) + EPS);
#pragma unroll
                for (int bj = 0; bj < 2; ++bj) { const f32x4 v0 = acc[ai][bj][m][0] * r, v1 = acc[ai][bj][m][1] * r;
                    u32x4 w; w.x = pkh(v0[0], v0[1]); w.y = pkh(v0[2], v0[3]); w.z = pkh(v1[0], v1[1]); w.w = pkh(v1[2], v1[3]);
                    if (!dry) *(u32x4*)((bj ? UPV : UPG) + off) = w; } }
    }
};

__device__ __forceinline__ float dpp_ror1(float v) { return __builtin_bit_cast(float, __builtin_amdgcn_update_dpp(0, __builtin_bit_cast(int, v), 0x121, 0xf, 0xf, false)); }
__device__ __forceinline__ float dpp_ror2(float v) { return __builtin_bit_cast(float, __builtin_amdgcn_update_dpp(0, __builtin_bit_cast(int, v), 0x122, 0xf, 0xf, false)); }
struct EpiUpAct {
    static constexpr bool PERM = true;
    const float* SSQ; h16* ACT; float* SG; float* SV; float* SL; const float* fcw; const float* fcb; LAS unsigned char* xl; int dry;
    __device__ __forceinline__ void operator()(AccRef acc, const pg8::Unit& u, int wr, int wc, int fr, int fq) const {
        const int row0 = u.pm * 256 + wr * 64 + fr, colg = u.pn * 128 + wc * 32 + 8 * fq, coll = wc * 32 + 8 * fq;
        float w0[8], w1[8], w2[8], bb[8];
        { const f32x4 a0 = *(const f32x4*)(fcw + colg), a1 = *(const f32x4*)(fcw + colg + 4), b0 = *(const f32x4*)(fcw + DFF + colg), b1 = *(const f32x4*)(fcw + DFF + colg + 4),
                      c0 = *(const f32x4*)(fcw + 2 * DFF + colg), c1 = *(const f32x4*)(fcw + 2 * DFF + colg + 4), d0 = *(const f32x4*)(fcb + colg), d1 = *(const f32x4*)(fcb + colg + 4);
#pragma unroll
          for (int e = 0; e < 4; ++e) { w0[e] = a0[e]; w0[4 + e] = a1[e]; w1[e] = b0[e]; w1[4 + e] = b1[e]; w2[e] = c0[e]; w2[4 + e] = c1[e]; bb[e] = d0[e]; bb[4 + e] = d1[e]; } }
        float rsv[2][4];
#pragma unroll
        for (int ai = 0; ai < 2; ++ai)
#pragma unroll
            for (int m = 0; m < 4; ++m) rsv[ai][m] = SSQ[row0 + ai * 128 + m * 16];
#pragma unroll
        for (int ai = 0; ai < 2; ++ai)
#pragma unroll
            for (int m = 0; m < 4; ++m) rsv[ai][m] = __builtin_amdgcn_rsqf(rsv[ai][m] * (1.0f / DM) + EPS);
        LAS float* X = (LAS float*)xl;
#pragma unroll
        for (int ai = 0; ai < 2; ++ai) { const float r3 = rsv[ai][3];
            if (fr >= 14) { LAS float* p = X + ((ai * 2 + wr) * 2 + (fr - 14)) * 128 + coll; *(LAS f32x4*)p = acc[ai][0][3][0] * r3; *(LAS f32x4*)(p + 4) = acc[ai][0][3][1] * r3; } }
        LDS_WAIT(); __builtin_amdgcn_s_barrier(); asm volatile("" ::: "memory");
#pragma unroll
        for (int ai = 0; ai < 2; ++ai) {
            float L0[8], L1[8];
            if (ai == 0 && wr == 0) {
#pragma unroll
                for (int e = 0; e < 8; ++e) { L0[e] = 0.f; L1[e] = 0.f; } }
            else { const int pb = wr == 1 ? ai * 2 : 1; const LAS float* p = X + (pb * 2) * 128 + coll;
                const f32x4 x0 = *(const LAS f32x4*)p, x1 = *(const LAS f32x4*)(p + 4), y0 = *(const LAS f32x4*)(p + 128), y1 = *(const LAS f32x4*)(p + 132);
#pragma unroll
                for (int e = 0; e < 4; ++e) { L0[e] = x0[e]; L0[4 + e] = x1[e]; L1[e] = y0[e]; L1[4 + e] = y1[e]; } }
            float q1[8], q2[8];
#pragma unroll
            for (int e = 0; e < 8; ++e) { q1[e] = L1[e]; q2[e] = fr == 0 ? L0[e] : L1[e]; }
#pragma unroll
            for (int m = 0; m < 4; ++m) { const int row = row0 + ai * 128 + m * 16;
                const float rr = rsv[ai][m];
                float g[8], a[8];
#pragma unroll
                for (int e = 0; e < 4; ++e) { g[e] = acc[ai][0][m][0][e] * rr; g[4 + e] = acc[ai][0][m][1][e] * rr; }
#pragma unroll
                for (int e = 0; e < 8; ++e) { const float r1 = dpp_ror1(g[e]), r2 = dpp_ror2(g[e]);
                    const float p1 = fr >= 1 ? r1 : q1[e], p2 = fr >= 2 ? r2 : q2[e];
                    const float y = bb[e] + w0[e] * p2 + w1[e] * p1 + w2[e] * g[e];
                    const float vv = (e < 4 ? acc[ai][1][m][0][e] : acc[ai][1][m][1][e - 4]) * rr;
                    a[e] = gelu_tanh(y) * vv; q1[e] = r1; q2[e] = r2; }
                const bool deferred = (ai == 0 && m == 0) && wr == 0 && fr < 2;
                if (!dry) {
                    if (!deferred) { u32x4 w; w.x = pkh(a[0], a[1]); w.y = pkh(a[2], a[3]); w.z = pkh(a[4], a[5]); w.w = pkh(a[6], a[7]); *(u32x4*)(ACT + (size_t)row * DFF + colg) = w; }
                    else { float* pg = SG + (size_t)(u.pm * 2 + fr) * DFF + colg; float* pv = SV + (size_t)(u.pm * 2 + fr) * DFF + colg;
                        *(f32x4*)pg = (f32x4){g[0], g[1], g[2], g[3]}; *(f32x4*)(pg + 4) = (f32x4){g[4], g[5], g[6], g[7]};
                        *(f32x4*)pv = acc[ai][1][m][0] * rr; *(f32x4*)(pv + 4) = acc[ai][1][m][1] * rr; }
                    if ((ai == 1 && m == 3) && wr == 1 && fr >= 14) { float* pl = SL + (size_t)(u.pm * 2 + fr - 14) * DFF + colg;
                        *(f32x4*)pl = (f32x4){g[0], g[1], g[2], g[3]}; *(f32x4*)(pl + 4) = (f32x4){g[4], g[5], g[6], g[7]}; } }
                __builtin_amdgcn_sched_barrier(0); }
        }
    }
};
__device__ __forceinline__ void act_fix_tile(const float* SG, const float* SV, const float* SL, const float* fcw, const float* fcb, h16* ACT, int pm, int tid, int dry) {
    constexpr int NCG = DFF / 8; const bool bs = (pm & 31) == 0;
    for (int it = tid; it < 2 * NCG; it += NTHR) { const int cg = it % NCG, rr = it / NCG, c0 = cg * 8;
        float y[8];
#pragma unroll
        for (int h = 0; h < 2; ++h) { const int c = c0 + 4 * h;
            const f32x4 g = *(const f32x4*)(SG + (size_t)(pm * 2 + rr) * DFF + c), v = *(const f32x4*)(SV + (size_t)(pm * 2 + rr) * DFF + c);
            f32x4 g1, g2; const f32x4 z = {0.f, 0.f, 0.f, 0.f};
            if (rr == 0) { g1 = bs ? z : *(const f32x4*)(SL + (size_t)((pm - 1) * 2 + 1) * DFF + c); g2 = bs ? z : *(const f32x4*)(SL + (size_t)((pm - 1) * 2) * DFF + c); }
            else { g1 = *(const f32x4*)(SG + (size_t)(pm * 2) * DFF + c); g2 = bs ? z : *(const f32x4*)(SL + (size_t)((pm - 1) * 2 + 1) * DFF + c); }
            const f32x4 a0 = *(const f32x4*)(fcw + c), a1 = *(const f32x4*)(fcw + DFF + c), a2 = *(const f32x4*)(fcw + 2 * DFF + c), b = *(const f32x4*)(fcb + c);
#pragma unroll
            for (int e = 0; e < 4; ++e) y[4 * h + e] = gelu_tanh(b[e] + a0[e] * g2[e] + a1[e] * g1[e] + a2[e] * g[e]) * v[e]; }
        u32x4 w; w.x = pkh(y[0], y[1]); w.y = pkh(y[2], y[3]); w.z = pkh(y[4], y[5]); w.w = pkh(y[6], y[7]);
        if (!dry) *(u32x4*)(ACT + (size_t)(pm * 256 + rr) * DFF + c0) = w; }
}

struct EpiGateSig {
    static constexpr bool PERM = true;
    const float* SSQ; h16* GS; int dry;
    __device__ __forceinline__ void operator()(AccRef acc, const pg8::Unit& u, int wr, int wc, int fr, int fq) const {
        const int row0 = u.pm * 256 + wr * 64 + fr; const unsigned fo = frag_off(u.pm, u.pn, wr * 4 + wc, fq * 16 + fr);
        float rsv[2][4];
#pragma unroll
        for (int ai = 0; ai < 2; ++ai)
#pragma unroll
            for (int m = 0; m < 4; ++m) rsv[ai][m] = SSQ[row0 + ai * 128 + m * 16];
        __builtin_amdgcn_sched_barrier(0);
#pragma unroll
        for (int ai = 0; ai < 2; ++ai)
#pragma unroll
            for (int m = 0; m < 4; ++m) { const float r = __builtin_amdgcn_rsqf(rsv[ai][m] * (1.0f / DM) + EPS);
#pragma unroll
                for (int bj = 0; bj < 2; ++bj) { const f32x4 v0 = acc[ai][bj][m][0] * r, v1 = acc[ai][bj][m][1] * r;
                    u32x4 w; w.x = pkh(sigmoid_f(v0[0]), sigmoid_f(v0[1])); w.y = pkh(sigmoid_f(v0[2]), sigmoid_f(v0[3])); w.z = pkh(sigmoid_f(v1[0]), sigmoid_f(v1[1])); w.w = pkh(sigmoid_f(v1[2]), sigmoid_f(v1[3]));
                    if (!dry) *(u32x4*)((char*)GS + fo + FRAG_SUB(ai, m, bj)) = w; }
                __builtin_amdgcn_sched_barrier(0); }
    }
};
struct EpiPleOut {
    static constexpr bool PERM = true;
    const h16* GS; const h16* X2; float* C; int dry;
    __device__ __forceinline__ void operator()(AccRef acc, const pg8::Unit& u, int wr, int wc, int fr, int fq) const {
        const int row0 = u.pm * 256 + wr * 64 + fr, col0 = u.pn * 256 + wc * 32 + 8 * fq;
        const unsigned e0 = (unsigned)row0 * DM + (unsigned)col0, fo = frag_off(u.pm, u.pn, wr * 4 + wc, fq * 16 + fr);
#pragma unroll
        for (int ai = 0; ai < 2; ++ai) {
            h8 gsv[4][2], xbv[4][2];
#pragma unroll
            for (int m = 0; m < 4; ++m)
#pragma unroll
                for (int bj = 0; bj < 2; ++bj) { const unsigned o2 = e0 + (unsigned)((ai * 128 + m * 16) * DM) + bj * 128;
                    gsv[m][bj] = *(const h8*)((const char*)GS + fo + FRAG_SUB(ai, m, bj)); xbv[m][bj] = *(const h8*)((const char*)X2 + (size_t)o2 * 2u); }
            __builtin_amdgcn_sched_barrier(0);
#pragma unroll
            for (int m = 0; m < 4; ++m) { const unsigned eo = e0 + (unsigned)((ai * 128 + m * 16) * DM);
#pragma unroll
                for (int bj = 0; bj < 2; ++bj) { const unsigned o2 = eo + bj * 128; const f32x4 a0 = acc[ai][bj][m][0], a1 = acc[ai][bj][m][1];
                    f32x4 o0, o1;
#pragma unroll
                    for (int j = 0; j < 4; ++j) { o0[j] = (float)xbv[m][bj][j] + (float)gsv[m][bj][j] * a0[j]; o1[j] = (float)xbv[m][bj][4 + j] + (float)gsv[m][bj][4 + j] * a1[j]; }
                    if (!dry) { *(f32x4*)((char*)C + (size_t)o2 * 4u) = o0; *(f32x4*)((char*)C + (size_t)o2 * 4u + 16) = o1; } } }
            __builtin_amdgcn_sched_barrier(0); }
    }
};


#define XB_TMO      128
#define XB_XCNT(j)  (256  + 64 * (j))
#define XB_XSUB(j)  (1280 + 64 * (j))
#define XB_XGEN(j)  (2304 + 64 * (j))
#define XB_TOP      3328
#define XB_TOPGEN   3392
#define XCD_BAR_WORDS 3456
#define XB_SPIN_CAP (1u << 20)

__device__ __forceinline__ unsigned xb_ld(unsigned* p)              { return __hip_atomic_load(p, __ATOMIC_RELAXED, __HIP_MEMORY_SCOPE_AGENT); }
__device__ __forceinline__ unsigned xb_add(unsigned* p, unsigned v) { return __hip_atomic_fetch_add(p, v, __ATOMIC_RELAXED, __HIP_MEMORY_SCOPE_AGENT); }
__device__ __forceinline__ unsigned xb_xcc_id() { return (unsigned)__builtin_amdgcn_s_getreg((3 << 11) | 20) & 0xFu; }
#define XB_SPIN(cond, bar) do { unsigned _sp = 0; while (cond) { __builtin_amdgcn_s_sleep(1); \
    if ((++_sp & 255u) == 0u) { if (xb_ld(&(bar)[XB_TMO])) break; if (_sp > XB_SPIN_CAP) { atomicAdd(&(bar)[XB_TMO], 1u); break; } } } } while (0)

struct XcdBarrier { unsigned* bar; unsigned x; volatile LAS unsigned* st; };

__device__ __forceinline__ XcdBarrier xcd_barrier_post(unsigned* bar, volatile LAS unsigned* st) {
    XcdBarrier b; b.bar = bar; b.x = xb_xcc_id(); b.st = st;
    if (threadIdx.x == 0) (void)xb_add(&bar[XB_XCNT(b.x)], 1u);
    return b;
}
__device__ __forceinline__ void xcd_barrier_complete(unsigned* bar, unsigned x, unsigned& nloc, unsigned& nx) {
    const unsigned G = gridDim.x * gridDim.y * gridDim.z;
    unsigned sum, cnt, mine, sp = 0u;
    for (;;) {
        sum = 0u; cnt = 0u; mine = 0u;
#pragma unroll
        for (unsigned j = 0; j < 16; ++j) { const unsigned c = xb_ld(&bar[XB_XCNT(j)]); sum += c; cnt += (c > 0u) ? 1u : 0u; mine = (j == x) ? c : mine; }
        if (sum == G) break;
        __builtin_amdgcn_s_sleep(1);
        if ((++sp & 255u) == 0u) { if (xb_ld(&bar[XB_TMO])) break; if (sp > XB_SPIN_CAP) { atomicAdd(&bar[XB_TMO], 1u); break; } }
    }
    nloc = mine > 0u ? mine : 1u; nx = cnt > 0u ? cnt : 1u;
}
__device__ __forceinline__ void xcd_barrier(const XcdBarrier& b) {
    asm volatile("s_waitcnt vmcnt(0)" ::: "memory");
    __syncthreads();
    if (threadIdx.x == 0) {
        unsigned* bar = b.bar;
        __builtin_amdgcn_s_waitcnt(0);
        unsigned nloc = b.st[0], nx = b.st[1];
        if (nloc == 0u) { xcd_barrier_complete(bar, b.x, nloc, nx); b.st[0] = nloc; b.st[1] = nx; }
        const unsigned old = xb_add(&bar[XB_XSUB(b.x)], 1u);
        const unsigned gen = old / nloc;
        if (old + 1u == (gen + 1u) * nloc) {
            __builtin_amdgcn_fence(__ATOMIC_RELEASE, "agent");
            asm volatile("s_waitcnt vmcnt(0)" ::: "memory");
            const unsigned og = xb_add(&bar[XB_TOP], 1u);
            const unsigned tg = og / nx;
            if (og + 1u == (tg + 1u) * nx) xb_add(&bar[XB_TOPGEN], 1u);
            else XB_SPIN(xb_ld(&bar[XB_TOPGEN]) == tg, bar);
            __builtin_amdgcn_fence(__ATOMIC_ACQUIRE, "agent");
            xb_add(&bar[XB_XGEN(b.x)], 1u);
            asm volatile("s_waitcnt vmcnt(0)" ::: "memory");
        } else {
            XB_SPIN(xb_ld(&bar[XB_XGEN(b.x)]) == gen, bar);
            __builtin_amdgcn_fence(__ATOMIC_ACQUIRE, "agent");
            asm volatile("s_waitcnt vmcnt(0)" ::: "memory");
        }
    }
    __syncthreads();
}

constexpr size_t MiB = 1u << 20;
constexpr size_t WS_CTL = 0, CTL_ZERO_BYTES = 1 * MiB;
constexpr size_t WS_SA = 1 * MiB, WS_SH = 2 * MiB;
constexpr size_t WS_WI = 3 * MiB;
constexpr size_t WS_KI = 4 * MiB;
constexpr size_t WS_W = 8 * MiB;
constexpr size_t W_IN = WS_W, W_LRU = W_IN + (size_t)NIN_PAD * DM * 2, W_ATT = W_LRU + 2 * MiB, W_OUT = W_ATT + 2 * MiB, W_PG = W_OUT + 2 * MiB,
                 W_UP = W_PG + 2 * MiB, W_DOWN = W_UP + 12 * MiB, W_PP = W_DOWN + 6 * MiB, W_GATE = W_PP + MiB / 2, W_END = W_GATE + MiB / 2;
static_assert(W_END <= 48 * MiB, "weights region");
constexpr size_t WS_A0 = 48 * MiB;
constexpr size_t WS_IDX = 48 * MiB, WS_NV = 64 * MiB;
constexpr size_t WS_K8 = 72 * MiB, WS_V8 = 80 * MiB;
constexpr size_t WS_T1 = 48 * MiB;
constexpr size_t WS_X1H = 48 * MiB;
constexpr size_t WS_PH = 112 * MiB;
constexpr size_t WS_LX = 128 * MiB;
constexpr size_t WS_GG = 192 * MiB;
constexpr size_t WS_Q = 256 * MiB;
constexpr size_t WS_K = 320 * MiB, WS_V = 336 * MiB;
constexpr size_t WS_QI = 352 * MiB;
constexpr size_t WS_SGA = 384 * MiB, WS_SGB = 448 * MiB;
constexpr size_t WS_UPG = 128 * MiB, WS_UPV = 320 * MiB;
constexpr size_t WS_X2H = 128 * MiB;
constexpr size_t WS_GS = 320 * MiB;
constexpr size_t WS_END = 512 * MiB;
constexpr int CW_BAR = 1024;
constexpr int CW_Q2 = 8192, CW_Q3 = 8192 + 256;
constexpr size_t CTL_SSQ1 = 256 * 1024, CTL_SSQ2 = 512 * 1024;
static_assert((CW_BAR + XCD_BAR_WORDS) * 4 <= 32768 && CTL_SSQ2 + MTOK * 4 <= CTL_ZERO_BYTES, "ctl map");

constexpr int LDS_BYTES = 159744;
constexpr int MISC_OFF = LDS_BYTES - 256;

struct Params {
    const float* in[25]; float* out; unsigned char* ws; int ph_lo, ph_hi, k_ple, pad;
};

#define DPP_ADDF(v, ctl, rm) v += __builtin_bit_cast(float, __builtin_amdgcn_update_dpp(0, __builtin_bit_cast(int, v), ctl, rm, 0xf, false))
__device__ __forceinline__ float row_sum(float v) { DPP_ADDF(v, 0xB1, 0xf); DPP_ADDF(v, 0x4E, 0xf); DPP_ADDF(v, 0x141, 0xf); DPP_ADDF(v, 0x140, 0xf); return v; }
__device__ __forceinline__ float wave_sum(float v) { v = row_sum(v); DPP_ADDF(v, 0x142, 0xa); DPP_ADDF(v, 0x143, 0xc); return __builtin_bit_cast(float, __builtin_amdgcn_readlane(__builtin_bit_cast(int, v), 63)); }
__device__ __forceinline__ float half_sum(float v, int lane) { v = row_sum(v); DPP_ADDF(v, 0x142, 0xa);
    const float lo = __builtin_bit_cast(float, __builtin_amdgcn_readlane(__builtin_bit_cast(int, v), 31)), hi = __builtin_bit_cast(float, __builtin_amdgcn_readlane(__builtin_bit_cast(int, v), 63)); return lane < 32 ? lo : hi; }
template <int MAP> __device__ __forceinline__ int rowmap(int n) {
    if (MAP == 1) return n < 4168 ? n : n + 184;
    if (MAP == 2) return n < DFF ? ((n >> 7) * 256 + (n & 127)) : (((n - DFF) >> 7) * 256 + 128 + ((n - DFF) & 127));
    return n;
}
template <int MAP> __device__ __forceinline__ void p0_transpose_item(const float* W, int K, int N, h16* WT, const float* gain, LAS float* scr, int item, int lane) {
    const int nblk = (N + 31) / 32, kb = item / nblk, nb = item % nblk, k0 = 64 * kb, n0 = 32 * nb;
    const int nn = n0 + (lane & 31);
    float wv_[32];
#pragma unroll
    for (int i = 0; i < 32; ++i) { const int kk = 2 * i + (lane >> 5); wv_[i] = 0.f; if (nn < N) wv_[i] = W[(size_t)(k0 + kk) * N + nn]; }
    const int c = lane & 7;
    float gk[8];
#pragma unroll
    for (int j = 0; j < 8; ++j) gk[j] = 1.f;
    if (gain) { const f32x4 g0 = *(const f32x4*)(gain + k0 + 8 * c), g1 = *(const f32x4*)(gain + k0 + 8 * c + 4);
#pragma unroll
        for (int j = 0; j < 4; ++j) { gk[j] = g0[j]; gk[4 + j] = g1[j]; } }
#pragma unroll
    for (int i = 0; i < 32; ++i) { const int kk = 2 * i + (lane >> 5); scr[kk * 33 + (lane & 31)] = wv_[i]; }
    LDS_WAIT(); asm volatile("" ::: "memory");
#pragma unroll
    for (int j = 0; j < 4; ++j) { const int n = (lane >> 3) + 8 * j; const LAS float* s = scr + (8 * c) * 33 + n;
        u32x4 o; o.x = pkh(s[0 * 33] * gk[0], s[1 * 33] * gk[1]); o.y = pkh(s[2 * 33] * gk[2], s[3 * 33] * gk[3]); o.z = pkh(s[4 * 33] * gk[4], s[5 * 33] * gk[5]); o.w = pkh(s[6 * 33] * gk[6], s[7 * 33] * gk[7]);
        if (n0 + n < N) *(u32x4*)(WT + (size_t)rowmap<MAP>(n0 + n) * K + k0 + 8 * c) = o; }
    LDS_WAIT(); asm volatile("" ::: "memory");
}

struct Ctx {
    unsigned char* ws; float* out; int dry;
    const float *conv_w, *conv_b, *ba, *bx, *lam, *qn, *kn, *relb, *fcw, *fcb;
};
__device__ __forceinline__ unsigned ordered_u32(float v) { const unsigned u = __builtin_bit_cast(unsigned, v); return u ^ ((unsigned)((int)u >> 31) | 0x80000000u); }

constexpr int UA_STR = 272;
constexpr int LRU_UA = 0, LRU_HL = 128 * UA_STR, LRU_PP = 2 * 128 * UA_STR;
__device__ __forceinline__ void lru1_item(const Ctx& C, LAS unsigned char* lds, int item) {
    int tid = threadIdx.x; asm volatile("" : "+v"(tid));
    const int lane = tid & 63, wv = tid >> 6;
    const int b = item >> 7, n = (item >> 4) & 7, jg = item & 15;
    const h16* LX = (const h16*)(C.ws + WS_LX);
    const int cg = tid & 15, rg = tid >> 4, ch0 = n * 128 + cg * 8, tl = rg * 4;
    float cb[8], cw[4][8];
    { const f32x4 t0 = *(const f32x4*)(C.conv_b + ch0), t1 = *(const f32x4*)(C.conv_b + ch0 + 4); for (int e = 0; e < 4; ++e) { cb[e] = t0[e]; cb[4 + e] = t1[e]; } }
#pragma unroll
    for (int jj = 0; jj < 4; ++jj) { const f32x4 w0 = *(const f32x4*)(C.conv_w + jj * DM + ch0), w1 = *(const f32x4*)(C.conv_w + jj * DM + ch0 + 4); for (int e = 0; e < 4; ++e) { cw[jj][e] = w0[e]; cw[jj][4 + e] = w1[e]; } }
    const int q = lane & 15, c = lane >> 4, oc = wv * 16 + q, ch = n * 128 + oc;
    const h16* WG = (const h16*)(C.ws + W_GATE) + (size_t)n * 256 * 128;
    h8 Ba[4], Bx[4];
#pragma unroll
    for (int ks = 0; ks < 4; ++ks) { Ba[ks] = *(const h8*)(WG + (size_t)oc * 128 + 32 * ks + 8 * c); Bx[ks] = *(const h8*)(WG + (size_t)(128 + oc) * 128 + 32 * ks + 8 * c); }
    const float bav = C.ba[ch], bxv = C.bx[ch], m8sp = -8.0f * 1.4426950408889634f * log1pf(expf(-C.lam[ch]));
#pragma unroll 1
    for (int j4 = 0; j4 < 4; ++j4) {
    const int j = jg * 4 + j4;
    const size_t mrow0 = (size_t)b * SEQ + (size_t)j * 128;
    {
        const int tseq = j * 128 + tl;
        h8 xr[7];
#pragma unroll
        for (int i = 0; i < 7; ++i) { const int tt = tseq - 3 + i; if (tt >= 0) xr[i] = *(const h8*)(LX + ((size_t)b * SEQ + tt) * DM + ch0); else { for (int e = 0; e < 8; ++e) xr[i][e] = (h16)0.f; } }
        float y[4][8];
#pragma unroll
        for (int r = 0; r < 4; ++r)
#pragma unroll
            for (int e = 0; e < 8; ++e) y[r][e] = cb[e];
#pragma unroll
        for (int jj = 0; jj < 4; ++jj)
#pragma unroll
            for (int r = 0; r < 4; ++r)
#pragma unroll
                for (int e = 0; e < 8; ++e) y[r][e] += cw[jj][e] * (float)xr[r + jj][e];
#pragma unroll
        for (int r = 0; r < 4; ++r) { u32x4 w; w.x = pkh(y[r][0], y[r][1]); w.y = pkh(y[r][2], y[r][3]); w.z = pkh(y[r][4], y[r][5]); w.w = pkh(y[r][6], y[r][7]);
            *(LAS u32x4*)(lds + LRU_UA + (tl + r) * UA_STR + cg * 16) = w; }
    }
    __syncthreads();
    {
        float cH = 0.f, cP = 1.f;
        for (int tt = 0; tt < 8; ++tt) {
            f32x4 aa = {0.f, 0.f, 0.f, 0.f}, ax = {0.f, 0.f, 0.f, 0.f};
#pragma unroll
            for (int ks = 0; ks < 4; ++ks) { const h8 A = *(const LAS h8*)(lds + LRU_UA + (16 * tt + q) * UA_STR + (32 * ks + 8 * c) * 2);
                aa = __builtin_amdgcn_mfma_f32_16x16x32_f16(A, Ba[ks], aa, 0, 0, 0); ax = __builtin_amdgcn_mfma_f32_16x16x32_f16(A, Bx[ks], ax, 0, 0, 0); }
            float hl[4], pl[4]; float h = 0.f, p = 1.f;
#pragma unroll
            for (int i = 0; i < 4; ++i) { const int t = 16 * tt + 4 * c + i;
                const float uav = (float)*(const LAS h16*)(lds + LRU_UA + t * UA_STR + oc * 2);
                const float ra = sigmoid_f(aa[i] + bav), ix = sigmoid_f(ax[i] + bxv);
                const float a = __builtin_amdgcn_exp2f(m8sp * ra);
                const float mult = __builtin_amdgcn_sqrtf(fmaxf(1.0f - a * a, 0.f));
                const float u = mult * ix * uav;
                h = a * h + u; p *= a; hl[i] = h; pl[i] = p; }
            float Ak[4], Hk[4];
#pragma unroll
            for (int k = 0; k < 4; ++k) { Ak[k] = __shfl(p, q + 16 * k); Hk[k] = __shfl(h, q + 16 * k); }
            float PA = 1.f, PH = 0.f;
#pragma unroll
            for (int k = 0; k < 3; ++k) if (k < c) { PH = PH * Ak[k] + Hk[k]; PA *= Ak[k]; }
            const float hin = cH * PA + PH, pin = cP * PA;
#pragma unroll
            for (int i = 0; i < 4; ++i) { const int t = 16 * tt + 4 * c + i;
                *(LAS h16*)(lds + LRU_HL + t * UA_STR + oc * 2) = (h16)(hl[i] + pl[i] * hin);
                *(LAS h16*)(lds + LRU_PP + t * UA_STR + oc * 2) = (h16)(pin * pl[i]); }
            const float AT = Ak[0] * Ak[1] * Ak[2] * Ak[3], HT = ((Hk[0] * Ak[1] + Hk[1]) * Ak[2] + Hk[2]) * Ak[3] + Hk[3];
            cH = cH * AT + HT; cP = cP * AT;
        }
        if (c == 0 && !C.dry) { const size_t so = ((size_t)b * 64 + j) * DM + ch; ((float*)(C.ws + WS_SA))[so] = cP; ((float*)(C.ws + WS_SH))[so] = cH; }
    }
    __syncthreads();
    {
        h16* HLOC = (h16*)C.out; h16* PPRD = (h16*)C.out + (size_t)MTOK * DM;
#pragma unroll
        for (int r = 0; r < 4; ++r) { const int t = rg * 4 + r; const size_t go = (mrow0 + t) * DM + n * 128 + cg * 8;
            const u32x4 w0 = *(const LAS u32x4*)(lds + LRU_HL + t * UA_STR + cg * 16), w1 = *(const LAS u32x4*)(lds + LRU_PP + t * UA_STR + cg * 16);
            if (!C.dry) { *(u32x4*)(HLOC + go) = w0; *(u32x4*)(PPRD + go) = w1; } }
    }
    __syncthreads();
    }
}

__device__ __forceinline__ void lru2_item(const Ctx& C, LAS unsigned char* lds, int item) {
    int tid = threadIdx.x; asm volatile("" : "+v"(tid));
    const int b = item >> 7, n = (item >> 4) & 7, jg = item & 15, j0 = jg * 4;
    LAS float* carry = (LAS float*)lds;
    if (tid < 128) { const int ch = n * 128 + tid; const float* SA = (const float*)(C.ws + WS_SA) + (size_t)b * 64 * DM + ch; const float* SH = (const float*)(C.ws + WS_SH) + (size_t)b * 64 * DM + ch;
        float cr = 0.f; int jj = 0;
        for (; jj + 8 <= j0; jj += 8) { float a8[8], h8v[8];
#pragma unroll
            for (int k = 0; k < 8; ++k) { a8[k] = SA[(size_t)(jj + k) * DM]; h8v[k] = SH[(size_t)(jj + k) * DM]; }
#pragma unroll
            for (int k = 0; k < 8; ++k) cr = a8[k] * cr + h8v[k]; }
        for (; jj < j0; ++jj) cr = SA[(size_t)jj * DM] * cr + SH[(size_t)jj * DM];
        float a4[4], h4[4];
#pragma unroll
        for (int k = 0; k < 4; ++k) { a4[k] = SA[(size_t)(j0 + k) * DM]; h4[k] = SH[(size_t)(j0 + k) * DM]; }
#pragma unroll
        for (int k = 0; k < 4; ++k) { carry[k * 128 + tid] = cr; cr = a4[k] * cr + h4[k]; } }
    __syncthreads();
    const int cg = tid & 15, rg = tid >> 4; const h16* HLOC = (const h16*)C.out; const h16* PPRD = (const h16*)C.out + (size_t)MTOK * DM;
    const h16* GG = (const h16*)(C.ws + WS_GG); h16* YA = (h16*)(C.ws + WS_LX);
#pragma unroll 1
    for (int k = 0; k < 4; ++k) {
        float cr[8];
#pragma unroll
        for (int e = 0; e < 8; ++e) cr[e] = carry[k * 128 + cg * 8 + e];
#pragma unroll
        for (int r = 0; r < 4; ++r) { const size_t go = ((size_t)b * SEQ + (j0 + k) * 128 + rg * 4 + r) * DM + n * 128 + cg * 8;
            const h8 hl = *(const h8*)(HLOC + go), pp = *(const h8*)(PPRD + go), gg = *(const h8*)(GG + go);
            float y[8];
#pragma unroll
            for (int e = 0; e < 8; ++e) y[e] = ((float)hl[e] + (float)pp[e] * cr[e]) * (float)gg[e];
            u32x4 w; w.x = pkh(y[0], y[1]); w.y = pkh(y[2], y[3]); w.z = pkh(y[4], y[5]); w.w = pkh(y[6], y[7]);
            if (!C.dry) *(u32x4*)(YA + go) = w; } }
}

__device__ __forceinline__ unsigned pk4_fp8_k(float a, float b, float c, float d) { int w = 0; w = __builtin_amdgcn_cvt_pk_fp8_f32(a, b, w, false); w = __builtin_amdgcn_cvt_pk_fp8_f32(c, d, w, true); return (unsigned)w; }
__device__ __forceinline__ void knorm_unit(const Ctx& C, int unit) {
    int tid = threadIdx.x; asm volatile("" : "+v"(tid));
    const int lane = tid & 63, wv = tid >> 6;
    const h16* K = (const h16*)(C.ws + WS_K); const h16* V = (const h16*)(C.ws + WS_V);
    unsigned* K8 = (unsigned*)(C.ws + WS_K8); unsigned* V8 = (unsigned*)(C.ws + WS_V8);
    const int col = lane * 4, d0 = col & 127;
    const f32x4 g = *(const f32x4*)(C.kn + d0);
#pragma unroll 1
    for (int hb = 0; hb < 2; ++hb) {
        h4 kv[8], vvv[8];
#pragma unroll
        for (int r = 0; r < 8; ++r) { const size_t row = (size_t)unit * 128 + wv * 16 + hb * 8 + r; kv[r] = *(const h4*)(K + row * 256 + col); vvv[r] = *(const h4*)(V + row * 256 + col); }
#pragma unroll
        for (int r = 0; r < 8; ++r) { const size_t row = (size_t)unit * 128 + wv * 16 + hb * 8 + r;
            float ss = 0.f, f[4];
#pragma unroll
            for (int e = 0; e < 4; ++e) { f[e] = (float)kv[r][e]; ss += f[e] * f[e]; }
            ss = half_sum(ss, lane);
            const float rs = __builtin_amdgcn_rsqf(ss * (1.0f / 128.0f) + EPS);
            const unsigned wk = pk4_fp8_k(f[0] * rs * g[0], f[1] * rs * g[1], f[2] * rs * g[2], f[3] * rs * g[3]);
            const unsigned wvv = pk4_fp8_k((float)vvv[r][0], (float)vvv[r][1], (float)vvv[r][2], (float)vvv[r][3]);
            if (!C.dry) { K8[row * 64 + lane] = wk; V8[row * 64 + lane] = wvv; } } }
}

#ifdef IX_PROBE
#define IX_PROBE_FINAL (C.dry && (IX_PROBE & 2))
#define IX_PROBE_NOFILT (C.dry && (IX_PROBE & 1))
#else
#define IX_PROBE_FINAL 0
#define IX_PROBE_NOFILT 0
#endif
constexpr int IX_SK = 256;
constexpr int IX_CAP = 1024;
constexpr int IX_ORD = 0;
constexpr int IX_KEY = IX_ORD + 16 * IX_CAP * 4;
constexpr int IX_HIST = IX_KEY + 16 * IX_CAP * 2;
constexpr int IX_CTR = IX_HIST + 8 * 512;
constexpr int IX_END = IX_CTR + 128;
static_assert(IX_END <= MISC_OFF, "indexer LDS");
constexpr int IX_NE = IX_CAP / 64;

struct IxBuf { LAS unsigned* ord; LAS unsigned short* key; };
#define IX_DPPMAX(v, ctl, rm) { const unsigned t_ = (unsigned)__builtin_amdgcn_update_dpp((int)(v), (int)(v), ctl, rm, 0xf, false); v = t_ > v ? t_ : v; }
__device__ __forceinline__ unsigned ix_rowmax(unsigned v) { IX_DPPMAX(v, 0xB1, 0xf) IX_DPPMAX(v, 0x4E, 0xf) IX_DPPMAX(v, 0x141, 0xf) IX_DPPMAX(v, 0x140, 0xf) return v; }
__device__ __forceinline__ unsigned ix_wavemax(unsigned v) { v = ix_rowmax(v); IX_DPPMAX(v, 0x142, 0xa) IX_DPPMAX(v, 0x143, 0xc) return (unsigned)__builtin_amdgcn_readlane((int)v, 63); }
__device__ __forceinline__ void ix_load_ord(const IxBuf& B, int cnt, int lane, unsigned (&o)[IX_NE]) {
#pragma unroll
    for (int k = 0; k < IX_NE; ++k) { const int idx = k * 64 + lane; o[k] = idx < cnt ? B.ord[idx] : 0u; }
}
__device__ __forceinline__ int ix_count_ge(const unsigned (&o)[IX_NE], unsigned x) {
    int c = 0;
#pragma unroll
    for (int k = 0; k < IX_NE; ++k) c += (int)__builtin_popcountll(__ballot(o[k] >= x));
    return c;
}
__device__ __forceinline__ unsigned ix_max(const unsigned (&o)[IX_NE]) {
    unsigned m = 0u;
#pragma unroll
    for (int k = 0; k < IX_NE; ++k) m = o[k] > m ? o[k] : m;
    return ix_wavemax(m);
}
__device__ __forceinline__ unsigned ix_tie_thr(const unsigned (&o)[IX_NE], const unsigned short (&kk)[IX_NE], unsigned x, int need) {
    unsigned lo = 0u, hi = 0x10000u;
    while (hi - lo > 1u) { const unsigned mid = (lo + hi) >> 1; int c = 0;
#pragma unroll
        for (int k = 0; k < IX_NE; ++k) c += (int)__builtin_popcountll(__ballot(o[k] == x && (unsigned)kk[k] >= mid));
        if (c >= need) lo = mid; else hi = mid; }
    return lo;
}
__device__ __forceinline__ int ix_rewrite(const IxBuf& B, const unsigned (&o)[IX_NE], const unsigned short (&kk)[IX_NE], int lane, unsigned x, unsigned th) {
    int base = 0;
#pragma unroll
    for (int k = 0; k < IX_NE; ++k) { const bool keep = o[k] > x || (o[k] == x && (unsigned)kk[k] >= th);
        const u64 m = __ballot(keep); const int pos = base + (int)__builtin_amdgcn_mbcnt_hi((unsigned)(m >> 32), __builtin_amdgcn_mbcnt_lo((unsigned)m, 0u));
        if (keep) { B.ord[pos] = o[k]; B.key[pos] = kk[k]; }
        base += (int)__builtin_popcountll(m); }
    LDS_WAIT();
    return base;
}
__device__ __forceinline__ unsigned ix_sample_pivot(unsigned s0, int rank) {
    int r = 0;
#define IX_ROT(n) { const unsigned t_ = (unsigned)__builtin_amdgcn_update_dpp(0, (int)s0, 0x120 + n, 0xf, 0xf, false); r += t_ > s0 ? 1 : 0; }
    IX_ROT(1) IX_ROT(2) IX_ROT(3) IX_ROT(4) IX_ROT(5) IX_ROT(6) IX_ROT(7) IX_ROT(8) IX_ROT(9) IX_ROT(10) IX_ROT(11) IX_ROT(12) IX_ROT(13) IX_ROT(14) IX_ROT(15)
#undef IX_ROT
    unsigned v = r >= rank ? s0 : 0u;
    v = ix_rowmax(v);
    return ((unsigned)__builtin_amdgcn_readlane((int)v, 0) >> 2) + ((unsigned)__builtin_amdgcn_readlane((int)v, 16) >> 2) + ((unsigned)__builtin_amdgcn_readlane((int)v, 32) >> 2) + ((unsigned)__builtin_amdgcn_readlane((int)v, 48) >> 2);
}
__device__ __forceinline__ unsigned ix_find_window(const unsigned (&o)[IX_NE], unsigned lo, unsigned hi, int cnt, int cmin, int cmax, bool& tie) {
    tie = false;
    int rank = (16 * ((cmin + cmax) / 2)) / cnt; rank = rank > 14 ? 14 : rank;
    unsigned x = ix_sample_pivot(o[0], rank);
    if (x <= lo || x >= hi) x = lo + ((hi - lo) >> 1);
    for (;;) { const int c = ix_count_ge(o, x);
        if (c > cmax) lo = x; else if (c < cmin) hi = x; else return x - 1u;
        if (hi - lo <= 1u) { tie = true; return lo; }
        x = lo + ((hi - lo) >> 1); }
}
__device__ __forceinline__ unsigned ix_compact(const IxBuf& B, int lane, int& cnt, unsigned T) {
    unsigned o[IX_NE]; ix_load_ord(B, cnt, lane, o);
    unsigned short kk[IX_NE];
#pragma unroll
    for (int k = 0; k < IX_NE; ++k) kk[k] = B.key[k * 64 + lane];
    LDS_WAIT();
    bool tie; unsigned th = 0x10000u;
    const unsigned x = ix_find_window(o, T, ix_max(o) + 1u, cnt, 256, 512, tie);
    if (tie) th = ix_tie_thr(o, kk, x, 512 - ix_count_ge(o, x + 1u));
    cnt = ix_rewrite(B, o, kk, lane, x, th); return x + 1u;
}
__device__ __forceinline__ unsigned ix_compact_to(const IxBuf& B, int lane, int& cnt, unsigned T) {
    unsigned o[IX_NE]; ix_load_ord(B, cnt, lane, o);
    unsigned short kk[IX_NE];
#pragma unroll
    for (int k = 0; k < IX_NE; ++k) kk[k] = B.key[k * 64 + lane];
    LDS_WAIT();
    bool tie; unsigned th = 0x10000u;
    const unsigned x = ix_find_window(o, T, ix_max(o) + 1u, cnt, 256, 320, tie);
    if (tie) th = ix_tie_thr(o, kk, x, 320 - ix_count_ge(o, x + 1u));
    cnt = ix_rewrite(B, o, kk, lane, x, th); return x + 1u;
}
__device__ __forceinline__ void ix_final(const IxBuf& B, LAS unsigned short* outl, int lane, int cnt, unsigned T, unsigned short* idx_row, int* nv_ptr, int dry) {
    if (cnt > 320) { cnt = cnt < IX_CAP ? cnt : IX_CAP; T = ix_compact_to(B, lane, cnt, T); }
    unsigned o[5]; unsigned short kk[5];
#pragma unroll
    for (int k = 0; k < 5; ++k) { const int idx = k * 64 + lane; o[k] = idx < cnt ? B.ord[idx] : 0u; kk[k] = B.key[idx]; }
    LDS_WAIT();
    unsigned x = 0u, th = 0u;
    if (cnt > 256) { unsigned mxv = 0u;
#pragma unroll
        for (int k = 0; k < 5; ++k) mxv = o[k] > mxv ? o[k] : mxv;
        mxv = ix_wavemax(mxv);
        unsigned lo = T, hi = mxv + 1u;
        for (;;) { if (hi - lo <= 1u) { x = lo; int ca = 0, need;
#pragma unroll
                for (int k = 0; k < 5; ++k) ca += (int)__builtin_popcountll(__ballot(o[k] >= lo + 1u));
                need = 256 - ca; unsigned tl = 0u, thh = 0x10000u;
                while (thh - tl > 1u) { const unsigned mid = (tl + thh) >> 1; int c = 0;
#pragma unroll
                    for (int k = 0; k < 5; ++k) c += (int)__builtin_popcountll(__ballot(o[k] == x && (unsigned)kk[k] >= mid));
                    if (c >= need) tl = mid; else thh = mid; }
                th = tl; break; }
            const unsigned mid = lo + ((hi - lo) >> 1); int c = 0;
#pragma unroll
            for (int k = 0; k < 5; ++k) c += (int)__builtin_popcountll(__ballot(o[k] >= mid));
            if (c == 256) { x = mid - 1u; th = 0x10000u; break; }
            if (c > 256) lo = mid; else hi = mid; } }
    int base = 0;
#pragma unroll
    for (int k = 0; k < 5; ++k) { const bool valid = k * 64 + lane < cnt; const bool sel = valid && (o[k] > x || (o[k] == x && (unsigned)kk[k] >= th));
        const u64 m = __ballot(sel); const int pos = base + (int)__builtin_amdgcn_mbcnt_hi((unsigned)(m >> 32), __builtin_amdgcn_mbcnt_lo((unsigned)m, 0u));
        if (sel && pos < 256) outl[pos] = (unsigned short)(0xFFFFu - (unsigned)kk[k]);
        base += (int)__builtin_popcountll(m); }
    LDS_WAIT();
    const int nsel = base < 256 ? base : 256;
    const u32x2 ow = *(const LAS u32x2*)(outl + lane * 4);
    if (!dry) { *(u32x2*)(idx_row + lane * 4) = ow; if (lane == 0) *nv_ptr = nsel; }
    LDS_WAIT();
}
__device__ __forceinline__ float ix_unordered(unsigned T) { const unsigned u = (T & 0x80000000u) ? (T ^ 0x80000000u) : ~T; return __builtin_bit_cast(float, u); }

__device__ __forceinline__ void indexer_unit(const Ctx& C, LAS unsigned char* lds, int unit) {
    int tid = threadIdx.x; asm volatile("" : "+v"(tid));
    const int lane = tid & 63, wv = __builtin_amdgcn_readfirstlane(tid >> 6);
    const int b = unit & 3, qt = 511 - (unit >> 2), t0 = qt * 16;
    const int q = lane & 15, c = lane >> 4;
    const size_t m0 = (size_t)b * SEQ + t0;
    const h16* QI = (const h16*)(C.ws + WS_QI); const h16* KI = (const h16*)(C.ws + WS_KI) + (size_t)b * SEQ * 64; const float* WI = (const float*)(C.ws + WS_WI);
    LAS unsigned* cntl = (LAS unsigned*)(lds + IX_CTR); volatile LAS float* taul = (volatile LAS float*)(lds + IX_CTR + 64);
    if (tid < 16) { cntl[tid] = 0u; taul[tid] = -3.402823466e38f; }
    h8 qf[8][2];
#pragma unroll
    for (int h = 0; h < 8; ++h)
#pragma unroll
        for (int ks = 0; ks < 2; ++ks) qf[h][ks] = *(const h8*)(QI + ((((m0 >> 4) * 8 + h) * 2 + ks) * 64 + lane) * 8);
    float wvv[8]; { const f32x4 w0 = *(const f32x4*)(WI + (m0 + q) * 8), w1 = *(const f32x4*)(WI + (m0 + q) * 8 + 4); for (int e = 0; e < 4; ++e) { wvv[e] = w0[e]; wvv[4 + e] = w1[e]; } }
#pragma unroll
    for (int h = 0; h < 8; ++h) wvv[h] *= 0.5f;
    h8 qs[2];
#pragma unroll
    for (int ks = 0; ks < 2; ++ks)
#pragma unroll
        for (int j = 0; j < 8; ++j) { float a = 0.f;
#pragma unroll
            for (int h = 0; h < 8; ++h) a += wvv[h] * (float)qf[h][ks][j];
            qs[ks][j] = (h16)a; }
    const int nkeys = t0 + 16, nslab = (nkeys + IX_SK - 1) / IX_SK;
    LAS unsigned* ordq = (LAS unsigned*)(lds + IX_ORD) + (size_t)q * IX_CAP; LAS unsigned short* keyq = (LAS unsigned short*)(lds + IX_KEY) + (size_t)q * IX_CAP;
    IxBuf BA, BB;
    BA.ord = (LAS unsigned*)(lds + IX_ORD) + (size_t)(2 * wv) * IX_CAP; BA.key = (LAS unsigned short*)(lds + IX_KEY) + (size_t)(2 * wv) * IX_CAP;
    BB.ord = BA.ord + IX_CAP; BB.key = BA.key + IX_CAP;
    LAS unsigned short* outl = (LAS unsigned short*)(lds + IX_HIST) + wv * 256;
    unsigned TA = 0x00800000u, TB = 0x00800000u; float tq = -3.402823466e38f;
    __syncthreads();
#define IX_LOADK(dst, s_) do { const int sc_ = (s_) < nslab - 1 ? (s_) : nslab - 1; _Pragma("unroll") for (int jt_ = 0; jt_ < 2; ++jt_) { int key0_ = sc_ * IX_SK + 32 * wv + 16 * jt_; key0_ = key0_ < nkeys ? key0_ : nkeys - 16; \
        const h16* p_ = KI + ((size_t)(key0_ >> 4) * 128 + lane) * 8;        \
        asm volatile("global_load_dwordx4 %0, %2, off\n\tglobal_load_dwordx4 %1, %2, off offset:1024" : "=&v"(dst[jt_][0]), "=&v"(dst[jt_][1]) : "v"(p_) : "memory"); } } while (0)
#define IX_WAITK(KF) asm volatile("s_waitcnt vmcnt(4)" : "+v"(KF[0][0]), "+v"(KF[0][1]), "+v"(KF[1][0]), "+v"(KF[1][1]) :: "memory")
#define IX_MM2(KF, A_, B_, Q0, Q1) do { A_ = __builtin_amdgcn_mfma_f32_16x16x32_f16(KF[0][0], Q0, (f32x4){0.f, 0.f, 0.f, 0.f}, 0, 0, 0); B_ = __builtin_amdgcn_mfma_f32_16x16x32_f16(KF[1][0], Q0, (f32x4){0.f, 0.f, 0.f, 0.f}, 0, 0, 0); \
        A_ = __builtin_amdgcn_mfma_f32_16x16x32_f16(KF[0][1], Q1, A_, 0, 0, 0); B_ = __builtin_amdgcn_mfma_f32_16x16x32_f16(KF[1][1], Q1, B_, 0, 0, 0); } while (0)
#define IX_SCORE2(KF, sca, scb) do { \
        f32x4 ta_[2], tb_[2]; \
        IX_MM2(KF, sca, scb, qs[0], qs[1]); IX_MM2(KF, ta_[0], tb_[0], qf[0][0], qf[0][1]); \
        _Pragma("unroll") for (int h = 0; h < 8; ++h) {        \
            __builtin_amdgcn_sched_barrier(0); \
            if (h < 7) IX_MM2(KF, ta_[(h + 1) & 1], tb_[(h + 1) & 1], qf[h + 1][0], qf[h + 1][1]); \
            __builtin_amdgcn_sched_barrier(0); \
            _Pragma("unroll") for (int i = 0; i < 4; ++i) { sca[i] = __builtin_fmaf(wvv[h], __builtin_fabsf(ta_[h & 1][i]), sca[i]); asm("" : "+v"(sca[i])); }   \
            _Pragma("unroll") for (int i = 0; i < 4; ++i) { scb[i] = __builtin_fmaf(wvv[h], __builtin_fabsf(tb_[h & 1][i]), scb[i]); asm("" : "+v"(scb[i])); } } \
        __builtin_amdgcn_sched_barrier(0); } while (0)
#define IX_SCORE(KF, sc, jt, key0) do { \
        sc = __builtin_amdgcn_mfma_f32_16x16x32_f16(KF[jt][0], qs[0], (f32x4){0.f, 0.f, 0.f, 0.f}, 0, 0, 0); sc = __builtin_amdgcn_mfma_f32_16x16x32_f16(KF[jt][1], qs[1], sc, 0, 0, 0); \
        _Pragma("unroll") for (int h = 0; h < 8; ++h) { f32x4 a = {0.f, 0.f, 0.f, 0.f}; \
            a = __builtin_amdgcn_mfma_f32_16x16x32_f16(KF[jt][0], qf[h][0], a, 0, 0, 0); a = __builtin_amdgcn_mfma_f32_16x16x32_f16(KF[jt][1], qf[h][1], a, 0, 0, 0); \
            _Pragma("unroll") for (int i = 0; i < 4; ++i) { sc[i] = __builtin_fmaf(wvv[h], __builtin_fabsf(a[i]), sc[i]); asm("" : "+v"(sc[i])); } } } while (0)
#define IX_MASK(sc, key0) do { if ((key0) + 15 > t0) {        \
            _Pragma("unroll") for (int i = 0; i < 4; ++i) if ((key0) + 4 * c + i > t0 + q) sc[i] = -INFINITY; } } while (0)
#define IX_ASK(sc, ps, pos) do { _Pragma("unroll") for (int i = 0; i < 4; ++i) { ps[i] = sc[i] >= tq; pos[i] = 0u; if (ps[i]) pos[i] = __hip_atomic_fetch_add(cntl + q, 1u, __ATOMIC_RELAXED, __HIP_MEMORY_SCOPE_WORKGROUP); } } while (0)
#define IX_PUT(sc, ps, pos, key0) do { _Pragma("unroll") for (int i = 0; i < 4; ++i) if (ps[i]) { ordq[pos[i]] = ordered_u32(sc[i] + 0.0f); keyq[pos[i]] = (unsigned short)(0xFFFFu - (unsigned)((key0) + 4 * c + i)); } } while (0)
#define IX_STEP(sv, KF) do { const int s_ = (sv); if (s_ < nslab) { \
        IX_WAITK(KF); \
        const int key0a = s_ * IX_SK + (2 * wv) * 16, key0b = key0a + 16; \
        const bool hb = key0b < nkeys;                                 \
        if (key0a < nkeys) { \
            f32x4 sca, scb; bool psa[4], psb[4]; unsigned posa[4], posb[4]; \
            if (hb) { IX_SCORE2(KF, sca, scb); IX_MASK(sca, key0a); IX_MASK(scb, key0b); \
                if (!IX_PROBE_NOFILT) { IX_ASK(sca, psa, posa); IX_ASK(scb, psb, posb); IX_PUT(sca, psa, posa, key0a); IX_PUT(scb, psb, posb, key0b); } } \
            else { IX_SCORE(KF, sca, 0, key0a); IX_MASK(sca, key0a); if (!IX_PROBE_NOFILT) { IX_ASK(sca, psa, posa); IX_PUT(sca, psa, posa, key0a); } } \
        } \
        IX_LOADK(KF, s_ + 2);                                         \
        LDS_WAIT(); \
        __syncthreads(); \
        const unsigned mycnt = cntl[q];                               \
        if (__ballot(mycnt > (unsigned)(IX_CAP - IX_SK)) != 0ull) {       \
            int ca = (int)cntl[2 * wv], cb = (int)cntl[2 * wv + 1]; ca = ca < IX_CAP ? ca : IX_CAP; cb = cb < IX_CAP ? cb : IX_CAP; \
            if (ca > 512) { TA = ix_compact(BA, lane, ca, TA); if (lane == 0) { cntl[2 * wv] = (unsigned)ca; taul[2 * wv] = ix_unordered(TA); } } \
            if (cb > 512) { TB = ix_compact(BB, lane, cb, TB); if (lane == 0) { cntl[2 * wv + 1] = (unsigned)cb; taul[2 * wv + 1] = ix_unordered(TB); } } \
            LDS_WAIT(); \
            __syncthreads(); \
            tq = taul[q]; } \
        } } while (0)
    h8 ka[2][2], kb[2][2];
    asm volatile("s_waitcnt vmcnt(0)" ::: "memory");
    IX_LOADK(ka, 0); IX_LOADK(kb, 1);
    for (int s = 0; s < nslab; s += 2) { IX_STEP(s, ka); IX_STEP(s + 1, kb); }
    asm volatile("s_waitcnt vmcnt(0)" : "+v"(ka[0][0]), "+v"(ka[0][1]), "+v"(ka[1][0]), "+v"(ka[1][1]), "+v"(kb[0][0]), "+v"(kb[0][1]), "+v"(kb[1][0]), "+v"(kb[1][1]) :: "memory");
#undef IX_STEP
#undef IX_SCORE
#undef IX_SCORE2
#undef IX_MM2
#undef IX_MASK
#undef IX_ASK
#undef IX_PUT
#undef IX_LOADK
#undef IX_WAITK
    LDS_WAIT();
    if (IX_PROBE_FINAL) return;
    unsigned short* IDX = (unsigned short*)(C.ws + WS_IDX); int* NV = (int*)(C.ws + WS_NV);
    int ca = (int)cntl[2 * wv], cb = (int)cntl[2 * wv + 1]; ca = ca < IX_CAP ? ca : IX_CAP; cb = cb < IX_CAP ? cb : IX_CAP;
    ix_final(BA, outl, lane, ca, TA, IDX + (m0 + 2 * wv) * 256, NV + m0 + 2 * wv, C.dry);
    ix_final(BB, outl, lane, cb, TB, IDX + (m0 + 2 * wv + 1) * 256, NV + m0 + 2 * wv + 1, C.dry);
}


constexpr int AT_CH = 4096;
constexpr int AT_NR = 4;
constexpr int AT_WAVE = AT_NR * AT_CH + 1024;
constexpr int AT_TAB = 8 * AT_WAVE;
constexpr int AT_QN = AT_TAB + 129 * 8 * 4;
constexpr int AT_END = AT_QN + 512;
static_assert(AT_END + 1024 <= MISC_OFF && (AT_WAVE % 16) == 0 && (AT_QN % 16) == 0, "attention LDS");
constexpr int AT_QPW = 8;
__device__ __forceinline__ int at_f(int row) { return 2 * ((row >> 1) & 3) | ((row >> 3) & 1); }

__device__ __forceinline__ void attn_build_tab(const Ctx& C, LAS unsigned char* lds) {
    LAS float* tab = (LAS float*)(lds + AT_TAB);
    for (int e = threadIdx.x; e < 129 * 8; e += NTHR) { const int d = e >> 3, h = e & 7; int bk;
        if (d < 16) bk = d; else { bk = 16 + (int)(logf((float)d / 16.0f) / 2.0794415416798357f * 16.0f); if (bk > 31) bk = 31; }
        tab[e] = C.relb[bk * 8 + h]; }
    if (threadIdx.x < 128) ((LAS float*)(lds + AT_QN))[threadIdx.x] = C.qn[threadIdx.x];
}
__device__ __forceinline__ void at_issue(const unsigned char* base, const LAS unsigned short* idl, int pos0, LAS unsigned char* buf, int lane) {
#pragma unroll
    for (int k2 = 0; k2 < 4; ++k2) { const int row = (lane >> 3) + 8 * k2, slot = lane & 7; const int idx = idl[pos0 + row];
        __builtin_amdgcn_global_load_lds((const unsigned*)(base + (size_t)idx * 256 + ((slot ^ at_f(row)) << 4)), (LAS unsigned*)(buf + k2 * 1024), 16, 0, 0); }
}
__device__ __forceinline__ unsigned pk4_fp8(float a, float b, float c, float d) { int w = 0; w = __builtin_amdgcn_cvt_pk_fp8_f32(a, b, w, false); w = __builtin_amdgcn_cvt_pk_fp8_f32(c, d, w, true); return (unsigned)w; }
__device__ __forceinline__ long mk64(unsigned lo, unsigned hi) { return (long)(((u64)hi << 32) | (u64)lo); }
#define AT_WAITN(n) asm volatile("s_waitcnt vmcnt(" #n ")" ::: "memory")

__device__ __forceinline__ void attn_item(const Ctx& C, LAS unsigned char* lds, int item) {
    int tid = threadIdx.x; asm volatile("" : "+v"(tid));
    const int lane = tid & 63, wv = __builtin_amdgcn_readfirstlane(tid >> 6);
    const int g = lane & 15, c = lane >> 4, gq = g & 3;
    const int qsel = item / (SEQ / (8 * AT_QPW)), b = qsel >> 1, n = qsel & 1, tbase = (item % (SEQ / (8 * AT_QPW))) * (8 * AT_QPW) + wv;
    LAS unsigned char* ring = lds + wv * AT_WAVE;
    LAS unsigned short* idlb = (LAS unsigned short*)(ring + AT_NR * AT_CH);
    const LAS float* tab = (const LAS float*)(lds + AT_TAB);
    const LAS float* qnl = (const LAS float*)(lds + AT_QN);
    const unsigned char* Kb = (const unsigned char*)(C.ws + WS_K8) + (size_t)b * SEQ * 256 + n * 128; const unsigned char* Vb = (const unsigned char*)(C.ws + WS_V8) + (size_t)b * SEQ * 256 + n * 128;
    const unsigned short* IDXb = (const unsigned short*)(C.ws + WS_IDX) + (size_t)b * SEQ * 256; const int* NVb = (const int*)(C.ws + WS_NV) + (size_t)b * SEQ;
    h16* Qb = (h16*)(C.ws + WS_Q) + (size_t)b * SEQ * DM + n * 512;
    const int fg = at_f(g), q4 = g >> 2, p4 = g & 3, rowA = 4 * c + q4, fr = at_f(rowA);
    u32x2 a_idx; int a_nv; h8 a_q[4];
#define AT_STAGE_A(tq) do { const size_t m_ = (size_t)(tq); a_idx = *(const u32x2*)(IDXb + m_ * 256 + lane * 4); a_nv = NVb[m_]; \
        _Pragma("unroll") for (int ks = 0; ks < 4; ++ks) a_q[ks] = *(const h8*)(Qb + m_ * DM + gq * 128 + 32 * c + 8 * ks); } while (0)
#define AT_STAGE_B(idl_, qf_, nv_) do { nv_ = a_nv; { const int p0 = lane * 4; unsigned s0 = a_idx.x & 0xFFFFu, s1 = a_idx.x >> 16, s2 = a_idx.y & 0xFFFFu, s3 = a_idx.y >> 16; \
          if (p0 + 0 >= nv_) s0 = 0; if (p0 + 1 >= nv_) s1 = 0; if (p0 + 2 >= nv_) s2 = 0; if (p0 + 3 >= nv_) s3 = 0; \
          u32x2 o_; o_.x = s0 | (s1 << 16); o_.y = s2 | (s3 << 16); *(LAS u32x2*)((idl_) + lane * 4) = o_; } \
        float ss_ = 0.f; _Pragma("unroll") for (int ks = 0; ks < 4; ++ks) _Pragma("unroll") for (int e = 0; e < 8; ++e) { const float x_ = (float)a_q[ks][e]; ss_ += x_ * x_; } \
        ss_ += __shfl_xor(ss_, 16); ss_ += __shfl_xor(ss_, 32); \
        const float rs_ = g < 4 ? __builtin_amdgcn_rsqf(ss_ * (1.0f / 128.0f) + EPS) : 0.f; \
        _Pragma("unroll") for (int ks = 0; ks < 4; ++ks) { const f32x4 g0 = *(const LAS f32x4*)(qnl + 32 * c + 8 * ks), g1 = *(const LAS f32x4*)(qnl + 32 * c + 8 * ks + 4); \
            qf_[ks] = mk64(pk4_fp8((float)a_q[ks][0] * rs_ * g0[0], (float)a_q[ks][1] * rs_ * g0[1], (float)a_q[ks][2] * rs_ * g0[2], (float)a_q[ks][3] * rs_ * g0[3]), \
                           pk4_fp8((float)a_q[ks][4] * rs_ * g1[0], (float)a_q[ks][5] * rs_ * g1[1], (float)a_q[ks][6] * rs_ * g1[2], (float)a_q[ks][7] * rs_ * g1[3])); } \
        LDS_WAIT(); } while (0)
    long qf[4]; int nv;
    AT_STAGE_A(tbase);
    AT_STAGE_B(idlb, qf, nv);
    AT_WAITN(0);
#pragma unroll
    for (int i = 0; i < AT_NR; ++i) at_issue(Kb, idlb, 32 * i, ring + i * AT_CH, lane);
#pragma unroll 1
    for (int k = 0; k < AT_QPW; ++k) {
        const int t = tbase + 8 * k, tn = k + 1 < AT_QPW ? t + 8 : t;
        const LAS unsigned short* idl = idlb + (k & 1) * 256; LAS unsigned short* idln = idlb + ((k + 1) & 1) * 256;
        float S[16][4];
#pragma unroll
        for (int kc = 0; kc < 8; ++kc) {
            LAS unsigned char* buf = ring + (kc & 3) * AT_CH;
            if (kc <= 4) AT_WAITN(12); else AT_WAITN(18);
#pragma unroll
            for (int j = 0; j < 2; ++j) { f32x4 a = {0.f, 0.f, 0.f, 0.f};
                const u32x4 A0 = *(const LAS u32x4*)(buf + (16 * j + g) * 128 + (((2 * c) ^ fg) << 4)), A1 = *(const LAS u32x4*)(buf + (16 * j + g) * 128 + (((2 * c + 1) ^ fg) << 4));
                a = __builtin_amdgcn_mfma_f32_16x16x32_fp8_fp8(mk64(A0.x, A0.y), qf[0], a, 0, 0, 0); a = __builtin_amdgcn_mfma_f32_16x16x32_fp8_fp8(mk64(A0.z, A0.w), qf[1], a, 0, 0, 0);
                a = __builtin_amdgcn_mfma_f32_16x16x32_fp8_fp8(mk64(A1.x, A1.y), qf[2], a, 0, 0, 0); a = __builtin_amdgcn_mfma_f32_16x16x32_fp8_fp8(mk64(A1.z, A1.w), qf[3], a, 0, 0, 0);
#pragma unroll
                for (int i = 0; i < 4; ++i) S[2 * kc + j][i] = a[i]; }
            LDS_WAIT();
            if (kc < 4) at_issue(Kb, idl, 32 * (kc + 4), buf, lane); else at_issue(Vb, idl, 32 * (kc - 4), buf, lane);
            if (kc == 4) AT_STAGE_A(tn);
        }
        const int rq = g >> 2;
        float V[4][4];
#pragma unroll
        for (int kk = 0; kk < 4; ++kk)
#pragma unroll
            for (int i = 0; i < 4; ++i) { int v = __builtin_bit_cast(int, S[kk][i]);
                v = __builtin_amdgcn_update_dpp(v, __builtin_bit_cast(int, S[4 + kk][i]), 0x114, 0xf, 0x2, false);
                v = __builtin_amdgcn_update_dpp(v, __builtin_bit_cast(int, S[8 + kk][i]), 0x118, 0xf, 0x4, false);
                v = __builtin_amdgcn_update_dpp(v, __builtin_bit_cast(int, S[12 + kk][i]), 0x11c, 0xf, 0x8, false);
                V[kk][i] = __builtin_bit_cast(float, v); }
        float mx = -INFINITY; const int nvc = nv - 4 * c - 64 * rq;
#pragma unroll
        for (int kk = 0; kk < 4; ++kk) { const u32x2 iw = *(const LAS u32x2*)(idl + 64 * rq + 16 * kk + 4 * c);
            const int ki[4] = {(int)(iw.x & 0xFFFFu), (int)(iw.x >> 16), (int)(iw.y & 0xFFFFu), (int)(iw.y >> 16)};
#pragma unroll
            for (int i = 0; i < 4; ++i) { int dist = t - ki[i]; dist = dist < 0 ? 0 : (dist > 128 ? 128 : dist);
                const float sv = V[kk][i] * 0.08838834764831845f + tab[dist * 8 + 4 * n + gq];
                const float s = (16 * kk + i) < nvc ? sv : -INFINITY; V[kk][i] = s; mx = fmaxf(mx, s); } }
        mx = fmaxf(mx, __builtin_bit_cast(float, __builtin_amdgcn_update_dpp(0, __builtin_bit_cast(int, mx), 0x124, 0xf, 0xf, false)));
        mx = fmaxf(mx, __builtin_bit_cast(float, __builtin_amdgcn_update_dpp(0, __builtin_bit_cast(int, mx), 0x128, 0xf, 0xf, false)));
        mx = fmaxf(mx, __shfl_xor(mx, 16)); mx = fmaxf(mx, __shfl_xor(mx, 32));
        float sum = 0.f; unsigned Pq[4];
#pragma unroll
        for (int kk = 0; kk < 4; ++kk) { float p[4];
#pragma unroll
            for (int i = 0; i < 4; ++i) { p[i] = __builtin_amdgcn_exp2f((V[kk][i] - mx) * 1.4426950408889634f); sum += p[i]; }
            Pq[kk] = pk4_fp8(p[0] * 256.0f, p[1] * 256.0f, p[2] * 256.0f, p[3] * 256.0f); }
        sum += __builtin_bit_cast(float, __builtin_amdgcn_update_dpp(0, __builtin_bit_cast(int, sum), 0x124, 0xf, 0xf, false));
        sum += __builtin_bit_cast(float, __builtin_amdgcn_update_dpp(0, __builtin_bit_cast(int, sum), 0x128, 0xf, 0xf, false));
        sum += __shfl_xor(sum, 16); sum += __shfl_xor(sum, 32);
        unsigned P8[16];
#pragma unroll
        for (int kk = 0; kk < 4; ++kk) { P8[kk] = Pq[kk];
            P8[4 + kk] = (unsigned)__builtin_amdgcn_update_dpp(0, (int)Pq[kk], 0x104, 0xf, 0xf, true);
            P8[8 + kk] = (unsigned)__builtin_amdgcn_update_dpp(0, (int)Pq[kk], 0x108, 0xf, 0xf, true);
            P8[12 + kk] = (unsigned)__builtin_amdgcn_update_dpp(0, (int)Pq[kk], 0x10c, 0xf, 0xf, true); }
        long qfn[4]; int nvn;
        AT_STAGE_B(idln, qfn, nvn);
        f32x4 oe[4], oo[4];
#pragma unroll
        for (int dt = 0; dt < 4; ++dt) { oe[dt] = (f32x4){0.f, 0.f, 0.f, 0.f}; oo[dt] = (f32x4){0.f, 0.f, 0.f, 0.f}; }
#pragma unroll
        for (int vc = 0; vc < 8; ++vc) {
            LAS unsigned char* buf = ring + (vc & 3) * AT_CH;
            if (vc == 0) AT_WAITN(18); else AT_WAITN(12);
            const long pf = mk64(P8[2 * vc], P8[2 * vc + 1]);
            u32x2 t0[4], t1[4];
            const unsigned ba = (unsigned)(size_t)buf;
#pragma unroll
            for (int dt = 0; dt < 4; ++dt) { const unsigned ad = ba + (unsigned)(rowA * 128 + (((2 * dt + (p4 >> 1)) ^ fr) << 4) + 8 * (p4 & 1));
                asm volatile("ds_read_b64_tr_b16 %0, %1" : "=&v"(t0[dt]) : "v"(ad) : "memory");
                asm volatile("ds_read_b64_tr_b16 %0, %1 offset:2048" : "=&v"(t1[dt]) : "v"(ad) : "memory"); }
            asm volatile("s_waitcnt lgkmcnt(0)" : "+v"(t0[0]), "+v"(t0[1]), "+v"(t0[2]), "+v"(t0[3]), "+v"(t1[0]), "+v"(t1[1]), "+v"(t1[2]), "+v"(t1[3]) :: "memory");
#pragma unroll
            for (int dt = 0; dt < 4; ++dt) {
                const long be = mk64(__builtin_amdgcn_perm(t0[dt].y, t0[dt].x, 0x06040200u), __builtin_amdgcn_perm(t1[dt].y, t1[dt].x, 0x06040200u));
                const long bo = mk64(__builtin_amdgcn_perm(t0[dt].y, t0[dt].x, 0x07050301u), __builtin_amdgcn_perm(t1[dt].y, t1[dt].x, 0x07050301u));
                oe[dt] = __builtin_amdgcn_mfma_f32_16x16x32_fp8_fp8(pf, be, oe[dt], 0, 0, 0); oo[dt] = __builtin_amdgcn_mfma_f32_16x16x32_fp8_fp8(pf, bo, oo[dt], 0, 0, 0); }
            if (vc < 4) at_issue(Vb, idl, 32 * (vc + 4), buf, lane); else at_issue(Kb, idln, 32 * (vc - 4), buf, lane);
        }
        float inv[4];
#pragma unroll
        for (int i = 0; i < 4; ++i) inv[i] = 1.0f / (256.0f * __shfl(sum, i));
        h16* Qo = Qb + (size_t)t * DM;
        LAS unsigned char* st = (LAS unsigned char*)(idlb + (k & 1) * 256);
#pragma unroll
        for (int hp = 0; hp < 2; ++hp) {
            if (c == 0) {
#pragma unroll
                for (int dt = 0; dt < 4; ++dt)
#pragma unroll
                    for (int i2 = 0; i2 < 2; ++i2) *(LAS unsigned*)(st + (i2 * 128 + 32 * dt + 2 * g) * 2) = pkh(oe[dt][2 * hp + i2] * inv[2 * hp + i2], oo[dt][2 * hp + i2] * inv[2 * hp + i2]);
            }
            LDS_WAIT();
            if (lane < 32) { const u32x4 ow = *(const LAS u32x4*)(st + lane * 16); if (!C.dry) *(u32x4*)(Qo + hp * 256 + lane * 8) = ow; }
            LDS_WAIT();
        }
#pragma unroll
        for (int ks = 0; ks < 4; ++ks) qf[ks] = qfn[ks];
        nv = nvn;
    }
    AT_WAITN(0);
#undef AT_STAGE_A
#undef AT_STAGE_B
}

__device__ __forceinline__ void act_phase(const Ctx& C, int gtid, int gthreads) {
    const h16* G = (const h16*)(C.ws + WS_UPG); h16* V = (h16*)(C.ws + WS_UPV);
    constexpr int NCG = DFF / 8, NITEM = (MTOK / 16) * NCG;
    for (int it = gtid; it < NITEM; it += gthreads) {
        const int cg = it % NCG, rb = it / NCG, c0 = cg * 8, r0 = rb * 16;
        float w[3][8], bb[8];
#pragma unroll
        for (int j = 0; j < 3; ++j) { const f32x4 a = *(const f32x4*)(C.fcw + j * DFF + c0), b2 = *(const f32x4*)(C.fcw + j * DFF + c0 + 4); for (int e = 0; e < 4; ++e) { w[j][e] = a[e]; w[j][4 + e] = b2[e]; } }
        { const f32x4 a = *(const f32x4*)(C.fcb + c0), b2 = *(const f32x4*)(C.fcb + c0 + 4); for (int e = 0; e < 4; ++e) { bb[e] = a[e]; bb[4 + e] = b2[e]; } }
        h8 gm2, gm1;
        const int tseq = r0 & (SEQ - 1);
        if (tseq >= 2) { gm2 = *(const h8*)(G + (size_t)(r0 - 2) * DFF + c0); gm1 = *(const h8*)(G + (size_t)(r0 - 1) * DFF + c0); }
        else { for (int e = 0; e < 8; ++e) { gm2[e] = (h16)0.f; gm1[e] = (h16)0.f; } }
#pragma unroll 4
        for (int r = 0; r < 16; ++r) { const size_t off = (size_t)(r0 + r) * DFF + c0;
            const h8 g0 = *(const h8*)(G + off), vv = *(const h8*)(V + off);
            float y[8];
#pragma unroll
            for (int e = 0; e < 8; ++e) { const float gf = bb[e] + w[0][e] * (float)gm2[e] + w[1][e] * (float)gm1[e] + w[2][e] * (float)g0[e]; y[e] = gelu_tanh(gf) * (float)vv[e]; }
            u32x4 o; o.x = pkh(y[0], y[1]); o.y = pkh(y[2], y[3]); o.z = pkh(y[4], y[5]); o.w = pkh(y[6], y[7]);
            if (!C.dry) *(u32x4*)(V + off) = o; gm2 = gm1; gm1 = g0; }
    }
}

__device__ __forceinline__ void p0_prologue(const Params& P, LAS unsigned char* lds) {
    const int tid = threadIdx.x, lane = tid & 63, wv = tid >> 6;
    LAS float* scr = (LAS float*)(lds + wv * 16384);
    const int gw = blockIdx.x * NWAVES + wv, NGW = gridDim.x * NWAVES;
    unsigned char* ws = P.ws;
    const float* w_in = P.in[3];
    constexpr int I_IN = 16 * 195;
    for (int it = gw; it < I_IN + 16 * 8; it += NGW) {
        if (it < I_IN) { p0_transpose_item<1>(w_in, DM, NIN, (h16*)(ws + W_IN), nullptr, scr, it, lane); continue; }
        const int r = it - I_IN, blk = r / 16, rr = r % 16, which = rr / 8, it2 = rr % 8;
        p0_transpose_item<0>((which ? P.in[8] : P.in[6]) + (size_t)blk * 128 * 128, 128, 128, (h16*)(ws + W_GATE) + (size_t)blk * 256 * 128 + (size_t)which * 128 * 128, nullptr, scr, it2, lane); }
    { u32x4* z = (u32x4*)((h16*)(ws + W_IN) + (size_t)4168 * DM); const int nz = 184 * DM * 2 / 16;
      for (int i = blockIdx.x * NTHR + tid; i < nz; i += gridDim.x * NTHR) z[i] = (u32x4){0u, 0u, 0u, 0u}; }
    { const float* x = P.in[0]; const float* gn = P.in[2]; h16* A0 = (h16*)(ws + WS_A0);
      f32x4 gv[4];
#pragma unroll
      for (int j = 0; j < 4; ++j) gv[j] = *(const f32x4*)(gn + 4 * lane + 256 * j);
      f32x4 nv[4];
      if (gw < MTOK) { const f32x4* xr = (const f32x4*)(x + (size_t)gw * DM) + lane;
#pragma unroll
          for (int j = 0; j < 4; ++j) nv[j] = xr[64 * j]; }
      for (int m = gw; m < MTOK; m += NGW) { f32x4 v[4]; float s = 0.f;
#pragma unroll
          for (int j = 0; j < 4; ++j) v[j] = nv[j];
          { const int mn = m + NGW < MTOK ? m + NGW : m; const f32x4* xr = (const f32x4*)(x + (size_t)mn * DM) + lane;
#pragma unroll
            for (int j = 0; j < 4; ++j) nv[j] = xr[64 * j]; }
#pragma unroll
          for (int j = 0; j < 4; ++j) s += (v[j].x * v[j].x + v[j].y * v[j].y) + (v[j].z * v[j].z + v[j].w * v[j].w);
          const float rs = __builtin_amdgcn_rsqf(wave_sum(s) * (1.0f / DM) + EPS);
          u32x2* o8 = (u32x2*)(A0 + (size_t)m * DM) + lane;
#pragma unroll
          for (int j = 0; j < 4; ++j) { u32x2 w; w.x = pkh(v[j].x * rs * gv[j].x, v[j].y * rs * gv[j].y); w.y = pkh(v[j].z * rs * gv[j].z, v[j].w * rs * gv[j].w); o8[64 * j] = w; } } }
}
constexpr int PD_SQ = 16 * 32, PD_UP = 16 * 192, PD_DN = 48 * 32, PD_PP = 4 * 32, PD_NTR = 4 * PD_SQ + PD_UP + PD_DN + PD_PP, PD_NT = PD_NTR / 32, PD_NP = MTOK * PLE / 4 / 8192;
static_assert(PD_NTR % 32 == 0, "deferred transposes");
__device__ __forceinline__ void p0_deferred_item(const Params& P, LAS unsigned char* lds, int item) {
    int tid = threadIdx.x; asm volatile("" : "+v"(tid));
    const int lane = tid & 63, wv = tid >> 6;
    unsigned char* ws = P.ws;
    if (item >= PD_NT) { const f32x4* p4 = (const f32x4*)P.in[1] + (size_t)(item - PD_NT) * 8192; u32x2* o = (u32x2*)(ws + WS_PH) + (size_t)(item - PD_NT) * 8192;
#pragma unroll 4
        for (int i = tid; i < 8192; i += NTHR) { const f32x4 v = p4[i]; u32x2 w; w.x = pkh(v.x, v.y); w.y = pkh(v.z, v.w); o[i] = w; }
        return; }
    LAS float* scr = (LAS float*)(lds + wv * 16384);
    const float *w_lru = P.in[14], *w_att = P.in[15], *w_out = P.in[16], *w_up = P.in[18], *w_down = P.in[21], *w_pg = P.in[23], *w_pp = P.in[24];
    for (int k = 0; k < 4; ++k) {
        int r = item * 32 + wv * 4 + k;
        if (r < PD_SQ) { p0_transpose_item<0>(w_lru, DM, DM, (h16*)(ws + W_LRU), nullptr, scr, r, lane); continue; } r -= PD_SQ;
        if (r < PD_SQ) { p0_transpose_item<0>(w_att, DM, DM, (h16*)(ws + W_ATT), nullptr, scr, r, lane); continue; } r -= PD_SQ;
        if (r < PD_SQ) { p0_transpose_item<0>(w_out, DM, DM, (h16*)(ws + W_OUT), nullptr, scr, r, lane); continue; } r -= PD_SQ;
        if (r < PD_SQ) { p0_transpose_item<0>(w_pg, DM, DM, (h16*)(ws + W_PG), P.in[22], scr, r, lane); continue; } r -= PD_SQ;
        if (r < PD_UP) { p0_transpose_item<2>(w_up, DM, 2 * DFF, (h16*)(ws + W_UP), P.in[17], scr, r, lane); continue; } r -= PD_UP;
        if (r < PD_DN) { p0_transpose_item<0>(w_down, DFF, DM, (h16*)(ws + W_DOWN), nullptr, scr, r, lane); continue; } r -= PD_DN;
        p0_transpose_item<0>(w_pp, PLE, DM, (h16*)(ws + W_PP), nullptr, scr, r, lane);
    }
}

__device__ __forceinline__ int next_unit(unsigned* head, volatile LAS unsigned* slot) {
    __syncthreads();
    if (threadIdx.x == 0) *slot = __hip_atomic_fetch_add(head, 1u, __ATOMIC_RELAXED, __HIP_MEMORY_SCOPE_AGENT);
    __syncthreads();
    return (int)*slot;
}

constexpr int NPHASE = 10;
__global__ void __launch_bounds__(NTHR, 2) fwd(Params P) {
    extern __shared__ __attribute__((aligned(16))) unsigned char lds_raw[];
    LAS unsigned char* lds = (LAS unsigned char*)lds_raw;
    volatile LAS unsigned* MISC = (volatile LAS unsigned*)(lds + MISC_OFF);
    const int tid = threadIdx.x;
    if (tid < 64) MISC[tid] = 0u;
    __syncthreads();
    unsigned char* ws = P.ws;
    unsigned* ctl = (unsigned*)(ws + WS_CTL);
    const int lo = P.ph_lo, hi = P.ph_hi;
    XcdBarrier bar; bar.bar = ctl + CW_BAR; bar.x = 0; bar.st = MISC;
    if (hi - lo > 1) bar = xcd_barrier_post(ctl + CW_BAR, MISC);
    const int dry = P.pad;
    Ctx C; C.ws = ws; C.out = P.out; C.dry = dry; C.conv_w = P.in[4]; C.conv_b = P.in[5]; C.ba = P.in[7]; C.bx = P.in[9]; C.lam = P.in[10]; C.qn = P.in[11]; C.kn = P.in[12]; C.relb = P.in[13]; C.fcw = P.in[19]; C.fcb = P.in[20];
    float* SSQ1 = (float*)(ws + CTL_SSQ1); float* SSQ2 = (float*)(ws + CTL_SSQ2);
#ifdef ONLY_PHASE
#define IN(k) ((k) == ONLY_PHASE)
#else
#define IN(k) (lo <= (k) && (k) < hi)
#endif
#define SEAM(k) do { if (IN(k) && IN((k) + 1)) xcd_barrier(bar); } while (0)

    if (IN(0)) { p0_prologue(P, lds); } SEAM(0);

    if (IN(1)) {
        pg8::Gemm g{(const h16*)(ws + WS_A0), (const h16*)(ws + W_IN), MTOK, NIN_PAD, DM}; pg8::StaticOrder S; S.init(MTOK, NIN_PAD, gridDim.x, blockIdx.x);
        EpiIn E{(h16*)(ws + WS_LX), (h16*)(ws + WS_GG), (h16*)(ws + WS_Q), (h16*)(ws + WS_K), (h16*)(ws + WS_V), (h16*)(ws + WS_QI), (h16*)(ws + WS_KI), (h16*)(ws + WS_SGA), (h16*)(ws + WS_SGB), (float*)(ws + WS_WI), dry};
        pg8::gemm_phase<EpiIn>(lds, g, S, E);
    } SEAM(1);

    if (IN(2)) {
        constexpr int N_IX = NB * (SEQ / 16), N_L1 = NB * 64 * 8 / 4, N_KN = MTOK / 128 / 4, N_PD = PD_NT + PD_NP, N_SM = N_KN + N_PD, N_BIG = N_L1 + N_IX, N_ALL = N_BIG + N_SM;
        static_assert(N_BIG >= 4 * N_SM, "interleave");
        unsigned* head = ctl + CW_Q2 + 128 * dry;
        int u = next_unit(head, MISC + 4);
        for (int it = 0; u < N_ALL; ++it) {
            unsigned nxt = 0u;
            if (tid == 0) nxt = __hip_atomic_fetch_add(head, 1u, __ATOMIC_RELAXED, __HIP_MEMORY_SCOPE_AGENT);
            int kind, idx;
            { int big = -1, sm = -1;
              if (u < 5 * N_SM) { if (u % 5 == 4) sm = u / 5; else big = 4 * (u / 5) + u % 5; } else big = u - N_SM;
              if (big >= 0) { if (big < N_L1) { kind = 1; idx = big; } else { kind = 0; idx = big - N_L1; } }
              else { if (sm < N_KN) { kind = 2; idx = sm; } else { kind = 3; idx = sm - N_KN; } } }
#ifdef PROBE_P2_KIND
            if (!(dry && kind != PROBE_P2_KIND))
#endif
            {
            if (kind == 0) indexer_unit(C, lds, idx);
            else if (kind == 1) lru1_item(C, lds, idx);
            else if (kind == 2) { for (int k = 0; k < 4; ++k) knorm_unit(C, idx * 4 + k); }
            else p0_deferred_item(P, lds, idx);
            }
            if (tid == 0) MISC[6 + (it & 1)] = nxt;
            __syncthreads();
            u = (int)MISC[6 + (it & 1)];
        }
    } SEAM(2);

    if (IN(3)) {
        constexpr int N_AQ = SEQ / (8 * AT_QPW), N_L2 = NB * 64 * 8 / 4;
        attn_build_tab(C, lds);
        unsigned* qh = ctl + CW_Q3 + 2048 * dry;
        if (tid == 0) MISC[5] = 0u;
        for (;;) {
            __syncthreads();
            if (tid == 0) { const unsigned x = xb_xcc_id() & 7u; unsigned k = MISC[5]; int u = -1;
                for (; k < 8u; ++k) { const unsigned q = (x + k) & 7u; const unsigned v = __hip_atomic_fetch_add(qh + 64 * q, 1u, __ATOMIC_RELAXED, __HIP_MEMORY_SCOPE_AGENT); if (v < (unsigned)N_AQ) { u = (int)(q * N_AQ + v); break; } }
                MISC[5] = k;
                if (u < 0) { const unsigned v = __hip_atomic_fetch_add(qh + 64 * 8, 1u, __ATOMIC_RELAXED, __HIP_MEMORY_SCOPE_AGENT); u = v < (unsigned)N_L2 ? (int)(8 * N_AQ + v) : -1; }
                MISC[4] = (unsigned)u; }
            __syncthreads();
            const int u = (int)MISC[4];
            if (u < 0) break;
            if (u < 8 * N_AQ) attn_item(C, lds, u);
            else lru2_item(C, lds + AT_END, u - 8 * N_AQ);
        }
    } SEAM(3);

    if (IN(4)) {
        pg8::StaticOrder S; S.init(MTOK, DM, gridDim.x, blockIdx.x);
        { pg8::Gemm g{(const h16*)(ws + WS_LX), (const h16*)(ws + W_LRU), MTOK, DM, DM}; EpiMerge<0> E{(const h16*)(ws + WS_SGA), (h16*)(ws + WS_T1), nullptr, dry}; pg8::gemm_phase<EpiMerge<0>>(lds, g, S, E); }
        { pg8::Gemm g{(const h16*)(ws + WS_Q), (const h16*)(ws + W_ATT), MTOK, DM, DM}; EpiMerge<1> E{(const h16*)(ws + WS_SGB), (h16*)(ws + WS_T1), (h16*)(ws + WS_GG), dry}; pg8::gemm_phase<EpiMerge<1>>(lds, g, S, E); }
    } SEAM(4);

    if (IN(5)) {
        pg8::Gemm g{(const h16*)(ws + WS_GG), (const h16*)(ws + W_OUT), MTOK, DM, DM}; pg8::StaticOrder S; S.init(MTOK, DM, gridDim.x, blockIdx.x);
        EpiResid<true> E{P.in[0], nullptr, (h16*)(ws + WS_X1H), SSQ1, dry}; pg8::gemm_phase<EpiResid<true>>(lds, g, S, E);
    } SEAM(5);

    if (IN(6)) {
        pg8::Gemm g{(const h16*)(ws + WS_X1H), (const h16*)(ws + W_UP), MTOK, 2 * DFF, DM}; pg8::StaticOrder S; S.init(MTOK, 2 * DFF, gridDim.x, blockIdx.x);
        EpiUpAct E{SSQ1, (h16*)(ws + WS_UPV), (float*)(ws + WS_UPG), (float*)(ws + WS_UPG + 4 * MiB), (float*)(ws + WS_UPG + 8 * MiB), C.fcw, C.fcb, lds + pg8::STAGE_BYTES, dry}; pg8::gemm_phase<EpiUpAct>(lds, g, S, E);
    } SEAM(6);


    if (IN(8)) {
        pg8::Gemm g{(const h16*)(ws + WS_UPV), (const h16*)(ws + W_DOWN), MTOK, DM, DFF}; pg8::StaticOrder S; S.init(MTOK, DM, gridDim.x, blockIdx.x);
        {
#pragma unroll
          for (int i = 0; i < 2; ++i) { pg8::Unit uu; if (S.next(i, uu)) act_fix_tile((const float*)(ws + WS_UPG), (const float*)(ws + WS_UPG + 4 * MiB), (const float*)(ws + WS_UPG + 8 * MiB), C.fcw, C.fcb, (h16*)(ws + WS_UPV), uu.pm, tid, dry); }
          static_assert((MTOK / 256) * (DM / 256) == 2 * 256, "two units per workgroup on a 256-workgroup grid");
          VM_WAIT(); __syncthreads(); }
        EpiResid<false> E{nullptr, (const h16*)(ws + WS_X1H), (h16*)(ws + WS_X2H), SSQ2, dry}; pg8::gemm_phase<EpiResid<false>>(lds, g, S, E);
    } SEAM(8);

    if (IN(9)) {
        pg8::StaticOrder S; S.init(MTOK, DM, gridDim.x, blockIdx.x);
        { pg8::Gemm g{(const h16*)(ws + WS_X2H), (const h16*)(ws + W_PG), MTOK, DM, DM}; EpiGateSig E{SSQ2, (h16*)(ws + WS_GS), dry}; pg8::gemm_phase<EpiGateSig>(lds, g, S, E); }
        { pg8::Gemm g{(const h16*)(ws + WS_PH), (const h16*)(ws + W_PP), MTOK, DM, P.k_ple}; EpiPleOut E{(const h16*)(ws + WS_GS), (const h16*)(ws + WS_X2H), P.out, dry}; pg8::gemm_phase<EpiPleOut>(lds, g, S, E); }
    }
#undef IN
#undef SEAM
}

#ifndef N_LAUNCHES
#define N_LAUNCHES 1
#endif
extern "C" void kernel_launch(void* const* d_in, const int* in_sizes, int n_in, void* d_out, int out_size, void* d_ws, size_t ws_size, hipStream_t stream) {
    static int grid = 0;
    if (grid == 0) {
        if (n_in != 25 || out_size != MTOK * DM || ws_size < WS_END) { fprintf(stderr, "kernel_launch: unexpected shapes (n_in %d out %d ws %zu)\n", n_in, out_size, ws_size); grid = -1; return; }
        int dev = 0, cus = 0, per_cu = 0;
        hipGetDevice(&dev); hipDeviceGetAttribute(&cus, hipDeviceAttributeMultiprocessorCount, dev);
        if (hipFuncSetAttribute((const void*)fwd, hipFuncAttributeMaxDynamicSharedMemorySize, LDS_BYTES) != hipSuccess) { fprintf(stderr, "kernel_launch: hipFuncSetAttribute failed\n"); grid = -1; return; }
        if (hipOccupancyMaxActiveBlocksPerMultiprocessor(&per_cu, (const void*)fwd, NTHR, LDS_BYTES) != hipSuccess || per_cu < 1) { fprintf(stderr, "kernel_launch: occupancy query says %d\n", per_cu); }
        (void)hipGetLastError();
        grid = cus > 0 ? cus : 256;
    }
    if (grid < 0) return;
    hipMemsetAsync((char*)d_ws + WS_CTL, 0, CTL_ZERO_BYTES, stream);
    Params p{};
    for (int i = 0; i < 25; ++i) p.in[i] = (const float*)d_in[i];
    p.out = (float*)d_out; p.ws = (unsigned char*)d_ws; p.k_ple = PLE; p.pad = 0;
    if (N_LAUNCHES == 1) { p.ph_lo = 0; p.ph_hi = NPHASE; hipLaunchKernelGGL(fwd, dim3(grid), dim3(NTHR), LDS_BYTES, stream, p); }
    else for (int ph = 0; ph < NPHASE; ++ph) { p.ph_lo = ph; p.ph_hi = ph + 1;
#ifdef PROBE_MASK
        if ((PROBE_MASK >> ph) & 1) { p.pad = 1; hipLaunchKernelGGL(fwd, dim3(grid), dim3(NTHR), LDS_BYTES, stream, p); p.pad = 0; }
#endif
        hipLaunchKernelGGL(fwd, dim3(grid), dim3(NTHR), LDS_BYTES, stream, p); }
}
```

```cpp
#include <hip/hip_runtime.h>
#include <cstdio>
#include <cstdint>

#define GAS __attribute__((address_space(1)))
#define LAS __attribute__((address_space(3)))
typedef _Float16 h16;
typedef _Float16 h8 __attribute__((ext_vector_type(8)));
typedef _Float16 h4 __attribute__((ext_vector_type(4)));
typedef _Float16 h2 __attribute__((ext_vector_type(2)));
typedef __fp16 fh4 __attribute__((__vector_size__(4 * sizeof(__fp16))));
typedef float f32x4 __attribute__((ext_vector_type(4)));
typedef float f32x2 __attribute__((ext_vector_type(2)));
typedef unsigned u32x4 __attribute__((ext_vector_type(4)));
typedef unsigned u32x2 __attribute__((ext_vector_type(2)));
typedef unsigned long long u64;

__device__ __forceinline__ unsigned pkh(float a, float b) { h2 r; r.x = (h16)a; r.y = (h16)b; return __builtin_bit_cast(unsigned, r); }
__device__ __forceinline__ float sigmoid_f(float x) { return __builtin_amdgcn_rcpf(1.0f + __builtin_amdgcn_exp2f(-1.4426950408889634f * x)); }
__device__ __forceinline__ float gelu_tanh(float x) { const float u = 1.5957691216057308f * (x + 0.044715f * x * x * x); return x * sigmoid_f(u); }
#define LDS_WAIT() asm volatile("s_waitcnt lgkmcnt(0)" ::: "memory")
#define VM_WAIT() asm volatile("s_waitcnt vmcnt(0)" ::: "memory")

namespace pg8 {
constexpr int BM = 256, BK = 64, HALF = 128, HTB = HALF * BK * 2, STAGE_BYTES = 8 * HTB, NXCD = 8, WGM = 8;
__host__ __device__ __forceinline__ int lds_byte(int r, int c) { const int st = (r >> 4) * 2 + (c >> 5), rr = r & 15, cc = c & 31, ob = rr * 64 + cc * 2; return st * 1024 + (ob ^ (((ob >> 9) & 1) << 5)); }
__host__ __device__ __forceinline__ void stage_rc(int b, int& R, int& C) { const int st = b / 1024, sb = b % 1024, swz = sb ^ (((sb >> 9) & 1) << 5); R = (st >> 1) * 16 + swz / 64; C = (st & 1) * 32 + (swz % 64) / 2; }
__host__ __device__ __forceinline__ int perm32(int rho) { const int n = rho >> 4, i = rho & 15; return 8 * (i >> 2) + 4 * n + (i & 3); }

struct Unit { int pm, pn; };
struct Gemm { const h16* A; const h16* Bt; int M, N, K; };

struct StaticOrder {
    int nM, nN, nwg, G, c;
    __host__ __device__ void init(int M, int N, int G_, int c_) { nM = M / BM; nN = N / BM; nwg = nM * nN; G = G_; c = c_; }
    __host__ __device__ __forceinline__ bool next(int i, Unit& u) const {
        const long L = (long)i * G + c; if (L >= nwg) return false;
        int wgid = (int)L; { const int q = nwg / NXCD, r = nwg % NXCD, xcd = wgid % NXCD, off = wgid / NXCD; wgid = (xcd < r ? xcd * (q + 1) : r * (q + 1) + (xcd - r) * q) + off; }
        const int nig = WGM * nN, gid = wgid / nig, fm = gid * WGM, gsz = (nM - fm) < WGM ? (nM - fm) : WGM;
        u.pm = fm + ((wgid % nig) % gsz); u.pn = (wgid % nig) / gsz; return true;
    }
};

template <class Epi, bool ALIGN_EPI = true, bool SP2 = true>
__device__ __forceinline__ void gemm_phase(LAS unsigned char* lds, const Gemm g, const StaticOrder& S, const Epi& E) {
    const int tid = threadIdx.x, wid = __builtin_amdgcn_readfirstlane(tid >> 6), lane = tid & 63, wr = wid >> 2, wc = wid & 3, fr = lane & 15, fq = lane >> 4;
    const int K = g.K, nt = K / BK;
    unsigned voffA[2], voffB[2];
#pragma unroll
    for (int i = 0; i < 2; ++i) { int R, C; stage_rc(tid * 16 + i * 8192, R, C); const int Rb = Epi::PERM ? ((R & ~31) + perm32(R & 31)) : R;
        voffA[i] = (unsigned)(R * K + C) * 2u; voffB[i] = (unsigned)(Rb * K + C) * 2u; }
    const size_t kstep = (size_t)(BK * 2);
    const size_t hstep = (size_t)HALF * K * 2;
    const size_t tstep = 2 * hstep;
    const unsigned ldsw = (unsigned)wid * 1024u;
    const int aoff = lds_byte(wr * 64 + fr, fq * 8), boff = lds_byte(wc * 32 + fr, fq * 8);
#define PG8_SA(b, h) (((b) * 2 + (h)) * HTB)
#define PG8_SB(b, h) ((4 + (b) * 2 + (h)) * HTB)
#define PG8_STAGE(bufoff, gbase, voff) do { _Pragma("unroll") for (int _i = 0; _i < 2; ++_i) \
        __builtin_amdgcn_global_load_lds((const unsigned*)((const char*)(gbase) + (voff)[_i]), (LAS unsigned*)(lds + (bufoff) + ldsw + _i * 8192), 16, 0, 0); } while (0)
#define PG8_LDA(dst, b, h) do { _Pragma("unroll") for (int m = 0; m < 4; ++m) _Pragma("unroll") for (int k = 0; k < 2; ++k) dst[m][k] = *(const LAS h8*)(lds + PG8_SA(b, h) + aoff + m * 2048 + k * 1024); } while (0)
#define PG8_LDB(dst, b, h) do { _Pragma("unroll") for (int n = 0; n < 2; ++n) _Pragma("unroll") for (int k = 0; k < 2; ++k) dst[n][k] = *(const LAS h8*)(lds + PG8_SB(b, h) + boff + n * 2048 + k * 1024); } while (0)
#define PG8_MMA(ai, bj, At, Bt) do { __builtin_amdgcn_s_setprio(1); _Pragma("unroll") for (int m = 0; m < 4; ++m) _Pragma("unroll") for (int n = 0; n < 2; ++n) _Pragma("unroll") for (int k = 0; k < 2; ++k) \
        acc[ai][bj][m][n] = __builtin_amdgcn_mfma_f32_16x16x32_f16(Bt[n][k], At[m][k], acc[ai][bj][m][n], 0, 0, 0); __builtin_amdgcn_s_setprio(0); } while (0)
#define PG8_WAIT_V(n) asm volatile("s_waitcnt vmcnt(" #n ")" ::: "memory")
#define PG8_WAIT_L(n) asm volatile("s_waitcnt lgkmcnt(" #n ")" ::: "memory")
#define PG8_BAR __builtin_amdgcn_s_barrier()
#define PG8_SCHED __builtin_amdgcn_sched_barrier(0)
    Unit cur, nxt; int ui = 0;
    if (!S.next(0, cur)) return;
    f32x4 acc[2][2][4][2];
#pragma unroll
    for (int a = 0; a < 2; ++a)
#pragma unroll
        for (int b = 0; b < 2; ++b)
#pragma unroll
            for (int m = 0; m < 4; ++m)
#pragma unroll
                for (int n = 0; n < 2; ++n) acc[a][b][m][n] = (f32x4){0.f, 0.f, 0.f, 0.f};
    h8 At[4][2], B0[2][2], B1[2][2];
    const char* cA = (const char*)g.A + (size_t)cur.pm * tstep; const char* cB = (const char*)g.Bt + (size_t)cur.pn * tstep;
    if constexpr (SP2) {
        PG8_STAGE(PG8_SB(0, 0), cB, voffB); PG8_STAGE(PG8_SB(0, 1), cB + hstep, voffB); PG8_STAGE(PG8_SA(0, 0), cA, voffA); PG8_STAGE(PG8_SA(0, 1), cA + hstep, voffA);
        if (wr == 1) PG8_BAR;
        PG8_WAIT_V(2); PG8_BAR;
        PG8_STAGE(PG8_SB(1, 0), cB + kstep, voffB); PG8_STAGE(PG8_SA(1, 0), cA + kstep, voffA); PG8_STAGE(PG8_SB(1, 1), cB + hstep + kstep, voffB);
        PG8_WAIT_V(6); PG8_BAR;
    } else {
        PG8_STAGE(PG8_SB(0, 0), cB, voffB); PG8_STAGE(PG8_SA(0, 0), cA, voffA); PG8_STAGE(PG8_SB(0, 1), cB + hstep, voffB); PG8_STAGE(PG8_SA(0, 1), cA + hstep, voffA);
        if (wr == 1) PG8_BAR;
        PG8_WAIT_V(4); PG8_BAR;
        PG8_STAGE(PG8_SB(1, 0), cB + kstep, voffB); PG8_STAGE(PG8_SA(1, 0), cA + kstep, voffA); PG8_STAGE(PG8_SB(1, 1), cB + hstep + kstep, voffB);
        PG8_WAIT_V(6); PG8_BAR;
    }
    for (;;) {
        const bool has_next = S.next(ui + 1, nxt);
        const char* nA = has_next ? (const char*)g.A + (size_t)nxt.pm * tstep : cA; const char* nB = has_next ? (const char*)g.Bt + (size_t)nxt.pn * tstep : cB;
        for (int t = 0; t < nt; t += 2) {
            const bool last = (t == nt - 2);
            const char* a1 = cA + (size_t)(t + 1) * kstep;
            const char* a2 = last ? nA : cA + (size_t)(t + 2) * kstep; const char* b2 = last ? nB : cB + (size_t)(t + 2) * kstep;
            const char* a3 = a2 + kstep; const char* b3 = b2 + kstep;
            if constexpr (SP2) {
            PG8_LDB(B0, 0, 0); PG8_LDB(B1, 0, 1); PG8_SCHED; PG8_LDA(At, 0, 0); PG8_STAGE(PG8_SA(1, 1), a1 + hstep, voffA);
            PG8_WAIT_V(8); PG8_WAIT_L(0); PG8_BAR; PG8_MMA(0, 0, At, B0); PG8_MMA(0, 1, At, B1); PG8_BAR; PG8_SCHED;
            PG8_LDA(At, 0, 1); PG8_STAGE(PG8_SB(0, 0), b2, voffB); PG8_STAGE(PG8_SB(0, 1), b2 + hstep, voffB); PG8_STAGE(PG8_SA(0, 0), a2, voffA);
            PG8_WAIT_V(8); PG8_WAIT_L(0); PG8_BAR; PG8_MMA(1, 0, At, B0); PG8_MMA(1, 1, At, B1); PG8_BAR; PG8_SCHED;
            PG8_LDB(B0, 1, 0); PG8_LDB(B1, 1, 1); PG8_SCHED; PG8_LDA(At, 1, 0); PG8_STAGE(PG8_SA(0, 1), a2 + hstep, voffA);
            PG8_WAIT_V(8); PG8_WAIT_L(0); PG8_BAR; PG8_MMA(0, 0, At, B0); PG8_MMA(0, 1, At, B1); PG8_BAR; PG8_SCHED;
            PG8_LDA(At, 1, 1); PG8_STAGE(PG8_SB(1, 0), b3, voffB); PG8_STAGE(PG8_SB(1, 1), b3 + hstep, voffB); PG8_STAGE(PG8_SA(1, 0), a3, voffA);
            PG8_WAIT_V(8); PG8_WAIT_L(0); PG8_BAR; PG8_MMA(1, 0, At, B0); PG8_MMA(1, 1, At, B1); PG8_BAR; PG8_SCHED;
            } else {
            PG8_LDB(B0, 0, 0); PG8_SCHED; PG8_LDA(At, 0, 0); PG8_STAGE(PG8_SA(1, 1), a1 + hstep, voffA);
            PG8_WAIT_L(8); PG8_BAR; PG8_WAIT_L(0); PG8_MMA(0, 0, At, B0); PG8_BAR; PG8_SCHED;
            PG8_LDB(B1, 0, 1); PG8_STAGE(PG8_SB(0, 0), b2, voffB);
            PG8_BAR; PG8_WAIT_L(0); PG8_MMA(0, 1, At, B1); PG8_BAR;
            PG8_LDA(At, 0, 1); PG8_STAGE(PG8_SA(0, 0), a2, voffA);
            PG8_BAR; PG8_WAIT_L(0); PG8_MMA(1, 0, At, B0); PG8_BAR; PG8_SCHED;
            PG8_STAGE(PG8_SB(0, 1), b2 + hstep, voffB);
            PG8_WAIT_V(6); PG8_BAR; PG8_MMA(1, 1, At, B1); PG8_BAR;
            PG8_LDB(B0, 1, 0); PG8_SCHED; PG8_LDA(At, 1, 0); PG8_STAGE(PG8_SA(0, 1), a2 + hstep, voffA);
            PG8_WAIT_L(8); PG8_BAR; PG8_WAIT_L(0); PG8_MMA(0, 0, At, B0); PG8_BAR; PG8_SCHED;
            PG8_LDB(B1, 1, 1); PG8_STAGE(PG8_SB(1, 0), b3, voffB);
            PG8_BAR; PG8_WAIT_L(0); PG8_MMA(0, 1, At, B1); PG8_BAR;
            PG8_LDA(At, 1, 1); PG8_STAGE(PG8_SA(1, 0), a3, voffA);
            PG8_BAR; PG8_WAIT_L(0); PG8_MMA(1, 0, At, B0); PG8_BAR; PG8_SCHED;
            PG8_STAGE(PG8_SB(1, 1), b3 + hstep, voffB);
            PG8_WAIT_V(6); PG8_BAR; PG8_MMA(1, 1, At, B1); PG8_BAR;
            }
        }
        if constexpr (ALIGN_EPI) { if (wr == 0) PG8_BAR; }
        E(acc, cur, wr, wc, fr, fq);
        if (!has_next) break;
#pragma unroll
        for (int a = 0; a < 2; ++a)
#pragma unroll
            for (int b = 0; b < 2; ++b)
#pragma unroll
                for (int m = 0; m < 4; ++m)
#pragma unroll
                    for (int n = 0; n < 2; ++n) acc[a][b][m][n] = (f32x4){0.f, 0.f, 0.f, 0.f};
        cur = nxt; cA = nA; cB = nB; ++ui;
        if constexpr (ALIGN_EPI) { if (wr == 1) PG8_BAR; }
    }
    PG8_WAIT_V(0);
    if constexpr (!ALIGN_EPI) { if (wr == 0) PG8_BAR; }
    PG8_BAR;
#undef PG8_SA
#undef PG8_SB
#undef PG8_STAGE
#undef PG8_LDA
#undef PG8_LDB
#undef PG8_MMA
#undef PG8_WAIT_V
#undef PG8_WAIT_L
#undef PG8_BAR
#undef PG8_SCHED
}
}

constexpr int NB = 4, SEQ = 8192, MTOK = NB * SEQ, DM = 1024, DFF = 3072, PLE = 256;
constexpr int NIN = 6216, NIN_PAD = 6400;
constexpr float EPS = 1e-6f;
constexpr int NWAVES = 8, NTHR = 512;

typedef const f32x4 (&AccRef)[2][2][4][2];

template <int ACT> __device__ __forceinline__ float act_f(float v) {
    if (ACT == 1) return gelu_tanh(v);
    if (ACT == 2) return sigmoid_f(v);
    if (ACT == 3) return v * 0.125f;
    return v;
}
template <int ACT> __device__ __forceinline__ void store_tile_h(AccRef acc, h16* base, int ldc, int row0, int col0, int dry) {
    const unsigned bo0 = ((unsigned)row0 * (unsigned)ldc + (unsigned)col0) * 2u;
#pragma unroll
    for (int ai = 0; ai < 2; ++ai)
#pragma unroll
        for (int m = 0; m < 4; ++m) { const unsigned bo = bo0 + (unsigned)((ai * 128 + m * 16) * ldc * 2);
#pragma unroll
            for (int bj = 0; bj < 2; ++bj) { const f32x4 v0 = acc[ai][bj][m][0], v1 = acc[ai][bj][m][1];
                u32x4 w; w.x = pkh(act_f<ACT>(v0[0]), act_f<ACT>(v0[1])); w.y = pkh(act_f<ACT>(v0[2]), act_f<ACT>(v0[3]));
                w.z = pkh(act_f<ACT>(v1[0]), act_f<ACT>(v1[1])); w.w = pkh(act_f<ACT>(v1[2]), act_f<ACT>(v1[3]));
                if (!dry) *(u32x4*)((char*)base + bo + bj * 256) = w; }
            if (ACT == 1 || ACT == 2) __builtin_amdgcn_sched_barrier(0); }
}

__device__ __forceinline__ unsigned frag_off(int pm, int pn, int wid, int lane) { return ((unsigned)((pm * 4 + pn) * 8 + wid) * 1024u + (unsigned)lane) * 16u; }
#define FRAG_SUB(ai, m, bj) ((unsigned)((((ai) * 4 + (m)) * 2 + (bj)) * 1024))
template <int ACT> __device__ __forceinline__ void store_tile_frag(AccRef acc, h16* base, unsigned fo, int dry) {
#pragma unroll
    for (int ai = 0; ai < 2; ++ai)
#pragma unroll
        for (int m = 0; m < 4; ++m) {
#pragma unroll
            for (int bj = 0; bj < 2; ++bj) { const f32x4 v0 = acc[ai][bj][m][0], v1 = acc[ai][bj][m][1];
                u32x4 w; w.x = pkh(act_f<ACT>(v0[0]), act_f<ACT>(v0[1])); w.y = pkh(act_f<ACT>(v0[2]), act_f<ACT>(v0[3]));
                w.z = pkh(act_f<ACT>(v1[0]), act_f<ACT>(v1[1])); w.w = pkh(act_f<ACT>(v1[2]), act_f<ACT>(v1[3]));
                if (!dry) *(u32x4*)((char*)base + fo + FRAG_SUB(ai, m, bj)) = w; }
            if (ACT == 1 || ACT == 2) __builtin_amdgcn_sched_barrier(0); }
}

struct EpiIn {
    static constexpr bool PERM = true;
    h16 *LX, *GG, *Q, *K, *V, *QI, *KI, *SGA, *SGB; float* WI; int dry;
    __device__ __forceinline__ void operator()(AccRef acc, const pg8::Unit& u, int wr, int wc, int fr, int fq) const {
        const int pn = u.pn, row0 = u.pm * 256 + wr * 64 + fr, cw = wc * 32 + 8 * fq;
        if (pn < 4 || (pn >= 8 && pn < 14)) {
            h16* base = pn < 4 ? LX : (pn < 12 ? Q : (pn == 12 ? K : V)); const int ldc = pn < 12 ? DM : 256; const int ct = pn < 4 ? pn * 256 : (pn < 12 ? (pn - 8) * 256 : 0);
            if (pn < 12) store_tile_h<0>(acc, base, DM, row0, ct + cw, dry); else store_tile_h<0>(acc, base, 256, row0, cw, dry);
            (void)ldc;
        }
        else if (pn < 8) store_tile_h<1>(acc, GG, DM, row0, (pn - 4) * 256 + cw, dry);
        else if (pn < 16) {
#pragma unroll
            for (int ai = 0; ai < 2; ++ai)
#pragma unroll
                for (int m = 0; m < 4; ++m) { const unsigned t16 = (unsigned)(u.pm * 16 + wr * 4 + ai * 8 + m);
#pragma unroll
                    for (int bj = 0; bj < 2; ++bj) { const f32x4 v0 = acc[ai][bj][m][0] * 0.125f, v1 = acc[ai][bj][m][1] * 0.125f;
                        const unsigned hh = (unsigned)((pn - 14) * 4 + bj * 2 + (wc >> 1)), slot = ((t16 * 8u + hh) * 2u + (unsigned)(wc & 1)) * 64u + (unsigned)(fq * 16 + fr);
                        u32x4 w; w.x = pkh(v0[0], v0[1]); w.y = pkh(v0[2], v0[3]); w.z = pkh(v1[0], v1[1]); w.w = pkh(v1[2], v1[3]);
                        if (!dry) *(u32x4*)((char*)QI + slot * 16u) = w; } }
        }
        else if (pn == 16) {
            if (wc < 2) {
#pragma unroll
                for (int ai = 0; ai < 2; ++ai)
#pragma unroll
                    for (int m = 0; m < 4; ++m) { const f32x4 v0 = acc[ai][0][m][0], v1 = acc[ai][0][m][1];
                        u32x4 w; w.x = pkh(v0[0], v0[1]); w.y = pkh(v0[2], v0[3]); w.z = pkh(v1[0], v1[1]); w.w = pkh(v1[2], v1[3]);
                        if (!dry) *(u32x4*)((char*)KI + ((unsigned)((u.pm * 16 + wr * 4 + ai * 8 + m) * 2 + wc) * 64u + (unsigned)(fq * 16 + fr)) * 16u) = w; }
            } else if (wc == 2 && fq == 0) {
#pragma unroll
                for (int ai = 0; ai < 2; ++ai)
#pragma unroll
                    for (int m = 0; m < 4; ++m) { float* p = WI + (size_t)(row0 + ai * 128 + m * 16) * 8;
                        if (!dry) { *(f32x4*)p = acc[ai][0][m][0] * 0.35355339059327373f; *(f32x4*)(p + 4) = acc[ai][0][m][1] * 0.35355339059327373f; } }
            }
        }
        else { h16* base = pn < 21 ? SGA : SGB; const int pl = pn < 21 ? pn - 17 : pn - 21; store_tile_frag<2>(acc, base, frag_off(u.pm, pl, wr * 4 + wc, fq * 16 + fr), dry); }
    }
};

template <int SECOND> struct EpiMerge {
    static constexpr bool PERM = true;
    const h16* SG; h16* T1; h16* OUT; int dry;
    __device__ __forceinline__ void operator()(AccRef acc, const pg8::Unit& u, int wr, int wc, int fr, int fq) const {
        const int row0 = u.pm * 256 + wr * 64 + fr, col0 = u.pn * 256 + wc * 32 + 8 * fq;
        const unsigned fo = frag_off(u.pm, u.pn, wr * 4 + wc, fq * 16 + fr);
#pragma unroll
        for (int ai = 0; ai < 2; ++ai) {
            h8 sg[4][2], t1[4][2];
#pragma unroll
            for (int m = 0; m < 4; ++m)
#pragma unroll
                for (int bj = 0; bj < 2; ++bj) { sg[m][bj] = *(const h8*)((const char*)SG + fo + FRAG_SUB(ai, m, bj)); if (SECOND) t1[m][bj] = *(const h8*)((const char*)T1 + fo + FRAG_SUB(ai, m, bj)); }
            __builtin_amdgcn_sched_barrier(0);
#pragma unroll
            for (int m = 0; m < 4; ++m) { const size_t off = (size_t)(row0 + ai * 128 + m * 16) * DM + col0;
#pragma unroll
                for (int bj = 0; bj < 2; ++bj) { const f32x4 v0 = acc[ai][bj][m][0], v1 = acc[ai][bj][m][1];
                    float r[8];
#pragma unroll
                    for (int j = 0; j < 4; ++j) { r[j] = (float)sg[m][bj][j] * v0[j]; r[4 + j] = (float)sg[m][bj][4 + j] * v1[j]; }
                    if (SECOND) {
#pragma unroll
                        for (int j = 0; j < 8; ++j) r[j] += (float)t1[m][bj][j]; }
                    u32x4 w; w.x = pkh(r[0], r[1]); w.y = pkh(r[2], r[3]); w.z = pkh(r[4], r[5]); w.w = pkh(r[6], r[7]);
                    if (!dry) { if (SECOND) *(u32x4*)(OUT + off + bj * 128) = w; else *(u32x4*)((char*)T1 + fo + FRAG_SUB(ai, m, bj)) = w; } } }
            __builtin_amdgcn_sched_barrier(0); }
    }
};

template <bool BASE_F32> struct EpiResid {
    static constexpr bool PERM = true;
    const float* BF; const h16* BH; h16* XOUT; float* SSQ; int dry;
    __device__ __forceinline__ void operator()(AccRef acc, const pg8::Unit& u, int wr, int wc, int fr, int fq) const {
        const int row0 = u.pm * 256 + wr * 64 + fr, col0 = u.pn * 256 + wc * 32 + 8 * fq;
#pragma unroll
        for (int ai = 0; ai < 2; ++ai) {
            f32x4 bf[4][2][2]; h8 bh[4][2];
#pragma unroll
            for (int m = 0; m < 4; ++m) { const size_t off = (size_t)(row0 + ai * 128 + m * 16) * DM + col0;
#pragma unroll
                for (int bj = 0; bj < 2; ++bj) { if (BASE_F32) { bf[m][bj][0] = *(const f32x4*)(BF + off + bj * 128); bf[m][bj][1] = *(const f32x4*)(BF + off + bj * 128 + 4); } else bh[m][bj] = *(const h8*)(BH + off + bj * 128); } }
            __builtin_amdgcn_sched_barrier(0);
#pragma unroll
            for (int m = 0; m < 4; ++m) { const int row = row0 + ai * 128 + m * 16; const size_t off = (size_t)row * DM + col0; float ss = 0.f;
#pragma unroll
                for (int bj = 0; bj < 2; ++bj) { const f32x4 v0 = acc[ai][bj][m][0], v1 = acc[ai][bj][m][1];
                    float r[8];
                    if (BASE_F32) {
#pragma unroll
                        for (int j = 0; j < 4; ++j) { r[j] = bf[m][bj][0][j] + v0[j]; r[4 + j] = bf[m][bj][1][j] + v1[j]; } }
                    else {
#pragma unroll
                        for (int j = 0; j < 4; ++j) { r[j] = (float)bh[m][bj][j] + v0[j]; r[4 + j] = (float)bh[m][bj][4 + j] + v1[j]; } }
#pragma unroll
                    for (int j = 0; j < 8; ++j) ss += r[j] * r[j];
                    u32x4 w; w.x = pkh(r[0], r[1]); w.y = pkh(r[2], r[3]); w.z = pkh(r[4], r[5]); w.w = pkh(r[6], r[7]);
                    if (!dry) *(u32x4*)(XOUT + off + bj * 128) = w; }
                ss += __shfl_xor(ss, 16); ss += __shfl_xor(ss, 32);
                if (fq == 0 && !dry) unsafeAtomicAdd(SSQ + row, ss); }
            __builtin_amdgcn_sched_barrier(0); }
    }
};

struct EpiUp {
    static constexpr bool PERM = true;
    const float* SSQ; h16* UPG; h16* UPV; int dry;
    __device__ __forceinline__ void operator()(AccRef acc, const pg8::Unit& u, int wr, int wc, int fr, int fq) const {
        const int row0 = u.pm * 256 + wr * 64 + fr, col0 = u.pn * 128 + wc * 32 + 8 * fq;
#pragma unroll
        for (int ai = 0; ai < 2; ++ai)
#pragma unroll
            for (int m = 0; m < 4; ++m) { const int row = row0 + ai * 128 + m * 16; const size_t off = (size_t)row * DFF + col0;
                const float r = __builtin_amdgcn_rsqf(SSQ[row] * (1.0f / DM) + EPS);
#pragma unroll
                for (int bj = 0; bj < 2; ++bj) { const f32x4 v0 = acc[ai][bj][m][0] * r, v1 = acc[ai][bj][m][1] * r;
                    u32x4 w; w.x = pkh(v0[0], v0[1]); w.y = pkh(v0[2], v0[3]); w.z = pkh(v1[0], v1[1]); w.w = pkh(v1[2], v1[3]);
                    if (!dry) *(u32x4*)((bj ? UPV : UPG) + off) = w; } }
    }
};

__device__ __forceinline__ float dpp_ror1(float v) { return __builtin_bit_cast(float, __builtin_amdgcn_update_dpp(0, __builtin_bit_cast(int, v), 0x121, 0xf, 0xf, false)); }
__device__ __forceinline__ float dpp_ror2(float v) { return __builtin_bit_cast(float, __builtin_amdgcn_update_dpp(0, __builtin_bit_cast(int, v), 0x122, 0xf, 0xf, false)); }
struct EpiUpAct {
    static constexpr bool PERM = true;
    const float* SSQ; h16* ACT; float* SG; float* SV; float* SL; const float* fcw; const float* fcb; LAS unsigned char* xl; int dry;
    __device__ __forceinline__ void operator()(AccRef acc, const pg8::Unit& u, int wr, int wc, int fr, int fq) const {
        const int row0 = u.pm * 256 + wr * 64 + fr, colg = u.pn * 128 + wc * 32 + 8 * fq, coll = wc * 32 + 8 * fq;
        float w0[8], w1[8], w2[8], bb[8];
        { const f32x4 a0 = *(const f32x4*)(fcw + colg), a1 = *(const f32x4*)(fcw + colg + 4), b0 = *(const f32x4*)(fcw + DFF + colg), b1 = *(const f32x4*)(fcw + DFF + colg + 4),
                      c0 = *(const f32x4*)(fcw + 2 * DFF + colg), c1 = *(const f32x4*)(fcw + 2 * DFF + colg + 4), d0 = *(const f32x4*)(fcb + colg), d1 = *(const f32x4*)(fcb + colg + 4);
#pragma unroll
          for (int e = 0; e < 4; ++e) { w0[e] = a0[e]; w0[4 + e] = a1[e]; w1[e] = b0[e]; w1[4 + e] = b1[e]; w2[e] = c0[e]; w2[4 + e] = c1[e]; bb[e] = d0[e]; bb[4 + e] = d1[e]; } }
        float rsv[2][4];
#pragma unroll
        for (int ai = 0; ai < 2; ++ai)
#pragma unroll
            for (int m = 0; m < 4; ++m) rsv[ai][m] = SSQ[row0 + ai * 128 + m * 16];
#pragma unroll
        for (int ai = 0; ai < 2; ++ai)
#pragma unroll
            for (int m = 0; m < 4; ++m) rsv[ai][m] = __builtin_amdgcn_rsqf(rsv[ai][m] * (1.0f / DM) + EPS);
        LAS float* X = (LAS float*)xl;
#pragma unroll
        for (int ai = 0; ai < 2; ++ai) { const float r3 = rsv[ai][3];
            if (fr >= 14) { LAS float* p = X + ((ai * 2 + wr) * 2 + (fr - 14)) * 128 + coll; *(LAS f32x4*)p = acc[ai][0][3][0] * r3; *(LAS f32x4*)(p + 4) = acc[ai][0][3][1] * r3; } }
        LDS_WAIT(); __builtin_amdgcn_s_barrier(); asm volatile("" ::: "memory");
#pragma unroll
        for (int ai = 0; ai < 2; ++ai) {
            float L0[8], L1[8];
            if (ai == 0 && wr == 0) {
#pragma unroll
                for (int e = 0; e < 8; ++e) { L0[e] = 0.f; L1[e] = 0.f; } }
            else { const int pb = wr == 1 ? ai * 2 : 1; const LAS float* p = X + (pb * 2) * 128 + coll;
                const f32x4 x0 = *(const LAS f32x4*)p, x1 = *(const LAS f32x4*)(p + 4), y0 = *(const LAS f32x4*)(p + 128), y1 = *(const LAS f32x4*)(p + 132);
#pragma unroll
                for (int e = 0; e < 4; ++e) { L0[e] = x0[e]; L0[4 + e] = x1[e]; L1[e] = y0[e]; L1[4 + e] = y1[e]; } }
            float q1[8], q2[8];
#pragma unroll
            for (int e = 0; e < 8; ++e) { q1[e] = L1[e]; q2[e] = fr == 0 ? L0[e] : L1[e]; }
#pragma unroll
            for (int m = 0; m < 4; ++m) { const int row = row0 + ai * 128 + m * 16;
                const float rr = rsv[ai][m];
                float g[8], a[8];
#pragma unroll
                for (int e = 0; e < 4; ++e) { g[e] = acc[ai][0][m][0][e] * rr; g[4 + e] = acc[ai][0][m][1][e] * rr; }
#pragma unroll
                for (int e = 0; e < 8; ++e) { const float r1 = dpp_ror1(g[e]), r2 = dpp_ror2(g[e]);
                    const float p1 = fr >= 1 ? r1 : q1[e], p2 = fr >= 2 ? r2 : q2[e];
                    const float y = bb[e] + w0[e] * p2 + w1[e] * p1 + w2[e] * g[e];
                    const float vv = (e < 4 ? acc[ai][1][m][0][e] : acc[ai][1][m][1][e - 4]) * rr;
                    a[e] = gelu_tanh(y) * vv; q1[e] = r1; q2[e] = r2; }
                const bool deferred = (ai == 0 && m == 0) && wr == 0 && fr < 2;
                if (!dry) {
                    if (!deferred) { u32x4 w; w.x = pkh(a[0], a[1]); w.y = pkh(a[2], a[3]); w.z = pkh(a[4], a[5]); w.w = pkh(a[6], a[7]); *(u32x4*)(ACT + (size_t)row * DFF + colg) = w; }
                    else { float* pg = SG + (size_t)(u.pm * 2 + fr) * DFF + colg; float* pv = SV + (size_t)(u.pm * 2 + fr) * DFF + colg;
                        *(f32x4*)pg = (f32x4){g[0], g[1], g[2], g[3]}; *(f32x4*)(pg + 4) = (f32x4){g[4], g[5], g[6], g[7]};
                        *(f32x4*)pv = acc[ai][1][m][0] * rr; *(f32x4*)(pv + 4) = acc[ai][1][m][1] * rr; }
                    if ((ai == 1 && m == 3) && wr == 1 && fr >= 14) { float* pl = SL + (size_t)(u.pm * 2 + fr - 14) * DFF + colg;
                        *(f32x4*)pl = (f32x4){g[0], g[1], g[2], g[3]}; *(f32x4*)(pl + 4) = (f32x4){g[4], g[5], g[6], g[7]}; } }
                __builtin_amdgcn_sched_barrier(0); }
        }
    }
};
__device__ __forceinline__ void act_fix_tile(const float* SG, const float* SV, const float* SL, const float* fcw, const float* fcb, h16* ACT, int pm, int tid, int dry) {
    constexpr int NCG = DFF / 8; const bool bs = (pm & 31) == 0;
    for (int it = tid; it < 2 * NCG; it += NTHR) { const int cg = it % NCG, rr = it / NCG, c0 = cg * 8;
        float y[8];
#pragma unroll
        for (int h = 0; h < 2; ++h) { const int c = c0 + 4 * h;
            const f32x4 g = *(const f32x4*)(SG + (size_t)(pm * 2 + rr) * DFF + c), v = *(const f32x4*)(SV + (size_t)(pm * 2 + rr) * DFF + c);
            f32x4 g1, g2; const f32x4 z = {0.f, 0.f, 0.f, 0.f};
            if (rr == 0) { g1 = bs ? z : *(const f32x4*)(SL + (size_t)((pm - 1) * 2 + 1) * DFF + c); g2 = bs ? z : *(const f32x4*)(SL + (size_t)((pm - 1) * 2) * DFF + c); }
            else { g1 = *(const f32x4*)(SG + (size_t)(pm * 2) * DFF + c); g2 = bs ? z : *(const f32x4*)(SL + (size_t)((pm - 1) * 2 + 1) * DFF + c); }
            const f32x4 a0 = *(const f32x4*)(fcw + c), a1 = *(const f32x4*)(fcw + DFF + c), a2 = *(const f32x4*)(fcw + 2 * DFF + c), b = *(const f32x4*)(fcb + c);
#pragma unroll
            for (int e = 0; e < 4; ++e) y[4 * h + e] = gelu_tanh(b[e] + a0[e] * g2[e] + a1[e] * g1[e] + a2[e] * g[e]) * v[e]; }
        u32x4 w; w.x = pkh(y[0], y[1]); w.y = pkh(y[2], y[3]); w.z = pkh(y[4], y[5]); w.w = pkh(y[6], y[7]);
        if (!dry) *(u32x4*)(ACT + (size_t)(pm * 256 + rr) * DFF + c0) = w; }
}

struct EpiGateSig {
    static constexpr bool PERM = true;
    const float* SSQ; h16* GS; int dry;
    __device__ __forceinline__ void operator()(AccRef acc, const pg8::Unit& u, int wr, int wc, int fr, int fq) const {
        const int row0 = u.pm * 256 + wr * 64 + fr; const unsigned fo = frag_off(u.pm, u.pn, wr * 4 + wc, fq * 16 + fr);
        float rsv[2][4];
#pragma unroll
        for (int ai = 0; ai < 2; ++ai)
#pragma unroll
            for (int m = 0; m < 4; ++m) rsv[ai][m] = SSQ[row0 + ai * 128 + m * 16];
        __builtin_amdgcn_sched_barrier(0);
#pragma unroll
        for (int ai = 0; ai < 2; ++ai)
#pragma unroll
            for (int m = 0; m < 4; ++m) { const float r = __builtin_amdgcn_rsqf(rsv[ai][m] * (1.0f / DM) + EPS);
#pragma unroll
                for (int bj = 0; bj < 2; ++bj) { const f32x4 v0 = acc[ai][bj][m][0] * r, v1 = acc[ai][bj][m][1] * r;
                    u32x4 w; w.x = pkh(sigmoid_f(v0[0]), sigmoid_f(v0[1])); w.y = pkh(sigmoid_f(v0[2]), sigmoid_f(v0[3])); w.z = pkh(sigmoid_f(v1[0]), sigmoid_f(v1[1])); w.w = pkh(sigmoid_f(v1[2]), sigmoid_f(v1[3]));
                    if (!dry) *(u32x4*)((char*)GS + fo + FRAG_SUB(ai, m, bj)) = w; }
                __builtin_amdgcn_sched_barrier(0); }
    }
};
struct EpiPleOut {
    static constexpr bool PERM = true;
    const h16* GS; const h16* X2; float* C; int dry;
    __device__ __forceinline__ void operator()(AccRef acc, const pg8::Unit& u, int wr, int wc, int fr, int fq) const {
        const int row0 = u.pm * 256 + wr * 64 + fr, col0 = u.pn * 256 + wc * 32 + 8 * fq;
        const unsigned e0 = (unsigned)row0 * DM + (unsigned)col0, fo = frag_off(u.pm, u.pn, wr * 4 + wc, fq * 16 + fr);
#pragma unroll
        for (int ai = 0; ai < 2; ++ai) {
            h8 gsv[4][2], xbv[4][2];
#pragma unroll
            for (int m = 0; m < 4; ++m)
#pragma unroll
                for (int bj = 0; bj < 2; ++bj) { const unsigned o2 = e0 + (unsigned)((ai * 128 + m * 16) * DM) + bj * 128;
                    gsv[m][bj] = *(const h8*)((const char*)GS + fo + FRAG_SUB(ai, m, bj)); xbv[m][bj] = *(const h8*)((const char*)X2 + (size_t)o2 * 2u); }
            __builtin_amdgcn_sched_barrier(0);
#pragma unroll
            for (int m = 0; m < 4; ++m) { const unsigned eo = e0 + (unsigned)((ai * 128 + m * 16) * DM);
#pragma unroll
                for (int bj = 0; bj < 2; ++bj) { const unsigned o2 = eo + bj * 128; const f32x4 a0 = acc[ai][bj][m][0], a1 = acc[ai][bj][m][1];
                    f32x4 o0, o1;
#pragma unroll
                    for (int j = 0; j < 4; ++j) { o0[j] = (float)xbv[m][bj][j] + (float)gsv[m][bj][j] * a0[j]; o1[j] = (float)xbv[m][bj][4 + j] + (float)gsv[m][bj][4 + j] * a1[j]; }
                    if (!dry) { *(f32x4*)((char*)C + (size_t)o2 * 4u) = o0; *(f32x4*)((char*)C + (size_t)o2 * 4u + 16) = o1; } } }
            __builtin_amdgcn_sched_barrier(0); }
    }
};


#define XB_TMO      128
#define XB_XCNT(j)  (256  + 64 * (j))
#define XB_XSUB(j)  (1280 + 64 * (j))
#define XB_XGEN(j)  (2304 + 64 * (j))
#define XB_TOP      3328
#define XB_TOPGEN   3392
#define XCD_BAR_WORDS 3456
#define XB_SPIN_CAP (1u << 20)

__device__ __forceinline__ unsigned xb_ld(unsigned* p)              { return __hip_atomic_load(p, __ATOMIC_RELAXED, __HIP_MEMORY_SCOPE_AGENT); }
__device__ __forceinline__ unsigned xb_add(unsigned* p, unsigned v) { return __hip_atomic_fetch_add(p, v, __ATOMIC_RELAXED, __HIP_MEMORY_SCOPE_AGENT); }
__device__ __forceinline__ unsigned xb_xcc_id() { return (unsigned)__builtin_amdgcn_s_getreg((3 << 11) | 20) & 0xFu; }
#define XB_SPIN(cond, bar) do { unsigned _sp = 0; while (cond) { __builtin_amdgcn_s_sleep(1); \
    if ((++_sp & 255u) == 0u) { if (xb_ld(&(bar)[XB_TMO])) break; if (_sp > XB_SPIN_CAP) { atomicAdd(&(bar)[XB_TMO], 1u); break; } } } } while (0)

struct XcdBarrier { unsigned* bar; unsigned x; volatile LAS unsigned* st; };

__device__ __forceinline__ XcdBarrier xcd_barrier_post(unsigned* bar, volatile LAS unsigned* st) {
    XcdBarrier b; b.bar = bar; b.x = xb_xcc_id(); b.st = st;
    if (threadIdx.x == 0) (void)xb_add(&bar[XB_XCNT(b.x)], 1u);
    return b;
}
__device__ __forceinline__ void xcd_barrier_complete(unsigned* bar, unsigned x, unsigned& nloc, unsigned& nx) {
    const unsigned G = gridDim.x * gridDim.y * gridDim.z;
    unsigned sum, cnt, mine, sp = 0u;
    for (;;) {
        sum = 0u; cnt = 0u; mine = 0u;
#pragma unroll
        for (unsigned j = 0; j < 16; ++j) { const unsigned c = xb_ld(&bar[XB_XCNT(j)]); sum += c; cnt += (c > 0u) ? 1u : 0u; mine = (j == x) ? c : mine; }
        if (sum == G) break;
        __builtin_amdgcn_s_sleep(1);
        if ((++sp & 255u) == 0u) { if (xb_ld(&bar[XB_TMO])) break; if (sp > XB_SPIN_CAP) { atomicAdd(&bar[XB_TMO], 1u); break; } }
    }
    nloc = mine > 0u ? mine : 1u; nx = cnt > 0u ? cnt : 1u;
}
__device__ __forceinline__ void xcd_barrier(const XcdBarrier& b) {
    asm volatile("s_waitcnt vmcnt(0)" ::: "memory");
    __syncthreads();
    if (threadIdx.x == 0) {
        unsigned* bar = b.bar;
        __builtin_amdgcn_s_waitcnt(0);
        unsigned nloc = b.st[0], nx = b.st[1];
        if (nloc == 0u) { xcd_barrier_complete(bar, b.x, nloc, nx); b.st[0] = nloc; b.st[1] = nx; }
        const unsigned old = xb_add(&bar[XB_XSUB(b.x)], 1u);
        const unsigned gen = old / nloc;
        if (old + 1u == (gen + 1u) * nloc) {
            __builtin_amdgcn_fence(__ATOMIC_RELEASE, "agent");
            asm volatile("s_waitcnt vmcnt(0)" ::: "memory");
            const unsigned og = xb_add(&bar[XB_TOP], 1u);
            const unsigned tg = og / nx;
            if (og + 1u == (tg + 1u) * nx) xb_add(&bar[XB_TOPGEN], 1u);
            else XB_SPIN(xb_ld(&bar[XB_TOPGEN]) == tg, bar);
            __builtin_amdgcn_fence(__ATOMIC_ACQUIRE, "agent");
            xb_add(&bar[XB_XGEN(b.x)], 1u);
            asm volatile("s_waitcnt vmcnt(0)" ::: "memory");
        } else {
            XB_SPIN(xb_ld(&bar[XB_XGEN(b.x)]) == gen, bar);
            __builtin_amdgcn_fence(__ATOMIC_ACQUIRE, "agent");
            asm volatile("s_waitcnt vmcnt(0)" ::: "memory");
        }
    }
    __syncthreads();
}

constexpr size_t MiB = 1u << 20;
constexpr size_t WS_CTL = 0, CTL_ZERO_BYTES = 1 * MiB;
constexpr size_t WS_SA = 1 * MiB, WS_SH = 2 * MiB;
constexpr size_t WS_WI = 3 * MiB;
constexpr size_t WS_KI = 4 * MiB;
constexpr size_t WS_W = 8 * MiB;
constexpr size_t W_IN = WS_W, W_LRU = W_IN + (size_t)NIN_PAD * DM * 2, W_ATT = W_LRU + 2 * MiB, W_OUT = W_ATT + 2 * MiB, W_PG = W_OUT + 2 * MiB,
                 W_UP = W_PG + 2 * MiB, W_DOWN = W_UP + 12 * MiB, W_PP = W_DOWN + 6 * MiB, W_GATE = W_PP + MiB / 2, W_END = W_GATE + MiB / 2;
static_assert(W_END <= 48 * MiB, "weights region");
constexpr size_t WS_A0 = 48 * MiB;
constexpr size_t WS_IDX = 48 * MiB, WS_NV = 64 * MiB;
constexpr size_t WS_K8 = 72 * MiB, WS_V8 = 80 * MiB;
constexpr size_t WS_T1 = 48 * MiB;
constexpr size_t WS_X1H = 48 * MiB;
constexpr size_t WS_PH = 112 * MiB;
constexpr size_t WS_LX = 128 * MiB;
constexpr size_t WS_GG = 192 * MiB;
constexpr size_t WS_Q = 256 * MiB;
constexpr size_t WS_K = 320 * MiB, WS_V = 336 * MiB;
constexpr size_t WS_QI = 352 * MiB;
constexpr size_t WS_SGA = 384 * MiB, WS_SGB = 448 * MiB;
constexpr size_t WS_UPG = 128 * MiB, WS_UPV = 320 * MiB;
constexpr size_t WS_X2H = 128 * MiB;
constexpr size_t WS_GS = 320 * MiB;
constexpr size_t WS_END = 512 * MiB;
constexpr int CW_BAR = 1024;
constexpr int CW_Q2 = 8192, CW_Q3 = 8192 + 256;
constexpr size_t CTL_SSQ1 = 256 * 1024, CTL_SSQ2 = 512 * 1024;
static_assert((CW_BAR + XCD_BAR_WORDS) * 4 <= 32768 && CTL_SSQ2 + MTOK * 4 <= CTL_ZERO_BYTES, "ctl map");

constexpr int LDS_BYTES = 159744;
constexpr int MISC_OFF = LDS_BYTES - 256;

struct Params {
    const float* in[25]; float* out; unsigned char* ws; int ph_lo, ph_hi, k_ple, pad;
};

#define DPP_ADDF(v, ctl, rm) v += __builtin_bit_cast(float, __builtin_amdgcn_update_dpp(0, __builtin_bit_cast(int, v), ctl, rm, 0xf, false))
__device__ __forceinline__ float row_sum(float v) { DPP_ADDF(v, 0xB1, 0xf); DPP_ADDF(v, 0x4E, 0xf); DPP_ADDF(v, 0x141, 0xf); DPP_ADDF(v, 0x140, 0xf); return v; }
__device__ __forceinline__ float wave_sum(float v) { v = row_sum(v); DPP_ADDF(v, 0x142, 0xa); DPP_ADDF(v, 0x143, 0xc); return __builtin_bit_cast(float, __builtin_amdgcn_readlane(__builtin_bit_cast(int, v), 63)); }
__device__ __forceinline__ float half_sum(float v, int lane) { v = row_sum(v); DPP_ADDF(v, 0x142, 0xa);
    const float lo = __builtin_bit_cast(float, __builtin_amdgcn_readlane(__builtin_bit_cast(int, v), 31)), hi = __builtin_bit_cast(float, __builtin_amdgcn_readlane(__builtin_bit_cast(int, v), 63)); return lane < 32 ? lo : hi; }
template <int MAP> __device__ __forceinline__ int rowmap(int n) {
    if (MAP == 1) return n < 4168 ? n : n + 184;
    if (MAP == 2) return n < DFF ? ((n >> 7) * 256 + (n & 127)) : (((n - DFF) >> 7) * 256 + 128 + ((n - DFF) & 127));
    return n;
}
template <int MAP> __device__ __forceinline__ void p0_transpose_item(const float* W, int K, int N, h16* WT, const float* gain, LAS float* scr, int item, int lane) {
    const int nblk = (N + 31) / 32, kb = item / nblk, nb = item % nblk, k0 = 64 * kb, n0 = 32 * nb;
    const int nn = n0 + (lane & 31);
    float wv_[32];
#pragma unroll
    for (int i = 0; i < 32; ++i) { const int kk = 2 * i + (lane >> 5); wv_[i] = 0.f; if (nn < N) wv_[i] = W[(size_t)(k0 + kk) * N + nn]; }
    const int c = lane & 7;
    float gk[8];
#pragma unroll
    for (int j = 0; j < 8; ++j) gk[j] = 1.f;
    if (gain) { const f32x4 g0 = *(const f32x4*)(gain + k0 + 8 * c), g1 = *(const f32x4*)(gain + k0 + 8 * c + 4);
#pragma unroll
        for (int j = 0; j < 4; ++j) { gk[j] = g0[j]; gk[4 + j] = g1[j]; } }
#pragma unroll
    for (int i = 0; i < 32; ++i) { const int kk = 2 * i + (lane >> 5); scr[kk * 33 + (lane & 31)] = wv_[i]; }
    LDS_WAIT(); asm volatile("" ::: "memory");
#pragma unroll
    for (int j = 0; j < 4; ++j) { const int n = (lane >> 3) + 8 * j; const LAS float* s = scr + (8 * c) * 33 + n;
        u32x4 o; o.x = pkh(s[0 * 33] * gk[0], s[1 * 33] * gk[1]); o.y = pkh(s[2 * 33] * gk[2], s[3 * 33] * gk[3]); o.z = pkh(s[4 * 33] * gk[4], s[5 * 33] * gk[5]); o.w = pkh(s[6 * 33] * gk[6], s[7 * 33] * gk[7]);
        if (n0 + n < N) *(u32x4*)(WT + (size_t)rowmap<MAP>(n0 + n) * K + k0 + 8 * c) = o; }
    LDS_WAIT(); asm volatile("" ::: "memory");
}

struct Ctx {
    unsigned char* ws; float* out; int dry;
    const float *conv_w, *conv_b, *ba, *bx, *lam, *qn, *kn, *relb, *fcw, *fcb;
};
__device__ __forceinline__ unsigned ordered_u32(float v) { const unsigned u = __builtin_bit_cast(unsigned, v); return u ^ ((unsigned)((int)u >> 31) | 0x80000000u); }

constexpr int UA_STR = 272;
constexpr int LRU_UA = 0, LRU_HL = 128 * UA_STR, LRU_PP = 2 * 128 * UA_STR;
__device__ __forceinline__ void lru1_item(const Ctx& C, LAS unsigned char* lds, int item) {
    int tid = threadIdx.x; asm volatile("" : "+v"(tid));
    const int lane = tid & 63, wv = tid >> 6;
    const int b = item >> 7, n = (item >> 4) & 7, jg = item & 15;
    const h16* LX = (const h16*)(C.ws + WS_LX);
    const int cg = tid & 15, rg = tid >> 4, ch0 = n * 128 + cg * 8, tl = rg * 4;
    float cb[8], cw[4][8];
    { const f32x4 t0 = *(const f32x4*)(C.conv_b + ch0), t1 = *(const f32x4*)(C.conv_b + ch0 + 4); for (int e = 0; e < 4; ++e) { cb[e] = t0[e]; cb[4 + e] = t1[e]; } }
#pragma unroll
    for (int jj = 0; jj < 4; ++jj) { const f32x4 w0 = *(const f32x4*)(C.conv_w + jj * DM + ch0), w1 = *(const f32x4*)(C.conv_w + jj * DM + ch0 + 4); for (int e = 0; e < 4; ++e) { cw[jj][e] = w0[e]; cw[jj][4 + e] = w1[e]; } }
    const int q = lane & 15, c = lane >> 4, oc = wv * 16 + q, ch = n * 128 + oc;
    const h16* WG = (const h16*)(C.ws + W_GATE) + (size_t)n * 256 * 128;
    h8 Ba[4], Bx[4];
#pragma unroll
    for (int ks = 0; ks < 4; ++ks) { Ba[ks] = *(const h8*)(WG + (size_t)oc * 128 + 32 * ks + 8 * c); Bx[ks] = *(const h8*)(WG + (size_t)(128 + oc) * 128 + 32 * ks + 8 * c); }
    const float bav = C.ba[ch], bxv = C.bx[ch], m8sp = -8.0f * 1.4426950408889634f * log1pf(expf(-C.lam[ch]));
    h8 xr[7];
#define LRU_LOADX(jn) do { const int tseq_ = (jn) * 128 + tl; _Pragma("unroll") for (int i = 0; i < 7; ++i) { const int tt = tseq_ - 3 + i; if (tt >= 0) xr[i] = *(const h8*)(LX + ((size_t)b * SEQ + tt) * DM + ch0); else { for (int e = 0; e < 8; ++e) xr[i][e] = (h16)0.f; } } } while (0)
    LRU_LOADX(jg * 4);
#pragma unroll 1
    for (int j4 = 0; j4 < 4; ++j4) {
    const int j = jg * 4 + j4;
    const size_t mrow0 = (size_t)b * SEQ + (size_t)j * 128;
    {
        float y[4][8];
#pragma unroll
        for (int r = 0; r < 4; ++r)
#pragma unroll
            for (int e = 0; e < 8; ++e) y[r][e] = cb[e];
#pragma unroll
        for (int jj = 0; jj < 4; ++jj)
#pragma unroll
            for (int r = 0; r < 4; ++r)
#pragma unroll
                for (int e = 0; e < 8; ++e) y[r][e] += cw[jj][e] * (float)xr[r + jj][e];
#pragma unroll
        for (int r = 0; r < 4; ++r) { u32x4 w; w.x = pkh(y[r][0], y[r][1]); w.y = pkh(y[r][2], y[r][3]); w.z = pkh(y[r][4], y[r][5]); w.w = pkh(y[r][6], y[r][7]);
            *(LAS u32x4*)(lds + LRU_UA + (tl + r) * UA_STR + cg * 16) = w; }
        if (j4 < 3) LRU_LOADX(j + 1);
    }
    __syncthreads();
    {
        float cH = 0.f, cP = 1.f;
        for (int tt = 0; tt < 8; ++tt) {
            f32x4 aa = {0.f, 0.f, 0.f, 0.f}, ax = {0.f, 0.f, 0.f, 0.f};
#pragma unroll
            for (int ks = 0; ks < 4; ++ks) { const h8 A = *(const LAS h8*)(lds + LRU_UA + (16 * tt + q) * UA_STR + (32 * ks + 8 * c) * 2);
                aa = __builtin_amdgcn_mfma_f32_16x16x32_f16(A, Ba[ks], aa, 0, 0, 0); ax = __builtin_amdgcn_mfma_f32_16x16x32_f16(A, Bx[ks], ax, 0, 0, 0); }
            float hl[4], pl[4]; float h = 0.f, p = 1.f;
#pragma unroll
            for (int i = 0; i < 4; ++i) { const int t = 16 * tt + 4 * c + i;
                const float uav = (float)*(const LAS h16*)(lds + LRU_UA + t * UA_STR + oc * 2);
                const float ra = sigmoid_f(aa[i] + bav), ix = sigmoid_f(ax[i] + bxv);
                const float a = __builtin_amdgcn_exp2f(m8sp * ra);
                const float mult = __builtin_amdgcn_sqrtf(fmaxf(1.0f - a * a, 0.f));
                const float u = mult * ix * uav;
                h = a * h + u; p *= a; hl[i] = h; pl[i] = p; }
            float Ak[4], Hk[4];
#pragma unroll
            for (int k = 0; k < 4; ++k) { Ak[k] = __shfl(p, q + 16 * k); Hk[k] = __shfl(h, q + 16 * k); }
            float PA = 1.f, PH = 0.f;
#pragma unroll
            for (int k = 0; k < 3; ++k) if (k < c) { PH = PH * Ak[k] + Hk[k]; PA *= Ak[k]; }
            const float hin = cH * PA + PH, pin = cP * PA;
#pragma unroll
            for (int i = 0; i < 4; ++i) { const int t = 16 * tt + 4 * c + i;
                *(LAS h16*)(lds + LRU_HL + t * UA_STR + oc * 2) = (h16)(hl[i] + pl[i] * hin);
                *(LAS h16*)(lds + LRU_PP + t * UA_STR + oc * 2) = (h16)(pin * pl[i]); }
            const float AT = Ak[0] * Ak[1] * Ak[2] * Ak[3], HT = ((Hk[0] * Ak[1] + Hk[1]) * Ak[2] + Hk[2]) * Ak[3] + Hk[3];
            cH = cH * AT + HT; cP = cP * AT;
        }
        if (c == 0 && !C.dry) { const size_t so = ((size_t)b * 64 + j) * DM + ch; ((float*)(C.ws + WS_SA))[so] = cP; ((float*)(C.ws + WS_SH))[so] = cH; }
    }
    __syncthreads();
    {
        h16* HLOC = (h16*)C.out; h16* PPRD = (h16*)C.out + (size_t)MTOK * DM;
#pragma unroll
        for (int r = 0; r < 4; ++r) { const int t = rg * 4 + r; const size_t go = (mrow0 + t) * DM + n * 128 + cg * 8;
            const u32x4 w0 = *(const LAS u32x4*)(lds + LRU_HL + t * UA_STR + cg * 16), w1 = *(const LAS u32x4*)(lds + LRU_PP + t * UA_STR + cg * 16);
            if (!C.dry) { *(u32x4*)(HLOC + go) = w0; *(u32x4*)(PPRD + go) = w1; } }
    }
    __syncthreads();
    }
#undef LRU_LOADX
}

__device__ __forceinline__ void lru2_item(const Ctx& C, LAS unsigned char* lds, int item) {
    int tid = threadIdx.x; asm volatile("" : "+v"(tid));
    const int b = item >> 7, n = (item >> 4) & 7, jg = item & 15, j0 = jg * 4;
    LAS float* carry = (LAS float*)lds;
    const int cg = tid & 15, rg = tid >> 4; const h16* HLOC = (const h16*)C.out; const h16* PPRD = (const h16*)C.out + (size_t)MTOK * DM;
    const h16* GG = (const h16*)(C.ws + WS_GG); h16* YA = (h16*)(C.ws + WS_LX);
    h8 nhl[4], npp[4], ngg[4];
#define LRU2_LOAD(kk) do { _Pragma("unroll") for (int r = 0; r < 4; ++r) { const size_t go_ = ((size_t)b * SEQ + (j0 + (kk)) * 128 + rg * 4 + r) * DM + n * 128 + cg * 8; \
        nhl[r] = *(const h8*)(HLOC + go_); npp[r] = *(const h8*)(PPRD + go_); ngg[r] = *(const h8*)(GG + go_); } } while (0)
    LRU2_LOAD(0);
    if (tid < 128) { const int ch = n * 128 + tid; const float* SA = (const float*)(C.ws + WS_SA) + (size_t)b * 64 * DM + ch; const float* SH = (const float*)(C.ws + WS_SH) + (size_t)b * 64 * DM + ch;
        float cr = 0.f; int jj = 0;
        for (; jj + 16 <= j0; jj += 16) { float a8[16], h8v[16];
#pragma unroll
            for (int k = 0; k < 16; ++k) { a8[k] = SA[(size_t)(jj + k) * DM]; h8v[k] = SH[(size_t)(jj + k) * DM]; }
#pragma unroll
            for (int k = 0; k < 16; ++k) cr = a8[k] * cr + h8v[k]; }
        for (; jj + 4 <= j0; jj += 4) { float a8[4], h8v[4];
#pragma unroll
            for (int k = 0; k < 4; ++k) { a8[k] = SA[(size_t)(jj + k) * DM]; h8v[k] = SH[(size_t)(jj + k) * DM]; }
#pragma unroll
            for (int k = 0; k < 4; ++k) cr = a8[k] * cr + h8v[k]; }
        for (; jj < j0; ++jj) cr = SA[(size_t)jj * DM] * cr + SH[(size_t)jj * DM];
        float a4[4], h4[4];
#pragma unroll
        for (int k = 0; k < 4; ++k) { a4[k] = SA[(size_t)(j0 + k) * DM]; h4[k] = SH[(size_t)(j0 + k) * DM]; }
#pragma unroll
        for (int k = 0; k < 4; ++k) { carry[k * 128 + tid] = cr; cr = a4[k] * cr + h4[k]; } }
    __syncthreads();
#pragma unroll 1
    for (int k = 0; k < 4; ++k) {
        float cr[8];
#pragma unroll
        for (int e = 0; e < 8; ++e) cr[e] = carry[k * 128 + cg * 8 + e];
        h8 hl[4], pp[4], gg[4];
#pragma unroll
        for (int r = 0; r < 4; ++r) { hl[r] = nhl[r]; pp[r] = npp[r]; gg[r] = ngg[r]; }
        if (k < 3) LRU2_LOAD(k + 1);
#pragma unroll
        for (int r = 0; r < 4; ++r) { const size_t go = ((size_t)b * SEQ + (j0 + k) * 128 + rg * 4 + r) * DM + n * 128 + cg * 8;
            float y[8];
#pragma unroll
            for (int e = 0; e < 8; ++e) y[e] = ((float)hl[r][e] + (float)pp[r][e] * cr[e]) * (float)gg[r][e];
            u32x4 w; w.x = pkh(y[0], y[1]); w.y = pkh(y[2], y[3]); w.z = pkh(y[4], y[5]); w.w = pkh(y[6], y[7]);
            if (!C.dry) *(u32x4*)(YA + go) = w; } }
#undef LRU2_LOAD
}

__device__ __forceinline__ unsigned pk4_fp8_k(float a, float b, float c, float d) { int w = 0; w = __builtin_amdgcn_cvt_pk_fp8_f32(a, b, w, false); w = __builtin_amdgcn_cvt_pk_fp8_f32(c, d, w, true); return (unsigned)w; }
__device__ __forceinline__ void knorm_unit(const Ctx& C, int unit) {
    int tid = threadIdx.x; asm volatile("" : "+v"(tid));
    const int lane = tid & 63, wv = tid >> 6;
    const h16* K = (const h16*)(C.ws + WS_K); const h16* V = (const h16*)(C.ws + WS_V);
    unsigned* K8 = (unsigned*)(C.ws + WS_K8); unsigned* V8 = (unsigned*)(C.ws + WS_V8);
    const int col = lane * 4, d0 = col & 127;
    const f32x4 g = *(const f32x4*)(C.kn + d0);
#pragma unroll 1
    for (int hb = 0; hb < 2; ++hb) {
        h4 kv[8], vvv[8];
#pragma unroll
        for (int r = 0; r < 8; ++r) { const size_t row = (size_t)unit * 128 + wv * 16 + hb * 8 + r; kv[r] = *(const h4*)(K + row * 256 + col); vvv[r] = *(const h4*)(V + row * 256 + col); }
#pragma unroll
        for (int r = 0; r < 8; ++r) { const size_t row = (size_t)unit * 128 + wv * 16 + hb * 8 + r;
            float ss = 0.f, f[4];
#pragma unroll
            for (int e = 0; e < 4; ++e) { f[e] = (float)kv[r][e]; ss += f[e] * f[e]; }
            ss = half_sum(ss, lane);
            const float rs = __builtin_amdgcn_rsqf(ss * (1.0f / 128.0f) + EPS);
            const unsigned wk = pk4_fp8_k(f[0] * rs * g[0], f[1] * rs * g[1], f[2] * rs * g[2], f[3] * rs * g[3]);
            const unsigned wvv = pk4_fp8_k((float)vvv[r][0], (float)vvv[r][1], (float)vvv[r][2], (float)vvv[r][3]);
            if (!C.dry) { K8[row * 64 + lane] = wk; V8[row * 64 + lane] = wvv; } } }
}

#ifdef IX_PROBE
#define IX_PROBE_FINAL (C.dry && (IX_PROBE & 2))
#define IX_PROBE_NOFILT (C.dry && (IX_PROBE & 1))
#else
#define IX_PROBE_FINAL 0
#define IX_PROBE_NOFILT 0
#endif
constexpr int IX_SK = 256;
constexpr int IX_CAP = 1024;
constexpr int IX_ORD = 0;
constexpr int IX_KEY = IX_ORD + 16 * IX_CAP * 4;
constexpr int IX_HIST = IX_KEY + 16 * IX_CAP * 2;
constexpr int IX_CTR = IX_HIST + 8 * 512;
constexpr int IX_END = IX_CTR + 128;
static_assert(IX_END <= MISC_OFF, "indexer LDS");
constexpr int IX_NE = IX_CAP / 64;

struct IxBuf { LAS unsigned* ord; LAS unsigned short* key; };
#define IX_DPPMAX(v, ctl, rm) { const unsigned t_ = (unsigned)__builtin_amdgcn_update_dpp((int)(v), (int)(v), ctl, rm, 0xf, false); v = t_ > v ? t_ : v; }
__device__ __forceinline__ unsigned ix_rowmax(unsigned v) { IX_DPPMAX(v, 0xB1, 0xf) IX_DPPMAX(v, 0x4E, 0xf) IX_DPPMAX(v, 0x141, 0xf) IX_DPPMAX(v, 0x140, 0xf) return v; }
__device__ __forceinline__ unsigned ix_wavemax(unsigned v) { v = ix_rowmax(v); IX_DPPMAX(v, 0x142, 0xa) IX_DPPMAX(v, 0x143, 0xc) return (unsigned)__builtin_amdgcn_readlane((int)v, 63); }
__device__ __forceinline__ void ix_load_ord(const IxBuf& B, int cnt, int lane, unsigned (&o)[IX_NE]) {
#pragma unroll
    for (int k = 0; k < IX_NE; ++k) { const int idx = k * 64 + lane; o[k] = idx < cnt ? B.ord[idx] : 0u; }
}
__device__ __forceinline__ int ix_count_ge(const unsigned (&o)[IX_NE], unsigned x) {
    int c = 0;
#pragma unroll
    for (int k = 0; k < IX_NE; ++k) c += (int)__builtin_popcountll(__ballot(o[k] >= x));
    return c;
}
__device__ __forceinline__ unsigned ix_max(const unsigned (&o)[IX_NE]) {
    unsigned m = 0u;
#pragma unroll
    for (int k = 0; k < IX_NE; ++k) m = o[k] > m ? o[k] : m;
    return ix_wavemax(m);
}
__device__ __forceinline__ unsigned ix_tie_thr(const unsigned (&o)[IX_NE], const unsigned short (&kk)[IX_NE], unsigned x, int need) {
    unsigned lo = 0u, hi = 0x10000u;
    while (hi - lo > 1u) { const unsigned mid = (lo + hi) >> 1; int c = 0;
#pragma unroll
        for (int k = 0; k < IX_NE; ++k) c += (int)__builtin_popcountll(__ballot(o[k] == x && (unsigned)kk[k] >= mid));
        if (c >= need) lo = mid; else hi = mid; }
    return lo;
}
__device__ __forceinline__ int ix_rewrite(const IxBuf& B, const unsigned (&o)[IX_NE], const unsigned short (&kk)[IX_NE], int lane, unsigned x, unsigned th) {
    int base = 0;
#pragma unroll
    for (int k = 0; k < IX_NE; ++k) { const bool keep = o[k] > x || (o[k] == x && (unsigned)kk[k] >= th);
        const u64 m = __ballot(keep); const int pos = base + (int)__builtin_amdgcn_mbcnt_hi((unsigned)(m >> 32), __builtin_amdgcn_mbcnt_lo((unsigned)m, 0u));
        if (keep) { B.ord[pos] = o[k]; B.key[pos] = kk[k]; }
        base += (int)__builtin_popcountll(m); }
    LDS_WAIT();
    return base;
}
__device__ __forceinline__ unsigned ix_sample_pivot(unsigned s0, int rank) {
    int r = 0;
#define IX_ROT(n) { const unsigned t_ = (unsigned)__builtin_amdgcn_update_dpp(0, (int)s0, 0x120 + n, 0xf, 0xf, false); r += t_ > s0 ? 1 : 0; }
    IX_ROT(1) IX_ROT(2) IX_ROT(3) IX_ROT(4) IX_ROT(5) IX_ROT(6) IX_ROT(7) IX_ROT(8) IX_ROT(9) IX_ROT(10) IX_ROT(11) IX_ROT(12) IX_ROT(13) IX_ROT(14) IX_ROT(15)
#undef IX_ROT
    unsigned v = r >= rank ? s0 : 0u;
    v = ix_rowmax(v);
    return ((unsigned)__builtin_amdgcn_readlane((int)v, 0) >> 2) + ((unsigned)__builtin_amdgcn_readlane((int)v, 16) >> 2) + ((unsigned)__builtin_amdgcn_readlane((int)v, 32) >> 2) + ((unsigned)__builtin_amdgcn_readlane((int)v, 48) >> 2);
}
__device__ __forceinline__ unsigned ix_find_window(const unsigned (&o)[IX_NE], unsigned lo, unsigned hi, int cnt, int cmin, int cmax, bool& tie) {
    tie = false;
    int rank = (16 * ((cmin + cmax) / 2)) / cnt; rank = rank > 14 ? 14 : rank;
    unsigned x = ix_sample_pivot(o[0], rank);
    if (x <= lo || x >= hi) x = lo + ((hi - lo) >> 1);
    for (;;) { const int c = ix_count_ge(o, x);
        if (c > cmax) lo = x; else if (c < cmin) hi = x; else return x - 1u;
        if (hi - lo <= 1u) { tie = true; return lo; }
        x = lo + ((hi - lo) >> 1); }
}
__device__ __forceinline__ unsigned ix_compact(const IxBuf& B, int lane, int& cnt, unsigned T) {
    unsigned o[IX_NE]; ix_load_ord(B, cnt, lane, o);
    unsigned short kk[IX_NE];
#pragma unroll
    for (int k = 0; k < IX_NE; ++k) kk[k] = B.key[k * 64 + lane];
    LDS_WAIT();
    bool tie; unsigned th = 0x10000u;
    const unsigned x = ix_find_window(o, T, ix_max(o) + 1u, cnt, 256, 512, tie);
    if (tie) th = ix_tie_thr(o, kk, x, 512 - ix_count_ge(o, x + 1u));
    cnt = ix_rewrite(B, o, kk, lane, x, th); return x + 1u;
}
__device__ __forceinline__ unsigned ix_compact_to(const IxBuf& B, int lane, int& cnt, unsigned T) {
    unsigned o[IX_NE]; ix_load_ord(B, cnt, lane, o);
    unsigned short kk[IX_NE];
#pragma unroll
    for (int k = 0; k < IX_NE; ++k) kk[k] = B.key[k * 64 + lane];
    LDS_WAIT();
    bool tie; unsigned th = 0x10000u;
    const unsigned x = ix_find_window(o, T, ix_max(o) + 1u, cnt, 256, 320, tie);
    if (tie) th = ix_tie_thr(o, kk, x, 320 - ix_count_ge(o, x + 1u));
    cnt = ix_rewrite(B, o, kk, lane, x, th); return x + 1u;
}
__device__ __forceinline__ void ix_final(const IxBuf& B, LAS unsigned short* outl, int lane, int cnt, unsigned T, unsigned short* idx_row, int* nv_ptr, int dry) {
    if (cnt > 320) { cnt = cnt < IX_CAP ? cnt : IX_CAP; T = ix_compact_to(B, lane, cnt, T); }
    unsigned o[5]; unsigned short kk[5];
#pragma unroll
    for (int k = 0; k < 5; ++k) { const int idx = k * 64 + lane; o[k] = idx < cnt ? B.ord[idx] : 0u; kk[k] = B.key[idx]; }
    LDS_WAIT();
    unsigned x = 0u, th = 0u;
    if (cnt > 256) { unsigned mxv = 0u;
#pragma unroll
        for (int k = 0; k < 5; ++k) mxv = o[k] > mxv ? o[k] : mxv;
        mxv = ix_wavemax(mxv);
        unsigned lo = T, hi = mxv + 1u;
        for (;;) { if (hi - lo <= 1u) { x = lo; int ca = 0, need;
#pragma unroll
                for (int k = 0; k < 5; ++k) ca += (int)__builtin_popcountll(__ballot(o[k] >= lo + 1u));
                need = 256 - ca; unsigned tl = 0u, thh = 0x10000u;
                while (thh - tl > 1u) { const unsigned mid = (tl + thh) >> 1; int c = 0;
#pragma unroll
                    for (int k = 0; k < 5; ++k) c += (int)__builtin_popcountll(__ballot(o[k] == x && (unsigned)kk[k] >= mid));
                    if (c >= need) tl = mid; else thh = mid; }
                th = tl; break; }
            const unsigned mid = lo + ((hi - lo) >> 1); int c = 0;
#pragma unroll
            for (int k = 0; k < 5; ++k) c += (int)__builtin_popcountll(__ballot(o[k] >= mid));
            if (c == 256) { x = mid - 1u; th = 0x10000u; break; }
            if (c > 256) lo = mid; else hi = mid; } }
    int base = 0;
#pragma unroll
    for (int k = 0; k < 5; ++k) { const bool valid = k * 64 + lane < cnt; const bool sel = valid && (o[k] > x || (o[k] == x && (unsigned)kk[k] >= th));
        const u64 m = __ballot(sel); const int pos = base + (int)__builtin_amdgcn_mbcnt_hi((unsigned)(m >> 32), __builtin_amdgcn_mbcnt_lo((unsigned)m, 0u));
        if (sel && pos < 256) outl[pos] = (unsigned short)(0xFFFFu - (unsigned)kk[k]);
        base += (int)__builtin_popcountll(m); }
    LDS_WAIT();
    const int nsel = base < 256 ? base : 256;
    const u32x2 ow = *(const LAS u32x2*)(outl + lane * 4);
    if (!dry) { *(u32x2*)(idx_row + lane * 4) = ow; if (lane == 0) *nv_ptr = nsel; }
    LDS_WAIT();
}
__device__ __forceinline__ float ix_unordered(unsigned T) { const unsigned u = (T & 0x80000000u) ? (T ^ 0x80000000u) : ~T; return __builtin_bit_cast(float, u); }

__device__ __forceinline__ void indexer_unit(const Ctx& C, LAS unsigned char* lds, int unit) {
    int tid = threadIdx.x; asm volatile("" : "+v"(tid));
    const int lane = tid & 63, wv = __builtin_amdgcn_readfirstlane(tid >> 6);
    const int b = unit & 3, qt = 511 - (unit >> 2), t0 = qt * 16;
    const int q = lane & 15, c = lane >> 4;
    const size_t m0 = (size_t)b * SEQ + t0;
    const h16* QI = (const h16*)(C.ws + WS_QI); const h16* KI = (const h16*)(C.ws + WS_KI) + (size_t)b * SEQ * 64; const float* WI = (const float*)(C.ws + WS_WI);
    LAS unsigned* cntl = (LAS unsigned*)(lds + IX_CTR); volatile LAS float* taul = (volatile LAS float*)(lds + IX_CTR + 64);
    if (tid < 16) { cntl[tid] = 0u; taul[tid] = -3.402823466e38f; }
    const int nkeys = t0 + 16, nslab = (nkeys + IX_SK - 1) / IX_SK;
#define IX_LOADK(dst, s_) do { const int sc_ = (s_) < nslab - 1 ? (s_) : nslab - 1; _Pragma("unroll") for (int jt_ = 0; jt_ < 2; ++jt_) { int key0_ = sc_ * IX_SK + 32 * wv + 16 * jt_; key0_ = key0_ < nkeys ? key0_ : nkeys - 16; \
        const h16* p_ = KI + ((size_t)(key0_ >> 4) * 128 + lane) * 8;        \
        asm volatile("global_load_dwordx4 %0, %2, off\n\tglobal_load_dwordx4 %1, %2, off offset:1024" : "=&v"(dst[jt_][0]), "=&v"(dst[jt_][1]) : "v"(p_) : "memory"); } } while (0)
#define IX_WAITK(KF) asm volatile("s_waitcnt vmcnt(4)" : "+v"(KF[0][0]), "+v"(KF[0][1]), "+v"(KF[1][0]), "+v"(KF[1][1]) :: "memory")
    h8 ka[2][2], kb[2][2];
    IX_LOADK(ka, 0); IX_LOADK(kb, 1);
    h8 qf[8][2];
#pragma unroll
    for (int h = 0; h < 8; ++h)
#pragma unroll
        for (int ks = 0; ks < 2; ++ks) qf[h][ks] = *(const h8*)(QI + ((((m0 >> 4) * 8 + h) * 2 + ks) * 64 + lane) * 8);
    float wvv[8]; { const f32x4 w0 = *(const f32x4*)(WI + (m0 + q) * 8), w1 = *(const f32x4*)(WI + (m0 + q) * 8 + 4); for (int e = 0; e < 4; ++e) { wvv[e] = w0[e]; wvv[4 + e] = w1[e]; } }
#pragma unroll
    for (int h = 0; h < 8; ++h) wvv[h] *= 0.5f;
    h8 qs[2];
#pragma unroll
    for (int ks = 0; ks < 2; ++ks)
#pragma unroll
        for (int j = 0; j < 8; ++j) { float a = 0.f;
#pragma unroll
            for (int h = 0; h < 8; ++h) a += wvv[h] * (float)qf[h][ks][j];
            qs[ks][j] = (h16)a; }
    LAS unsigned* ordq = (LAS unsigned*)(lds + IX_ORD) + (size_t)q * IX_CAP; LAS unsigned short* keyq = (LAS unsigned short*)(lds + IX_KEY) + (size_t)q * IX_CAP;
    IxBuf BA, BB;
    BA.ord = (LAS unsigned*)(lds + IX_ORD) + (size_t)(2 * wv) * IX_CAP; BA.key = (LAS unsigned short*)(lds + IX_KEY) + (size_t)(2 * wv) * IX_CAP;
    BB.ord = BA.ord + IX_CAP; BB.key = BA.key + IX_CAP;
    LAS unsigned short* outl = (LAS unsigned short*)(lds + IX_HIST) + wv * 256;
    unsigned TA = 0x00800000u, TB = 0x00800000u; float tq = -3.402823466e38f;
    __syncthreads();
#define IX_MM2(KF, A_, B_, Q0, Q1) do { A_ = __builtin_amdgcn_mfma_f32_16x16x32_f16(KF[0][0], Q0, (f32x4){0.f, 0.f, 0.f, 0.f}, 0, 0, 0); B_ = __builtin_amdgcn_mfma_f32_16x16x32_f16(KF[1][0], Q0, (f32x4){0.f, 0.f, 0.f, 0.f}, 0, 0, 0); \
        A_ = __builtin_amdgcn_mfma_f32_16x16x32_f16(KF[0][1], Q1, A_, 0, 0, 0); B_ = __builtin_amdgcn_mfma_f32_16x16x32_f16(KF[1][1], Q1, B_, 0, 0, 0); } while (0)
#define IX_SCORE2(KF, sca, scb) do { \
        f32x4 ta_[2], tb_[2]; \
        IX_MM2(KF, sca, scb, qs[0], qs[1]); IX_MM2(KF, ta_[0], tb_[0], qf[0][0], qf[0][1]); \
        _Pragma("unroll") for (int h = 0; h < 8; ++h) {        \
            __builtin_amdgcn_sched_barrier(0); \
            if (h < 7) IX_MM2(KF, ta_[(h + 1) & 1], tb_[(h + 1) & 1], qf[h + 1][0], qf[h + 1][1]); \
            __builtin_amdgcn_sched_barrier(0); \
            _Pragma("unroll") for (int i = 0; i < 4; ++i) { sca[i] = __builtin_fmaf(wvv[h], __builtin_fabsf(ta_[h & 1][i]), sca[i]); asm("" : "+v"(sca[i])); }   \
            _Pragma("unroll") for (int i = 0; i < 4; ++i) { scb[i] = __builtin_fmaf(wvv[h], __builtin_fabsf(tb_[h & 1][i]), scb[i]); asm("" : "+v"(scb[i])); } } \
        __builtin_amdgcn_sched_barrier(0); } while (0)
#define IX_SCORE(KF, sc, jt, key0) do { \
        sc = __builtin_amdgcn_mfma_f32_16x16x32_f16(KF[jt][0], qs[0], (f32x4){0.f, 0.f, 0.f, 0.f}, 0, 0, 0); sc = __builtin_amdgcn_mfma_f32_16x16x32_f16(KF[jt][1], qs[1], sc, 0, 0, 0); \
        _Pragma("unroll") for (int h = 0; h < 8; ++h) { f32x4 a = {0.f, 0.f, 0.f, 0.f}; \
            a = __builtin_amdgcn_mfma_f32_16x16x32_f16(KF[jt][0], qf[h][0], a, 0, 0, 0); a = __builtin_amdgcn_mfma_f32_16x16x32_f16(KF[jt][1], qf[h][1], a, 0, 0, 0); \
            _Pragma("unroll") for (int i = 0; i < 4; ++i) { sc[i] = __builtin_fmaf(wvv[h], __builtin_fabsf(a[i]), sc[i]); asm("" : "+v"(sc[i])); } } } while (0)
#define IX_MASK(sc, key0) do { if ((key0) + 15 > t0) {        \
            _Pragma("unroll") for (int i = 0; i < 4; ++i) if ((key0) + 4 * c + i > t0 + q) sc[i] = -INFINITY; } } while (0)
#define IX_ASK(sc, ps, pos) do { _Pragma("unroll") for (int i = 0; i < 4; ++i) { ps[i] = sc[i] >= tq; pos[i] = 0u; if (ps[i]) pos[i] = __hip_atomic_fetch_add(cntl + q, 1u, __ATOMIC_RELAXED, __HIP_MEMORY_SCOPE_WORKGROUP); } } while (0)
#define IX_PUT(sc, ps, pos, key0) do { _Pragma("unroll") for (int i = 0; i < 4; ++i) if (ps[i]) { ordq[pos[i]] = ordered_u32(sc[i] + 0.0f); keyq[pos[i]] = (unsigned short)(0xFFFFu - (unsigned)((key0) + 4 * c + i)); } } while (0)
#define IX_STEP(sv, KF) do { const int s_ = (sv); if (s_ < nslab) { \
        IX_WAITK(KF); \
        const int key0a = s_ * IX_SK + (2 * wv) * 16, key0b = key0a + 16; \
        const bool hb = key0b < nkeys;                                 \
        if (key0a < nkeys) { \
            f32x4 sca, scb; bool psa[4], psb[4]; unsigned posa[4], posb[4]; \
            if (hb) { IX_SCORE2(KF, sca, scb); IX_MASK(sca, key0a); IX_MASK(scb, key0b); \
                if (!IX_PROBE_NOFILT) { IX_ASK(sca, psa, posa); IX_ASK(scb, psb, posb); IX_PUT(sca, psa, posa, key0a); IX_PUT(scb, psb, posb, key0b); } } \
            else { IX_SCORE(KF, sca, 0, key0a); IX_MASK(sca, key0a); if (!IX_PROBE_NOFILT) { IX_ASK(sca, psa, posa); IX_PUT(sca, psa, posa, key0a); } } \
        } \
        IX_LOADK(KF, s_ + 2);                                         \
        LDS_WAIT(); \
        __syncthreads(); \
        const unsigned mycnt = cntl[q];                               \
        if (__ballot(mycnt > (unsigned)(IX_CAP - IX_SK)) != 0ull) {       \
            int ca = (int)cntl[2 * wv], cb = (int)cntl[2 * wv + 1]; ca = ca < IX_CAP ? ca : IX_CAP; cb = cb < IX_CAP ? cb : IX_CAP; \
            if (ca > 512) { TA = ix_compact(BA, lane, ca, TA); if (lane == 0) { cntl[2 * wv] = (unsigned)ca; taul[2 * wv] = ix_unordered(TA); } } \
            if (cb > 512) { TB = ix_compact(BB, lane, cb, TB); if (lane == 0) { cntl[2 * wv + 1] = (unsigned)cb; taul[2 * wv + 1] = ix_unordered(TB); } } \
            LDS_WAIT(); \
            __syncthreads(); \
            tq = taul[q]; } \
        } } while (0)
    for (int s = 0; s < nslab; s += 2) { IX_STEP(s, ka); IX_STEP(s + 1, kb); }
    asm volatile("s_waitcnt vmcnt(0)" : "+v"(ka[0][0]), "+v"(ka[0][1]), "+v"(ka[1][0]), "+v"(ka[1][1]), "+v"(kb[0][0]), "+v"(kb[0][1]), "+v"(kb[1][0]), "+v"(kb[1][1]) :: "memory");
#undef IX_STEP
#undef IX_SCORE
#undef IX_SCORE2
#undef IX_MM2
#undef IX_MASK
#undef IX_ASK
#undef IX_PUT
#undef IX_LOADK
#undef IX_WAITK
    LDS_WAIT();
    if (IX_PROBE_FINAL) return;
    unsigned short* IDX = (unsigned short*)(C.ws + WS_IDX); int* NV = (int*)(C.ws + WS_NV);
    int ca = (int)cntl[2 * wv], cb = (int)cntl[2 * wv + 1]; ca = ca < IX_CAP ? ca : IX_CAP; cb = cb < IX_CAP ? cb : IX_CAP;
    ix_final(BA, outl, lane, ca, TA, IDX + (m0 + 2 * wv) * 256, NV + m0 + 2 * wv, C.dry);
    ix_final(BB, outl, lane, cb, TB, IDX + (m0 + 2 * wv + 1) * 256, NV + m0 + 2 * wv + 1, C.dry);
}


constexpr int AT_CH = 4096;
constexpr int AT_NR = 4;
constexpr int AT_WAVE = AT_NR * AT_CH + 1024;
constexpr int AT_TAB = 8 * AT_WAVE;
constexpr int AT_QN = AT_TAB + 129 * 8 * 4;
constexpr int AT_END = AT_QN + 512;
static_assert(AT_END + 1024 <= MISC_OFF && (AT_WAVE % 16) == 0 && (AT_QN % 16) == 0, "attention LDS");
constexpr int AT_QPW = 8;
__device__ __forceinline__ int at_f(int row) { return 2 * ((row >> 1) & 3) | ((row >> 3) & 1); }

__device__ __forceinline__ void attn_build_tab(const Ctx& C, LAS unsigned char* lds) {
    LAS float* tab = (LAS float*)(lds + AT_TAB);
    for (int e = threadIdx.x; e < 129 * 8; e += NTHR) { const int d = e >> 3, h = e & 7; int bk;
        if (d < 16) bk = d; else { bk = 16 + (int)(logf((float)d / 16.0f) / 2.0794415416798357f * 16.0f); if (bk > 31) bk = 31; }
        tab[e] = C.relb[bk * 8 + h]; }
    if (threadIdx.x < 128) ((LAS float*)(lds + AT_QN))[threadIdx.x] = C.qn[threadIdx.x];
}
__device__ __forceinline__ void at_issue(const unsigned char* base, const LAS unsigned short* idl, int pos0, LAS unsigned char* buf, int lane) {
#pragma unroll
    for (int k2 = 0; k2 < 4; ++k2) { const int row = (lane >> 3) + 8 * k2, slot = lane & 7; const int idx = idl[pos0 + row];
        __builtin_amdgcn_global_load_lds((const unsigned*)(base + (size_t)idx * 256 + ((slot ^ at_f(row)) << 4)), (LAS unsigned*)(buf + k2 * 1024), 16, 0, 0); }
}
__device__ __forceinline__ unsigned pk4_fp8(float a, float b, float c, float d) { int w = 0; w = __builtin_amdgcn_cvt_pk_fp8_f32(a, b, w, false); w = __builtin_amdgcn_cvt_pk_fp8_f32(c, d, w, true); return (unsigned)w; }
__device__ __forceinline__ long mk64(unsigned lo, unsigned hi) { return (long)(((u64)hi << 32) | (u64)lo); }
#define AT_WAITN(n) asm volatile("s_waitcnt vmcnt(" #n ")" ::: "memory")

__device__ __forceinline__ void attn_item(const Ctx& C, LAS unsigned char* lds, int item) {
    int tid = threadIdx.x; asm volatile("" : "+v"(tid));
    const int lane = tid & 63, wv = __builtin_amdgcn_readfirstlane(tid >> 6);
    const int g = lane & 15, c = lane >> 4, gq = g & 3;
    const int qsel = item / (SEQ / (8 * AT_QPW)), b = qsel >> 1, n = qsel & 1, tbase = (item % (SEQ / (8 * AT_QPW))) * (8 * AT_QPW) + wv;
    LAS unsigned char* ring = lds + wv * AT_WAVE;
    LAS unsigned short* idlb = (LAS unsigned short*)(ring + AT_NR * AT_CH);
    const LAS float* tab = (const LAS float*)(lds + AT_TAB);
    const LAS float* qnl = (const LAS float*)(lds + AT_QN);
    const unsigned char* Kb = (const unsigned char*)(C.ws + WS_K8) + (size_t)b * SEQ * 256 + n * 128; const unsigned char* Vb = (const unsigned char*)(C.ws + WS_V8) + (size_t)b * SEQ * 256 + n * 128;
    const unsigned short* IDXb = (const unsigned short*)(C.ws + WS_IDX) + (size_t)b * SEQ * 256; const int* NVb = (const int*)(C.ws + WS_NV) + (size_t)b * SEQ;
    h16* Qb = (h16*)(C.ws + WS_Q) + (size_t)b * SEQ * DM + n * 512;
    const int fg = at_f(g), q4 = g >> 2, p4 = g & 3, rowA = 4 * c + q4, fr = at_f(rowA);
    u32x2 a_idx; int a_nv; h8 a_q[4];
#define AT_STAGE_A(tq) do { const size_t m_ = (size_t)(tq); a_idx = *(const u32x2*)(IDXb + m_ * 256 + lane * 4); a_nv = NVb[m_]; \
        _Pragma("unroll") for (int ks = 0; ks < 4; ++ks) a_q[ks] = *(const h8*)(Qb + m_ * DM + gq * 128 + 32 * c + 8 * ks); } while (0)
#define AT_STAGE_B(idl_, qf_, nv_) do { nv_ = a_nv; { const int p0 = lane * 4; unsigned s0 = a_idx.x & 0xFFFFu, s1 = a_idx.x >> 16, s2 = a_idx.y & 0xFFFFu, s3 = a_idx.y >> 16; \
          if (p0 + 0 >= nv_) s0 = 0; if (p0 + 1 >= nv_) s1 = 0; if (p0 + 2 >= nv_) s2 = 0; if (p0 + 3 >= nv_) s3 = 0; \
          u32x2 o_; o_.x = s0 | (s1 << 16); o_.y = s2 | (s3 << 16); *(LAS u32x2*)((idl_) + lane * 4) = o_; } \
        float ss_ = 0.f; _Pragma("unroll") for (int ks = 0; ks < 4; ++ks) _Pragma("unroll") for (int e = 0; e < 8; ++e) { const float x_ = (float)a_q[ks][e]; ss_ += x_ * x_; } \
        ss_ += __shfl_xor(ss_, 16); ss_ += __shfl_xor(ss_, 32); \
        const float rs_ = g < 4 ? __builtin_amdgcn_rsqf(ss_ * (1.0f / 128.0f) + EPS) : 0.f; \
        _Pragma("unroll") for (int ks = 0; ks < 4; ++ks) { const f32x4 g0 = *(const LAS f32x4*)(qnl + 32 * c + 8 * ks), g1 = *(const LAS f32x4*)(qnl + 32 * c + 8 * ks + 4); \
            qf_[ks] = mk64(pk4_fp8((float)a_q[ks][0] * rs_ * g0[0], (float)a_q[ks][1] * rs_ * g0[1], (float)a_q[ks][2] * rs_ * g0[2], (float)a_q[ks][3] * rs_ * g0[3]), \
                           pk4_fp8((float)a_q[ks][4] * rs_ * g1[0], (float)a_q[ks][5] * rs_ * g1[1], (float)a_q[ks][6] * rs_ * g1[2], (float)a_q[ks][7] * rs_ * g1[3])); } \
        LDS_WAIT(); } while (0)
    long qf[4]; int nv;
    AT_STAGE_A(tbase);
    AT_STAGE_B(idlb, qf, nv);
    AT_WAITN(0);
#pragma unroll
    for (int i = 0; i < AT_NR; ++i) at_issue(Kb, idlb, 32 * i, ring + i * AT_CH, lane);
#pragma unroll 1
    for (int k = 0; k < AT_QPW; ++k) {
        const int t = tbase + 8 * k, tn = k + 1 < AT_QPW ? t + 8 : t;
        const LAS unsigned short* idl = idlb + (k & 1) * 256; LAS unsigned short* idln = idlb + ((k + 1) & 1) * 256;
        float S[16][4];
#pragma unroll
        for (int kc = 0; kc < 8; ++kc) {
            LAS unsigned char* buf = ring + (kc & 3) * AT_CH;
            if (kc <= 4) AT_WAITN(12); else AT_WAITN(18);
#pragma unroll
            for (int j = 0; j < 2; ++j) { f32x4 a = {0.f, 0.f, 0.f, 0.f};
                const u32x4 A0 = *(const LAS u32x4*)(buf + (16 * j + g) * 128 + (((2 * c) ^ fg) << 4)), A1 = *(const LAS u32x4*)(buf + (16 * j + g) * 128 + (((2 * c + 1) ^ fg) << 4));
                a = __builtin_amdgcn_mfma_f32_16x16x32_fp8_fp8(mk64(A0.x, A0.y), qf[0], a, 0, 0, 0); a = __builtin_amdgcn_mfma_f32_16x16x32_fp8_fp8(mk64(A0.z, A0.w), qf[1], a, 0, 0, 0);
                a = __builtin_amdgcn_mfma_f32_16x16x32_fp8_fp8(mk64(A1.x, A1.y), qf[2], a, 0, 0, 0); a = __builtin_amdgcn_mfma_f32_16x16x32_fp8_fp8(mk64(A1.z, A1.w), qf[3], a, 0, 0, 0);
#pragma unroll
                for (int i = 0; i < 4; ++i) S[2 * kc + j][i] = a[i]; }
            LDS_WAIT();
            if (kc < 4) at_issue(Kb, idl, 32 * (kc + 4), buf, lane); else at_issue(Vb, idl, 32 * (kc - 4), buf, lane);
            if (kc == 4) AT_STAGE_A(tn);
        }
        const int rq = g >> 2;
        float V[4][4];
#pragma unroll
        for (int kk = 0; kk < 4; ++kk)
#pragma unroll
            for (int i = 0; i < 4; ++i) { int v = __builtin_bit_cast(int, S[kk][i]);
                v = __builtin_amdgcn_update_dpp(v, __builtin_bit_cast(int, S[4 + kk][i]), 0x114, 0xf, 0x2, false);
                v = __builtin_amdgcn_update_dpp(v, __builtin_bit_cast(int, S[8 + kk][i]), 0x118, 0xf, 0x4, false);
                v = __builtin_amdgcn_update_dpp(v, __builtin_bit_cast(int, S[12 + kk][i]), 0x11c, 0xf, 0x8, false);
                V[kk][i] = __builtin_bit_cast(float, v); }
        float mx = -INFINITY; const int nvc = nv - 4 * c - 64 * rq;
#pragma unroll
        for (int kk = 0; kk < 4; ++kk) { const u32x2 iw = *(const LAS u32x2*)(idl + 64 * rq + 16 * kk + 4 * c);
            const int ki[4] = {(int)(iw.x & 0xFFFFu), (int)(iw.x >> 16), (int)(iw.y & 0xFFFFu), (int)(iw.y >> 16)};
#pragma unroll
            for (int i = 0; i < 4; ++i) { int dist = t - ki[i]; dist = dist < 0 ? 0 : (dist > 128 ? 128 : dist);
                const float sv = V[kk][i] * 0.08838834764831845f + tab[dist * 8 + 4 * n + gq];
                const float s = (16 * kk + i) < nvc ? sv : -INFINITY; V[kk][i] = s; mx = fmaxf(mx, s); } }
        mx = fmaxf(mx, __builtin_bit_cast(float, __builtin_amdgcn_update_dpp(0, __builtin_bit_cast(int, mx), 0x124, 0xf, 0xf, false)));
        mx = fmaxf(mx, __builtin_bit_cast(float, __builtin_amdgcn_update_dpp(0, __builtin_bit_cast(int, mx), 0x128, 0xf, 0xf, false)));
        mx = fmaxf(mx, __shfl_xor(mx, 16)); mx = fmaxf(mx, __shfl_xor(mx, 32));
        float sum = 0.f; unsigned Pq[4];
#pragma unroll
        for (int kk = 0; kk < 4; ++kk) { float p[4];
#pragma unroll
            for (int i = 0; i < 4; ++i) { p[i] = __builtin_amdgcn_exp2f((V[kk][i] - mx) * 1.4426950408889634f); sum += p[i]; }
            Pq[kk] = pk4_fp8(p[0] * 256.0f, p[1] * 256.0f, p[2] * 256.0f, p[3] * 256.0f); }
        sum += __builtin_bit_cast(float, __builtin_amdgcn_update_dpp(0, __builtin_bit_cast(int, sum), 0x124, 0xf, 0xf, false));
        sum += __builtin_bit_cast(float, __builtin_amdgcn_update_dpp(0, __builtin_bit_cast(int, sum), 0x128, 0xf, 0xf, false));
        sum += __shfl_xor(sum, 16); sum += __shfl_xor(sum, 32);
        unsigned P8[16];
#pragma unroll
        for (int kk = 0; kk < 4; ++kk) { P8[kk] = Pq[kk];
            P8[4 + kk] = (unsigned)__builtin_amdgcn_update_dpp(0, (int)Pq[kk], 0x104, 0xf, 0xf, true);
            P8[8 + kk] = (unsigned)__builtin_amdgcn_update_dpp(0, (int)Pq[kk], 0x108, 0xf, 0xf, true);
            P8[12 + kk] = (unsigned)__builtin_amdgcn_update_dpp(0, (int)Pq[kk], 0x10c, 0xf, 0xf, true); }
        long qfn[4]; int nvn;
        AT_STAGE_B(idln, qfn, nvn);
        f32x4 oe[4], oo[4];
#pragma unroll
        for (int dt = 0; dt < 4; ++dt) { oe[dt] = (f32x4){0.f, 0.f, 0.f, 0.f}; oo[dt] = (f32x4){0.f, 0.f, 0.f, 0.f}; }
#pragma unroll
        for (int vc = 0; vc < 8; ++vc) {
            LAS unsigned char* buf = ring + (vc & 3) * AT_CH;
            if (vc == 0) AT_WAITN(18); else AT_WAITN(12);
            const long pf = mk64(P8[2 * vc], P8[2 * vc + 1]);
            u32x2 t0[4], t1[4];
            const unsigned ba = (unsigned)(size_t)buf;
#pragma unroll
            for (int dt = 0; dt < 4; ++dt) { const unsigned ad = ba + (unsigned)(rowA * 128 + (((2 * dt + (p4 >> 1)) ^ fr) << 4) + 8 * (p4 & 1));
                asm volatile("ds_read_b64_tr_b16 %0, %1" : "=&v"(t0[dt]) : "v"(ad) : "memory");
                asm volatile("ds_read_b64_tr_b16 %0, %1 offset:2048" : "=&v"(t1[dt]) : "v"(ad) : "memory"); }
            asm volatile("s_waitcnt lgkmcnt(0)" : "+v"(t0[0]), "+v"(t0[1]), "+v"(t0[2]), "+v"(t0[3]), "+v"(t1[0]), "+v"(t1[1]), "+v"(t1[2]), "+v"(t1[3]) :: "memory");
#pragma unroll
            for (int dt = 0; dt < 4; ++dt) {
                const long be = mk64(__builtin_amdgcn_perm(t0[dt].y, t0[dt].x, 0x06040200u), __builtin_amdgcn_perm(t1[dt].y, t1[dt].x, 0x06040200u));
                const long bo = mk64(__builtin_amdgcn_perm(t0[dt].y, t0[dt].x, 0x07050301u), __builtin_amdgcn_perm(t1[dt].y, t1[dt].x, 0x07050301u));
                oe[dt] = __builtin_amdgcn_mfma_f32_16x16x32_fp8_fp8(pf, be, oe[dt], 0, 0, 0); oo[dt] = __builtin_amdgcn_mfma_f32_16x16x32_fp8_fp8(pf, bo, oo[dt], 0, 0, 0); }
            if (vc < 4) at_issue(Vb, idl, 32 * (vc + 4), buf, lane); else at_issue(Kb, idln, 32 * (vc - 4), buf, lane);
        }
        float inv[4];
#pragma unroll
        for (int i = 0; i < 4; ++i) inv[i] = 1.0f / (256.0f * __shfl(sum, i));
        h16* Qo = Qb + (size_t)t * DM;
        LAS unsigned char* st = (LAS unsigned char*)(idlb + (k & 1) * 256);
#pragma unroll
        for (int hp = 0; hp < 2; ++hp) {
            if (c == 0) {
#pragma unroll
                for (int dt = 0; dt < 4; ++dt)
#pragma unroll
                    for (int i2 = 0; i2 < 2; ++i2) *(LAS unsigned*)(st + (i2 * 128 + 32 * dt + 2 * g) * 2) = pkh(oe[dt][2 * hp + i2] * inv[2 * hp + i2], oo[dt][2 * hp + i2] * inv[2 * hp + i2]);
            }
            LDS_WAIT();
            if (lane < 32) { const u32x4 ow = *(const LAS u32x4*)(st + lane * 16); if (!C.dry) *(u32x4*)(Qo + hp * 256 + lane * 8) = ow; }
            LDS_WAIT();
        }
#pragma unroll
        for (int ks = 0; ks < 4; ++ks) qf[ks] = qfn[ks];
        nv = nvn;
    }
    AT_WAITN(0);
#undef AT_STAGE_A
#undef AT_STAGE_B
}

__device__ __forceinline__ void act_phase(const Ctx& C, int gtid, int gthreads) {
    const h16* G = (const h16*)(C.ws + WS_UPG); h16* V = (h16*)(C.ws + WS_UPV);
    constexpr int NCG = DFF / 8, NITEM = (MTOK / 16) * NCG;
    for (int it = gtid; it < NITEM; it += gthreads) {
        const int cg = it % NCG, rb = it / NCG, c0 = cg * 8, r0 = rb * 16;
        float w[3][8], bb[8];
#pragma unroll
        for (int j = 0; j < 3; ++j) { const f32x4 a = *(const f32x4*)(C.fcw + j * DFF + c0), b2 = *(const f32x4*)(C.fcw + j * DFF + c0 + 4); for (int e = 0; e < 4; ++e) { w[j][e] = a[e]; w[j][4 + e] = b2[e]; } }
        { const f32x4 a = *(const f32x4*)(C.fcb + c0), b2 = *(const f32x4*)(C.fcb + c0 + 4); for (int e = 0; e < 4; ++e) { bb[e] = a[e]; bb[4 + e] = b2[e]; } }
        h8 gm2, gm1;
        const int tseq = r0 & (SEQ - 1);
        if (tseq >= 2) { gm2 = *(const h8*)(G + (size_t)(r0 - 2) * DFF + c0); gm1 = *(const h8*)(G + (size_t)(r0 - 1) * DFF + c0); }
        else { for (int e = 0; e < 8; ++e) { gm2[e] = (h16)0.f; gm1[e] = (h16)0.f; } }
#pragma unroll 4
        for (int r = 0; r < 16; ++r) { const size_t off = (size_t)(r0 + r) * DFF + c0;
            const h8 g0 = *(const h8*)(G + off), vv = *(const h8*)(V + off);
            float y[8];
#pragma unroll
            for (int e = 0; e < 8; ++e) { const float gf = bb[e] + w[0][e] * (float)gm2[e] + w[1][e] * (float)gm1[e] + w[2][e] * (float)g0[e]; y[e] = gelu_tanh(gf) * (float)vv[e]; }
            u32x4 o; o.x = pkh(y[0], y[1]); o.y = pkh(y[2], y[3]); o.z = pkh(y[4], y[5]); o.w = pkh(y[6], y[7]);
            if (!C.dry) *(u32x4*)(V + off) = o; gm2 = gm1; gm1 = g0; }
    }
}

__device__ __forceinline__ void p0_prologue(const Params& P, LAS unsigned char* lds) {
    const int tid = threadIdx.x, lane = tid & 63, wv = tid >> 6;
    LAS float* scr = (LAS float*)(lds + wv * 16384);
    const int gw = blockIdx.x * NWAVES + wv, NGW = gridDim.x * NWAVES;
    unsigned char* ws = P.ws;
    const float* w_in = P.in[3];
    constexpr int I_IN = 16 * 195;
    for (int it = gw; it < I_IN + 16 * 8; it += NGW) {
        if (it < I_IN) { p0_transpose_item<1>(w_in, DM, NIN, (h16*)(ws + W_IN), nullptr, scr, it, lane); continue; }
        const int r = it - I_IN, blk = r / 16, rr = r % 16, which = rr / 8, it2 = rr % 8;
        p0_transpose_item<0>((which ? P.in[8] : P.in[6]) + (size_t)blk * 128 * 128, 128, 128, (h16*)(ws + W_GATE) + (size_t)blk * 256 * 128 + (size_t)which * 128 * 128, nullptr, scr, it2, lane); }
    { u32x4* z = (u32x4*)((h16*)(ws + W_IN) + (size_t)4168 * DM); const int nz = 184 * DM * 2 / 16;
      for (int i = blockIdx.x * NTHR + tid; i < nz; i += gridDim.x * NTHR) z[i] = (u32x4){0u, 0u, 0u, 0u}; }
    { const float* x = P.in[0]; const float* gn = P.in[2]; h16* A0 = (h16*)(ws + WS_A0);
      f32x4 gv[4];
#pragma unroll
      for (int j = 0; j < 4; ++j) gv[j] = *(const f32x4*)(gn + 4 * lane + 256 * j);
      f32x4 nv[4];
      if (gw < MTOK) { const f32x4* xr = (const f32x4*)(x + (size_t)gw * DM) + lane;
#pragma unroll
          for (int j = 0; j < 4; ++j) nv[j] = xr[64 * j]; }
      for (int m = gw; m < MTOK; m += NGW) { f32x4 v[4]; float s = 0.f;
#pragma unroll
          for (int j = 0; j < 4; ++j) v[j] = nv[j];
          { const int mn = m + NGW < MTOK ? m + NGW : m; const f32x4* xr = (const f32x4*)(x + (size_t)mn * DM) + lane;
#pragma unroll
            for (int j = 0; j < 4; ++j) nv[j] = xr[64 * j]; }
#pragma unroll
          for (int j = 0; j < 4; ++j) s += (v[j].x * v[j].x + v[j].y * v[j].y) + (v[j].z * v[j].z + v[j].w * v[j].w);
          const float rs = __builtin_amdgcn_rsqf(wave_sum(s) * (1.0f / DM) + EPS);
          u32x2* o8 = (u32x2*)(A0 + (size_t)m * DM) + lane;
#pragma unroll
          for (int j = 0; j < 4; ++j) { u32x2 w; w.x = pkh(v[j].x * rs * gv[j].x, v[j].y * rs * gv[j].y); w.y = pkh(v[j].z * rs * gv[j].z, v[j].w * rs * gv[j].w); o8[64 * j] = w; } } }
}
constexpr int PD_SQ = 16 * 32, PD_UP = 16 * 192, PD_DN = 48 * 32, PD_PP = 4 * 32, PD_NTR = 4 * PD_SQ + PD_UP + PD_DN + PD_PP, PD_NT = PD_NTR / 32, PD_NP = MTOK * PLE / 4 / 8192;
static_assert(PD_NTR % 32 == 0, "deferred transposes");
__device__ __forceinline__ void p0_deferred_item(const Params& P, LAS unsigned char* lds, int item) {
    int tid = threadIdx.x; asm volatile("" : "+v"(tid));
    const int lane = tid & 63, wv = tid >> 6;
    unsigned char* ws = P.ws;
    if (item >= PD_NT) { const f32x4* p4 = (const f32x4*)P.in[1] + (size_t)(item - PD_NT) * 8192; u32x2* o = (u32x2*)(ws + WS_PH) + (size_t)(item - PD_NT) * 8192;
#pragma unroll 4
        for (int i = tid; i < 8192; i += NTHR) { const f32x4 v = p4[i]; u32x2 w; w.x = pkh(v.x, v.y); w.y = pkh(v.z, v.w); o[i] = w; }
        return; }
    LAS float* scr = (LAS float*)(lds + wv * 16384);
    const float *w_lru = P.in[14], *w_att = P.in[15], *w_out = P.in[16], *w_up = P.in[18], *w_down = P.in[21], *w_pg = P.in[23], *w_pp = P.in[24];
    for (int k = 0; k < 4; ++k) {
        int r = item * 32 + wv * 4 + k;
        if (r < PD_SQ) { p0_transpose_item<0>(w_lru, DM, DM, (h16*)(ws + W_LRU), nullptr, scr, r, lane); continue; } r -= PD_SQ;
        if (r < PD_SQ) { p0_transpose_item<0>(w_att, DM, DM, (h16*)(ws + W_ATT), nullptr, scr, r, lane); continue; } r -= PD_SQ;
        if (r < PD_SQ) { p0_transpose_item<0>(w_out, DM, DM, (h16*)(ws + W_OUT), nullptr, scr, r, lane); continue; } r -= PD_SQ;
        if (r < PD_SQ) { p0_transpose_item<0>(w_pg, DM, DM, (h16*)(ws + W_PG), P.in[22], scr, r, lane); continue; } r -= PD_SQ;
        if (r < PD_UP) { p0_transpose_item<2>(w_up, DM, 2 * DFF, (h16*)(ws + W_UP), P.in[17], scr, r, lane); continue; } r -= PD_UP;
        if (r < PD_DN) { p0_transpose_item<0>(w_down, DFF, DM, (h16*)(ws + W_DOWN), nullptr, scr, r, lane); continue; } r -= PD_DN;
        p0_transpose_item<0>(w_pp, PLE, DM, (h16*)(ws + W_PP), nullptr, scr, r, lane);
    }
}

__device__ __forceinline__ int next_unit(unsigned* head, volatile LAS unsigned* slot) {
    __syncthreads();
    if (threadIdx.x == 0) *slot = __hip_atomic_fetch_add(head, 1u, __ATOMIC_RELAXED, __HIP_MEMORY_SCOPE_AGENT);
    __syncthreads();
    return (int)*slot;
}

constexpr int NPHASE = 10;
__global__ void __launch_bounds__(NTHR, 2) fwd(Params P) {
    extern __shared__ __attribute__((aligned(16))) unsigned char lds_raw[];
    LAS unsigned char* lds = (LAS unsigned char*)lds_raw;
    volatile LAS unsigned* MISC = (volatile LAS unsigned*)(lds + MISC_OFF);
    const int tid = threadIdx.x;
    if (tid < 64) MISC[tid] = 0u;
    __syncthreads();
    unsigned char* ws = P.ws;
    unsigned* ctl = (unsigned*)(ws + WS_CTL);
    const int lo = P.ph_lo, hi = P.ph_hi;
    XcdBarrier bar; bar.bar = ctl + CW_BAR; bar.x = 0; bar.st = MISC;
    if (hi - lo > 1) bar = xcd_barrier_post(ctl + CW_BAR, MISC);
    const int dry = P.pad;
    Ctx C; C.ws = ws; C.out = P.out; C.dry = dry; C.conv_w = P.in[4]; C.conv_b = P.in[5]; C.ba = P.in[7]; C.bx = P.in[9]; C.lam = P.in[10]; C.qn = P.in[11]; C.kn = P.in[12]; C.relb = P.in[13]; C.fcw = P.in[19]; C.fcb = P.in[20];
    float* SSQ1 = (float*)(ws + CTL_SSQ1); float* SSQ2 = (float*)(ws + CTL_SSQ2);
#ifdef ONLY_PHASE
#define IN(k) ((k) == ONLY_PHASE)
#else
#define IN(k) (lo <= (k) && (k) < hi)
#endif
#define SEAM(k) do { if (IN(k) && IN((k) + 1)) xcd_barrier(bar); } while (0)

    if (IN(0)) { p0_prologue(P, lds); } SEAM(0);

    if (IN(1)) {
        pg8::Gemm g{(const h16*)(ws + WS_A0), (const h16*)(ws + W_IN), MTOK, NIN_PAD, DM}; pg8::StaticOrder S; S.init(MTOK, NIN_PAD, gridDim.x, blockIdx.x);
        EpiIn E{(h16*)(ws + WS_LX), (h16*)(ws + WS_GG), (h16*)(ws + WS_Q), (h16*)(ws + WS_K), (h16*)(ws + WS_V), (h16*)(ws + WS_QI), (h16*)(ws + WS_KI), (h16*)(ws + WS_SGA), (h16*)(ws + WS_SGB), (float*)(ws + WS_WI), dry};
        pg8::gemm_phase<EpiIn>(lds, g, S, E);
    } SEAM(1);

    if (IN(2)) {
        constexpr int N_IX = NB * (SEQ / 16), N_L1 = NB * 64 * 8 / 4, N_KN = MTOK / 128 / 4, N_PD = PD_NT + PD_NP, N_SM = N_KN + N_PD, N_BIG = N_L1 + N_IX, N_ALL = N_BIG + N_SM;
        static_assert(N_BIG >= 4 * N_SM, "interleave");
        unsigned* head = ctl + CW_Q2 + 128 * dry;
        int u = next_unit(head, MISC + 4);
        for (int it = 0; u < N_ALL; ++it) {
            unsigned nxt = 0u;
            if (tid == 0) nxt = __hip_atomic_fetch_add(head, 1u, __ATOMIC_RELAXED, __HIP_MEMORY_SCOPE_AGENT);
            int kind, idx;
            { int big = -1, sm = -1;
              if (u < 5 * N_SM) { if (u % 5 == 4) sm = u / 5; else big = 4 * (u / 5) + u % 5; } else big = u - N_SM;
              if (big >= 0) { if (big < N_L1) { kind = 1; idx = big; } else { kind = 0; idx = big - N_L1; } }
              else { if (sm < N_KN) { kind = 2; idx = sm; } else { kind = 3; idx = sm - N_KN; } } }
#ifdef PROBE_P2_KIND
            if (!(dry && kind != PROBE_P2_KIND))
#endif
            {
            if (kind == 0) indexer_unit(C, lds, idx);
            else if (kind == 1) lru1_item(C, lds, idx);
            else if (kind == 2) { for (int k = 0; k < 4; ++k) knorm_unit(C, idx * 4 + k); }
            else p0_deferred_item(P, lds, idx);
            }
            if (tid == 0) MISC[6 + (it & 1)] = nxt;
            __syncthreads();
            u = (int)MISC[6 + (it & 1)];
        }
    } SEAM(2);

    if (IN(3)) {
        constexpr int N_AQ = SEQ / (8 * AT_QPW), N_L2 = NB * 64 * 8 / 4;
        attn_build_tab(C, lds);
        unsigned* qh = ctl + CW_Q3 + 2048 * dry;
        if (tid == 0) MISC[5] = 0u;
        for (;;) {
            __syncthreads();
            if (tid == 0) { const unsigned x = xb_xcc_id() & 7u; unsigned k = MISC[5]; int u = -1;
                for (; k < 8u; ++k) { const unsigned q = (x + k) & 7u; const unsigned v = __hip_atomic_fetch_add(qh + 64 * q, 1u, __ATOMIC_RELAXED, __HIP_MEMORY_SCOPE_AGENT); if (v < (unsigned)N_AQ) { u = (int)(q * N_AQ + v); break; } }
                MISC[5] = k;
                if (u < 0) { const unsigned v = __hip_atomic_fetch_add(qh + 64 * 8, 1u, __ATOMIC_RELAXED, __HIP_MEMORY_SCOPE_AGENT); u = v < (unsigned)N_L2 ? (int)(8 * N_AQ + v) : -1; }
                MISC[4] = (unsigned)u; }
            __syncthreads();
            const int u = (int)MISC[4];
            if (u < 0) break;
            if (u < 8 * N_AQ) attn_item(C, lds, u);
            else lru2_item(C, lds + AT_END, u - 8 * N_AQ);
        }
    } SEAM(3);

    if (IN(4)) {
        pg8::StaticOrder S; S.init(MTOK, DM, gridDim.x, blockIdx.x);
        { pg8::Gemm g{(const h16*)(ws + WS_LX), (const h16*)(ws + W_LRU), MTOK, DM, DM}; EpiMerge<0> E{(const h16*)(ws + WS_SGA), (h16*)(ws + WS_T1), nullptr, dry}; pg8::gemm_phase<EpiMerge<0>>(lds, g, S, E); }
        { pg8::Gemm g{(const h16*)(ws + WS_Q), (const h16*)(ws + W_ATT), MTOK, DM, DM}; EpiMerge<1> E{(const h16*)(ws + WS_SGB), (h16*)(ws + WS_T1), (h16*)(ws + WS_GG), dry}; pg8::gemm_phase<EpiMerge<1>>(lds, g, S, E); }
    } SEAM(4);

    if (IN(5)) {
        pg8::Gemm g{(const h16*)(ws + WS_GG), (const h16*)(ws + W_OUT), MTOK, DM, DM}; pg8::StaticOrder S; S.init(MTOK, DM, gridDim.x, blockIdx.x);
        EpiResid<true> E{P.in[0], nullptr, (h16*)(ws + WS_X1H), SSQ1, dry}; pg8::gemm_phase<EpiResid<true>>(lds, g, S, E);
    } SEAM(5);

    if (IN(6)) {
        pg8::Gemm g{(const h16*)(ws + WS_X1H), (const h16*)(ws + W_UP), MTOK, 2 * DFF, DM}; pg8::StaticOrder S; S.init(MTOK, 2 * DFF, gridDim.x, blockIdx.x);
        EpiUpAct E{SSQ1, (h16*)(ws + WS_UPV), (float*)(ws + WS_UPG), (float*)(ws + WS_UPG + 4 * MiB), (float*)(ws + WS_UPG + 8 * MiB), C.fcw, C.fcb, lds + pg8::STAGE_BYTES, dry}; pg8::gemm_phase<EpiUpAct>(lds, g, S, E);
    } SEAM(6);


    if (IN(8)) {
        pg8::Gemm g{(const h16*)(ws + WS_UPV), (const h16*)(ws + W_DOWN), MTOK, DM, DFF}; pg8::StaticOrder S; S.init(MTOK, DM, gridDim.x, blockIdx.x);
        {
#pragma unroll
          for (int i = 0; i < 2; ++i) { pg8::Unit uu; if (S.next(i, uu)) act_fix_tile((const float*)(ws + WS_UPG), (const float*)(ws + WS_UPG + 4 * MiB), (const float*)(ws + WS_UPG + 8 * MiB), C.fcw, C.fcb, (h16*)(ws + WS_UPV), uu.pm, tid, dry); }
          static_assert((MTOK / 256) * (DM / 256) == 2 * 256, "two units per workgroup on a 256-workgroup grid");
          VM_WAIT(); __syncthreads(); }
        EpiResid<false> E{nullptr, (const h16*)(ws + WS_X1H), (h16*)(ws + WS_X2H), SSQ2, dry}; pg8::gemm_phase<EpiResid<false>>(lds, g, S, E);
    } SEAM(8);

    if (IN(9)) {
        pg8::StaticOrder S; S.init(MTOK, DM, gridDim.x, blockIdx.x);
        { pg8::Gemm g{(const h16*)(ws + WS_X2H), (const h16*)(ws + W_PG), MTOK, DM, DM}; EpiGateSig E{SSQ2, (h16*)(ws + WS_GS), dry}; pg8::gemm_phase<EpiGateSig>(lds, g, S, E); }
        { pg8::Gemm g{(const h16*)(ws + WS_PH), (const h16*)(ws + W_PP), MTOK, DM, P.k_ple}; EpiPleOut E{(const h16*)(ws + WS_GS), (const h16*)(ws + WS_X2H), P.out, dry}; pg8::gemm_phase<EpiPleOut>(lds, g, S, E); }
    }
#undef IN
#undef SEAM
}

#ifndef N_LAUNCHES
#define N_LAUNCHES 1
#endif
extern "C" void kernel_launch(void* const* d_in, const int* in_sizes, int n_in, void* d_out, int out_size, void* d_ws, size_t ws_size, hipStream_t stream) {
    static int grid = 0;
    if (grid == 0) {
        if (n_in != 25 || out_size != MTOK * DM || ws_size < WS_END) { fprintf(stderr, "kernel_launch: unexpected shapes (n_in %d out %d ws %zu)\n", n_in, out_size, ws_size); grid = -1; return; }
        int dev = 0, cus = 0, per_cu = 0;
        hipGetDevice(&dev); hipDeviceGetAttribute(&cus, hipDeviceAttributeMultiprocessorCount, dev);
        if (hipFuncSetAttribute((const void*)fwd, hipFuncAttributeMaxDynamicSharedMemorySize, LDS_BYTES) != hipSuccess) { fprintf(stderr, "kernel_launch: hipFuncSetAttribute failed\n"); grid = -1; return; }
        if (hipOccupancyMaxActiveBlocksPerMultiprocessor(&per_cu, (const void*)fwd, NTHR, LDS_BYTES) != hipSuccess || per_cu < 1) { fprintf(stderr, "kernel_launch: occupancy query says %d\n", per_cu); }
        (void)hipGetLastError();
        grid = cus > 0 ? cus : 256;
    }
    if (grid < 0) return;
    hipMemsetAsync((char*)d_ws + WS_CTL, 0, CTL_ZERO_BYTES, stream);
    Params p{};
    for (int i = 0; i < 25; ++i) p.in[i] = (const float*)d_in[i];
    p.out = (float*)d_out; p.ws = (unsigned char*)d_ws; p.k_ple = PLE; p.pad = 0;
    if (N_LAUNCHES == 1) { p.ph_lo = 0; p.ph_hi = NPHASE; hipLaunchKernelGGL(fwd, dim3(grid), dim3(NTHR), LDS_BYTES, stream, p); }
    else for (int ph = 0; ph < NPHASE; ++ph) { p.ph_lo = ph; p.ph_hi = ph + 1;
#ifdef PROBE_MASK
        if ((PROBE_MASK >> ph) & 1) { p.pad = 1; hipLaunchKernelGGL(fwd, dim3(grid), dim3(NTHR), LDS_BYTES, stream, p); p.pad = 0; }
#endif
        hipLaunchKernelGGL(fwd, dim3(grid), dim3(NTHR), LDS_BYTES, stream, p); }
}
```

```cpp
#include <hip/hip_runtime.h>
#include <cstdio>
#include <cstdint>

#define GAS __attribute__((address_space(1)))
#define LAS __attribute__((address_space(3)))
typedef _Float16 h16;
typedef _Float16 h8 __attribute__((ext_vector_type(8)));
typedef _Float16 h4 __attribute__((ext_vector_type(4)));
typedef _Float16 h2 __attribute__((ext_vector_type(2)));
typedef __fp16 fh4 __attribute__((__vector_size__(4 * sizeof(__fp16))));
typedef float f32x4 __attribute__((ext_vector_type(4)));
typedef float f32x2 __attribute__((ext_vector_type(2)));
typedef unsigned u32x4 __attribute__((ext_vector_type(4)));
typedef unsigned u32x2 __attribute__((ext_vector_type(2)));
typedef unsigned long long u64;

__device__ __forceinline__ unsigned pkh(float a, float b) { h2 r; r.x = (h16)a; r.y = (h16)b; return __builtin_bit_cast(unsigned, r); }
__device__ __forceinline__ float sigmoid_f(float x) { return __builtin_amdgcn_rcpf(1.0f + __builtin_amdgcn_exp2f(-1.4426950408889634f * x)); }
__device__ __forceinline__ float gelu_tanh(float x) { const float u = 1.5957691216057308f * (x + 0.044715f * x * x * x); return x * sigmoid_f(u); }
#define LDS_WAIT() asm volatile("s_waitcnt lgkmcnt(0)" ::: "memory")
#define VM_WAIT() asm volatile("s_waitcnt vmcnt(0)" ::: "memory")

namespace pg8 {
constexpr int BM = 256, BK = 64, HALF = 128, HTB = HALF * BK * 2, STAGE_BYTES = 8 * HTB, NXCD = 8, WGM = 8;
__host__ __device__ __forceinline__ int lds_byte(int r, int c) { const int st = (r >> 4) * 2 + (c >> 5), rr = r & 15, cc = c & 31, ob = rr * 64 + cc * 2; return st * 1024 + (ob ^ (((ob >> 9) & 1) << 5)); }
__host__ __device__ __forceinline__ void stage_rc(int b, int& R, int& C) { const int st = b / 1024, sb = b % 1024, swz = sb ^ (((sb >> 9) & 1) << 5); R = (st >> 1) * 16 + swz / 64; C = (st & 1) * 32 + (swz % 64) / 2; }
__host__ __device__ __forceinline__ int perm32(int rho) { const int n = rho >> 4, i = rho & 15; return 8 * (i >> 2) + 4 * n + (i & 3); }

struct Unit { int pm, pn; };
struct Gemm { const h16* A; const h16* Bt; int M, N, K; };

struct StaticOrder {
    int nM, nN, nwg, G, c;
    __host__ __device__ void init(int M, int N, int G_, int c_) { nM = M / BM; nN = N / BM; nwg = nM * nN; G = G_; c = c_; }
    __host__ __device__ __forceinline__ bool next(int i, Unit& u) const {
        const long L = (long)i * G + c; if (L >= nwg) return false;
        int wgid = (int)L; { const int q = nwg / NXCD, r = nwg % NXCD, xcd = wgid % NXCD, off = wgid / NXCD; wgid = (xcd < r ? xcd * (q + 1) : r * (q + 1) + (xcd - r) * q) + off; }
        const int nig = WGM * nN, gid = wgid / nig, fm = gid * WGM, gsz = (nM - fm) < WGM ? (nM - fm) : WGM;
        u.pm = fm + ((wgid % nig) % gsz); u.pn = (wgid % nig) / gsz; return true;
    }
};

template <class Epi, bool ALIGN_EPI = true, bool SP2 = true>
__device__ __forceinline__ void gemm_phase(LAS unsigned char* lds, const Gemm g, const StaticOrder& S, const Epi& E) {
    const int tid = threadIdx.x, wid = __builtin_amdgcn_readfirstlane(tid >> 6), lane = tid & 63, wr = wid >> 2, wc = wid & 3, fr = lane & 15, fq = lane >> 4;
    const int K = g.K, nt = K / BK;
    unsigned voffA[2], voffB[2];
#pragma unroll
    for (int i = 0; i < 2; ++i) { int R, C; stage_rc(tid * 16 + i * 8192, R, C); const int Rb = Epi::PERM ? ((R & ~31) + perm32(R & 31)) : R;
        voffA[i] = (unsigned)(R * K + C) * 2u; voffB[i] = (unsigned)(Rb * K + C) * 2u; }
    const size_t kstep = (size_t)(BK * 2);
    const size_t hstep = (size_t)HALF * K * 2;
    const size_t tstep = 2 * hstep;
    const unsigned ldsw = (unsigned)wid * 1024u;
    const int aoff = lds_byte(wr * 64 + fr, fq * 8), boff = lds_byte(wc * 32 + fr, fq * 8);
#define PG8_SA(b, h) (((b) * 2 + (h)) * HTB)
#define PG8_SB(b, h) ((4 + (b) * 2 + (h)) * HTB)
#define PG8_STAGE(bufoff, gbase, voff) do { _Pragma("unroll") for (int _i = 0; _i < 2; ++_i) \
        __builtin_amdgcn_global_load_lds((const unsigned*)((const char*)(gbase) + (voff)[_i]), (LAS unsigned*)(lds + (bufoff) + ldsw + _i * 8192), 16, 0, 0); } while (0)
#define PG8_LDA(dst, b, h) do { _Pragma("unroll") for (int m = 0; m < 4; ++m) _Pragma("unroll") for (int k = 0; k < 2; ++k) dst[m][k] = *(const LAS h8*)(lds + PG8_SA(b, h) + aoff + m * 2048 + k * 1024); } while (0)
#define PG8_LDB(dst, b, h) do { _Pragma("unroll") for (int n = 0; n < 2; ++n) _Pragma("unroll") for (int k = 0; k < 2; ++k) dst[n][k] = *(const LAS h8*)(lds + PG8_SB(b, h) + boff + n * 2048 + k * 1024); } while (0)
#define PG8_MMA(ai, bj, At, Bt) do { __builtin_amdgcn_s_setprio(1); _Pragma("unroll") for (int m = 0; m < 4; ++m) _Pragma("unroll") for (int n = 0; n < 2; ++n) _Pragma("unroll") for (int k = 0; k < 2; ++k) \
        acc[ai][bj][m][n] = __builtin_amdgcn_mfma_f32_16x16x32_f16(Bt[n][k], At[m][k], acc[ai][bj][m][n], 0, 0, 0); __builtin_amdgcn_s_setprio(0); } while (0)
#define PG8_WAIT_V(n) asm volatile("s_waitcnt vmcnt(" #n ")" ::: "memory")
#define PG8_WAIT_L(n) asm volatile("s_waitcnt lgkmcnt(" #n ")" ::: "memory")
#define PG8_BAR __builtin_amdgcn_s_barrier()
#define PG8_SCHED __builtin_amdgcn_sched_barrier(0)
    Unit cur, nxt; int ui = 0;
    if (!S.next(0, cur)) return;
    f32x4 acc[2][2][4][2];
#pragma unroll
    for (int a = 0; a < 2; ++a)
#pragma unroll
        for (int b = 0; b < 2; ++b)
#pragma unroll
            for (int m = 0; m < 4; ++m)
#pragma unroll
                for (int n = 0; n < 2; ++n) acc[a][b][m][n] = (f32x4){0.f, 0.f, 0.f, 0.f};
    h8 At[4][2], B0[2][2], B1[2][2];
    const char* cA = (const char*)g.A + (size_t)cur.pm * tstep; const char* cB = (const char*)g.Bt + (size_t)cur.pn * tstep;
    if constexpr (SP2) {
        PG8_STAGE(PG8_SB(0, 0), cB, voffB); PG8_STAGE(PG8_SB(0, 1), cB + hstep, voffB); PG8_STAGE(PG8_SA(0, 0), cA, voffA); PG8_STAGE(PG8_SA(0, 1), cA + hstep, voffA);
        if (wr == 1) PG8_BAR;
        PG8_WAIT_V(2); PG8_BAR;
        PG8_STAGE(PG8_SB(1, 0), cB + kstep, voffB); PG8_STAGE(PG8_SA(1, 0), cA + kstep, voffA); PG8_STAGE(PG8_SB(1, 1), cB + hstep + kstep, voffB);
        PG8_WAIT_V(6); PG8_BAR;
    } else {
        PG8_STAGE(PG8_SB(0, 0), cB, voffB); PG8_STAGE(PG8_SA(0, 0), cA, voffA); PG8_STAGE(PG8_SB(0, 1), cB + hstep, voffB); PG8_STAGE(PG8_SA(0, 1), cA + hstep, voffA);
        if (wr == 1) PG8_BAR;
        PG8_WAIT_V(4); PG8_BAR;
        PG8_STAGE(PG8_SB(1, 0), cB + kstep, voffB); PG8_STAGE(PG8_SA(1, 0), cA + kstep, voffA); PG8_STAGE(PG8_SB(1, 1), cB + hstep + kstep, voffB);
        PG8_WAIT_V(6); PG8_BAR;
    }
    for (;;) {
        const bool has_next = S.next(ui + 1, nxt);
        const char* nA = has_next ? (const char*)g.A + (size_t)nxt.pm * tstep : cA; const char* nB = has_next ? (const char*)g.Bt + (size_t)nxt.pn * tstep : cB;
        for (int t = 0; t < nt; t += 2) {
            const bool last = (t == nt - 2);
            const char* a1 = cA + (size_t)(t + 1) * kstep;
            const char* a2 = last ? nA : cA + (size_t)(t + 2) * kstep; const char* b2 = last ? nB : cB + (size_t)(t + 2) * kstep;
            const char* a3 = a2 + kstep; const char* b3 = b2 + kstep;
            if constexpr (SP2) {
            PG8_LDB(B0, 0, 0); PG8_LDB(B1, 0, 1); PG8_SCHED; PG8_LDA(At, 0, 0); PG8_STAGE(PG8_SA(1, 1), a1 + hstep, voffA);
            PG8_WAIT_V(8); PG8_WAIT_L(0); PG8_BAR; PG8_MMA(0, 0, At, B0); PG8_MMA(0, 1, At, B1); PG8_BAR; PG8_SCHED;
            PG8_LDA(At, 0, 1); PG8_STAGE(PG8_SB(0, 0), b2, voffB); PG8_STAGE(PG8_SB(0, 1), b2 + hstep, voffB); PG8_STAGE(PG8_SA(0, 0), a2, voffA);
            PG8_WAIT_V(8); PG8_WAIT_L(0); PG8_BAR; PG8_MMA(1, 0, At, B0); PG8_MMA(1, 1, At, B1); PG8_BAR; PG8_SCHED;
            PG8_LDB(B0, 1, 0); PG8_LDB(B1, 1, 1); PG8_SCHED; PG8_LDA(At, 1, 0); PG8_STAGE(PG8_SA(0, 1), a2 + hstep, voffA);
            PG8_WAIT_V(8); PG8_WAIT_L(0); PG8_BAR; PG8_MMA(0, 0, At, B0); PG8_MMA(0, 1, At, B1); PG8_BAR; PG8_SCHED;
            PG8_LDA(At, 1, 1); PG8_STAGE(PG8_SB(1, 0), b3, voffB); PG8_STAGE(PG8_SB(1, 1), b3 + hstep, voffB); PG8_STAGE(PG8_SA(1, 0), a3, voffA);
            PG8_WAIT_V(8); PG8_WAIT_L(0); PG8_BAR; PG8_MMA(1, 0, At, B0); PG8_MMA(1, 1, At, B1); PG8_BAR; PG8_SCHED;
            } else {
            PG8_LDB(B0, 0, 0); PG8_SCHED; PG8_LDA(At, 0, 0); PG8_STAGE(PG8_SA(1, 1), a1 + hstep, voffA);
            PG8_WAIT_L(8); PG8_BAR; PG8_WAIT_L(0); PG8_MMA(0, 0, At, B0); PG8_BAR; PG8_SCHED;
            PG8_LDB(B1, 0, 1); PG8_STAGE(PG8_SB(0, 0), b2, voffB);
            PG8_BAR; PG8_WAIT_L(0); PG8_MMA(0, 1, At, B1); PG8_BAR;
            PG8_LDA(At, 0, 1); PG8_STAGE(PG8_SA(0, 0), a2, voffA);
            PG8_BAR; PG8_WAIT_L(0); PG8_MMA(1, 0, At, B0); PG8_BAR; PG8_SCHED;
            PG8_STAGE(PG8_SB(0, 1), b2 + hstep, voffB);
            PG8_WAIT_V(6); PG8_BAR; PG8_MMA(1, 1, At, B1); PG8_BAR;
            PG8_LDB(B0, 1, 0); PG8_SCHED; PG8_LDA(At, 1, 0); PG8_STAGE(PG8_SA(0, 1), a2 + hstep, voffA);
            PG8_WAIT_L(8); PG8_BAR; PG8_WAIT_L(0); PG8_MMA(0, 0, At, B0); PG8_BAR; PG8_SCHED;
            PG8_LDB(B1, 1, 1); PG8_STAGE(PG8_SB(1, 0), b3, voffB);
            PG8_BAR; PG8_WAIT_L(0); PG8_MMA(0, 1, At, B1); PG8_BAR;
            PG8_LDA(At, 1, 1); PG8_STAGE(PG8_SA(1, 0), a3, voffA);
            PG8_BAR; PG8_WAIT_L(0); PG8_MMA(1, 0, At, B0); PG8_BAR; PG8_SCHED;
            PG8_STAGE(PG8_SB(1, 1), b3 + hstep, voffB);
            PG8_WAIT_V(6); PG8_BAR; PG8_MMA(1, 1, At, B1); PG8_BAR;
            }
        }
        if constexpr (ALIGN_EPI) { if (wr == 0) PG8_BAR; }
        E(acc, cur, wr, wc, fr, fq);
        if (!has_next) break;
#pragma unroll
        for (int a = 0; a < 2; ++a)
#pragma unroll
            for (int b = 0; b < 2; ++b)
#pragma unroll
                for (int m = 0; m < 4; ++m)
#pragma unroll
                    for (int n = 0; n < 2; ++n) acc[a][b][m][n] = (f32x4){0.f, 0.f, 0.f, 0.f};
        cur = nxt; cA = nA; cB = nB; ++ui;
        if constexpr (ALIGN_EPI) { if (wr == 1) PG8_BAR; }
    }
    PG8_WAIT_V(0);
    if constexpr (!ALIGN_EPI) { if (wr == 0) PG8_BAR; }
    PG8_BAR;
#undef PG8_SA
#undef PG8_SB
#undef PG8_STAGE
#undef PG8_LDA
#undef PG8_LDB
#undef PG8_MMA
#undef PG8_WAIT_V
#undef PG8_WAIT_L
#undef PG8_BAR
#undef PG8_SCHED
}
}

constexpr int NB = 4, SEQ = 8192, MTOK = NB * SEQ, DM = 1024, DFF = 3072, PLE = 256;
constexpr int NIN = 6216, NIN_PAD = 6400;
constexpr float EPS = 1e-6f;
constexpr int NWAVES = 8, NTHR = 512;

typedef const f32x4 (&AccRef)[2][2][4][2];

template <int ACT> __device__ __forceinline__ float act_f(float v) {
    if (ACT == 1) return gelu_tanh(v);
    if (ACT == 2) return sigmoid_f(v);
    if (ACT == 3) return v * 0.125f;
    return v;
}
template <int ACT> __device__ __forceinline__ void store_tile_h(AccRef acc, h16* base, int ldc, int row0, int col0, int dry) {
    const unsigned bo0 = ((unsigned)row0 * (unsigned)ldc + (unsigned)col0) * 2u;
#pragma unroll
    for (int ai = 0; ai < 2; ++ai)
#pragma unroll
        for (int m = 0; m < 4; ++m) { const unsigned bo = bo0 + (unsigned)((ai * 128 + m * 16) * ldc * 2);
#pragma unroll
            for (int bj = 0; bj < 2; ++bj) { const f32x4 v0 = acc[ai][bj][m][0], v1 = acc[ai][bj][m][1];
                u32x4 w; w.x = pkh(act_f<ACT>(v0[0]), act_f<ACT>(v0[1])); w.y = pkh(act_f<ACT>(v0[2]), act_f<ACT>(v0[3]));
                w.z = pkh(act_f<ACT>(v1[0]), act_f<ACT>(v1[1])); w.w = pkh(act_f<ACT>(v1[2]), act_f<ACT>(v1[3]));
                if (!dry) *(u32x4*)((char*)base + bo + bj * 256) = w; }
            if (ACT == 1 || ACT == 2) __builtin_amdgcn_sched_barrier(0); }
}

__device__ __forceinline__ unsigned frag_off(int pm, int pn, int wid, int lane) { return ((unsigned)((pm * 4 + pn) * 8 + wid) * 1024u + (unsigned)lane) * 16u; }
#define FRAG_SUB(ai, m, bj) ((unsigned)((((ai) * 4 + (m)) * 2 + (bj)) * 1024))
template <int ACT> __device__ __forceinline__ void store_tile_frag(AccRef acc, h16* base, unsigned fo, int dry) {
#pragma unroll
    for (int ai = 0; ai < 2; ++ai)
#pragma unroll
        for (int m = 0; m < 4; ++m) {
#pragma unroll
            for (int bj = 0; bj < 2; ++bj) { const f32x4 v0 = acc[ai][bj][m][0], v1 = acc[ai][bj][m][1];
                u32x4 w; w.x = pkh(act_f<ACT>(v0[0]), act_f<ACT>(v0[1])); w.y = pkh(act_f<ACT>(v0[2]), act_f<ACT>(v0[3]));
                w.z = pkh(act_f<ACT>(v1[0]), act_f<ACT>(v1[1])); w.w = pkh(act_f<ACT>(v1[2]), act_f<ACT>(v1[3]));
                if (!dry) *(u32x4*)((char*)base + fo + FRAG_SUB(ai, m, bj)) = w; }
            if (ACT == 1 || ACT == 2) __builtin_amdgcn_sched_barrier(0); }
}

struct EpiIn {
    static constexpr bool PERM = true;
    h16 *LX, *GG, *Q, *K, *V, *QI, *KI, *SGA, *SGB; float* WI; int dry;
    __device__ __forceinline__ void operator()(AccRef acc, const pg8::Unit& u, int wr, int wc, int fr, int fq) const {
        const int pn = u.pn, row0 = u.pm * 256 + wr * 64 + fr, cw = wc * 32 + 8 * fq;
        if (pn < 4 || (pn >= 8 && pn < 14)) {
            h16* base = pn < 4 ? LX : (pn < 12 ? Q : (pn == 12 ? K : V)); const int ldc = pn < 12 ? DM : 256; const int ct = pn < 4 ? pn * 256 : (pn < 12 ? (pn - 8) * 256 : 0);
            if (pn < 12) store_tile_h<0>(acc, base, DM, row0, ct + cw, dry); else store_tile_h<0>(acc, base, 256, row0, cw, dry);
            (void)ldc;
        }
        else if (pn < 8) store_tile_h<1>(acc, GG, DM, row0, (pn - 4) * 256 + cw, dry);
        else if (pn < 16) {
#pragma unroll
            for (int ai = 0; ai < 2; ++ai)
#pragma unroll
                for (int m = 0; m < 4; ++m) { const unsigned t16 = (unsigned)(u.pm * 16 + wr * 4 + ai * 8 + m);
#pragma unroll
                    for (int bj = 0; bj < 2; ++bj) { const f32x4 v0 = acc[ai][bj][m][0] * 0.125f, v1 = acc[ai][bj][m][1] * 0.125f;
                        const unsigned hh = (unsigned)((pn - 14) * 4 + bj * 2 + (wc >> 1)), slot = ((t16 * 8u + hh) * 2u + (unsigned)(wc & 1)) * 64u + (unsigned)(fq * 16 + fr);
                        u32x4 w; w.x = pkh(v0[0], v0[1]); w.y = pkh(v0[2], v0[3]); w.z = pkh(v1[0], v1[1]); w.w = pkh(v1[2], v1[3]);
                        if (!dry) *(u32x4*)((char*)QI + slot * 16u) = w; } }
        }
        else if (pn == 16) {
            if (wc < 2) {
#pragma unroll
                for (int ai = 0; ai < 2; ++ai)
#pragma unroll
                    for (int m = 0; m < 4; ++m) { const f32x4 v0 = acc[ai][0][m][0], v1 = acc[ai][0][m][1];
                        u32x4 w; w.x = pkh(v0[0], v0[1]); w.y = pkh(v0[2], v0[3]); w.z = pkh(v1[0], v1[1]); w.w = pkh(v1[2], v1[3]);
                        if (!dry) *(u32x4*)((char*)KI + ((unsigned)((u.pm * 16 + wr * 4 + ai * 8 + m) * 2 + wc) * 64u + (unsigned)(fq * 16 + fr)) * 16u) = w; }
            } else if (wc == 2 && fq == 0) {
#pragma unroll
                for (int ai = 0; ai < 2; ++ai)
#pragma unroll
                    for (int m = 0; m < 4; ++m) { float* p = WI + (size_t)(row0 + ai * 128 + m * 16) * 8;
                        if (!dry) { *(f32x4*)p = acc[ai][0][m][0] * 0.35355339059327373f; *(f32x4*)(p + 4) = acc[ai][0][m][1] * 0.35355339059327373f; } }
            }
        }
        else { h16* base = pn < 21 ? SGA : SGB; const int pl = pn < 21 ? pn - 17 : pn - 21; store_tile_frag<2>(acc, base, frag_off(u.pm, pl, wr * 4 + wc, fq * 16 + fr), dry); }
    }
};

template <int SECOND> struct EpiMerge {
    static constexpr bool PERM = true;
    const h16* SG; h16* T1; h16* OUT; int dry;
    __device__ __forceinline__ void operator()(AccRef acc, const pg8::Unit& u, int wr, int wc, int fr, int fq) const {
        const int row0 = u.pm * 256 + wr * 64 + fr, col0 = u.pn * 256 + wc * 32 + 8 * fq;
        const unsigned fo = frag_off(u.pm, u.pn, wr * 4 + wc, fq * 16 + fr);
#pragma unroll
        for (int ai = 0; ai < 2; ++ai) {
            h8 sg[4][2], t1[4][2];
#pragma unroll
            for (int m = 0; m < 4; ++m)
#pragma unroll
                for (int bj = 0; bj < 2; ++bj) { sg[m][bj] = *(const h8*)((const char*)SG + fo + FRAG_SUB(ai, m, bj)); if (SECOND) t1[m][bj] = *(const h8*)((const char*)T1 + fo + FRAG_SUB(ai, m, bj)); }
            __builtin_amdgcn_sched_barrier(0);
#pragma unroll
            for (int m = 0; m < 4; ++m) { const size_t off = (size_t)(row0 + ai * 128 + m * 16) * DM + col0;
#pragma unroll
                for (int bj = 0; bj < 2; ++bj) { const f32x4 v0 = acc[ai][bj][m][0], v1 = acc[ai][bj][m][1];
                    float r[8];
#pragma unroll
                    for (int j = 0; j < 4; ++j) { r[j] = (float)sg[m][bj][j] * v0[j]; r[4 + j] = (float)sg[m][bj][4 + j] * v1[j]; }
                    if (SECOND) {
#pragma unroll
                        for (int j = 0; j < 8; ++j) r[j] += (float)t1[m][bj][j]; }
                    u32x4 w; w.x = pkh(r[0], r[1]); w.y = pkh(r[2], r[3]); w.z = pkh(r[4], r[5]); w.w = pkh(r[6], r[7]);
                    if (!dry) { if (SECOND) *(u32x4*)(OUT + off + bj * 128) = w; else *(u32x4*)((char*)T1 + fo + FRAG_SUB(ai, m, bj)) = w; } } }
            __builtin_amdgcn_sched_barrier(0); }
    }
};

template <bool BASE_F32> struct EpiResid {
    static constexpr bool PERM = true;
    const float* BF; const h16* BH; h16* XOUT; float* SSQ; int dry;
    __device__ __forceinline__ void operator()(AccRef acc, const pg8::Unit& u, int wr, int wc, int fr, int fq) const {
        const int row0 = u.pm * 256 + wr * 64 + fr, col0 = u.pn * 256 + wc * 32 + 8 * fq;
#pragma unroll
        for (int ai = 0; ai < 2; ++ai) {
            f32x4 bf[4][2][2]; h8 bh[4][2];
#pragma unroll
            for (int m = 0; m < 4; ++m) { const size_t off = (size_t)(row0 + ai * 128 + m * 16) * DM + col0;
#pragma unroll
                for (int bj = 0; bj < 2; ++bj) { if (BASE_F32) { bf[m][bj][0] = *(const f32x4*)(BF + off + bj * 128); bf[m][bj][1] = *(const f32x4*)(BF + off + bj * 128 + 4); } else bh[m][bj] = *(const h8*)(BH + off + bj * 128); } }
            __builtin_amdgcn_sched_barrier(0);
#pragma unroll
            for (int m = 0; m < 4; ++m) { const int row = row0 + ai * 128 + m * 16; const size_t off = (size_t)row * DM + col0; float ss = 0.f;
#pragma unroll
                for (int bj = 0; bj < 2; ++bj) { const f32x4 v0 = acc[ai][bj][m][0], v1 = acc[ai][bj][m][1];
                    float r[8];
                    if (BASE_F32) {
#pragma unroll
                        for (int j = 0; j < 4; ++j) { r[j] = bf[m][bj][0][j] + v0[j]; r[4 + j] = bf[m][bj][1][j] + v1[j]; } }
                    else {
#pragma unroll
                        for (int j = 0; j < 4; ++j) { r[j] = (float)bh[m][bj][j] + v0[j]; r[4 + j] = (float)bh[m][bj][4 + j] + v1[j]; } }
#pragma unroll
                    for (int j = 0; j < 8; ++j) ss += r[j] * r[j];
                    u32x4 w; w.x = pkh(r[0], r[1]); w.y = pkh(r[2], r[3]); w.z = pkh(r[4], r[5]); w.w = pkh(r[6], r[7]);
                    if (!dry) *(u32x4*)(XOUT + off + bj * 128) = w; }
                ss += __shfl_xor(ss, 16); ss += __shfl_xor(ss, 32);
                if (fq == 0 && !dry) unsafeAtomicAdd(SSQ + row, ss); }
            __builtin_amdgcn_sched_barrier(0); }
    }
};

struct EpiUp {
    static constexpr bool PERM = true;
    const float* SSQ; h16* UPG; h16* UPV; int dry;
    __device__ __forceinline__ void operator()(AccRef acc, const pg8::Unit& u, int wr, int wc, int fr, int fq) const {
        const int row0 = u.pm * 256 + wr * 64 + fr, col0 = u.pn * 128 + wc * 32 + 8 * fq;
#pragma unroll
        for (int ai = 0; ai < 2; ++ai)
#pragma unroll
            for (int m = 0; m < 4; ++m) { const int row = row0 + ai * 128 + m * 16; const size_t off = (size_t)row * DFF + col0;
                const float r = __builtin_amdgcn_rsqf(SSQ[row] * (1.0f / DM) + EPS);
#pragma unroll
                for (int bj = 0; bj < 2; ++bj) { const f32x4 v0 = acc[ai][bj][m][0] * r, v1 = acc[ai][bj][m][1] * r;
                    u32x4 w; w.x = pkh(v0[0], v0[1]); w.y = pkh(v0[2], v0[3]); w.z = pkh(v1[0], v1[1]); w.w = pkh(v1[2], v1[3]);
                    if (!dry) *(u32x4*)((bj ? UPV : UPG) + off) = w; } }
    }
};

__device__ __forceinline__ float dpp_ror1(float v) { return __builtin_bit_cast(float, __builtin_amdgcn_update_dpp(0, __builtin_bit_cast(int, v), 0x121, 0xf, 0xf, false)); }
__device__ __forceinline__ float dpp_ror2(float v) { return __builtin_bit_cast(float, __builtin_amdgcn_update_dpp(0, __builtin_bit_cast(int, v), 0x122, 0xf, 0xf, false)); }
struct EpiUpAct {
    static constexpr bool PERM = true;
    const float* SSQ; h16* ACT; float* SG; float* SV; float* SL; const float* fcw; const float* fcb; LAS unsigned char* xl; int dry;
    __device__ __forceinline__ void operator()(AccRef acc, const pg8::Unit& u, int wr, int wc, int fr, int fq) const {
        const int row0 = u.pm * 256 + wr * 64 + fr, colg = u.pn * 128 + wc * 32 + 8 * fq, coll = wc * 32 + 8 * fq;
        float w0[8], w1[8], w2[8], bb[8];
        { const f32x4 a0 = *(const f32x4*)(fcw + colg), a1 = *(const f32x4*)(fcw + colg + 4), b0 = *(const f32x4*)(fcw + DFF + colg), b1 = *(const f32x4*)(fcw + DFF + colg + 4),
                      c0 = *(const f32x4*)(fcw + 2 * DFF + colg), c1 = *(const f32x4*)(fcw + 2 * DFF + colg + 4), d0 = *(const f32x4*)(fcb + colg), d1 = *(const f32x4*)(fcb + colg + 4);
#pragma unroll
          for (int e = 0; e < 4; ++e) { w0[e] = a0[e]; w0[4 + e] = a1[e]; w1[e] = b0[e]; w1[4 + e] = b1[e]; w2[e] = c0[e]; w2[4 + e] = c1[e]; bb[e] = d0[e]; bb[4 + e] = d1[e]; } }
        float rsv[2][4];
#pragma unroll
        for (int ai = 0; ai < 2; ++ai)
#pragma unroll
            for (int m = 0; m < 4; ++m) rsv[ai][m] = SSQ[row0 + ai * 128 + m * 16];
#pragma unroll
        for (int ai = 0; ai < 2; ++ai)
#pragma unroll
            for (int m = 0; m < 4; ++m) rsv[ai][m] = __builtin_amdgcn_rsqf(rsv[ai][m] * (1.0f / DM) + EPS);
        LAS float* X = (LAS float*)xl;
#pragma unroll
        for (int ai = 0; ai < 2; ++ai) { const float r3 = rsv[ai][3];
            if (fr >= 14) { LAS float* p = X + ((ai * 2 + wr) * 2 + (fr - 14)) * 128 + coll; *(LAS f32x4*)p = acc[ai][0][3][0] * r3; *(LAS f32x4*)(p + 4) = acc[ai][0][3][1] * r3; } }
        LDS_WAIT(); __builtin_amdgcn_s_barrier(); asm volatile("" ::: "memory");
#pragma unroll
        for (int ai = 0; ai < 2; ++ai) {
            float L0[8], L1[8];
            if (ai == 0 && wr == 0) {
#pragma unroll
                for (int e = 0; e < 8; ++e) { L0[e] = 0.f; L1[e] = 0.f; } }
            else { const int pb = wr == 1 ? ai * 2 : 1; const LAS float* p = X + (pb * 2) * 128 + coll;
                const f32x4 x0 = *(const LAS f32x4*)p, x1 = *(const LAS f32x4*)(p + 4), y0 = *(const LAS f32x4*)(p + 128), y1 = *(const LAS f32x4*)(p + 132);
#pragma unroll
                for (int e = 0; e < 4; ++e) { L0[e] = x0[e]; L0[4 + e] = x1[e]; L1[e] = y0[e]; L1[4 + e] = y1[e]; } }
            float q1[8], q2[8];
#pragma unroll
            for (int e = 0; e < 8; ++e) { q1[e] = L1[e]; q2[e] = fr == 0 ? L0[e] : L1[e]; }
#pragma unroll
            for (int m = 0; m < 4; ++m) { const int row = row0 + ai * 128 + m * 16;
                const float rr = rsv[ai][m];
                float g[8], a[8];
#pragma unroll
                for (int e = 0; e < 4; ++e) { g[e] = acc[ai][0][m][0][e] * rr; g[4 + e] = acc[ai][0][m][1][e] * rr; }
#pragma unroll
                for (int e = 0; e < 8; ++e) { const float r1 = dpp_ror1(g[e]), r2 = dpp_ror2(g[e]);
                    const float p1 = fr >= 1 ? r1 : q1[e], p2 = fr >= 2 ? r2 : q2[e];
                    const float y = bb[e] + w0[e] * p2 + w1[e] * p1 + w2[e] * g[e];
                    const float vv = (e < 4 ? acc[ai][1][m][0][e] : acc[ai][1][m][1][e - 4]) * rr;
                    a[e] = gelu_tanh(y) * vv; q1[e] = r1; q2[e] = r2; }
                const bool deferred = (ai == 0 && m == 0) && wr == 0 && fr < 2;
                if (!dry) {
                    if (!deferred) { u32x4 w; w.x = pkh(a[0], a[1]); w.y = pkh(a[2], a[3]); w.z = pkh(a[4], a[5]); w.w = pkh(a[6], a[7]); *(u32x4*)(ACT + (size_t)row * DFF + colg) = w; }
                    else { float* pg = SG + (size_t)(u.pm * 2 + fr) * DFF + colg; float* pv = SV + (size_t)(u.pm * 2 + fr) * DFF + colg;
                        *(f32x4*)pg = (f32x4){g[0], g[1], g[2], g[3]}; *(f32x4*)(pg + 4) = (f32x4){g[4], g[5], g[6], g[7]};
                        *(f32x4*)pv = acc[ai][1][m][0] * rr; *(f32x4*)(pv + 4) = acc[ai][1][m][1] * rr; }
                    if ((ai == 1 && m == 3) && wr == 1 && fr >= 14) { float* pl = SL + (size_t)(u.pm * 2 + fr - 14) * DFF + colg;
                        *(f32x4*)pl = (f32x4){g[0], g[1], g[2], g[3]}; *(f32x4*)(pl + 4) = (f32x4){g[4], g[5], g[6], g[7]}; } }
                __builtin_amdgcn_sched_barrier(0); }
        }
    }
};
__device__ __forceinline__ void act_fix_tile(const float* SG, const float* SV, const float* SL, const float* fcw, const float* fcb, h16* ACT, int pm, int tid, int dry) {
    constexpr int NCG = DFF / 8; const bool bs = (pm & 31) == 0;
    for (int it = tid; it < 2 * NCG; it += NTHR) { const int cg = it % NCG, rr = it / NCG, c0 = cg * 8;
        float y[8];
#pragma unroll
        for (int h = 0; h < 2; ++h) { const int c = c0 + 4 * h;
            const f32x4 g = *(const f32x4*)(SG + (size_t)(pm * 2 + rr) * DFF + c), v = *(const f32x4*)(SV + (size_t)(pm * 2 + rr) * DFF + c);
            f32x4 g1, g2; const f32x4 z = {0.f, 0.f, 0.f, 0.f};
            if (rr == 0) { g1 = bs ? z : *(const f32x4*)(SL + (size_t)((pm - 1) * 2 + 1) * DFF + c); g2 = bs ? z : *(const f32x4*)(SL + (size_t)((pm - 1) * 2) * DFF + c); }
            else { g1 = *(const f32x4*)(SG + (size_t)(pm * 2) * DFF + c); g2 = bs ? z : *(const f32x4*)(SL + (size_t)((pm - 1) * 2 + 1) * DFF + c); }
            const f32x4 a0 = *(const f32x4*)(fcw + c), a1 = *(const f32x4*)(fcw + DFF + c), a2 = *(const f32x4*)(fcw + 2 * DFF + c), b = *(const f32x4*)(fcb + c);
#pragma unroll
            for (int e = 0; e < 4; ++e) y[4 * h + e] = gelu_tanh(b[e] + a0[e] * g2[e] + a1[e] * g1[e] + a2[e] * g[e]) * v[e]; }
        u32x4 w; w.x = pkh(y[0], y[1]); w.y = pkh(y[2], y[3]); w.z = pkh(y[4], y[5]); w.w = pkh(y[6], y[7]);
        if (!dry) *(u32x4*)(ACT + (size_t)(pm * 256 + rr) * DFF + c0) = w; }
}

struct EpiGateSig {
    static constexpr bool PERM = true;
    const float* SSQ; h16* GS; int dry;
    __device__ __forceinline__ void operator()(AccRef acc, const pg8::Unit& u, int wr, int wc, int fr, int fq) const {
        const int row0 = u.pm * 256 + wr * 64 + fr; const unsigned fo = frag_off(u.pm, u.pn, wr * 4 + wc, fq * 16 + fr);
        float rsv[2][4];
#pragma unroll
        for (int ai = 0; ai < 2; ++ai)
#pragma unroll
            for (int m = 0; m < 4; ++m) rsv[ai][m] = SSQ[row0 + ai * 128 + m * 16];
        __builtin_amdgcn_sched_barrier(0);
#pragma unroll
        for (int ai = 0; ai < 2; ++ai)
#pragma unroll
            for (int m = 0; m < 4; ++m) { const float r = __builtin_amdgcn_rsqf(rsv[ai][m] * (1.0f / DM) + EPS);
#pragma unroll
                for (int bj = 0; bj < 2; ++bj) { const f32x4 v0 = acc[ai][bj][m][0] * r, v1 = acc[ai][bj][m][1] * r;
                    u32x4 w; w.x = pkh(sigmoid_f(v0[0]), sigmoid_f(v0[1])); w.y = pkh(sigmoid_f(v0[2]), sigmoid_f(v0[3])); w.z = pkh(sigmoid_f(v1[0]), sigmoid_f(v1[1])); w.w = pkh(sigmoid_f(v1[2]), sigmoid_f(v1[3]));
                    if (!dry) *(u32x4*)((char*)GS + fo + FRAG_SUB(ai, m, bj)) = w; }
                __builtin_amdgcn_sched_barrier(0); }
    }
};
struct EpiPleOut {
    static constexpr bool PERM = true;
    const h16* GS; const h16* X2; float* C; int dry;
    __device__ __forceinline__ void operator()(AccRef acc, const pg8::Unit& u, int wr, int wc, int fr, int fq) const {
        const int row0 = u.pm * 256 + wr * 64 + fr, col0 = u.pn * 256 + wc * 32 + 8 * fq;
        const unsigned e0 = (unsigned)row0 * DM + (unsigned)col0, fo = frag_off(u.pm, u.pn, wr * 4 + wc, fq * 16 + fr);
#pragma unroll
        for (int ai = 0; ai < 2; ++ai) {
            h8 gsv[4][2], xbv[4][2];
#pragma unroll
            for (int m = 0; m < 4; ++m)
#pragma unroll
                for (int bj = 0; bj < 2; ++bj) { const unsigned o2 = e0 + (unsigned)((ai * 128 + m * 16) * DM) + bj * 128;
                    gsv[m][bj] = *(const h8*)((const char*)GS + fo + FRAG_SUB(ai, m, bj)); xbv[m][bj] = *(const h8*)((const char*)X2 + (size_t)o2 * 2u); }
            __builtin_amdgcn_sched_barrier(0);
#pragma unroll
            for (int m = 0; m < 4; ++m) { const unsigned eo = e0 + (unsigned)((ai * 128 + m * 16) * DM);
#pragma unroll
                for (int bj = 0; bj < 2; ++bj) { const unsigned o2 = eo + bj * 128; const f32x4 a0 = acc[ai][bj][m][0], a1 = acc[ai][bj][m][1];
                    f32x4 o0, o1;
#pragma unroll
                    for (int j = 0; j < 4; ++j) { o0[j] = (float)xbv[m][bj][j] + (float)gsv[m][bj][j] * a0[j]; o1[j] = (float)xbv[m][bj][4 + j] + (float)gsv[m][bj][4 + j] * a1[j]; }
                    if (!dry) { *(f32x4*)((char*)C + (size_t)o2 * 4u) = o0; *(f32x4*)((char*)C + (size_t)o2 * 4u + 16) = o1; } } }
            __builtin_amdgcn_sched_barrier(0); }
    }
};


#define XB_TMO      128
#define XB_XCNT(j)  (256  + 64 * (j))
#define XB_XSUB(j)  (1280 + 64 * (j))
#define XB_XGEN(j)  (2304 + 64 * (j))
#define XB_TOP      3328
#define XB_TOPGEN   3392
#define XCD_BAR_WORDS 3456
#define XB_SPIN_CAP (1u << 20)

__device__ __forceinline__ unsigned xb_ld(unsigned* p)              { return __hip_atomic_load(p, __ATOMIC_RELAXED, __HIP_MEMORY_SCOPE_AGENT); }
__device__ __forceinline__ unsigned xb_add(unsigned* p, unsigned v) { return __hip_atomic_fetch_add(p, v, __ATOMIC_RELAXED, __HIP_MEMORY_SCOPE_AGENT); }
__device__ __forceinline__ unsigned xb_xcc_id() { return (unsigned)__builtin_amdgcn_s_getreg((3 << 11) | 20) & 0xFu; }
#define XB_SPIN(cond, bar) do { unsigned _sp = 0; while (cond) { __builtin_amdgcn_s_sleep(1); \
    if ((++_sp & 255u) == 0u) { if (xb_ld(&(bar)[XB_TMO])) break; if (_sp > XB_SPIN_CAP) { atomicAdd(&(bar)[XB_TMO], 1u); break; } } } } while (0)

struct XcdBarrier { unsigned* bar; unsigned x; volatile LAS unsigned* st; };

__device__ __forceinline__ XcdBarrier xcd_barrier_post(unsigned* bar, volatile LAS unsigned* st) {
    XcdBarrier b; b.bar = bar; b.x = xb_xcc_id(); b.st = st;
    if (threadIdx.x == 0) (void)xb_add(&bar[XB_XCNT(b.x)], 1u);
    return b;
}
__device__ __forceinline__ void xcd_barrier_complete(unsigned* bar, unsigned x, unsigned& nloc, unsigned& nx) {
    const unsigned G = gridDim.x * gridDim.y * gridDim.z;
    unsigned sum, cnt, mine, sp = 0u;
    for (;;) {
        sum = 0u; cnt = 0u; mine = 0u;
#pragma unroll
        for (unsigned j = 0; j < 16; ++j) { const unsigned c = xb_ld(&bar[XB_XCNT(j)]); sum += c; cnt += (c > 0u) ? 1u : 0u; mine = (j == x) ? c : mine; }
        if (sum == G) break;
        __builtin_amdgcn_s_sleep(1);
        if ((++sp & 255u) == 0u) { if (xb_ld(&bar[XB_TMO])) break; if (sp > XB_SPIN_CAP) { atomicAdd(&bar[XB_TMO], 1u); break; } }
    }
    nloc = mine > 0u ? mine : 1u; nx = cnt > 0u ? cnt : 1u;
}
__device__ __forceinline__ void xcd_barrier(const XcdBarrier& b) {
    asm volatile("s_waitcnt vmcnt(0)" ::: "memory");
    __syncthreads();
    if (threadIdx.x == 0) {
        unsigned* bar = b.bar;
        __builtin_amdgcn_s_waitcnt(0);
        unsigned nloc = b.st[0], nx = b.st[1];
        if (nloc == 0u) { xcd_barrier_complete(bar, b.x, nloc, nx); b.st[0] = nloc; b.st[1] = nx; }
        const unsigned old = xb_add(&bar[XB_XSUB(b.x)], 1u);
        const unsigned gen = old / nloc;
        if (old + 1u == (gen + 1u) * nloc) {
            __builtin_amdgcn_fence(__ATOMIC_RELEASE, "agent");
            asm volatile("s_waitcnt vmcnt(0)" ::: "memory");
            const unsigned og = xb_add(&bar[XB_TOP], 1u);
            const unsigned tg = og / nx;
            if (og + 1u == (tg + 1u) * nx) xb_add(&bar[XB_TOPGEN], 1u);
            else XB_SPIN(xb_ld(&bar[XB_TOPGEN]) == tg, bar);
            __builtin_amdgcn_fence(__ATOMIC_ACQUIRE, "agent");
            xb_add(&bar[XB_XGEN(b.x)], 1u);
            asm volatile("s_waitcnt vmcnt(0)" ::: "memory");
        } else {
            XB_SPIN(xb_ld(&bar[XB_XGEN(b.x)]) == gen, bar);
            __builtin_amdgcn_fence(__ATOMIC_ACQUIRE, "agent");
            asm volatile("s_waitcnt vmcnt(0)" ::: "memory");
        }
    }
    __syncthreads();
}

constexpr size_t MiB = 1u << 20;
constexpr size_t WS_CTL = 0, CTL_ZERO_BYTES = 1 * MiB;
constexpr size_t WS_SA = 1 * MiB, WS_SH = 2 * MiB;
constexpr size_t WS_WI = 3 * MiB;
constexpr size_t WS_KI = 4 * MiB;
constexpr size_t WS_W = 8 * MiB;
constexpr size_t W_IN = WS_W, W_LRU = W_IN + (size_t)NIN_PAD * DM * 2, W_ATT = W_LRU + 2 * MiB, W_OUT = W_ATT + 2 * MiB, W_PG = W_OUT + 2 * MiB,
                 W_UP = W_PG + 2 * MiB, W_DOWN = W_UP + 12 * MiB, W_PP = W_DOWN + 6 * MiB, W_GATE = W_PP + MiB / 2, W_END = W_GATE + MiB / 2;
static_assert(W_END <= 48 * MiB, "weights region");
constexpr size_t WS_A0 = 48 * MiB;
constexpr size_t WS_IDX = 48 * MiB, WS_NV = 64 * MiB;
constexpr size_t WS_K8 = 72 * MiB, WS_V8 = 80 * MiB;
constexpr size_t WS_T1 = 48 * MiB;
constexpr size_t WS_X1H = 48 * MiB;
constexpr size_t WS_PH = 112 * MiB;
constexpr size_t WS_LX = 128 * MiB;
constexpr size_t WS_GG = 192 * MiB;
constexpr size_t WS_Q = 256 * MiB;
constexpr size_t WS_K = 320 * MiB, WS_V = 336 * MiB;
constexpr size_t WS_QI = 352 * MiB;
constexpr size_t WS_SGA = 384 * MiB, WS_SGB = 448 * MiB;
constexpr size_t WS_UPG = 128 * MiB, WS_UPV = 320 * MiB;
constexpr size_t WS_X2H = 128 * MiB;
constexpr size_t WS_GS = 320 * MiB;
constexpr size_t WS_END = 512 * MiB;
constexpr int CW_BAR = 1024;
constexpr int CW_Q2 = 8192, CW_Q3 = 8192 + 256;
constexpr size_t CTL_SSQ1 = 256 * 1024, CTL_SSQ2 = 512 * 1024;
static_assert((CW_BAR + XCD_BAR_WORDS) * 4 <= 32768 && CTL_SSQ2 + MTOK * 4 <= CTL_ZERO_BYTES, "ctl map");

constexpr int LDS_BYTES = 159744;
constexpr int MISC_OFF = LDS_BYTES - 256;

struct Params {
    const float* in[25]; float* out; unsigned char* ws; int ph_lo, ph_hi, k_ple, pad;
};

#define DPP_ADDF(v, ctl, rm) v += __builtin_bit_cast(float, __builtin_amdgcn_update_dpp(0, __builtin_bit_cast(int, v), ctl, rm, 0xf, false))
__device__ __forceinline__ float row_sum(float v) { DPP_ADDF(v, 0xB1, 0xf); DPP_ADDF(v, 0x4E, 0xf); DPP_ADDF(v, 0x141, 0xf); DPP_ADDF(v, 0x140, 0xf); return v; }
__device__ __forceinline__ float wave_sum(float v) { v = row_sum(v); DPP_ADDF(v, 0x142, 0xa); DPP_ADDF(v, 0x143, 0xc); return __builtin_bit_cast(float, __builtin_amdgcn_readlane(__builtin_bit_cast(int, v), 63)); }
__device__ __forceinline__ float half_sum(float v, int lane) { v = row_sum(v); DPP_ADDF(v, 0x142, 0xa);
    const float lo = __builtin_bit_cast(float, __builtin_amdgcn_readlane(__builtin_bit_cast(int, v), 31)), hi = __builtin_bit_cast(float, __builtin_amdgcn_readlane(__builtin_bit_cast(int, v), 63)); return lane < 32 ? lo : hi; }
template <int MAP> __device__ __forceinline__ int rowmap(int n) {
    if (MAP == 1) return n < 4168 ? n : n + 184;
    if (MAP == 2) return n < DFF ? ((n >> 7) * 256 + (n & 127)) : (((n - DFF) >> 7) * 256 + 128 + ((n - DFF) & 127));
    return n;
}
template <int MAP> __device__ __forceinline__ void p0_transpose_item(const float* W, int K, int N, h16* WT, const float* gain, LAS float* scr, int item, int lane) {
    const int nblk = (N + 31) / 32, kb = item / nblk, nb = item % nblk, k0 = 64 * kb, n0 = 32 * nb;
    const int nn = n0 + (lane & 31);
    float wv_[32];
#pragma unroll
    for (int i = 0; i < 32; ++i) { const int kk = 2 * i + (lane >> 5); wv_[i] = 0.f; if (nn < N) wv_[i] = W[(size_t)(k0 + kk) * N + nn]; }
    const int c = lane & 7;
    float gk[8];
#pragma unroll
    for (int j = 0; j < 8; ++j) gk[j] = 1.f;
    if (gain) { const f32x4 g0 = *(const f32x4*)(gain + k0 + 8 * c), g1 = *(const f32x4*)(gain + k0 + 8 * c + 4);
#pragma unroll
        for (int j = 0; j < 4; ++j) { gk[j] = g0[j]; gk[4 + j] = g1[j]; } }
#pragma unroll
    for (int i = 0; i < 32; ++i) { const int kk = 2 * i + (lane >> 5); scr[kk * 33 + (lane & 31)] = wv_[i]; }
    LDS_WAIT(); asm volatile("" ::: "memory");
#pragma unroll
    for (int j = 0; j < 4; ++j) { const int n = (lane >> 3) + 8 * j; const LAS float* s = scr + (8 * c) * 33 + n;
        u32x4 o; o.x = pkh(s[0 * 33] * gk[0], s[1 * 33] * gk[1]); o.y = pkh(s[2 * 33] * gk[2], s[3 * 33] * gk[3]); o.z = pkh(s[4 * 33] * gk[4], s[5 * 33] * gk[5]); o.w = pkh(s[6 * 33] * gk[6], s[7 * 33] * gk[7]);
        if (n0 + n < N) *(u32x4*)(WT + (size_t)rowmap<MAP>(n0 + n) * K + k0 + 8 * c) = o; }
    LDS_WAIT(); asm volatile("" ::: "memory");
}

struct Ctx {
    unsigned char* ws; float* out; int dry;
    const float *conv_w, *conv_b, *ba, *bx, *lam, *qn, *kn, *relb, *fcw, *fcb;
};
__device__ __forceinline__ unsigned ordered_u32(float v) { const unsigned u = __builtin_bit_cast(unsigned, v); return u ^ ((unsigned)((int)u >> 31) | 0x80000000u); }

constexpr int UA_STR = 272;
constexpr int LRU_UA = 0, LRU_HL = 128 * UA_STR, LRU_PP = 2 * 128 * UA_STR;
__device__ __forceinline__ void lru1_item(const Ctx& C, LAS unsigned char* lds, int item) {
    int tid = threadIdx.x; asm volatile("" : "+v"(tid));
    const int lane = tid & 63, wv = tid >> 6;
    const int b = item >> 7, n = (item >> 4) & 7, jg = item & 15;
    const h16* LX = (const h16*)(C.ws + WS_LX);
    const int cg = tid & 15, rg = tid >> 4, ch0 = n * 128 + cg * 8, tl = rg * 4;
    float cb[8], cw[4][8];
    { const f32x4 t0 = *(const f32x4*)(C.conv_b + ch0), t1 = *(const f32x4*)(C.conv_b + ch0 + 4); for (int e = 0; e < 4; ++e) { cb[e] = t0[e]; cb[4 + e] = t1[e]; } }
#pragma unroll
    for (int jj = 0; jj < 4; ++jj) { const f32x4 w0 = *(const f32x4*)(C.conv_w + jj * DM + ch0), w1 = *(const f32x4*)(C.conv_w + jj * DM + ch0 + 4); for (int e = 0; e < 4; ++e) { cw[jj][e] = w0[e]; cw[jj][4 + e] = w1[e]; } }
    const int q = lane & 15, c = lane >> 4, oc = wv * 16 + q, ch = n * 128 + oc;
    const h16* WG = (const h16*)(C.ws + W_GATE) + (size_t)n * 256 * 128;
    h8 Ba[4], Bx[4];
#pragma unroll
    for (int ks = 0; ks < 4; ++ks) { Ba[ks] = *(const h8*)(WG + (size_t)oc * 128 + 32 * ks + 8 * c); Bx[ks] = *(const h8*)(WG + (size_t)(128 + oc) * 128 + 32 * ks + 8 * c); }
    const float bav = C.ba[ch], bxv = C.bx[ch], m8sp = -8.0f * 1.4426950408889634f * log1pf(expf(-C.lam[ch]));
    h8 xr[7];
#define LRU_LOADX(jn) do { const int tseq_ = (jn) * 128 + tl; _Pragma("unroll") for (int i = 0; i < 7; ++i) { const int tt = tseq_ - 3 + i; if (tt >= 0) xr[i] = *(const h8*)(LX + ((size_t)b * SEQ + tt) * DM + ch0); else { for (int e = 0; e < 8; ++e) xr[i][e] = (h16)0.f; } } } while (0)
    LRU_LOADX(jg * 4);
#pragma unroll 1
    for (int j4 = 0; j4 < 4; ++j4) {
    const int j = jg * 4 + j4;
    const size_t mrow0 = (size_t)b * SEQ + (size_t)j * 128;
    {
        float y[4][8];
#pragma unroll
        for (int r = 0; r < 4; ++r)
#pragma unroll
            for (int e = 0; e < 8; ++e) y[r][e] = cb[e];
#pragma unroll
        for (int jj = 0; jj < 4; ++jj)
#pragma unroll
            for (int r = 0; r < 4; ++r)
#pragma unroll
                for (int e = 0; e < 8; ++e) y[r][e] += cw[jj][e] * (float)xr[r + jj][e];
#pragma unroll
        for (int r = 0; r < 4; ++r) { u32x4 w; w.x = pkh(y[r][0], y[r][1]); w.y = pkh(y[r][2], y[r][3]); w.z = pkh(y[r][4], y[r][5]); w.w = pkh(y[r][6], y[r][7]);
            *(LAS u32x4*)(lds + LRU_UA + (tl + r) * UA_STR + cg * 16) = w; }
        if (j4 < 3) LRU_LOADX(j + 1);
    }
    __syncthreads();
    {
        float cH = 0.f, cP = 1.f;
        for (int tt = 0; tt < 8; ++tt) {
            f32x4 aa = {0.f, 0.f, 0.f, 0.f}, ax = {0.f, 0.f, 0.f, 0.f};
#pragma unroll
            for (int ks = 0; ks < 4; ++ks) { const h8 A = *(const LAS h8*)(lds + LRU_UA + (16 * tt + q) * UA_STR + (32 * ks + 8 * c) * 2);
                aa = __builtin_amdgcn_mfma_f32_16x16x32_f16(A, Ba[ks], aa, 0, 0, 0); ax = __builtin_amdgcn_mfma_f32_16x16x32_f16(A, Bx[ks], ax, 0, 0, 0); }
            float hl[4], pl[4]; float h = 0.f, p = 1.f;
#pragma unroll
            for (int i = 0; i < 4; ++i) { const int t = 16 * tt + 4 * c + i;
                const float uav = (float)*(const LAS h16*)(lds + LRU_UA + t * UA_STR + oc * 2);
                const float ra = sigmoid_f(aa[i] + bav), ix = sigmoid_f(ax[i] + bxv);
                const float a = __builtin_amdgcn_exp2f(m8sp * ra);
                const float mult = __builtin_amdgcn_sqrtf(fmaxf(1.0f - a * a, 0.f));
                const float u = mult * ix * uav;
                h = a * h + u; p *= a; hl[i] = h; pl[i] = p; }
            float Ak[4], Hk[4];
#pragma unroll
            for (int k = 0; k < 4; ++k) { Ak[k] = __shfl(p, q + 16 * k); Hk[k] = __shfl(h, q + 16 * k); }
            float PA = 1.f, PH = 0.f;
#pragma unroll
            for (int k = 0; k < 3; ++k) if (k < c) { PH = PH * Ak[k] + Hk[k]; PA *= Ak[k]; }
            const float hin = cH * PA + PH, pin = cP * PA;
#pragma unroll
            for (int i = 0; i < 4; ++i) { const int t = 16 * tt + 4 * c + i;
                *(LAS h16*)(lds + LRU_HL + t * UA_STR + oc * 2) = (h16)(hl[i] + pl[i] * hin);
                *(LAS h16*)(lds + LRU_PP + t * UA_STR + oc * 2) = (h16)(pin * pl[i]); }
            const float AT = Ak[0] * Ak[1] * Ak[2] * Ak[3], HT = ((Hk[0] * Ak[1] + Hk[1]) * Ak[2] + Hk[2]) * Ak[3] + Hk[3];
            cH = cH * AT + HT; cP = cP * AT;
        }
        if (c == 0 && !C.dry) { const size_t so = ((size_t)b * 64 + j) * DM + ch; ((float*)(C.ws + WS_SA))[so] = cP; ((float*)(C.ws + WS_SH))[so] = cH; }
    }
    __syncthreads();
    {
        h16* HLOC = (h16*)C.out; h16* PPRD = (h16*)C.out + (size_t)MTOK * DM;
#pragma unroll
        for (int r = 0; r < 4; ++r) { const int t = rg * 4 + r; const size_t go = (mrow0 + t) * DM + n * 128 + cg * 8;
            const u32x4 w0 = *(const LAS u32x4*)(lds + LRU_HL + t * UA_STR + cg * 16), w1 = *(const LAS u32x4*)(lds + LRU_PP + t * UA_STR + cg * 16);
            if (!C.dry) { *(u32x4*)(HLOC + go) = w0; *(u32x4*)(PPRD + go) = w1; } }
    }
    __syncthreads();
    }
#undef LRU_LOADX
}

__device__ __forceinline__ void lru2_item(const Ctx& C, LAS unsigned char* lds, int item) {
    int tid = threadIdx.x; asm volatile("" : "+v"(tid));
    const int b = item >> 7, n = (item >> 4) & 7, jg = item & 15, j0 = jg * 4;
    LAS float* carry = (LAS float*)lds;
    const int cg = tid & 15, rg = tid >> 4; const h16* HLOC = (const h16*)C.out; const h16* PPRD = (const h16*)C.out + (size_t)MTOK * DM;
    const h16* GG = (const h16*)(C.ws + WS_GG); h16* YA = (h16*)(C.ws + WS_LX);
    h8 nhl[4], npp[4], ngg[4];
#define LRU2_LOAD(kk) do { _Pragma("unroll") for (int r = 0; r < 4; ++r) { const size_t go_ = ((size_t)b * SEQ + (j0 + (kk)) * 128 + rg * 4 + r) * DM + n * 128 + cg * 8; \
        nhl[r] = *(const h8*)(HLOC + go_); npp[r] = *(const h8*)(PPRD + go_); ngg[r] = *(const h8*)(GG + go_); } } while (0)
    LRU2_LOAD(0);
    if (tid < 128) { const int ch = n * 128 + tid; const float* SA = (const float*)(C.ws + WS_SA) + (size_t)b * 64 * DM + ch; const float* SH = (const float*)(C.ws + WS_SH) + (size_t)b * 64 * DM + ch;
        float cr = 0.f; int jj = 0;
        for (; jj + 16 <= j0; jj += 16) { float a8[16], h8v[16];
#pragma unroll
            for (int k = 0; k < 16; ++k) { a8[k] = SA[(size_t)(jj + k) * DM]; h8v[k] = SH[(size_t)(jj + k) * DM]; }
#pragma unroll
            for (int k = 0; k < 16; ++k) cr = a8[k] * cr + h8v[k]; }
        for (; jj + 4 <= j0; jj += 4) { float a8[4], h8v[4];
#pragma unroll
            for (int k = 0; k < 4; ++k) { a8[k] = SA[(size_t)(jj + k) * DM]; h8v[k] = SH[(size_t)(jj + k) * DM]; }
#pragma unroll
            for (int k = 0; k < 4; ++k) cr = a8[k] * cr + h8v[k]; }
        for (; jj < j0; ++jj) cr = SA[(size_t)jj * DM] * cr + SH[(size_t)jj * DM];
        float a4[4], h4[4];
#pragma unroll
        for (int k = 0; k < 4; ++k) { a4[k] = SA[(size_t)(j0 + k) * DM]; h4[k] = SH[(size_t)(j0 + k) * DM]; }
#pragma unroll
        for (int k = 0; k < 4; ++k) { carry[k * 128 + tid] = cr; cr = a4[k] * cr + h4[k]; } }
    __syncthreads();
#pragma unroll 1
    for (int k = 0; k < 4; ++k) {
        float cr[8];
#pragma unroll
        for (int e = 0; e < 8; ++e) cr[e] = carry[k * 128 + cg * 8 + e];
        h8 hl[4], pp[4], gg[4];
#pragma unroll
        for (int r = 0; r < 4; ++r) { hl[r] = nhl[r]; pp[r] = npp[r]; gg[r] = ngg[r]; }
        if (k < 3) LRU2_LOAD(k + 1);
#pragma unroll
        for (int r = 0; r < 4; ++r) { const size_t go = ((size_t)b * SEQ + (j0 + k) * 128 + rg * 4 + r) * DM + n * 128 + cg * 8;
            float y[8];
#pragma unroll
            for (int e = 0; e < 8; ++e) y[e] = ((float)hl[r][e] + (float)pp[r][e] * cr[e]) * (float)gg[r][e];
            u32x4 w; w.x = pkh(y[0], y[1]); w.y = pkh(y[2], y[3]); w.z = pkh(y[4], y[5]); w.w = pkh(y[6], y[7]);
            if (!C.dry) *(u32x4*)(YA + go) = w; } }
#undef LRU2_LOAD
}

__device__ __forceinline__ unsigned pk4_fp8_k(float a, float b, float c, float d) { int w = 0; w = __builtin_amdgcn_cvt_pk_fp8_f32(a, b, w, false); w = __builtin_amdgcn_cvt_pk_fp8_f32(c, d, w, true); return (unsigned)w; }
__device__ __forceinline__ void knorm_unit(const Ctx& C, int unit) {
    int tid = threadIdx.x; asm volatile("" : "+v"(tid));
    const int lane = tid & 63, wv = tid >> 6;
    const h16* K = (const h16*)(C.ws + WS_K); const h16* V = (const h16*)(C.ws + WS_V);
    unsigned* K8 = (unsigned*)(C.ws + WS_K8); unsigned* V8 = (unsigned*)(C.ws + WS_V8);
    const int col = lane * 4, d0 = col & 127;
    const f32x4 g = *(const f32x4*)(C.kn + d0);
#pragma unroll 1
    for (int hb = 0; hb < 2; ++hb) {
        h4 kv[8], vvv[8];
#pragma unroll
        for (int r = 0; r < 8; ++r) { const size_t row = (size_t)unit * 128 + wv * 16 + hb * 8 + r; kv[r] = *(const h4*)(K + row * 256 + col); vvv[r] = *(const h4*)(V + row * 256 + col); }
#pragma unroll
        for (int r = 0; r < 8; ++r) { const size_t row = (size_t)unit * 128 + wv * 16 + hb * 8 + r;
            float ss = 0.f, f[4];
#pragma unroll
            for (int e = 0; e < 4; ++e) { f[e] = (float)kv[r][e]; ss += f[e] * f[e]; }
            ss = half_sum(ss, lane);
            const float rs = __builtin_amdgcn_rsqf(ss * (1.0f / 128.0f) + EPS);
            const unsigned wk = pk4_fp8_k(f[0] * rs * g[0], f[1] * rs * g[1], f[2] * rs * g[2], f[3] * rs * g[3]);
            const unsigned wvv = pk4_fp8_k((float)vvv[r][0], (float)vvv[r][1], (float)vvv[r][2], (float)vvv[r][3]);
            if (!C.dry) { K8[row * 64 + lane] = wk; V8[row * 64 + lane] = wvv; } } }
}

#ifdef IX_PROBE
#define IX_PROBE_FINAL (C.dry && (IX_PROBE & 2))
#define IX_PROBE_NOFILT (C.dry && (IX_PROBE & 1))
#else
#define IX_PROBE_FINAL 0
#define IX_PROBE_NOFILT 0
#endif
constexpr int IX_SK = 256;
constexpr int IX_CAP = 1024;
constexpr int IX_ORD = 0;
constexpr int IX_KEY = IX_ORD + 16 * IX_CAP * 4;
constexpr int IX_HIST = IX_KEY + 16 * IX_CAP * 2;
constexpr int IX_CTR = IX_HIST + 8 * 512;
constexpr int IX_END = IX_CTR + 128;
static_assert(IX_END <= MISC_OFF, "indexer LDS");
constexpr int IX_NE = IX_CAP / 64;

struct IxBuf { LAS unsigned* ord; LAS unsigned short* key; };
#define IX_DPPMAX(v, ctl, rm) { const unsigned t_ = (unsigned)__builtin_amdgcn_update_dpp((int)(v), (int)(v), ctl, rm, 0xf, false); v = t_ > v ? t_ : v; }
__device__ __forceinline__ unsigned ix_rowmax(unsigned v) { IX_DPPMAX(v, 0xB1, 0xf) IX_DPPMAX(v, 0x4E, 0xf) IX_DPPMAX(v, 0x141, 0xf) IX_DPPMAX(v, 0x140, 0xf) return v; }
__device__ __forceinline__ unsigned ix_wavemax(unsigned v) { v = ix_rowmax(v); IX_DPPMAX(v, 0x142, 0xa) IX_DPPMAX(v, 0x143, 0xc) return (unsigned)__builtin_amdgcn_readlane((int)v, 63); }
__device__ __forceinline__ void ix_load_ord(const IxBuf& B, int cnt, int lane, unsigned (&o)[IX_NE]) {
#pragma unroll
    for (int k = 0; k < IX_NE; ++k) { const int idx = k * 64 + lane; o[k] = idx < cnt ? B.ord[idx] : 0u; }
}
__device__ __forceinline__ int ix_count_ge(const unsigned (&o)[IX_NE], unsigned x) {
    int c = 0;
#pragma unroll
    for (int k = 0; k < IX_NE; ++k) c += (int)__builtin_popcountll(__ballot(o[k] >= x));
    return c;
}
__device__ __forceinline__ unsigned ix_max(const unsigned (&o)[IX_NE]) {
    unsigned m = 0u;
#pragma unroll
    for (int k = 0; k < IX_NE; ++k) m = o[k] > m ? o[k] : m;
    return ix_wavemax(m);
}
__device__ __forceinline__ unsigned ix_tie_thr(const unsigned (&o)[IX_NE], const unsigned short (&kk)[IX_NE], unsigned x, int need) {
    unsigned lo = 0u, hi = 0x10000u;
    while (hi - lo > 1u) { const unsigned mid = (lo + hi) >> 1; int c = 0;
#pragma unroll
        for (int k = 0; k < IX_NE; ++k) c += (int)__builtin_popcountll(__ballot(o[k] == x && (unsigned)kk[k] >= mid));
        if (c >= need) lo = mid; else hi = mid; }
    return lo;
}
__device__ __forceinline__ int ix_rewrite(const IxBuf& B, const unsigned (&o)[IX_NE], const unsigned short (&kk)[IX_NE], int lane, unsigned x, unsigned th) {
    int base = 0;
#pragma unroll
    for (int k = 0; k < IX_NE; ++k) { const bool keep = o[k] > x || (o[k] == x && (unsigned)kk[k] >= th);
        const u64 m = __ballot(keep); const int pos = base + (int)__builtin_amdgcn_mbcnt_hi((unsigned)(m >> 32), __builtin_amdgcn_mbcnt_lo((unsigned)m, 0u));
        if (keep) { B.ord[pos] = o[k]; B.key[pos] = kk[k]; }
        base += (int)__builtin_popcountll(m); }
    LDS_WAIT();
    return base;
}
__device__ __forceinline__ unsigned ix_sample_pivot(unsigned s0, int rank) {
    int r = 0;
#define IX_ROT(n) { const unsigned t_ = (unsigned)__builtin_amdgcn_update_dpp(0, (int)s0, 0x120 + n, 0xf, 0xf, false); r += t_ > s0 ? 1 : 0; }
    IX_ROT(1) IX_ROT(2) IX_ROT(3) IX_ROT(4) IX_ROT(5) IX_ROT(6) IX_ROT(7) IX_ROT(8) IX_ROT(9) IX_ROT(10) IX_ROT(11) IX_ROT(12) IX_ROT(13) IX_ROT(14) IX_ROT(15)
#undef IX_ROT
    unsigned v = r >= rank ? s0 : 0u;
    v = ix_rowmax(v);
    return ((unsigned)__builtin_amdgcn_readlane((int)v, 0) >> 2) + ((unsigned)__builtin_amdgcn_readlane((int)v, 16) >> 2) + ((unsigned)__builtin_amdgcn_readlane((int)v, 32) >> 2) + ((unsigned)__builtin_amdgcn_readlane((int)v, 48) >> 2);
}
__device__ __forceinline__ unsigned ix_find_window(const unsigned (&o)[IX_NE], unsigned lo, unsigned hi, int cnt, int cmin, int cmax, bool& tie) {
    tie = false;
    int rank = (16 * ((cmin + cmax) / 2)) / cnt; rank = rank > 14 ? 14 : rank;
    unsigned x = ix_sample_pivot(o[0], rank);
    if (x <= lo || x >= hi) x = lo + ((hi - lo) >> 1);
    for (;;) { const int c = ix_count_ge(o, x);
        if (c > cmax) lo = x; else if (c < cmin) hi = x; else return x - 1u;
        if (hi - lo <= 1u) { tie = true; return lo; }
        x = lo + ((hi - lo) >> 1); }
}
__device__ __forceinline__ unsigned ix_compact(const IxBuf& B, int lane, int& cnt, unsigned T) {
    unsigned o[IX_NE]; ix_load_ord(B, cnt, lane, o);
    unsigned short kk[IX_NE];
#pragma unroll
    for (int k = 0; k < IX_NE; ++k) kk[k] = B.key[k * 64 + lane];
    LDS_WAIT();
    bool tie; unsigned th = 0x10000u;
    const unsigned x = ix_find_window(o, T, ix_max(o) + 1u, cnt, 256, 320, tie);
    if (tie) th = ix_tie_thr(o, kk, x, 320 - ix_count_ge(o, x + 1u));
    cnt = ix_rewrite(B, o, kk, lane, x, th); return x + 1u;
}
__device__ __forceinline__ unsigned ix_compact_to(const IxBuf& B, int lane, int& cnt, unsigned T) {
    unsigned o[IX_NE]; ix_load_ord(B, cnt, lane, o);
    unsigned short kk[IX_NE];
#pragma unroll
    for (int k = 0; k < IX_NE; ++k) kk[k] = B.key[k * 64 + lane];
    LDS_WAIT();
    bool tie; unsigned th = 0x10000u;
    const unsigned x = ix_find_window(o, T, ix_max(o) + 1u, cnt, 256, 320, tie);
    if (tie) th = ix_tie_thr(o, kk, x, 320 - ix_count_ge(o, x + 1u));
    cnt = ix_rewrite(B, o, kk, lane, x, th); return x + 1u;
}
__device__ __forceinline__ void ix_final(const IxBuf& B, LAS unsigned short* outl, int lane, int cnt, unsigned T, unsigned short* idx_row, int* nv_ptr, int dry) {
    if (cnt > 320) { cnt = cnt < IX_CAP ? cnt : IX_CAP; T = ix_compact_to(B, lane, cnt, T); }
    unsigned o[5]; unsigned short kk[5];
#pragma unroll
    for (int k = 0; k < 5; ++k) { const int idx = k * 64 + lane; o[k] = idx < cnt ? B.ord[idx] : 0u; kk[k] = B.key[idx]; }
    LDS_WAIT();
    unsigned x = 0u, th = 0u;
    if (cnt > 256) { unsigned mxv = 0u;
#pragma unroll
        for (int k = 0; k < 5; ++k) mxv = o[k] > mxv ? o[k] : mxv;
        mxv = ix_wavemax(mxv);
        unsigned lo = T, hi = mxv + 1u;
        for (;;) { if (hi - lo <= 1u) { x = lo; int ca = 0, need;
#pragma unroll
                for (int k = 0; k < 5; ++k) ca += (int)__builtin_popcountll(__ballot(o[k] >= lo + 1u));
                need = 256 - ca; unsigned tl = 0u, thh = 0x10000u;
                while (thh - tl > 1u) { const unsigned mid = (tl + thh) >> 1; int c = 0;
#pragma unroll
                    for (int k = 0; k < 5; ++k) c += (int)__builtin_popcountll(__ballot(o[k] == x && (unsigned)kk[k] >= mid));
                    if (c >= need) tl = mid; else thh = mid; }
                th = tl; break; }
            const unsigned mid = lo + ((hi - lo) >> 1); int c = 0;
#pragma unroll
            for (int k = 0; k < 5; ++k) c += (int)__builtin_popcountll(__ballot(o[k] >= mid));
            if (c == 256) { x = mid - 1u; th = 0x10000u; break; }
            if (c > 256) lo = mid; else hi = mid; } }
    int base = 0;
#pragma unroll
    for (int k = 0; k < 5; ++k) { const bool valid = k * 64 + lane < cnt; const bool sel = valid && (o[k] > x || (o[k] == x && (unsigned)kk[k] >= th));
        const u64 m = __ballot(sel); const int pos = base + (int)__builtin_amdgcn_mbcnt_hi((unsigned)(m >> 32), __builtin_amdgcn_mbcnt_lo((unsigned)m, 0u));
        if (sel && pos < 256) outl[pos] = (unsigned short)(0xFFFFu - (unsigned)kk[k]);
        base += (int)__builtin_popcountll(m); }
    LDS_WAIT();
    const int nsel = base < 256 ? base : 256;
    const u32x2 ow = *(const LAS u32x2*)(outl + lane * 4);
    if (!dry) { *(u32x2*)(idx_row + lane * 4) = ow; if (lane == 0) *nv_ptr = nsel; }
    LDS_WAIT();
}
__device__ __forceinline__ float ix_unordered(unsigned T) { const unsigned u = (T & 0x80000000u) ? (T ^ 0x80000000u) : ~T; return __builtin_bit_cast(float, u); }

__device__ __forceinline__ void indexer_unit(const Ctx& C, LAS unsigned char* lds, int unit) {
    int tid = threadIdx.x; asm volatile("" : "+v"(tid));
    const int lane = tid & 63, wv = __builtin_amdgcn_readfirstlane(tid >> 6);
    const int b = unit & 3, qt = 511 - (unit >> 2), t0 = qt * 16;
    const int q = lane & 15, c = lane >> 4;
    const size_t m0 = (size_t)b * SEQ + t0;
    const h16* QI = (const h16*)(C.ws + WS_QI); const h16* KI = (const h16*)(C.ws + WS_KI) + (size_t)b * SEQ * 64; const float* WI = (const float*)(C.ws + WS_WI);
    LAS unsigned* cntl = (LAS unsigned*)(lds + IX_CTR); volatile LAS float* taul = (volatile LAS float*)(lds + IX_CTR + 64);
    if (tid < 16) { cntl[tid] = 0u; taul[tid] = -3.402823466e38f; }
    const int nkeys = t0 + 16, nslab = (nkeys + IX_SK - 1) / IX_SK;
#define IX_LOADK(dst, s_) do { const int sc_ = (s_) < nslab - 1 ? (s_) : nslab - 1; _Pragma("unroll") for (int jt_ = 0; jt_ < 2; ++jt_) { int key0_ = sc_ * IX_SK + 32 * wv + 16 * jt_; key0_ = key0_ < nkeys ? key0_ : nkeys - 16; \
        const h16* p_ = KI + ((size_t)(key0_ >> 4) * 128 + lane) * 8;        \
        asm volatile("global_load_dwordx4 %0, %2, off\n\tglobal_load_dwordx4 %1, %2, off offset:1024" : "=&v"(dst[jt_][0]), "=&v"(dst[jt_][1]) : "v"(p_) : "memory"); } } while (0)
#define IX_WAITK(KF) asm volatile("s_waitcnt vmcnt(4)" : "+v"(KF[0][0]), "+v"(KF[0][1]), "+v"(KF[1][0]), "+v"(KF[1][1]) :: "memory")
    h8 ka[2][2], kb[2][2];
    IX_LOADK(ka, 0); IX_LOADK(kb, 1);
    h8 qf[8][2];
#pragma unroll
    for (int h = 0; h < 8; ++h)
#pragma unroll
        for (int ks = 0; ks < 2; ++ks) qf[h][ks] = *(const h8*)(QI + ((((m0 >> 4) * 8 + h) * 2 + ks) * 64 + lane) * 8);
    float wvv[8]; { const f32x4 w0 = *(const f32x4*)(WI + (m0 + q) * 8), w1 = *(const f32x4*)(WI + (m0 + q) * 8 + 4); for (int e = 0; e < 4; ++e) { wvv[e] = w0[e]; wvv[4 + e] = w1[e]; } }
#pragma unroll
    for (int h = 0; h < 8; ++h) wvv[h] *= 0.5f;
    h8 qs[2];
#pragma unroll
    for (int ks = 0; ks < 2; ++ks)
#pragma unroll
        for (int j = 0; j < 8; ++j) { float a = 0.f;
#pragma unroll
            for (int h = 0; h < 8; ++h) a += wvv[h] * (float)qf[h][ks][j];
            qs[ks][j] = (h16)a; }
    LAS unsigned* ordq = (LAS unsigned*)(lds + IX_ORD) + (size_t)q * IX_CAP; LAS unsigned short* keyq = (LAS unsigned short*)(lds + IX_KEY) + (size_t)q * IX_CAP;
    IxBuf BA, BB;
    BA.ord = (LAS unsigned*)(lds + IX_ORD) + (size_t)(2 * wv) * IX_CAP; BA.key = (LAS unsigned short*)(lds + IX_KEY) + (size_t)(2 * wv) * IX_CAP;
    BB.ord = BA.ord + IX_CAP; BB.key = BA.key + IX_CAP;
    LAS unsigned short* outl = (LAS unsigned short*)(lds + IX_HIST) + wv * 256;
    unsigned TA = 0x00800000u, TB = 0x00800000u; float tq = -3.402823466e38f;
    __syncthreads();
#define IX_MM2(KF, A_, B_, Q0, Q1) do { A_ = __builtin_amdgcn_mfma_f32_16x16x32_f16(KF[0][0], Q0, (f32x4){0.f, 0.f, 0.f, 0.f}, 0, 0, 0); B_ = __builtin_amdgcn_mfma_f32_16x16x32_f16(KF[1][0], Q0, (f32x4){0.f, 0.f, 0.f, 0.f}, 0, 0, 0); \
        A_ = __builtin_amdgcn_mfma_f32_16x16x32_f16(KF[0][1], Q1, A_, 0, 0, 0); B_ = __builtin_amdgcn_mfma_f32_16x16x32_f16(KF[1][1], Q1, B_, 0, 0, 0); } while (0)
#define IX_SCORE2(KF, sca, scb) do { \
        f32x4 ta_[2], tb_[2]; \
        IX_MM2(KF, sca, scb, qs[0], qs[1]); IX_MM2(KF, ta_[0], tb_[0], qf[0][0], qf[0][1]); \
        _Pragma("unroll") for (int h = 0; h < 8; ++h) {        \
            __builtin_amdgcn_sched_barrier(0); \
            if (h < 7) IX_MM2(KF, ta_[(h + 1) & 1], tb_[(h + 1) & 1], qf[h + 1][0], qf[h + 1][1]); \
            __builtin_amdgcn_sched_barrier(0); \
            _Pragma("unroll") for (int i = 0; i < 4; ++i) { sca[i] = __builtin_fmaf(wvv[h], __builtin_fabsf(ta_[h & 1][i]), sca[i]); asm("" : "+v"(sca[i])); }   \
            _Pragma("unroll") for (int i = 0; i < 4; ++i) { scb[i] = __builtin_fmaf(wvv[h], __builtin_fabsf(tb_[h & 1][i]), scb[i]); asm("" : "+v"(scb[i])); } } \
        __builtin_amdgcn_sched_barrier(0); } while (0)
#define IX_SCORE(KF, sc, jt, key0) do { \
        sc = __builtin_amdgcn_mfma_f32_16x16x32_f16(KF[jt][0], qs[0], (f32x4){0.f, 0.f, 0.f, 0.f}, 0, 0, 0); sc = __builtin_amdgcn_mfma_f32_16x16x32_f16(KF[jt][1], qs[1], sc, 0, 0, 0); \
        _Pragma("unroll") for (int h = 0; h < 8; ++h) { f32x4 a = {0.f, 0.f, 0.f, 0.f}; \
            a = __builtin_amdgcn_mfma_f32_16x16x32_f16(KF[jt][0], qf[h][0], a, 0, 0, 0); a = __builtin_amdgcn_mfma_f32_16x16x32_f16(KF[jt][1], qf[h][1], a, 0, 0, 0); \
            _Pragma("unroll") for (int i = 0; i < 4; ++i) { sc[i] = __builtin_fmaf(wvv[h], __builtin_fabsf(a[i]), sc[i]); asm("" : "+v"(sc[i])); } } } while (0)
#define IX_MASK(sc, key0) do { if ((key0) + 15 > t0) {        \
            _Pragma("unroll") for (int i = 0; i < 4; ++i) if ((key0) + 4 * c + i > t0 + q) sc[i] = -INFINITY; } } while (0)
#define IX_ASK(sc, ps, pos) do { _Pragma("unroll") for (int i = 0; i < 4; ++i) { ps[i] = sc[i] >= tq; pos[i] = 0u; if (ps[i]) pos[i] = __hip_atomic_fetch_add(cntl + q, 1u, __ATOMIC_RELAXED, __HIP_MEMORY_SCOPE_WORKGROUP); } } while (0)
#define IX_PUT(sc, ps, pos, key0) do { _Pragma("unroll") for (int i = 0; i < 4; ++i) if (ps[i]) { ordq[pos[i]] = ordered_u32(sc[i] + 0.0f); keyq[pos[i]] = (unsigned short)(0xFFFFu - (unsigned)((key0) + 4 * c + i)); } } while (0)
#define IX_STEP(sv, KF) do { const int s_ = (sv); if (s_ < nslab) { \
        IX_WAITK(KF); \
        const int key0a = s_ * IX_SK + (2 * wv) * 16, key0b = key0a + 16; \
        const bool hb = key0b < nkeys;                                 \
        if (key0a < nkeys) { \
            f32x4 sca, scb; bool psa[4], psb[4]; unsigned posa[4], posb[4]; \
            if (hb) { IX_SCORE2(KF, sca, scb); IX_MASK(sca, key0a); IX_MASK(scb, key0b); \
                if (!IX_PROBE_NOFILT) { IX_ASK(sca, psa, posa); IX_ASK(scb, psb, posb); IX_PUT(sca, psa, posa, key0a); IX_PUT(scb, psb, posb, key0b); } } \
            else { IX_SCORE(KF, sca, 0, key0a); IX_MASK(sca, key0a); if (!IX_PROBE_NOFILT) { IX_ASK(sca, psa, posa); IX_PUT(sca, psa, posa, key0a); } } \
        } \
        IX_LOADK(KF, s_ + 2);                                         \
        LDS_WAIT(); \
        __syncthreads(); \
        const unsigned mycnt = cntl[q];                               \
        if (__ballot(mycnt > (unsigned)(IX_CAP - IX_SK)) != 0ull) {       \
            int ca = (int)cntl[2 * wv], cb = (int)cntl[2 * wv + 1]; ca = ca < IX_CAP ? ca : IX_CAP; cb = cb < IX_CAP ? cb : IX_CAP; \
            if (ca > 512) { TA = ix_compact(BA, lane, ca, TA); if (lane == 0) { cntl[2 * wv] = (unsigned)ca; taul[2 * wv] = ix_unordered(TA); } } \
            if (cb > 512) { TB = ix_compact(BB, lane, cb, TB); if (lane == 0) { cntl[2 * wv + 1] = (unsigned)cb; taul[2 * wv + 1] = ix_unordered(TB); } } \
            LDS_WAIT(); \
            __syncthreads(); \
            tq = taul[q]; } \
        } } while (0)
    for (int s = 0; s < nslab; s += 2) { IX_STEP(s, ka); IX_STEP(s + 1, kb); }
    asm volatile("s_waitcnt vmcnt(0)" : "+v"(ka[0][0]), "+v"(ka[0][1]), "+v"(ka[1][0]), "+v"(ka[1][1]), "+v"(kb[0][0]), "+v"(kb[0][1]), "+v"(kb[1][0]), "+v"(kb[1][1]) :: "memory");
#undef IX_STEP
#undef IX_SCORE
#undef IX_SCORE2
#undef IX_MM2
#undef IX_MASK
#undef IX_ASK
#undef IX_PUT
#undef IX_LOADK
#undef IX_WAITK
    LDS_WAIT();
    if (IX_PROBE_FINAL) return;
    unsigned short* IDX = (unsigned short*)(C.ws + WS_IDX); int* NV = (int*)(C.ws + WS_NV);
    int ca = (int)cntl[2 * wv], cb = (int)cntl[2 * wv + 1]; ca = ca < IX_CAP ? ca : IX_CAP; cb = cb < IX_CAP ? cb : IX_CAP;
    ix_final(BA, outl, lane, ca, TA, IDX + (m0 + 2 * wv) * 256, NV + m0 + 2 * wv, C.dry);
    ix_final(BB, outl, lane, cb, TB, IDX + (m0 + 2 * wv + 1) * 256, NV + m0 + 2 * wv + 1, C.dry);
}


constexpr int AT_CH = 4096;
constexpr int AT_NR = 4;
constexpr int AT_WAVE = AT_NR * AT_CH + 1024;
constexpr int AT_TAB = 8 * AT_WAVE;
constexpr int AT_QN = AT_TAB + 129 * 8 * 4;
constexpr int AT_END = AT_QN + 512;
static_assert(AT_END + 1024 <= MISC_OFF && (AT_WAVE % 16) == 0 && (AT_QN % 16) == 0, "attention LDS");
constexpr int AT_QPW = 8;
__device__ __forceinline__ int at_f(int row) { return 2 * ((row >> 1) & 3) | ((row >> 3) & 1); }

__device__ __forceinline__ void attn_build_tab(const Ctx& C, LAS unsigned char* lds) {
    LAS float* tab = (LAS float*)(lds + AT_TAB);
    for (int e = threadIdx.x; e < 129 * 8; e += NTHR) { const int d = e >> 3, h = e & 7; int bk;
        if (d < 16) bk = d; else { bk = 16 + (int)(logf((float)d / 16.0f) / 2.0794415416798357f * 16.0f); if (bk > 31) bk = 31; }
        tab[e] = C.relb[bk * 8 + h]; }
    if (threadIdx.x < 128) ((LAS float*)(lds + AT_QN))[threadIdx.x] = C.qn[threadIdx.x];
}
__device__ __forceinline__ void at_issue(const unsigned char* base, const LAS unsigned short* idl, int pos0, LAS unsigned char* buf, int lane) {
#pragma unroll
    for (int k2 = 0; k2 < 4; ++k2) { const int row = (lane >> 3) + 8 * k2, slot = lane & 7; const int idx = idl[pos0 + row];
        __builtin_amdgcn_global_load_lds((const unsigned*)(base + (size_t)idx * 256 + ((slot ^ at_f(row)) << 4)), (LAS unsigned*)(buf + k2 * 1024), 16, 0, 0); }
}
__device__ __forceinline__ unsigned pk4_fp8(float a, float b, float c, float d) { int w = 0; w = __builtin_amdgcn_cvt_pk_fp8_f32(a, b, w, false); w = __builtin_amdgcn_cvt_pk_fp8_f32(c, d, w, true); return (unsigned)w; }
__device__ __forceinline__ long mk64(unsigned lo, unsigned hi) { return (long)(((u64)hi << 32) | (u64)lo); }
#define AT_WAITN(n) asm volatile("s_waitcnt vmcnt(" #n ")" ::: "memory")

__device__ __forceinline__ void attn_item(const Ctx& C, LAS unsigned char* lds, int item) {
    int tid = threadIdx.x; asm volatile("" : "+v"(tid));
    const int lane = tid & 63, wv = __builtin_amdgcn_readfirstlane(tid >> 6);
    const int g = lane & 15, c = lane >> 4, gq = g & 3;
    const int qsel = item / (SEQ / (8 * AT_QPW)), b = qsel >> 1, n = qsel & 1, tbase = (item % (SEQ / (8 * AT_QPW))) * (8 * AT_QPW) + wv;
    LAS unsigned char* ring = lds + wv * AT_WAVE;
    LAS unsigned short* idlb = (LAS unsigned short*)(ring + AT_NR * AT_CH);
    const LAS float* tab = (const LAS float*)(lds + AT_TAB);
    const LAS float* qnl = (const LAS float*)(lds + AT_QN);
    const unsigned char* Kb = (const unsigned char*)(C.ws + WS_K8) + (size_t)b * SEQ * 256 + n * 128; const unsigned char* Vb = (const unsigned char*)(C.ws + WS_V8) + (size_t)b * SEQ * 256 + n * 128;
    const unsigned short* IDXb = (const unsigned short*)(C.ws + WS_IDX) + (size_t)b * SEQ * 256; const int* NVb = (const int*)(C.ws + WS_NV) + (size_t)b * SEQ;
    h16* Qb = (h16*)(C.ws + WS_Q) + (size_t)b * SEQ * DM + n * 512;
    const int fg = at_f(g), q4 = g >> 2, p4 = g & 3, rowA = 4 * c + q4, fr = at_f(rowA);
    u32x2 a_idx; int a_nv; h8 a_q[4];
#define AT_STAGE_A(tq) do { const size_t m_ = (size_t)(tq); a_idx = *(const u32x2*)(IDXb + m_ * 256 + lane * 4); a_nv = NVb[m_]; \
        _Pragma("unroll") for (int ks = 0; ks < 4; ++ks) a_q[ks] = *(const h8*)(Qb + m_ * DM + gq * 128 + 32 * c + 8 * ks); } while (0)
#define AT_STAGE_B(idl_, qf_, nv_) do { nv_ = a_nv; { const int p0 = lane * 4; unsigned s0 = a_idx.x & 0xFFFFu, s1 = a_idx.x >> 16, s2 = a_idx.y & 0xFFFFu, s3 = a_idx.y >> 16; \
          if (p0 + 0 >= nv_) s0 = 0; if (p0 + 1 >= nv_) s1 = 0; if (p0 + 2 >= nv_) s2 = 0; if (p0 + 3 >= nv_) s3 = 0; \
          u32x2 o_; o_.x = s0 | (s1 << 16); o_.y = s2 | (s3 << 16); *(LAS u32x2*)((idl_) + lane * 4) = o_; } \
        float ss_ = 0.f; _Pragma("unroll") for (int ks = 0; ks < 4; ++ks) _Pragma("unroll") for (int e = 0; e < 8; ++e) { const float x_ = (float)a_q[ks][e]; ss_ += x_ * x_; } \
        ss_ += __shfl_xor(ss_, 16); ss_ += __shfl_xor(ss_, 32); \
        const float rs_ = g < 4 ? __builtin_amdgcn_rsqf(ss_ * (1.0f / 128.0f) + EPS) : 0.f; \
        _Pragma("unroll") for (int ks = 0; ks < 4; ++ks) { const f32x4 g0 = *(const LAS f32x4*)(qnl + 32 * c + 8 * ks), g1 = *(const LAS f32x4*)(qnl + 32 * c + 8 * ks + 4); \
            qf_[ks] = mk64(pk4_fp8((float)a_q[ks][0] * rs_ * g0[0], (float)a_q[ks][1] * rs_ * g0[1], (float)a_q[ks][2] * rs_ * g0[2], (float)a_q[ks][3] * rs_ * g0[3]), \
                           pk4_fp8((float)a_q[ks][4] * rs_ * g1[0], (float)a_q[ks][5] * rs_ * g1[1], (float)a_q[ks][6] * rs_ * g1[2], (float)a_q[ks][7] * rs_ * g1[3])); } \
        LDS_WAIT(); } while (0)
    long qf[4]; int nv;
    AT_STAGE_A(tbase);
    AT_STAGE_B(idlb, qf, nv);
    AT_WAITN(0);
#pragma unroll
    for (int i = 0; i < AT_NR; ++i) at_issue(Kb, idlb, 32 * i, ring + i * AT_CH, lane);
#pragma unroll 1
    for (int k = 0; k < AT_QPW; ++k) {
        const int t = tbase + 8 * k, tn = k + 1 < AT_QPW ? t + 8 : t;
        const LAS unsigned short* idl = idlb + (k & 1) * 256; LAS unsigned short* idln = idlb + ((k + 1) & 1) * 256;
        float S[16][4];
#pragma unroll
        for (int kc = 0; kc < 8; ++kc) {
            LAS unsigned char* buf = ring + (kc & 3) * AT_CH;
            if (kc <= 4) AT_WAITN(12); else AT_WAITN(18);
#pragma unroll
            for (int j = 0; j < 2; ++j) { f32x4 a = {0.f, 0.f, 0.f, 0.f};
                const u32x4 A0 = *(const LAS u32x4*)(buf + (16 * j + g) * 128 + (((2 * c) ^ fg) << 4)), A1 = *(const LAS u32x4*)(buf + (16 * j + g) * 128 + (((2 * c + 1) ^ fg) << 4));
                a = __builtin_amdgcn_mfma_f32_16x16x32_fp8_fp8(mk64(A0.x, A0.y), qf[0], a, 0, 0, 0); a = __builtin_amdgcn_mfma_f32_16x16x32_fp8_fp8(mk64(A0.z, A0.w), qf[1], a, 0, 0, 0);
                a = __builtin_amdgcn_mfma_f32_16x16x32_fp8_fp8(mk64(A1.x, A1.y), qf[2], a, 0, 0, 0); a = __builtin_amdgcn_mfma_f32_16x16x32_fp8_fp8(mk64(A1.z, A1.w), qf[3], a, 0, 0, 0);
#pragma unroll
                for (int i = 0; i < 4; ++i) S[2 * kc + j][i] = a[i]; }
            LDS_WAIT();
            if (kc < 4) at_issue(Kb, idl, 32 * (kc + 4), buf, lane); else at_issue(Vb, idl, 32 * (kc - 4), buf, lane);
            if (kc == 4) AT_STAGE_A(tn);
        }
        const int rq = g >> 2;
        float V[4][4];
#pragma unroll
        for (int kk = 0; kk < 4; ++kk)
#pragma unroll
            for (int i = 0; i < 4; ++i) { int v = __builtin_bit_cast(int, S[kk][i]);
                v = __builtin_amdgcn_update_dpp(v, __builtin_bit_cast(int, S[4 + kk][i]), 0x114, 0xf, 0x2, false);
                v = __builtin_amdgcn_update_dpp(v, __builtin_bit_cast(int, S[8 + kk][i]), 0x118, 0xf, 0x4, false);
                v = __builtin_amdgcn_update_dpp(v, __builtin_bit_cast(int, S[12 + kk][i]), 0x11c, 0xf, 0x8, false);
                V[kk][i] = __builtin_bit_cast(float, v); }
        float mx = -INFINITY; const int nvc = nv - 4 * c - 64 * rq;
#pragma unroll
        for (int kk = 0; kk < 4; ++kk) { const u32x2 iw = *(const LAS u32x2*)(idl + 64 * rq + 16 * kk + 4 * c);
            const int ki[4] = {(int)(iw.x & 0xFFFFu), (int)(iw.x >> 16), (int)(iw.y & 0xFFFFu), (int)(iw.y >> 16)};
#pragma unroll
            for (int i = 0; i < 4; ++i) { int dist = t - ki[i]; dist = dist < 0 ? 0 : (dist > 128 ? 128 : dist);
                const float sv = V[kk][i] * 0.08838834764831845f + tab[dist * 8 + 4 * n + gq];
                const float s = (16 * kk + i) < nvc ? sv : -INFINITY; V[kk][i] = s; mx = fmaxf(mx, s); } }
        mx = fmaxf(mx, __builtin_bit_cast(float, __builtin_amdgcn_update_dpp(0, __builtin_bit_cast(int, mx), 0x124, 0xf, 0xf, false)));
        mx = fmaxf(mx, __builtin_bit_cast(float, __builtin_amdgcn_update_dpp(0, __builtin_bit_cast(int, mx), 0x128, 0xf, 0xf, false)));
        mx = fmaxf(mx, __shfl_xor(mx, 16)); mx = fmaxf(mx, __shfl_xor(mx, 32));
        float sum = 0.f; unsigned Pq[4];
#pragma unroll
        for (int kk = 0; kk < 4; ++kk) { float p[4];
#pragma unroll
            for (int i = 0; i < 4; ++i) { p[i] = __builtin_amdgcn_exp2f((V[kk][i] - mx) * 1.4426950408889634f); sum += p[i]; }
            Pq[kk] = pk4_fp8(p[0] * 256.0f, p[1] * 256.0f, p[2] * 256.0f, p[3] * 256.0f); }
        sum += __builtin_bit_cast(float, __builtin_amdgcn_update_dpp(0, __builtin_bit_cast(int, sum), 0x124, 0xf, 0xf, false));
        sum += __builtin_bit_cast(float, __builtin_amdgcn_update_dpp(0, __builtin_bit_cast(int, sum), 0x128, 0xf, 0xf, false));
        sum += __shfl_xor(sum, 16); sum += __shfl_xor(sum, 32);
        unsigned P8[16];
#pragma unroll
        for (int kk = 0; kk < 4; ++kk) { P8[kk] = Pq[kk];
            P8[4 + kk] = (unsigned)__builtin_amdgcn_update_dpp(0, (int)Pq[kk], 0x104, 0xf, 0xf, true);
            P8[8 + kk] = (unsigned)__builtin_amdgcn_update_dpp(0, (int)Pq[kk], 0x108, 0xf, 0xf, true);
            P8[12 + kk] = (unsigned)__builtin_amdgcn_update_dpp(0, (int)Pq[kk], 0x10c, 0xf, 0xf, true); }
        long qfn[4]; int nvn;
        AT_STAGE_B(idln, qfn, nvn);
        f32x4 oe[4], oo[4];
#pragma unroll
        for (int dt = 0; dt < 4; ++dt) { oe[dt] = (f32x4){0.f, 0.f, 0.f, 0.f}; oo[dt] = (f32x4){0.f, 0.f, 0.f, 0.f}; }
#pragma unroll
        for (int vc = 0; vc < 8; ++vc) {
            LAS unsigned char* buf = ring + (vc & 3) * AT_CH;
            if (vc == 0) AT_WAITN(18); else AT_WAITN(12);
            const long pf = mk64(P8[2 * vc], P8[2 * vc + 1]);
            u32x2 t0[4], t1[4];
            const unsigned ba = (unsigned)(size_t)buf;
#pragma unroll
            for (int dt = 0; dt < 4; ++dt) { const unsigned ad = ba + (unsigned)(rowA * 128 + (((2 * dt + (p4 >> 1)) ^ fr) << 4) + 8 * (p4 & 1));
                asm volatile("ds_read_b64_tr_b16 %0, %1" : "=&v"(t0[dt]) : "v"(ad) : "memory");
                asm volatile("ds_read_b64_tr_b16 %0, %1 offset:2048" : "=&v"(t1[dt]) : "v"(ad) : "memory"); }
            asm volatile("s_waitcnt lgkmcnt(0)" : "+v"(t0[0]), "+v"(t0[1]), "+v"(t0[2]), "+v"(t0[3]), "+v"(t1[0]), "+v"(t1[1]), "+v"(t1[2]), "+v"(t1[3]) :: "memory");
#pragma unroll
            for (int dt = 0; dt < 4; ++dt) {
                const long be = mk64(__builtin_amdgcn_perm(t0[dt].y, t0[dt].x, 0x06040200u), __builtin_amdgcn_perm(t1[dt].y, t1[dt].x, 0x06040200u));
                const long bo = mk64(__builtin_amdgcn_perm(t0[dt].y, t0[dt].x, 0x07050301u), __builtin_amdgcn_perm(t1[dt].y, t1[dt].x, 0x07050301u));
                oe[dt] = __builtin_amdgcn_mfma_f32_16x16x32_fp8_fp8(pf, be, oe[dt], 0, 0, 0); oo[dt] = __builtin_amdgcn_mfma_f32_16x16x32_fp8_fp8(pf, bo, oo[dt], 0, 0, 0); }
            if (vc < 4) at_issue(Vb, idl, 32 * (vc + 4), buf, lane); else at_issue(Kb, idln, 32 * (vc - 4), buf, lane);
        }
        float inv[4];
#pragma unroll
        for (int i = 0; i < 4; ++i) inv[i] = 1.0f / (256.0f * __shfl(sum, i));
        h16* Qo = Qb + (size_t)t * DM;
        LAS unsigned char* st = (LAS unsigned char*)(idlb + (k & 1) * 256);
#pragma unroll
        for (int hp = 0; hp < 2; ++hp) {
            if (c == 0) {
#pragma unroll
                for (int dt = 0; dt < 4; ++dt)
#pragma unroll
                    for (int i2 = 0; i2 < 2; ++i2) *(LAS unsigned*)(st + (i2 * 128 + 32 * dt + 2 * g) * 2) = pkh(oe[dt][2 * hp + i2] * inv[2 * hp + i2], oo[dt][2 * hp + i2] * inv[2 * hp + i2]);
            }
            LDS_WAIT();
            if (lane < 32) { const u32x4 ow = *(const LAS u32x4*)(st + lane * 16); if (!C.dry) *(u32x4*)(Qo + hp * 256 + lane * 8) = ow; }
            LDS_WAIT();
        }
#pragma unroll
        for (int ks = 0; ks < 4; ++ks) qf[ks] = qfn[ks];
        nv = nvn;
    }
    AT_WAITN(0);
#undef AT_STAGE_A
#undef AT_STAGE_B
}

__device__ __forceinline__ void act_phase(const Ctx& C, int gtid, int gthreads) {
    const h16* G = (const h16*)(C.ws + WS_UPG); h16* V = (h16*)(C.ws + WS_UPV);
    constexpr int NCG = DFF / 8, NITEM = (MTOK / 16) * NCG;
    for (int it = gtid; it < NITEM; it += gthreads) {
        const int cg = it % NCG, rb = it / NCG, c0 = cg * 8, r0 = rb * 16;
        float w[3][8], bb[8];
#pragma unroll
        for (int j = 0; j < 3; ++j) { const f32x4 a = *(const f32x4*)(C.fcw + j * DFF + c0), b2 = *(const f32x4*)(C.fcw + j * DFF + c0 + 4); for (int e = 0; e < 4; ++e) { w[j][e] = a[e]; w[j][4 + e] = b2[e]; } }
        { const f32x4 a = *(const f32x4*)(C.fcb + c0), b2 = *(const f32x4*)(C.fcb + c0 + 4); for (int e = 0; e < 4; ++e) { bb[e] = a[e]; bb[4 + e] = b2[e]; } }
        h8 gm2, gm1;
        const int tseq = r0 & (SEQ - 1);
        if (tseq >= 2) { gm2 = *(const h8*)(G + (size_t)(r0 - 2) * DFF + c0); gm1 = *(const h8*)(G + (size_t)(r0 - 1) * DFF + c0); }
        else { for (int e = 0; e < 8; ++e) { gm2[e] = (h16)0.f; gm1[e] = (h16)0.f; } }
#pragma unroll 4
        for (int r = 0; r < 16; ++r) { const size_t off = (size_t)(r0 + r) * DFF + c0;
            const h8 g0 = *(const h8*)(G + off), vv = *(const h8*)(V + off);
            float y[8];
#pragma unroll
            for (int e = 0; e < 8; ++e) { const float gf = bb[e] + w[0][e] * (float)gm2[e] + w[1][e] * (float)gm1[e] + w[2][e] * (float)g0[e]; y[e] = gelu_tanh(gf) * (float)vv[e]; }
            u32x4 o; o.x = pkh(y[0], y[1]); o.y = pkh(y[2], y[3]); o.z = pkh(y[4], y[5]); o.w = pkh(y[6], y[7]);
            if (!C.dry) *(u32x4*)(V + off) = o; gm2 = gm1; gm1 = g0; }
    }
}

__device__ __forceinline__ void p0_prologue(const Params& P, LAS unsigned char* lds) {
    const int tid = threadIdx.x, lane = tid & 63, wv = tid >> 6;
    LAS float* scr = (LAS float*)(lds + wv * 16384);
    const int gw = blockIdx.x * NWAVES + wv, NGW = gridDim.x * NWAVES;
    unsigned char* ws = P.ws;
    const float* w_in = P.in[3];
    constexpr int I_IN = 16 * 195;
    for (int it = gw; it < I_IN + 16 * 8; it += NGW) {
        if (it < I_IN) { p0_transpose_item<1>(w_in, DM, NIN, (h16*)(ws + W_IN), nullptr, scr, it, lane); continue; }
        const int r = it - I_IN, blk = r / 16, rr = r % 16, which = rr / 8, it2 = rr % 8;
        p0_transpose_item<0>((which ? P.in[8] : P.in[6]) + (size_t)blk * 128 * 128, 128, 128, (h16*)(ws + W_GATE) + (size_t)blk * 256 * 128 + (size_t)which * 128 * 128, nullptr, scr, it2, lane); }
    { u32x4* z = (u32x4*)((h16*)(ws + W_IN) + (size_t)4168 * DM); const int nz = 184 * DM * 2 / 16;
      for (int i = blockIdx.x * NTHR + tid; i < nz; i += gridDim.x * NTHR) z[i] = (u32x4){0u, 0u, 0u, 0u}; }
    { const float* x = P.in[0]; const float* gn = P.in[2]; h16* A0 = (h16*)(ws + WS_A0);
      f32x4 gv[4];
#pragma unroll
      for (int j = 0; j < 4; ++j) gv[j] = *(const f32x4*)(gn + 4 * lane + 256 * j);
      f32x4 nv[4];
      if (gw < MTOK) { const f32x4* xr = (const f32x4*)(x + (size_t)gw * DM) + lane;
#pragma unroll
          for (int j = 0; j < 4; ++j) nv[j] = xr[64 * j]; }
      for (int m = gw; m < MTOK; m += NGW) { f32x4 v[4]; float s = 0.f;
#pragma unroll
          for (int j = 0; j < 4; ++j) v[j] = nv[j];
          { const int mn = m + NGW < MTOK ? m + NGW : m; const f32x4* xr = (const f32x4*)(x + (size_t)mn * DM) + lane;
#pragma unroll
            for (int j = 0; j < 4; ++j) nv[j] = xr[64 * j]; }
#pragma unroll
          for (int j = 0; j < 4; ++j) s += (v[j].x * v[j].x + v[j].y * v[j].y) + (v[j].z * v[j].z + v[j].w * v[j].w);
          const float rs = __builtin_amdgcn_rsqf(wave_sum(s) * (1.0f / DM) + EPS);
          u32x2* o8 = (u32x2*)(A0 + (size_t)m * DM) + lane;
#pragma unroll
          for (int j = 0; j < 4; ++j) { u32x2 w; w.x = pkh(v[j].x * rs * gv[j].x, v[j].y * rs * gv[j].y); w.y = pkh(v[j].z * rs * gv[j].z, v[j].w * rs * gv[j].w); o8[64 * j] = w; } } }
}
constexpr int PD_SQ = 16 * 32, PD_UP = 16 * 192, PD_DN = 48 * 32, PD_PP = 4 * 32, PD_NTR = 4 * PD_SQ + PD_UP + PD_DN + PD_PP, PD_NT = PD_NTR / 32, PD_NP = MTOK * PLE / 4 / 8192;
static_assert(PD_NTR % 32 == 0, "deferred transposes");
__device__ __forceinline__ void p0_deferred_item(const Params& P, LAS unsigned char* lds, int item) {
    int tid = threadIdx.x; asm volatile("" : "+v"(tid));
    const int lane = tid & 63, wv = tid >> 6;
    unsigned char* ws = P.ws;
    if (item >= PD_NT) { const f32x4* p4 = (const f32x4*)P.in[1] + (size_t)(item - PD_NT) * 8192; u32x2* o = (u32x2*)(ws + WS_PH) + (size_t)(item - PD_NT) * 8192;
#pragma unroll 4
        for (int i = tid; i < 8192; i += NTHR) { const f32x4 v = p4[i]; u32x2 w; w.x = pkh(v.x, v.y); w.y = pkh(v.z, v.w); o[i] = w; }
        return; }
    LAS float* scr = (LAS float*)(lds + wv * 16384);
    const float *w_lru = P.in[14], *w_att = P.in[15], *w_out = P.in[16], *w_up = P.in[18], *w_down = P.in[21], *w_pg = P.in[23], *w_pp = P.in[24];
    for (int k = 0; k < 4; ++k) {
        int r = item * 32 + wv * 4 + k;
        if (r < PD_SQ) { p0_transpose_item<0>(w_lru, DM, DM, (h16*)(ws + W_LRU), nullptr, scr, r, lane); continue; } r -= PD_SQ;
        if (r < PD_SQ) { p0_transpose_item<0>(w_att, DM, DM, (h16*)(ws + W_ATT), nullptr, scr, r, lane); continue; } r -= PD_SQ;
        if (r < PD_SQ) { p0_transpose_item<0>(w_out, DM, DM, (h16*)(ws + W_OUT), nullptr, scr, r, lane); continue; } r -= PD_SQ;
        if (r < PD_SQ) { p0_transpose_item<0>(w_pg, DM, DM, (h16*)(ws + W_PG), P.in[22], scr, r, lane); continue; } r -= PD_SQ;
        if (r < PD_UP) { p0_transpose_item<2>(w_up, DM, 2 * DFF, (h16*)(ws + W_UP), P.in[17], scr, r, lane); continue; } r -= PD_UP;
        if (r < PD_DN) { p0_transpose_item<0>(w_down, DFF, DM, (h16*)(ws + W_DOWN), nullptr, scr, r, lane); continue; } r -= PD_DN;
        p0_transpose_item<0>(w_pp, PLE, DM, (h16*)(ws + W_PP), nullptr, scr, r, lane);
    }
}

__device__ __forceinline__ int next_unit(unsigned* head, volatile LAS unsigned* slot) {
    __syncthreads();
    if (threadIdx.x == 0) *slot = __hip_atomic_fetch_add(head, 1u, __ATOMIC_RELAXED, __HIP_MEMORY_SCOPE_AGENT);
    __syncthreads();
    return (int)*slot;
}

constexpr int NPHASE = 10;
__global__ void __launch_bounds__(NTHR, 2) fwd(Params P) {
    extern __shared__ __attribute__((aligned(16))) unsigned char lds_raw[];
    LAS unsigned char* lds = (LAS unsigned char*)lds_raw;
    volatile LAS unsigned* MISC = (volatile LAS unsigned*)(lds + MISC_OFF);
    const int tid = threadIdx.x;
    if (tid < 64) MISC[tid] = 0u;
    __syncthreads();
    unsigned char* ws = P.ws;
    unsigned* ctl = (unsigned*)(ws + WS_CTL);
    const int lo = P.ph_lo, hi = P.ph_hi;
    XcdBarrier bar; bar.bar = ctl + CW_BAR; bar.x = 0; bar.st = MISC;
    if (hi - lo > 1) bar = xcd_barrier_post(ctl + CW_BAR, MISC);
    const int dry = P.pad;
    Ctx C; C.ws = ws; C.out = P.out; C.dry = dry; C.conv_w = P.in[4]; C.conv_b = P.in[5]; C.ba = P.in[7]; C.bx = P.in[9]; C.lam = P.in[10]; C.qn = P.in[11]; C.kn = P.in[12]; C.relb = P.in[13]; C.fcw = P.in[19]; C.fcb = P.in[20];
    float* SSQ1 = (float*)(ws + CTL_SSQ1); float* SSQ2 = (float*)(ws + CTL_SSQ2);
#ifdef ONLY_PHASE
#define IN(k) ((k) == ONLY_PHASE)
#else
#define IN(k) (lo <= (k) && (k) < hi)
#endif
#define SEAM(k) do { if (IN(k) && IN((k) + 1)) xcd_barrier(bar); } while (0)

    if (IN(0)) { p0_prologue(P, lds); } SEAM(0);

    if (IN(1)) {
        pg8::Gemm g{(const h16*)(ws + WS_A0), (const h16*)(ws + W_IN), MTOK, NIN_PAD, DM}; pg8::StaticOrder S; S.init(MTOK, NIN_PAD, gridDim.x, blockIdx.x);
        EpiIn E{(h16*)(ws + WS_LX), (h16*)(ws + WS_GG), (h16*)(ws + WS_Q), (h16*)(ws + WS_K), (h16*)(ws + WS_V), (h16*)(ws + WS_QI), (h16*)(ws + WS_KI), (h16*)(ws + WS_SGA), (h16*)(ws + WS_SGB), (float*)(ws + WS_WI), dry};
        pg8::gemm_phase<EpiIn>(lds, g, S, E);
    } SEAM(1);

    if (IN(2)) {
        constexpr int N_IX = NB * (SEQ / 16), N_L1 = NB * 64 * 8 / 4, N_KN = MTOK / 128 / 4, N_PD = PD_NT + PD_NP, N_SM = N_KN + N_PD, N_BIG = N_L1 + N_IX, N_ALL = N_BIG + N_SM;
        static_assert(N_BIG >= 4 * N_SM, "interleave");
        unsigned* head = ctl + CW_Q2 + 128 * dry;
        int u = next_unit(head, MISC + 4);
        for (int it = 0; u < N_ALL; ++it) {
            unsigned nxt = 0u;
            if (tid == 0) nxt = __hip_atomic_fetch_add(head, 1u, __ATOMIC_RELAXED, __HIP_MEMORY_SCOPE_AGENT);
            int kind, idx;
            { int big = -1, sm = -1;
              if (u < 5 * N_SM) { if (u % 5 == 4) sm = u / 5; else big = 4 * (u / 5) + u % 5; } else big = u - N_SM;
              if (big >= 0) { if (big < N_L1) { kind = 1; idx = big; } else { kind = 0; idx = big - N_L1; } }
              else { if (sm < N_KN) { kind = 2; idx = sm; } else { kind = 3; idx = sm - N_KN; } } }
#ifdef PROBE_P2_KIND
            if (!(dry && kind != PROBE_P2_KIND))
#endif
            {
            if (kind == 0) indexer_unit(C, lds, idx);
            else if (kind == 1) lru1_item(C, lds, idx);
            else if (kind == 2) { for (int k = 0; k < 4; ++k) knorm_unit(C, idx * 4 + k); }
            else p0_deferred_item(P, lds, idx);
            }
            if (tid == 0) MISC[6 + (it & 1)] = nxt;
            __syncthreads();
            u = (int)MISC[6 + (it & 1)];
        }
    } SEAM(2);

    if (IN(3)) {
        constexpr int N_AQ = SEQ / (8 * AT_QPW), N_L2 = NB * 64 * 8 / 4;
        attn_build_tab(C, lds);
        unsigned* qh = ctl + CW_Q3 + 2048 * dry;
        if (tid == 0) MISC[5] = 0u;
        for (;;) {
            __syncthreads();
            if (tid == 0) { const unsigned x = xb_xcc_id() & 7u; unsigned k = MISC[5]; int u = -1;
                for (; k < 8u; ++k) { const unsigned q = (x + k) & 7u; const unsigned v = __hip_atomic_fetch_add(qh + 64 * q, 1u, __ATOMIC_RELAXED, __HIP_MEMORY_SCOPE_AGENT); if (v < (unsigned)N_AQ) { u = (int)(q * N_AQ + v); break; } }
                MISC[5] = k;
                if (u < 0) { const unsigned v = __hip_atomic_fetch_add(qh + 64 * 8, 1u, __ATOMIC_RELAXED, __HIP_MEMORY_SCOPE_AGENT); u = v < (unsigned)N_L2 ? (int)(8 * N_AQ + v) : -1; }
                MISC[4] = (unsigned)u; }
            __syncthreads();
            const int u = (int)MISC[4];
            if (u < 0) break;
            if (u < 8 * N_AQ) attn_item(C, lds, u);
            else lru2_item(C, lds + AT_END, u - 8 * N_AQ);
        }
    } SEAM(3);

    if (IN(4)) {
        pg8::StaticOrder S; S.init(MTOK, DM, gridDim.x, blockIdx.x);
        { pg8::Gemm g{(const h16*)(ws + WS_LX), (const h16*)(ws + W_LRU), MTOK, DM, DM}; EpiMerge<0> E{(const h16*)(ws + WS_SGA), (h16*)(ws + WS_T1), nullptr, dry}; pg8::gemm_phase<EpiMerge<0>>(lds, g, S, E); }
        { pg8::Gemm g{(const h16*)(ws + WS_Q), (const h16*)(ws + W_ATT), MTOK, DM, DM}; EpiMerge<1> E{(const h16*)(ws + WS_SGB), (h16*)(ws + WS_T1), (h16*)(ws + WS_GG), dry}; pg8::gemm_phase<EpiMerge<1>>(lds, g, S, E); }
    } SEAM(4);

    if (IN(5)) {
        pg8::Gemm g{(const h16*)(ws + WS_GG), (const h16*)(ws + W_OUT), MTOK, DM, DM}; pg8::StaticOrder S; S.init(MTOK, DM, gridDim.x, blockIdx.x);
        EpiResid<true> E{P.in[0], nullptr, (h16*)(ws + WS_X1H), SSQ1, dry}; pg8::gemm_phase<EpiResid<true>>(lds, g, S, E);
    } SEAM(5);

    if (IN(6)) {
        pg8::Gemm g{(const h16*)(ws + WS_X1H), (const h16*)(ws + W_UP), MTOK, 2 * DFF, DM}; pg8::StaticOrder S; S.init(MTOK, 2 * DFF, gridDim.x, blockIdx.x);
        EpiUpAct E{SSQ1, (h16*)(ws + WS_UPV), (float*)(ws + WS_UPG), (float*)(ws + WS_UPG + 4 * MiB), (float*)(ws + WS_UPG + 8 * MiB), C.fcw, C.fcb, lds + pg8::STAGE_BYTES, dry}; pg8::gemm_phase<EpiUpAct>(lds, g, S, E);
    } SEAM(6);


    if (IN(8)) {
        pg8::Gemm g{(const h16*)(ws + WS_UPV), (const h16*)(ws + W_DOWN), MTOK, DM, DFF}; pg8::StaticOrder S; S.init(MTOK, DM, gridDim.x, blockIdx.x);
        {
#pragma unroll
          for (int i = 0; i < 2; ++i) { pg8::Unit uu; if (S.next(i, uu)) act_fix_tile((const float*)(ws + WS_UPG), (const float*)(ws + WS_UPG + 4 * MiB), (const float*)(ws + WS_UPG + 8 * MiB), C.fcw, C.fcb, (h16*)(ws + WS_UPV), uu.pm, tid, dry); }
          static_assert((MTOK / 256) * (DM / 256) == 2 * 256, "two units per workgroup on a 256-workgroup grid");
          VM_WAIT(); __syncthreads(); }
        EpiResid<false> E{nullptr, (const h16*)(ws + WS_X1H), (h16*)(ws + WS_X2H), SSQ2, dry}; pg8::gemm_phase<EpiResid<false>>(lds, g, S, E);
    } SEAM(8);

    if (IN(9)) {
        pg8::StaticOrder S; S.init(MTOK, DM, gridDim.x, blockIdx.x);
        { pg8::Gemm g{(const h16*)(ws + WS_X2H), (const h16*)(ws + W_PG), MTOK, DM, DM}; EpiGateSig E{SSQ2, (h16*)(ws + WS_GS), dry}; pg8::gemm_phase<EpiGateSig>(lds, g, S, E); }
        { pg8::Gemm g{(const h16*)(ws + WS_PH), (const h16*)(ws + W_PP), MTOK, DM, P.k_ple}; EpiPleOut E{(const h16*)(ws + WS_GS), (const h16*)(ws + WS_X2H), P.out, dry}; pg8::gemm_phase<EpiPleOut>(lds, g, S, E); }
    }
#undef IN
#undef SEAM
}

#ifndef N_LAUNCHES
#define N_LAUNCHES 1
#endif
extern "C" void kernel_launch(void* const* d_in, const int* in_sizes, int n_in, void* d_out, int out_size, void* d_ws, size_t ws_size, hipStream_t stream) {
    static int grid = 0;
    if (grid == 0) {
        if (n_in != 25 || out_size != MTOK * DM || ws_size < WS_END) { fprintf(stderr, "kernel_launch: unexpected shapes (n_in %d out %d ws %zu)\n", n_in, out_size, ws_size); grid = -1; return; }
        int dev = 0, cus = 0, per_cu = 0;
        hipGetDevice(&dev); hipDeviceGetAttribute(&cus, hipDeviceAttributeMultiprocessorCount, dev);
        if (hipFuncSetAttribute((const void*)fwd, hipFuncAttributeMaxDynamicSharedMemorySize, LDS_BYTES) != hipSuccess) { fprintf(stderr, "kernel_launch: hipFuncSetAttribute failed\n"); grid = -1; return; }
        if (hipOccupancyMaxActiveBlocksPerMultiprocessor(&per_cu, (const void*)fwd, NTHR, LDS_BYTES) != hipSuccess || per_cu < 1) { fprintf(stderr, "kernel_launch: occupancy query says %d\n", per_cu); }
        (void)hipGetLastError();
        grid = cus > 0 ? cus : 256;
    }
    if (grid < 0) return;
    hipMemsetAsync((char*)d_ws + WS_CTL, 0, CTL_ZERO_BYTES, stream);
    Params p{};
    for (int i = 0; i < 25; ++i) p.in[i] = (const float*)d_in[i];
    p.out = (float*)d_out; p.ws = (unsigned char*)d_ws; p.k_ple = PLE; p.pad = 0;
    if (N_LAUNCHES == 1) { p.ph_lo = 0; p.ph_hi = NPHASE; hipLaunchKernelGGL(fwd, dim3(grid), dim3(NTHR), LDS_BYTES, stream, p); }
    else for (int ph = 0; ph < NPHASE; ++ph) { p.ph_lo = ph; p.ph_hi = ph + 1;
#ifdef PROBE_MASK
        if ((PROBE_MASK >> ph) & 1) { p.pad = 1; hipLaunchKernelGGL(fwd, dim3(grid), dim3(NTHR), LDS_BYTES, stream, p); p.pad = 0; }
#endif
        hipLaunchKernelGGL(fwd, dim3(grid), dim3(NTHR), LDS_BYTES, stream, p); }
}
```
